# Optimizing an MI355X kernel written in HIP

```python
import math
import jax, jax.numpy as jnp
from jax import lax
import numpy as np

D_MODEL = 1024
BATCH = 8
SEQ = 4096
DEPTH = 2

HEAD_DIM = 64
RWKV_HEADS = 8
ATTN_HEADS = 8
RWKV_WIDTH = RWKV_HEADS * HEAD_DIM
ATTN_WIDTH = ATTN_HEADS * HEAD_DIM
MIX_WIDTH = RWKV_WIDTH + ATTN_WIDTH
IDX_HEADS = 8
IDX_DIM = 64
TOPK_MAX = 256
QUERY_BLOCK = 128
DECAY_LORA = 64
ICLR_LORA = 64
VRES_LORA = 32
GATE_LORA = 128
D_FF = 4 * D_MODEL
N_BUCKETS = 32
MAX_DISTANCE = 128
RMS_EPS = 1e-6
LNX_EPS = 64e-5
IN_COLS = 3 * RWKV_WIDTH + 3 * ATTN_WIDTH + IDX_HEADS * IDX_DIM + IDX_DIM + IDX_HEADS

kernel_name = "hymba_rwkv7_dsa_adaln_trunk"


def rmsnorm(x, g):
    xf = x.astype(jnp.float32)
    y = xf * lax.rsqrt(jnp.mean(xf * xf, axis=-1, keepdims=True) + RMS_EPS)
    return (y * g.astype(jnp.float32)).astype(x.dtype)


def token_shift(z):
    return jnp.pad(z[:, :-1], ((0, 0), (1, 0), (0, 0)))


def split_heads(z, n):
    return z.reshape(*z.shape[:-1], n, z.shape[-1] // n)


def t5_bucket(dist):
    max_exact = N_BUCKETS // 2
    n = jnp.maximum(dist, 0)
    nf = jnp.maximum(n, 1).astype(jnp.float32)
    large = max_exact + (jnp.log(nf / max_exact) / math.log(MAX_DISTANCE / max_exact)
                         * (N_BUCKETS - max_exact)).astype(jnp.int32)
    large = jnp.minimum(large, N_BUCKETS - 1)
    return jnp.where(n < max_exact, n, large)


def rwkv7_recurrence(r, decay, k, v, kk, a):
    B, T, H, N = r.shape

    def step(S, inp):
        r_t, w_t, k_t, v_t, kk_t, a_t = inp
        s_kk = jnp.einsum('bhvk,bhk->bhv', S, kk_t)
        S = (S * w_t[:, :, None, :]
             - s_kk[..., None] * (kk_t * a_t)[:, :, None, :]
             + v_t[..., None] * k_t[:, :, None, :])
        return S, jnp.einsum('bhvk,bhk->bhv', S, r_t)

    xs = tuple(jnp.moveaxis(z.astype(jnp.float32), 1, 0) for z in (r, decay, k, v, kk, a))
    s0 = jnp.zeros((B, H, N, N), jnp.float32)
    _, ys = lax.scan(step, s0, xs)
    return jnp.moveaxis(ys, 0, 1)


def rwkv7_group(h, rkv, v_first, mu_rkv, mu_lora, decay_w0, decay_a, decay_b, iclr_a0, iclr_a,
                iclr_b, gate_a, gate_b, k_k, k_a, r_k, lnx_g, lnx_b, vres):
    B, T, _ = h.shape
    f32 = jnp.float32
    rkv = rkv + (token_shift(rkv) - rkv) * mu_rkv.reshape(-1)
    r, k, v = jnp.split(rkv, 3, axis=-1)
    dx = token_shift(h) - h
    xw = h + dx * mu_lora[0]
    xa = h + dx * mu_lora[1]
    xg = h + dx * mu_lora[2]
    wlog = (decay_w0 + jnp.tanh(xw @ decay_a) @ decay_b).astype(f32)
    wlog = -jax.nn.softplus(-wlog) - 0.5
    decay = jnp.exp(-jnp.exp(wlog))
    a = jax.nn.sigmoid(iclr_a0 + (xa @ iclr_a) @ iclr_b)
    g = jax.nn.sigmoid(xg @ gate_a) @ gate_b
    kk = split_heads(k * k_k, RWKV_HEADS).astype(f32)
    kk = kk / jnp.maximum(jnp.sqrt(jnp.sum(kk * kk, axis=-1, keepdims=True)), 1e-12)
    k = k * (1.0 + (a - 1.0) * k_a)
    if vres is None:
        v_first = v
    else:
        mu_v, v0, v_a, v_b = vres
        xv = h + dx * mu_v
        v = v + (v_first - v) * jax.nn.sigmoid(v0 + (xv @ v_a) @ v_b)
    rh = split_heads(r, RWKV_HEADS).astype(f32)
    kh = split_heads(k, RWKV_HEADS).astype(f32)
    vh = split_heads(v, RWKV_HEADS).astype(f32)
    ah = split_heads(a, RWKV_HEADS).astype(f32)
    y = rwkv7_recurrence(rh, split_heads(decay, RWKV_HEADS), kh, vh, kk, ah)
    mean = jnp.mean(y, axis=-1, keepdims=True)
    var = jnp.mean((y - mean) ** 2, axis=-1, keepdims=True)
    yn = ((y - mean) * lax.rsqrt(var + LNX_EPS) * lnx_g.reshape(RWKV_HEADS, HEAD_DIM).astype(f32)
          + lnx_b.reshape(RWKV_HEADS, HEAD_DIM).astype(f32))
    bonus = jnp.sum(rh * kh * r_k.astype(f32), axis=-1, keepdims=True) * vh
    out = (yn + bonus).reshape(B, T, RWKV_WIDTH) * g.astype(f32)
    return out.astype(h.dtype), v_first


def dsa_attention(q, k, v, qi, ki, wi, rel_bias):
    B, T, H, Dh = q.shape
    L = k.shape[1]
    n_sel = min(TOPK_MAX, L // 4)
    nb = T // QUERY_BLOCK
    key_pos = jnp.arange(L, dtype=jnp.int32)
    kif = ki.astype(jnp.float32)

    def blocks(z):
        return jnp.moveaxis(z.reshape(B, nb, QUERY_BLOCK, *z.shape[2:]), 1, 0)

    def one_block(args):
        start, q_b, qi_b, wi_b = args
        q_pos = start + jnp.arange(QUERY_BLOCK, dtype=jnp.int32)
        dots = jnp.einsum('bqhd,bsd->bqhs', qi_b.astype(jnp.float32), kif) * (IDX_DIM ** -0.5)
        w_b = wi_b.astype(jnp.float32) * (IDX_HEADS ** -0.5)
        score = jnp.einsum('bqh,bqhs->bqs', w_b, jax.nn.relu(dots))
        admissible = key_pos[None, :] <= q_pos[:, None]
        score = jnp.where(admissible[None], score, -jnp.inf)
        _, idx = lax.top_k(score, n_sel)
        valid = idx <= q_pos[None, :, None]
        k_sel = jax.vmap(lambda kb, ib: kb[ib])(k, idx)
        v_sel = jax.vmap(lambda vb, ib: vb[ib])(v, idx)
        logits = jnp.einsum('bqhd,bqkhd->bqhk', q_b, k_sel).astype(jnp.float32) * (Dh ** -0.5)
        bias = rel_bias[t5_bucket(q_pos[None, :, None] - idx)]
        logits = logits + jnp.moveaxis(bias, -1, 2).astype(jnp.float32)
        logits = jnp.where(valid[:, :, None, :], logits, -jnp.inf)
        p = jax.nn.softmax(logits, axis=-1)
        return jnp.einsum('bqhk,bqkhd->bqhd', p.astype(v.dtype), v_sel)

    starts = jnp.arange(nb, dtype=jnp.int32) * QUERY_BLOCK
    out = lax.map(one_block, (starts, blocks(q), blocks(qi), blocks(wi)))
    return jnp.moveaxis(out, 0, 1).reshape(B, T, H, Dh)


def setup_inputs(seed: int = 0) -> dict:
    key = jax.random.key(seed)
    ks = iter(jax.random.split(key, 40))
    nrm = lambda shape, scale: jax.random.normal(next(ks), shape, jnp.float32) * scale
    uni = lambda shape, lo, hi: jax.random.uniform(next(ks), shape, jnp.float32, lo, hi)
    L, D, R, A = DEPTH, D_MODEL, RWKV_WIDTH, ATTN_WIDTH
    return {
        "x": nrm((BATCH, SEQ, D), 1.0),
        "c": nrm((BATCH, D), 1.0),
        "w_ada": nrm((L, D, 6 * D), 0.5 * D ** -0.5),
        "b_ada": nrm((L, 6 * D), 0.01),
        "norm1_g": 1.0 + nrm((L, D), 0.02),
        "norm2_g": 1.0 + nrm((L, D), 0.02),
        "w_in": nrm((L, D, IN_COLS), D ** -0.5),
        "mu_rkv": uni((L, 3, R), 0.0, 1.0),
        "mu_lora": uni((L, 3, D), 0.0, 1.0),
        "decay_w0": uni((L, R), -4.0, -0.5),
        "decay_a": nrm((L, D, DECAY_LORA), D ** -0.5),
        "decay_b": nrm((L, DECAY_LORA, R), 0.1 * DECAY_LORA ** -0.5),
        "iclr_a0": nrm((L, R), 0.1),
        "iclr_a": nrm((L, D, ICLR_LORA), D ** -0.5),
        "iclr_b": nrm((L, ICLR_LORA, R), 0.3 * ICLR_LORA ** -0.5),
        "gate_a": nrm((L, D, GATE_LORA), D ** -0.5),
        "gate_b": nrm((L, GATE_LORA, R), GATE_LORA ** -0.5),
        "k_k": 0.85 + nrm((L, R), 0.05),
        "k_a": 1.0 + nrm((L, R), 0.05),
        "r_k": nrm((L, RWKV_HEADS, HEAD_DIM), 0.1),
        "lnx_g": 1.0 + nrm((L, R), 0.02),
        "lnx_b": nrm((L, R), 0.01),
        "vres_mu": uni((L - 1, D), 0.0, 1.0),
        "vres_v0": nrm((L - 1, R), 0.1),
        "vres_a": nrm((L - 1, D, VRES_LORA), D ** -0.5),
        "vres_b": nrm((L - 1, VRES_LORA, R), 0.3 * VRES_LORA ** -0.5),
        "attn_out_g": 1.0 + nrm((L, A), 0.02),
        "rel_bias": nrm((N_BUCKETS, ATTN_HEADS), 0.5),
        "w_out": nrm((L, MIX_WIDTH, D), MIX_WIDTH ** -0.5),
        "w_mlp1": nrm((L, D, D_FF), D ** -0.5),
        "w_mlp2": nrm((L, D_FF, D), D_FF ** -0.5),
        "final_g": 1.0 + nrm((D,), 0.02),
    }


def reference(x, c, w_ada, b_ada, norm1_g, norm2_g, w_in, mu_rkv, mu_lora, decay_w0, decay_a,
              decay_b, iclr_a0, iclr_a, iclr_b, gate_a, gate_b, k_k, k_a, r_k, lnx_g, lnx_b,
              vres_mu, vres_v0, vres_a, vres_b, attn_out_g, rel_bias, w_out, w_mlp1, w_mlp2,
              final_g):
    B, T, D = x.shape
    R, A = RWKV_WIDTH, ATTN_WIDTH
    cuts = np.cumsum([R, R, R, A, A, A, IDX_HEADS * IDX_DIM, IDX_DIM]).tolist()
    c_act = jax.nn.silu(c)
    v_first = None
    for l in range(DEPTH):
        mod = c_act @ w_ada[l] + b_ada[l]
        sh1, sc1, gt1, sh2, sc2, gt2 = jnp.split(mod, 6, axis=-1)
        h = rmsnorm(x, norm1_g[l]) * (1.0 + sc1[:, None]) + sh1[:, None]
        proj = h @ w_in[l]
        r_p, k_p, v_p, q_a, k_att, v_att, qi, ki, wi = jnp.split(proj, cuts, axis=-1)
        vres = None if l == 0 else (vres_mu[l - 1], vres_v0[l - 1], vres_a[l - 1], vres_b[l - 1])
        rwkv_out, v_first = rwkv7_group(
            h, jnp.concatenate([r_p, k_p, v_p], axis=-1), v_first, mu_rkv[l], mu_lora[l],
            decay_w0[l], decay_a[l], decay_b[l], iclr_a0[l], iclr_a[l], iclr_b[l], gate_a[l],
            gate_b[l], k_k[l], k_a[l], r_k[l], lnx_g[l], lnx_b[l], vres)
        att = dsa_attention(split_heads(q_a, ATTN_HEADS), split_heads(k_att, ATTN_HEADS),
                            split_heads(v_att, ATTN_HEADS), split_heads(qi, IDX_HEADS), ki, wi,
                            rel_bias)
        att = rmsnorm(att, attn_out_g[l].reshape(ATTN_HEADS, HEAD_DIM)).reshape(B, T, A)
        mixed = jnp.concatenate([rwkv_out, att], axis=-1) @ w_out[l]
        x = x + gt1[:, None] * mixed
        h2 = rmsnorm(x, norm2_g[l]) * (1.0 + sc2[:, None]) + sh2[:, None]
        u = jnp.square(jax.nn.relu(h2 @ w_mlp1[l]))
        x = x + gt2[:, None] * (u @ w_mlp2[l])
    return rmsnorm(x, final_g)
```

```cpp
#include <hip/hip_runtime.h>
#include <hip/hip_bf16.h>
#include <cstdio>
#include <cstdint>
#include <cmath>
namespace pg8 {
#define PG8_LAS __attribute__((address_space(3)))
typedef unsigned short bf16_t;
typedef short bf16x8 __attribute__((ext_vector_type(8)));
typedef float f32x4 __attribute__((ext_vector_type(4)));
typedef unsigned u32x4 __attribute__((ext_vector_type(4)));
constexpr int BM = 256, BK = 64, HALF = 128, HTB = HALF * BK * 2  , STAGE_BYTES = 8 * HTB, NXCD = 8, WGM = 8;

__host__ __device__ __forceinline__ int lds_byte(int r, int c) { const int st = (r >> 4) * 2 + (c >> 5), rr = r & 15, cc = c & 31, ob = rr * 64 + cc * 2; return st * 1024 + (ob ^ (((ob >> 9) & 1) << 5)); }
__host__ __device__ __forceinline__ void stage_rc(int b, int& R, int& C) { const int st = b / 1024, sb = b % 1024, swz = sb ^ (((sb >> 9) & 1) << 5); R = (st >> 1) * 16 + swz / 64; C = (st & 1) * 32 + (swz % 64) / 2; }
__host__ __device__ __forceinline__ int perm32(int rho) { const int n = rho >> 4, i = rho & 15; return 8 * (i >> 2) + 4 * n + (i & 3); }

struct Unit { int pm, pn; };
struct Gemm { const bf16_t* A; const bf16_t* Bt; int M, N, K, lda, ldb; };

struct StaticOrder {
    int nM, nN, nwg, G, c;
    __host__ __device__ void init(int M, int N, int G_, int c_) { nM = M / BM; nN = N / BM; nwg = nM * nN; G = G_; c = c_; }
    __host__ __device__ bool next(int i, Unit& u) const {
        const long L = (long)i * G + c; if (L >= nwg) return false;
        int wgid = (int)L; { const int q = nwg / NXCD, r = nwg % NXCD, xcd = wgid % NXCD, off = wgid / NXCD; wgid = (xcd < r ? xcd * (q + 1) : r * (q + 1) + (xcd - r) * q) + off; }
        const int nig = WGM * nN, gid = wgid / nig, fm = gid * WGM, gsz = (nM - fm) < WGM ? (nM - fm) : WGM;
        u.pm = fm + ((wgid % nig) % gsz); u.pn = (wgid % nig) / gsz; return true;
    }
    __device__ __forceinline__ void a_ready(const Unit&) const {}
    __device__ __forceinline__ void done(const Unit&) const {}
};

typedef _Float16 f16x2_t __attribute__((ext_vector_type(2)));
typedef _Float16 half8 __attribute__((ext_vector_type(8)));
__device__ __forceinline__ unsigned cvt_pk_bf16(float lo, float hi) { f16x2_t h = {(_Float16)lo, (_Float16)hi}; return __builtin_bit_cast(unsigned, h); }
__device__ __forceinline__ unsigned cvt_pk_f16(float lo, float hi) { f16x2_t h = {(_Float16)lo, (_Float16)hi}; return __builtin_bit_cast(unsigned, h); }
__device__ __forceinline__ float bf_lo(unsigned w) { return (float)__builtin_bit_cast(f16x2_t, w)[0]; }
__device__ __forceinline__ float bf_hi(unsigned w) { return (float)__builtin_bit_cast(f16x2_t, w)[1]; }
__device__ __forceinline__ float sigmoidf_(float x) { return __builtin_amdgcn_rcpf(1.0f + __expf(-x)); }

template <int MODE> struct EpiBf {
    static constexpr bool PERM = true, AFTER_DRAIN = false;
    bf16_t* O; int ldc; int qlo, qhi; float qscale;
    __device__ __forceinline__ void operator()(const f32x4 (&acc)[2][2][4][2], const Unit& u, int wr, int wc, int fr, int fq) const {
        const int row0 = u.pm * BM + wr * 64 + fr, col0 = u.pn * BM + wc * 32 + 8 * fq;
        const float sc = (MODE == 0 && u.pn >= qlo && u.pn < qhi) ? qscale : 1.f;
#pragma unroll
        for (int ai = 0; ai < 2; ++ai)
#pragma unroll
            for (int m = 0; m < 4; ++m) { bf16_t* rowp = O + (size_t)(row0 + ai * HALF + m * 16) * ldc + col0;
#pragma unroll
                for (int bj = 0; bj < 2; ++bj) { f32x4 v0 = acc[ai][bj][m][0], v1 = acc[ai][bj][m][1];
                    if (MODE == 1) { v0 = __builtin_elementwise_max(v0, (f32x4){0.f, 0.f, 0.f, 0.f}); v1 = __builtin_elementwise_max(v1, (f32x4){0.f, 0.f, 0.f, 0.f}); v0 = v0 * v0; v1 = v1 * v1; }
                    else { v0 = v0 * sc; v1 = v1 * sc; }
                    u32x4 w; w.x = cvt_pk_bf16(v0[0], v0[1]); w.y = cvt_pk_bf16(v0[2], v0[3]); w.z = cvt_pk_bf16(v1[0], v1[1]); w.w = cvt_pk_bf16(v1[2], v1[3]);
                    *(u32x4*)(rowp + bj * HALF) = w; } }
    }
};
struct EpiResid {
    static constexpr bool PERM = false, AFTER_DRAIN = false;
    const float* base; float* out; const float* gate; int ldc;
    __device__ __forceinline__ void operator()(const f32x4 (&acc)[2][2][4][2], const Unit& u, int wr, int wc, int fr, int fq) const {
        const int row0 = u.pm * BM + wr * 64 + fr, col0 = u.pn * BM + wc * 32 + 4 * fq;
        const float* gp = gate + (size_t)((u.pm * BM) >> 12) * 6144 + col0;
#pragma unroll
        for (int bj = 0; bj < 2; ++bj)
#pragma unroll
            for (int n = 0; n < 2; ++n) { const f32x4 gv = *(const f32x4*)(gp + bj * HALF + n * 16);
#pragma unroll
                for (int ai = 0; ai < 2; ++ai)
#pragma unroll
                    for (int m = 0; m < 4; ++m) { const size_t off = (size_t)(row0 + ai * HALF + m * 16) * ldc + col0 + bj * HALF + n * 16;
                        const f32x4 bs = *(const f32x4*)(base + off); *(f32x4*)(out + off) = bs + gv * acc[ai][bj][m][n]; } }
    }
};
struct EpiDecIclr {
    static constexpr bool PERM = true, AFTER_DRAIN = false;
    _Float16* E; _Float16* A; const float* w0; const float* a0;
    __device__ __forceinline__ void operator()(const f32x4 (&acc)[2][2][4][2], const Unit& u, int wr, int wc, int fr, int fq) const {
        const int row0 = u.pm * BM + wr * 64 + fr; const int kind = u.pn >> 1; const int c0 = (u.pn & 1) * BM + wc * 32 + 8 * fq;
        _Float16* O = kind ? A : E; const float* bp = kind ? a0 : w0;
#pragma unroll
        for (int bj = 0; bj < 2; ++bj) { const f32x4 bv0 = *(const f32x4*)(bp + c0 + bj * HALF), bv1 = *(const f32x4*)(bp + c0 + bj * HALF + 4);
#pragma unroll
            for (int ai = 0; ai < 2; ++ai)
#pragma unroll
                for (int m = 0; m < 4; ++m) { _Float16* rowp = O + (size_t)(row0 + ai * HALF + m * 16) * 512 + c0 + bj * HALF;
                    const f32x4 v0 = acc[ai][bj][m][0] + bv0, v1 = acc[ai][bj][m][1] + bv1;
                    u32x4 w; w.x = cvt_pk_f16(v0[0], v0[1]); w.y = cvt_pk_f16(v0[2], v0[3]); w.z = cvt_pk_f16(v1[0], v1[1]); w.w = cvt_pk_f16(v1[2], v1[3]);
                    *(u32x4*)rowp = w; asm volatile("" ::: "memory"); } }
    }
};
struct EpiVres {
    static constexpr bool PERM = true, AFTER_DRAIN = false;
    const bf16_t* PV; int ldp; bf16_t* VF; const float* v0; const float* muv;
    __device__ __forceinline__ void operator()(const f32x4 (&acc)[2][2][4][2], const Unit& u, int wr, int wc, int fr, int fq) const {
        const int row0 = u.pm * BM + wr * 64 + fr; const int c0 = u.pn * BM + wc * 32 + 8 * fq;
#pragma unroll
        for (int bj = 0; bj < 2; ++bj) { const int c = c0 + bj * HALF;
            float b8[8], m8[8];
#pragma unroll
            for (int i = 0; i < 8; ++i) { b8[i] = v0[c + i]; m8[i] = muv[c + i]; }
#pragma unroll
            for (int ai = 0; ai < 2; ++ai)
#pragma unroll
                for (int m = 0; m < 4; ++m) { const int row = row0 + ai * HALF + m * 16;
                    const u32x4 vc = *(const u32x4*)(PV + (size_t)row * ldp + c);
                    u32x4 vp = (u32x4){0u, 0u, 0u, 0u}; if ((row & 4095) != 0) vp = *(const u32x4*)(PV + (size_t)(row - 1) * ldp + c);
                    const u32x4 vf = *(const u32x4*)(VF + (size_t)row * 512 + c);
                    float o[8];
#pragma unroll
                    for (int i = 0; i < 8; ++i) { const unsigned wc_ = vc[i >> 1], wp_ = vp[i >> 1], wf_ = vf[i >> 1];
                        const float xc = (i & 1) ? bf_hi(wc_) : bf_lo(wc_), xp = (i & 1) ? bf_hi(wp_) : bf_lo(wp_), xf = (i & 1) ? bf_hi(wf_) : bf_lo(wf_);
                        const float a = (i < 4) ? acc[ai][bj][m][0][i & 3] : acc[ai][bj][m][1][i & 3];
                        const float vl = xc + (xp - xc) * m8[i]; const float g = sigmoidf_(b8[i] + a); o[i] = vl + (xf - vl) * g; }
                    u32x4 w; w.x = cvt_pk_bf16(o[0], o[1]); w.y = cvt_pk_bf16(o[2], o[3]); w.z = cvt_pk_bf16(o[4], o[5]); w.w = cvt_pk_bf16(o[6], o[7]);
                    *(u32x4*)(VF + (size_t)row * 512 + c) = w; asm volatile("" ::: "memory"); } }
    }
};

template <class Epi, class Sched, bool ALIGN_EPI = false, bool SP2 = false>
__device__ __forceinline__ void gemm_phase(PG8_LAS unsigned char* lds, const Gemm g, const Sched& S, const Epi& E, const int tid) {
    const int wid = __builtin_amdgcn_readfirstlane(tid >> 6), lane = tid & 63, wr = wid >> 2, wc = wid & 3, fr = lane & 15, fq = lane >> 4;
    const int K = g.K, nt = K / BK;
    unsigned voffA[2], voffB[2];
#pragma unroll
    for (int i = 0; i < 2; ++i) { int R, C; stage_rc(tid * 16 + i * 8192, R, C); const int Rb = Epi::PERM ? ((R & ~31) + perm32(R & 31)) : R;
        voffA[i] = (unsigned)(R * g.lda + C) * 2u; voffB[i] = (unsigned)(Rb * g.ldb + C) * 2u; }
    const size_t kstep = (size_t)(BK * 2);
    const size_t hstepA = (size_t)HALF * g.lda * 2, hstepB = (size_t)HALF * g.ldb * 2;
    const size_t tstepA = 2 * hstepA, tstepB = 2 * hstepB;
    const unsigned ldsw = (unsigned)wid * 1024u;
    const int aoff = lds_byte(wr * 64 + fr, fq * 8), boff = lds_byte(wc * 32 + fr, fq * 8);
#define PG8_SA(b, h) (((b) * 2 + (h)) * HTB)
#define PG8_SB(b, h) ((4 + (b) * 2 + (h)) * HTB)
#define PG8_STAGE(bufoff, gbase, voff) do { _Pragma("unroll") for (int _i = 0; _i < 2; ++_i) \
        __builtin_amdgcn_global_load_lds((const unsigned*)((const char*)(gbase) + (voff)[_i]), (PG8_LAS unsigned*)(lds + (bufoff) + ldsw + _i * 8192), 16, 0, 0); } while (0)
#define PG8_LDA(dst, b, h) do { _Pragma("unroll") for (int m = 0; m < 4; ++m) _Pragma("unroll") for (int k = 0; k < 2; ++k) dst[m][k] = *(const PG8_LAS bf16x8*)(lds + PG8_SA(b, h) + aoff + m * 2048 + k * 1024); } while (0)
#define PG8_LDB(dst, b, h) do { _Pragma("unroll") for (int n = 0; n < 2; ++n) _Pragma("unroll") for (int k = 0; k < 2; ++k) dst[n][k] = *(const PG8_LAS bf16x8*)(lds + PG8_SB(b, h) + boff + n * 2048 + k * 1024); } while (0)
#define PG8_MMA(ai, bj, At, Bt) do { __builtin_amdgcn_s_setprio(1); _Pragma("unroll") for (int m = 0; m < 4; ++m) _Pragma("unroll") for (int n = 0; n < 2; ++n) _Pragma("unroll") for (int k = 0; k < 2; ++k) \
        acc[ai][bj][m][n] = __builtin_amdgcn_mfma_f32_16x16x32_f16(__builtin_bit_cast(half8, Bt[n][k]), __builtin_bit_cast(half8, At[m][k]), acc[ai][bj][m][n], 0, 0, 0); __builtin_amdgcn_s_setprio(0); } while (0)
#define PG8_WAIT_V(n) asm volatile("s_waitcnt vmcnt(" #n ")" ::: "memory")
#define PG8_WAIT_L(n) asm volatile("s_waitcnt lgkmcnt(" #n ")" ::: "memory")
#define PG8_BAR __builtin_amdgcn_s_barrier()
#define PG8_SCHED __builtin_amdgcn_sched_barrier(0)
    Unit cur, nxt; int ui = 0;
    if (!S.next(0, cur)) return;
    f32x4 acc[2][2][4][2];
#pragma unroll
    for (int a = 0; a < 2; ++a)
#pragma unroll
        for (int b = 0; b < 2; ++b)
#pragma unroll
            for (int m = 0; m < 4; ++m)
#pragma unroll
                for (int n = 0; n < 2; ++n) acc[a][b][m][n] = (f32x4){0.f, 0.f, 0.f, 0.f};
    bf16x8 At[4][2], B0[2][2], B1[2][2];
    const char* cA = (const char*)g.A + (size_t)cur.pm * tstepA; const char* cB = (const char*)g.Bt + (size_t)cur.pn * tstepB;
    S.a_ready(cur);
    if constexpr (SP2) {
        PG8_STAGE(PG8_SB(0, 0), cB, voffB); PG8_STAGE(PG8_SB(0, 1), cB + hstepB, voffB); PG8_STAGE(PG8_SA(0, 0), cA, voffA); PG8_STAGE(PG8_SA(0, 1), cA + hstepA, voffA);
        if (wr == 1) PG8_BAR;
        PG8_WAIT_V(2); PG8_BAR;
        PG8_STAGE(PG8_SB(1, 0), cB + kstep, voffB); PG8_STAGE(PG8_SA(1, 0), cA + kstep, voffA); PG8_STAGE(PG8_SB(1, 1), cB + hstepB + kstep, voffB);
        PG8_WAIT_V(6); PG8_BAR;
    } else {
        PG8_STAGE(PG8_SB(0, 0), cB, voffB); PG8_STAGE(PG8_SA(0, 0), cA, voffA); PG8_STAGE(PG8_SB(0, 1), cB + hstepB, voffB); PG8_STAGE(PG8_SA(0, 1), cA + hstepA, voffA);
        if (wr == 1) PG8_BAR;
        PG8_WAIT_V(4); PG8_BAR;
        PG8_STAGE(PG8_SB(1, 0), cB + kstep, voffB); PG8_STAGE(PG8_SA(1, 0), cA + kstep, voffA); PG8_STAGE(PG8_SB(1, 1), cB + hstepB + kstep, voffB);
        PG8_WAIT_V(6); PG8_BAR;
    }
    for (;;) {
        const bool has_next = S.next(ui + 1, nxt);
        const char* nA = has_next ? (const char*)g.A + (size_t)nxt.pm * tstepA : cA; const char* nB = has_next ? (const char*)g.Bt + (size_t)nxt.pn * tstepB : cB;
        for (int t = 0; t < nt; t += 2) {
            const bool last = (t == nt - 2);
            const char* a1 = cA + (size_t)(t + 1) * kstep;
            const char* a2 = last ? nA : cA + (size_t)(t + 2) * kstep; const char* b2 = last ? nB : cB + (size_t)(t + 2) * kstep;
            const char* a3 = a2 + kstep; const char* b3 = b2 + kstep;
            if (last && has_next) S.a_ready(nxt);
            if constexpr (SP2) {
            PG8_LDB(B0, 0, 0); PG8_LDB(B1, 0, 1); PG8_SCHED; PG8_LDA(At, 0, 0); PG8_STAGE(PG8_SA(1, 1), a1 + hstepA, voffA);
            PG8_WAIT_V(8); PG8_WAIT_L(0); PG8_BAR; PG8_MMA(0, 0, At, B0); PG8_MMA(0, 1, At, B1); PG8_BAR; PG8_SCHED;
            PG8_LDA(At, 0, 1); PG8_STAGE(PG8_SB(0, 0), b2, voffB); PG8_STAGE(PG8_SB(0, 1), b2 + hstepB, voffB); PG8_STAGE(PG8_SA(0, 0), a2, voffA);
            PG8_WAIT_V(8); PG8_WAIT_L(0); PG8_BAR; PG8_MMA(1, 0, At, B0); PG8_MMA(1, 1, At, B1); PG8_BAR; PG8_SCHED;
            PG8_LDB(B0, 1, 0); PG8_LDB(B1, 1, 1); PG8_SCHED; PG8_LDA(At, 1, 0); PG8_STAGE(PG8_SA(0, 1), a2 + hstepA, voffA);
            PG8_WAIT_V(8); PG8_WAIT_L(0); PG8_BAR; PG8_MMA(0, 0, At, B0); PG8_MMA(0, 1, At, B1); PG8_BAR; PG8_SCHED;
            PG8_LDA(At, 1, 1); PG8_STAGE(PG8_SB(1, 0), b3, voffB); PG8_STAGE(PG8_SB(1, 1), b3 + hstepB, voffB); PG8_STAGE(PG8_SA(1, 0), a3, voffA);
            PG8_WAIT_V(8); PG8_WAIT_L(0); PG8_BAR; PG8_MMA(1, 0, At, B0); PG8_MMA(1, 1, At, B1); PG8_BAR; PG8_SCHED;
            } else {
            PG8_LDB(B0, 0, 0); PG8_SCHED; PG8_LDA(At, 0, 0); PG8_STAGE(PG8_SA(1, 1), a1 + hstepA, voffA);
            PG8_WAIT_L(8); PG8_BAR; PG8_WAIT_L(0); PG8_MMA(0, 0, At, B0); PG8_BAR; PG8_SCHED;
            PG8_LDB(B1, 0, 1); PG8_STAGE(PG8_SB(0, 0), b2, voffB);
            PG8_BAR; PG8_WAIT_L(0); PG8_MMA(0, 1, At, B1); PG8_BAR;
            PG8_LDA(At, 0, 1); PG8_STAGE(PG8_SA(0, 0), a2, voffA);
            PG8_BAR; PG8_WAIT_L(0); PG8_MMA(1, 0, At, B0); PG8_BAR; PG8_SCHED;
            PG8_STAGE(PG8_SB(0, 1), b2 + hstepB, voffB);
            PG8_WAIT_V(6); PG8_BAR; PG8_MMA(1, 1, At, B1); PG8_BAR;
            PG8_LDB(B0, 1, 0); PG8_SCHED; PG8_LDA(At, 1, 0); PG8_STAGE(PG8_SA(0, 1), a2 + hstepA, voffA);
            PG8_WAIT_L(8); PG8_BAR; PG8_WAIT_L(0); PG8_MMA(0, 0, At, B0); PG8_BAR; PG8_SCHED;
            PG8_LDB(B1, 1, 1); PG8_STAGE(PG8_SB(1, 0), b3, voffB);
            PG8_BAR; PG8_WAIT_L(0); PG8_MMA(0, 1, At, B1); PG8_BAR;
            PG8_LDA(At, 1, 1); PG8_STAGE(PG8_SA(1, 0), a3, voffA);
            PG8_BAR; PG8_WAIT_L(0); PG8_MMA(1, 0, At, B0); PG8_BAR; PG8_SCHED;
            PG8_STAGE(PG8_SB(1, 1), b3 + hstepB, voffB);
            PG8_WAIT_V(6); PG8_BAR; PG8_MMA(1, 1, At, B1); PG8_BAR;
            }
        }
        if constexpr (ALIGN_EPI) { if (wr == 0) PG8_BAR; }
        if constexpr (!Epi::AFTER_DRAIN) { E(acc, cur, wr, wc, fr, fq); S.done(cur); }
        if (!has_next) break;
#pragma unroll
        for (int a = 0; a < 2; ++a)
#pragma unroll
            for (int b = 0; b < 2; ++b)
#pragma unroll
                for (int m = 0; m < 4; ++m)
#pragma unroll
                    for (int n = 0; n < 2; ++n) acc[a][b][m][n] = (f32x4){0.f, 0.f, 0.f, 0.f};
        cur = nxt; cA = nA; cB = nB; ++ui;
        if constexpr (ALIGN_EPI) { if (wr == 1) PG8_BAR; }
    }
    PG8_WAIT_V(0);
    if constexpr (!ALIGN_EPI) { if (wr == 0) PG8_BAR; }
    PG8_BAR;
    if constexpr (Epi::AFTER_DRAIN) { E.fused(acc, cur, wr, wc, fr, fq, lds, wid, lane); S.done(cur); }
#undef PG8_SA
#undef PG8_SB
#undef PG8_STAGE
#undef PG8_LDA
#undef PG8_LDB
#undef PG8_MMA
#undef PG8_WAIT_V
#undef PG8_WAIT_L
#undef PG8_BAR
#undef PG8_SCHED
}
}
constexpr int NB = 8, T = 4096, D = 1024, M = NB * T, NP = 4352, FF = 4096, LA = 384;
constexpr int C_R = 0, C_K = 512, C_V = 1024, C_QA = 1536, C_KA = 2048, C_VA = 2560, C_QI = 3072, C_KI = 3584, C_WI = 3648, C_P1 = 3656, C_P2 = 3944, C_END = 4232, C_Y = 3656, C_RK = 4168;
#define GAS __attribute__((address_space(1)))
#define LAS __attribute__((address_space(3)))
typedef unsigned short bf16_t;
typedef short bf16x8 __attribute__((ext_vector_type(8)));
typedef float f32x4 __attribute__((ext_vector_type(4)));
typedef float f32x16 __attribute__((ext_vector_type(16)));
typedef unsigned u32x4 __attribute__((ext_vector_type(4)));
typedef unsigned u32x2 __attribute__((ext_vector_type(2)));
typedef short s16x4 __attribute__((ext_vector_type(4)));
#define LDS_WAIT() asm volatile("s_waitcnt lgkmcnt(0)" ::: "memory")
#define VM_WAIT() asm volatile("s_waitcnt vmcnt(0)" ::: "memory")
__device__ __forceinline__ float bfl(unsigned w) { return (float)__builtin_bit_cast(pg8::f16x2_t, w)[0]; }
__device__ __forceinline__ float bfh(unsigned w) { return (float)__builtin_bit_cast(pg8::f16x2_t, w)[1]; }
__device__ __forceinline__ float bf1(bf16_t v) { return (float)__builtin_bit_cast(_Float16, v); }
__device__ __forceinline__ unsigned pkbf(float lo, float hi) { return pg8::cvt_pk_bf16(lo, hi); }
template <int CTRL> __device__ __forceinline__ float dpp_f(float x) { return __builtin_bit_cast(float, __builtin_amdgcn_update_dpp(0, __builtin_bit_cast(int, x), CTRL, 0xf, 0xf, true)); }
__device__ __forceinline__ float allsum8(float x) { x += dpp_f<0xB1>(x); x += dpp_f<0x4E>(x); x += dpp_f<0x141>(x); return x; }
__device__ __forceinline__ float allsum16(float x) { x = allsum8(x); x += dpp_f<0x140>(x); return x; }
__device__ __forceinline__ float wave_sum(float v) {
#pragma unroll
    for (int o = 1; o < 64; o <<= 1) v += __shfl_xor(v, o);
    return v;
}

namespace att {
__device__ __forceinline__ int crow(int r, int hi) { return (r & 3) + 8 * (r >> 2) + 4 * hi; }
#define SBAR() __builtin_amdgcn_sched_barrier(0)
__device__ __forceinline__ void glds16(const void* gsrc, unsigned lds_dst) { unsigned keep;
    asm volatile("s_mov_b32 %0, m0\n\ts_mov_b32 m0, %2\n\ts_nop 0\n\tglobal_load_lds_dwordx4 %1, off\n\ts_mov_b32 m0, %0" : "=&s"(keep) : "v"(gsrc), "s"(lds_dst) : "memory"); }
typedef LAS const char* lds_cptr;
__device__ __forceinline__ void qkt(f32x16& p0, f32x16& p1, lds_cptr kb, const bf16x8* qr) {
    const f32x16 z = {};
#pragma unroll
    for (int d0 = 0; d0 < 4; ++d0) {
        const bf16x8 b0 = *(const LAS bf16x8*)(kb + d0 * 2048);
        const bf16x8 b1 = *(const LAS bf16x8*)(kb + d0 * 2048 + 512);
        if (d0 == 0) { p0 = __builtin_amdgcn_mfma_f32_32x32x16_f16(__builtin_bit_cast(pg8::half8, b0), __builtin_bit_cast(pg8::half8, qr[0]), z, 0, 0, 0); p1 = __builtin_amdgcn_mfma_f32_32x32x16_f16(__builtin_bit_cast(pg8::half8, b1), __builtin_bit_cast(pg8::half8, qr[0]), z, 0, 0, 0); }
        else { p0 = __builtin_amdgcn_mfma_f32_32x32x16_f16(__builtin_bit_cast(pg8::half8, b0), __builtin_bit_cast(pg8::half8, qr[d0]), p0, 0, 0, 0); p1 = __builtin_amdgcn_mfma_f32_32x32x16_f16(__builtin_bit_cast(pg8::half8, b1), __builtin_bit_cast(pg8::half8, qr[d0]), p1, 0, 0, 0); } }
}
__device__ __forceinline__ void pv(f32x16* o, int vb, bf16x8 pa0, bf16x8 pa1, bf16x8 pa2, bf16x8 pa3) {
#pragma unroll
    for (int d0 = 0; d0 < 2; ++d0) { s16x4 lo[4], hi[4];
#pragma unroll
        for (int ks = 0; ks < 4; ++ks) {
            asm volatile("ds_read_b64_tr_b16 %0,%1 offset:%c2" : "=&v"(lo[ks]) : "v"(vb), "i"(d0 * 4096 + ks * 1024) : "memory");
            asm volatile("ds_read_b64_tr_b16 %0,%1 offset:%c2" : "=&v"(hi[ks]) : "v"(vb), "i"(d0 * 4096 + ks * 1024 + 512) : "memory"); }
        asm volatile("s_waitcnt lgkmcnt(0)" ::: "memory"); SBAR();
#define PK(k) (bf16x8){lo[k][0], lo[k][1], lo[k][2], lo[k][3], hi[k][0], hi[k][1], hi[k][2], hi[k][3]}
        o[d0] = __builtin_amdgcn_mfma_f32_32x32x16_f16(__builtin_bit_cast(pg8::half8, pa0), __builtin_bit_cast(pg8::half8, PK(0)), o[d0], 0, 0, 0);
        o[d0] = __builtin_amdgcn_mfma_f32_32x32x16_f16(__builtin_bit_cast(pg8::half8, pa1), __builtin_bit_cast(pg8::half8, PK(1)), o[d0], 0, 0, 0);
        o[d0] = __builtin_amdgcn_mfma_f32_32x32x16_f16(__builtin_bit_cast(pg8::half8, pa2), __builtin_bit_cast(pg8::half8, PK(2)), o[d0], 0, 0, 0);
        o[d0] = __builtin_amdgcn_mfma_f32_32x32x16_f16(__builtin_bit_cast(pg8::half8, pa3), __builtin_bit_cast(pg8::half8, PK(3)), o[d0], 0, 0, 0);
#undef PK
    }
}
constexpr int SLOTB = 8192;
constexpr int L_K = 0, L_V = 2 * SLOTB, L_WS = 4 * SLOTB, L_OST = L_WS + 8 * 64 * 4, L_BT = L_OST + 8 * 8192, L_END = L_BT + 8 * 129 * 4;
constexpr float C2 = 0.125f * 1.4426950408889634f;

__device__ __forceinline__ int t5_bucket(int n) {
    if (n < 16) return n;
    const int thr[15] = {19, 21, 24, 27, 31, 35, 40, 46, 52, 59, 67, 77, 87, 99, 113};
    int b = 16;
#pragma unroll
    for (int i = 0; i < 15; ++i) b += (n >= thr[i]) ? 1 : 0;
    return b;
}
__device__ __forceinline__ void build_bias_table(const float* rel_bias, LAS char* shm, int tid) {
    LAS float* BT = (LAS float*)(shm + L_BT);
    for (int i = tid; i < 8 * 129; i += 512) { const int h = i / 129, d = i % 129;
        BT[i] = (d >= 128) ? 0.f : (rel_bias[t5_bucket(d) * 8 + h] - rel_bias[31 * 8 + h]) * 1.4426950408889634f; }
}

__device__ __forceinline__ void attn_unit(int b, int h, int qb, const bf16_t* PROJ, const unsigned long long* MASK, bf16_t* MIX, const float* gain, LAS char* shm, const int tid) {
    const int lane = tid & 63, r32 = lane & 31, hi = lane >> 5; const int wid = __builtin_amdgcn_readfirstlane(tid >> 6);
    const long rowbase = (long)b * T; const int q0 = qb * 256;
    const bf16_t* Qw = PROJ + (rowbase + q0 + wid * 32) * NP + C_QA + h * 64;
    const bf16_t* Kh = PROJ + rowbase * NP + C_KA + h * 64; const bf16_t* Vh = PROJ + rowbase * NP + C_VA + h * 64;
    const unsigned lds0 = (unsigned)(uintptr_t)shm;
    LAS float* wsf = (LAS float*)(shm + L_WS) + wid * 64;
    const LAS float* BT = (const LAS float*)(shm + L_BT) + h * 129;
    const bf16_t* ksrc = Kh + (long)lane * NP + wid * 8;
    const bf16_t* vsrc = Vh + (long)(16 * (wid & 3) + (lane >> 2)) * NP + (wid >> 2) * 32 + (lane & 3) * 8;
    const unsigned kdst = lds0 + L_K + wid * 1024, vdst = lds0 + L_V + wid * 1024;
#define DMA_K(t, slot) glds16(ksrc + (long)(t) * 64 * NP, (unsigned)__builtin_amdgcn_readfirstlane(kdst + (slot)))
#define DMA_V(t, slot) glds16(vsrc + (long)(t) * 64 * NP, (unsigned)__builtin_amdgcn_readfirstlane(vdst + (slot)))
    const int vb0 = (int)(lds0 + L_V) + ((lane >> 4) & 1) * 32 + (lane & 3) * 8 + (4 * hi + ((lane & 15) >> 2)) * 64;
    const lds_cptr kp0 = (lds_cptr)shm + L_K + hi * 1024 + r32 * 16;
    const int NT = (q0 + 256) / 64;
    const int qabs = q0 + wid * 32 + r32;
    const unsigned long long* mp = MASK + (size_t)b * 64 * 4096 + qabs;
    unsigned long long mw_next;
#define MASK_LD(t) asm volatile("global_load_dwordx2 %0, %1, off" : "=&v"(mw_next) : "v"(mp + (size_t)(t) * 4096) : "memory")
    MASK_LD(0); DMA_K(0, 0); DMA_V(0, 0);
    bf16x8 qr[4];
#pragma unroll
    for (int d0 = 0; d0 < 4; ++d0) qr[d0] = *(const bf16x8*)(Qw + (long)r32 * NP + d0 * 16 + hi * 8);
    float m_run = -1e30f, l_run = 0.f; f32x16 o[2]; o[0] = f32x16{}; o[1] = f32x16{};
    for (int t = 0; t < NT; ++t) {
        const int slot = (t & 1) * SLOTB;
        asm volatile("s_waitcnt vmcnt(0) lgkmcnt(0)\n\ts_barrier" ::: "memory");
        asm volatile("" : "+v"(mw_next)); const unsigned long long mw = mw_next;
        if (t + 1 < NT) { MASK_LD(t + 1); DMA_K(t + 1, slot ^ SLOTB); DMA_V(t + 1, slot ^ SLOTB); }
        f32x16 p0, p1; qkt(p0, p1, kp0 + slot, qr);
        if (64 * t + 191 > q0 + 32 * wid) {
#pragma unroll
            for (int r = 0; r < 16; ++r) { const int d0_ = qabs - (64 * t + crow(r, hi));
                const int i0 = d0_ < 0 ? 0 : (d0_ > 128 ? 128 : d0_); const int d1_ = d0_ - 32; const int i1 = d1_ < 0 ? 0 : (d1_ > 128 ? 128 : d1_);
                p0[r] += BT[i0]; p1[r] += BT[i1]; }
        }
        { const unsigned mlo = (unsigned)mw >> (4 * hi), mhi = (unsigned)(mw >> 32) >> (4 * hi); const float NEG = -INFINITY;
#pragma unroll
          for (int r = 0; r < 16; ++r) { const int bit = (r & 3) + 8 * (r >> 2); p0[r] = ((mlo >> bit) & 1u) ? p0[r] : NEG; p1[r] = ((mhi >> bit) & 1u) ? p1[r] : NEG; } }
        float rm = p0[0];
#pragma unroll
        for (int r = 1; r < 16; ++r) rm = fmaxf(rm, p0[r]);
#pragma unroll
        for (int r = 0; r < 16; ++r) rm = fmaxf(rm, p1[r]);
        { auto rr = __builtin_amdgcn_permlane32_swap(__float_as_uint(rm), __float_as_uint(rm), false, false); rm = fmaxf(__uint_as_float(rr[0]), __uint_as_float(rr[1])); }
        const float m_new = fmaxf(m_run, rm); const float f = __builtin_amdgcn_exp2f(m_run - m_new); m_run = m_new;
        float sacc = 0.f;
#pragma unroll
        for (int r = 0; r < 16; ++r) { p0[r] = __builtin_amdgcn_exp2f(p0[r] - m_new); p1[r] = __builtin_amdgcn_exp2f(p1[r] - m_new); sacc += p0[r] + p1[r]; }
        l_run = l_run * f + sacc;
        if (hi == 0) wsf[r32] = f;
        LDS_WAIT();
#pragma unroll
        for (int r = 0; r < 16; ++r) { const float fr_ = wsf[crow(r, hi)]; o[0][r] *= fr_; o[1][r] *= fr_; }
        u32x4 pw0, pw1, pw2, pw3;
#define PKW(P, B) pkbf(P[B], P[B + 1])
        pw0 = (u32x4){PKW(p0, 0), PKW(p0, 2), PKW(p0, 4), PKW(p0, 6)}; pw1 = (u32x4){PKW(p0, 8), PKW(p0, 10), PKW(p0, 12), PKW(p0, 14)};
        pw2 = (u32x4){PKW(p1, 0), PKW(p1, 2), PKW(p1, 4), PKW(p1, 6)}; pw3 = (u32x4){PKW(p1, 8), PKW(p1, 10), PKW(p1, 12), PKW(p1, 14)};
#undef PKW
        LDS_WAIT(); SBAR();
        pv(o, vb0 + slot, __builtin_bit_cast(bf16x8, pw0), __builtin_bit_cast(bf16x8, pw1), __builtin_bit_cast(bf16x8, pw2), __builtin_bit_cast(bf16x8, pw3));
    }
    { auto rr = __builtin_amdgcn_permlane32_swap(__float_as_uint(l_run), __float_as_uint(l_run), false, false); l_run = __uint_as_float(rr[0]) + __uint_as_float(rr[1]); }
    LDS_WAIT();
    if (hi == 0) wsf[32 + r32] = l_run;
    LDS_WAIT();
    LAS float* stg = (LAS float*)(shm + L_OST) + wid * 2048;
#pragma unroll
    for (int r = 0; r < 16; ++r) { const int orow = crow(r, hi); const float rl = 1.0f / wsf[32 + orow];
#pragma unroll
        for (int d0 = 0; d0 < 2; ++d0) stg[orow * 64 + d0 * 32 + r32] = o[d0][r] * rl; }
    LDS_WAIT();
    bf16_t* Ow = MIX + (rowbase + q0 + wid * 32) * 1024 + 512 + h * 64;
#pragma unroll
    for (int i = 0; i < 4; ++i) { const int row = i * 8 + (lane >> 3), ch = lane & 7;
        const f32x4 a = *(const LAS f32x4*)(stg + row * 64 + ch * 8), c = *(const LAS f32x4*)(stg + row * 64 + ch * 8 + 4);
        float ss = (a[0] * a[0] + a[1] * a[1]) + (a[2] * a[2] + a[3] * a[3]) + (c[0] * c[0] + c[1] * c[1]) + (c[2] * c[2] + c[3] * c[3]);
        ss = allsum8(ss);
        const float rs = rsqrtf(ss * (1.0f / 64.0f) + 1e-6f);
        const f32x4 g0 = *(const f32x4*)(gain + h * 64 + ch * 8), g1 = *(const f32x4*)(gain + h * 64 + ch * 8 + 4);
        u32x4 w; w.x = pkbf(a[0] * rs * g0[0], a[1] * rs * g0[1]); w.y = pkbf(a[2] * rs * g0[2], a[3] * rs * g0[3]); w.z = pkbf(c[0] * rs * g1[0], c[1] * rs * g1[1]); w.w = pkbf(c[2] * rs * g1[2], c[3] * rs * g1[3]);
        *(u32x4*)(Ow + (long)row * 1024 + ch * 8) = w; }
    asm volatile("s_waitcnt lgkmcnt(0)\n\ts_barrier" ::: "memory");
#undef DMA_K
#undef DMA_V
#undef MASK_LD
}
#undef SBAR
}

#define GAS __attribute__((address_space(1)))
#define LAS __attribute__((address_space(3)))
typedef unsigned short bf16;
typedef unsigned v4u __attribute__((ext_vector_type(4)));
typedef float f32x4 __attribute__((ext_vector_type(4)));
typedef short bf16x8 __attribute__((ext_vector_type(8)));
typedef GAS unsigned gu32;
typedef GAS unsigned long long gu64;
#define RLX_AGENT __ATOMIC_RELAXED, __HIP_MEMORY_SCOPE_AGENT
#define LDS_WAIT() asm volatile("s_waitcnt lgkmcnt(0)" ::: "memory")
#define VM_WAIT() asm volatile("s_waitcnt vmcnt(0)" ::: "memory")
__device__ __forceinline__ unsigned long long rt() { return __builtin_amdgcn_s_memrealtime(); }
__device__ __forceinline__ unsigned f2bf(float f) { unsigned u = __builtin_bit_cast(unsigned, f); return (u + 0x7fffu + ((u >> 16) & 1u)) >> 16; }
__device__ __forceinline__ unsigned pk2(float lo, float hi) { return f2bf(lo) | (f2bf(hi) << 16); }

#define XB_TMO      128
#define XB_XCNT(j)  (256  + 64 * (j))
#define XB_XSUB(j)  (1280 + 64 * (j))
#define XB_XGEN(j)  (2304 + 64 * (j))
#define XB_TOP      3328
#define XB_TOPGEN   3392
#define XCD_BAR_WORDS 3456
#define XB_SPIN_CAP (1u << 22)

__device__ __forceinline__ unsigned xb_ld(unsigned* p)              { return __hip_atomic_load(p, __ATOMIC_RELAXED, __HIP_MEMORY_SCOPE_AGENT); }
__device__ __forceinline__ unsigned xb_add(unsigned* p, unsigned v) { return __hip_atomic_fetch_add(p, v, __ATOMIC_RELAXED, __HIP_MEMORY_SCOPE_AGENT); }
__device__ __forceinline__ unsigned xb_xcc_id() { return (unsigned)__builtin_amdgcn_s_getreg((3 << 11) | 20) & 0xFu; }
#define XB_SPIN(cond, bar) do { unsigned _sp = 0; while (cond) { __builtin_amdgcn_s_sleep(1); \
    if ((++_sp & 255u) == 0u) { if (xb_ld(&(bar)[XB_TMO])) break; if (_sp > XB_SPIN_CAP) { atomicAdd(&(bar)[XB_TMO], 1u); break; } } } } while (0)

struct XcdBarrier {
    unsigned* bar; unsigned x;
    volatile LAS unsigned* st;
};

__device__ __forceinline__ XcdBarrier xcd_barrier_post(unsigned* bar, volatile LAS unsigned* st) {
    XcdBarrier b; b.bar = bar; b.x = xb_xcc_id(); b.st = st;
    if (threadIdx.x == 0) (void)xb_add(&bar[XB_XCNT(b.x)], 1u);
    return b;
}
__device__ __forceinline__ void xcd_barrier_complete(unsigned* bar, unsigned x, unsigned& nloc, unsigned& nx) {
    const unsigned G = gridDim.x * gridDim.y * gridDim.z;
    unsigned sum, cnt, mine, sp = 0u;
    for (;;) {
        sum = 0u; cnt = 0u; mine = 0u;
#pragma unroll
        for (unsigned j = 0; j < 16; ++j) { const unsigned c = xb_ld(&bar[XB_XCNT(j)]); sum += c; cnt += (c > 0u) ? 1u : 0u; mine = (j == x) ? c : mine; }
        if (sum == G) break;
        __builtin_amdgcn_s_sleep(1);
        if ((++sp & 255u) == 0u) { if (xb_ld(&bar[XB_TMO])) break; if (sp > XB_SPIN_CAP) { atomicAdd(&bar[XB_TMO], 1u); break; } }
    }
    nloc = mine > 0u ? mine : 1u; nx = cnt > 0u ? cnt : 1u;
}

__device__ __forceinline__ void xcd_barrier(const XcdBarrier& b) {
    asm volatile("s_waitcnt vmcnt(0)" ::: "memory");
    __syncthreads();
    if (threadIdx.x == 0) {
        unsigned* bar = b.bar;
        __builtin_amdgcn_s_waitcnt(0);
        unsigned nloc = b.st[0], nx = b.st[1];
        if (nloc == 0u) { xcd_barrier_complete(bar, b.x, nloc, nx); b.st[0] = nloc; b.st[1] = nx; }
        const unsigned old = xb_add(&bar[XB_XSUB(b.x)], 1u);
        const unsigned gen = old / nloc;
        if (old + 1u == (gen + 1u) * nloc) {
            __builtin_amdgcn_fence(__ATOMIC_RELEASE, "agent");
            asm volatile("s_waitcnt vmcnt(0)" ::: "memory");
            const unsigned og = xb_add(&bar[XB_TOP], 1u);
            const unsigned tg = og / nx;
            if (og + 1u == (tg + 1u) * nx) xb_add(&bar[XB_TOPGEN], 1u);
            else XB_SPIN(xb_ld(&bar[XB_TOPGEN]) == tg, bar);
            __builtin_amdgcn_fence(__ATOMIC_ACQUIRE, "agent");
            xb_add(&bar[XB_XGEN(b.x)], 1u);
            asm volatile("s_waitcnt vmcnt(0)" ::: "memory");
        } else {
            XB_SPIN(xb_ld(&bar[XB_XGEN(b.x)]) == gen, bar);
            __builtin_amdgcn_fence(__ATOMIC_ACQUIRE, "agent");
            asm volatile("s_waitcnt vmcnt(0)" ::: "memory");
        }
    }
    __syncthreads();
}
constexpr size_t MiB = 1u << 20;
constexpr size_t WS_CTL = 0, CTL_ZERO_BYTES = 1 * MiB;
constexpr size_t WS_MOD = 1 * MiB;
constexpr size_t WS_LW = 2 * MiB;
constexpr size_t WS_WIN = 3 * MiB, WS_WOUT = 12 * MiB, WS_W1 = 14 * MiB, WS_W2 = 22 * MiB;
constexpr size_t WS_LACT = 30 * MiB;
constexpr size_t WS_MASK = 54 * MiB;
constexpr size_t WS_VF = 70 * MiB;
constexpr size_t WS_H = 102 * MiB;
constexpr size_t WS_MIX = 166 * MiB;
constexpr size_t WS_PROJ = 230 * MiB;
constexpr size_t WS_END = 502 * MiB;
static_assert(WS_WIN + (size_t)NP * D * 2 <= WS_WOUT && WS_W2 + (size_t)D * FF * 2 <= WS_LACT && WS_LACT + (size_t)M * LA * 2 <= WS_MASK && WS_MASK + (size_t)NB * 64 * 4096 * 8 <= WS_VF &&
              WS_VF + (size_t)M * 512 * 2 <= WS_H && WS_H + (size_t)M * D * 2 <= WS_MIX && WS_MIX + (size_t)M * D * 2 <= WS_PROJ && WS_PROJ + (size_t)M * NP * 2 <= WS_END, "d_ws map");
constexpr int CW_BAR = 4096;
constexpr int RING_BYTES = 131072, HIST_OFF = 131072, LDSCTL_OFF = 131072 + 8192, MISC_OFF = LDSCTL_OFF + 320, LDS_BYTES = 147456;
static_assert(att::L_END <= RING_BYTES && MISC_OFF + 128 <= LDS_BYTES, "LDS map");
constexpr int NWAVES = 8;

__device__ __forceinline__ void ph_mod(const float* c, const float* w_ada, const float* b_ada, float* MOD, LAS unsigned char* lds, int vcu, int G, int tid) {
    LAS float* ca = (LAS float*)lds; LAS float* part = (LAS float*)(lds + 32768);
    for (int i = tid; i < NB * D; i += 512) { const float v = c[i]; ca[i] = v / (1.f + __expf(-v)); }
    __syncthreads();
    const int wave = tid >> 6, lane = tid & 63;
    for (int task = vcu; task < 192; task += G) {
        const int l = task / 96, j0 = (task % 96) * 64;
        float acc[8];
#pragma unroll
        for (int b = 0; b < 8; ++b) acc[b] = 0.f;
        const float* wp = w_ada + ((size_t)l * D + wave * 128) * 6144 + j0 + lane;
#pragma unroll 8
        for (int k = 0; k < 128; ++k) { const float w = wp[(size_t)k * 6144];
#pragma unroll
            for (int b = 0; b < 8; ++b) acc[b] += ca[b * D + wave * 128 + k] * w; }
#pragma unroll
        for (int b = 0; b < 8; ++b) part[(wave * 8 + b) * 64 + lane] = acc[b];
        __syncthreads();
        { float s = 0.f;
#pragma unroll
          for (int w = 0; w < 8; ++w) s += part[(w * 8 + wave) * 64 + lane];
          MOD[((size_t)l * 8 + wave) * 6144 + j0 + lane] = s + b_ada[l * 6144 + j0 + lane]; }
        __syncthreads();
    }
}

__device__ __forceinline__ void tr_item(const float* W, int ldw, int nvalid, int K, bf16_t* WT, int row_off, LAS float* scr, int kb, int nb, int lane, const float* mu, int mode) {
    const int k0 = 64 * kb, n0 = 32 * nb; const int n = n0 + (lane & 31);
#pragma unroll 8
    for (int i = 0; i < 32; ++i) { const int kk = 2 * i + (lane >> 5); float v = (n < nvalid) ? W[(size_t)(k0 + kk) * ldw + n] : 0.f;
        if (mode) { const float m = mu[k0 + kk]; v *= (mode == 1) ? (1.f - m) : m; }
        scr[kk * 33 + (lane & 31)] = v; }
    LDS_WAIT(); asm volatile("" ::: "memory");
    const int c = lane & 7;
#pragma unroll
    for (int j = 0; j < 4; ++j) { const int nn = (lane >> 3) + 8 * j; const LAS float* s = scr + (8 * c) * 33 + nn;
        u32x4 o; o.x = pkbf(s[0 * 33], s[1 * 33]); o.y = pkbf(s[2 * 33], s[3 * 33]); o.z = pkbf(s[4 * 33], s[5 * 33]); o.w = pkbf(s[6 * 33], s[7 * 33]);
        if (n0 + nn < nvalid) *(u32x4*)(WT + (size_t)(row_off + n0 + nn) * K + k0 + 8 * c) = o; }
    LDS_WAIT(); asm volatile("" ::: "memory");
}
struct WPtrs { const float *w_in, *decay_a, *iclr_a, *gate_a, *vres_a, *mu_lora, *vres_mu, *w_out, *w1, *w2, *decay_b, *iclr_b, *gate_b, *vres_b; };
__device__ __forceinline__ void ph_weights(const WPtrs& P, int l, unsigned char* ws, LAS unsigned char* lds, int vcu, int G, int tid) {
    const int wave = tid >> 6, lane = tid & 63; const int gw = vcu * NWAVES + wave, NGW = G * NWAVES;
    LAS float* scr = (LAS float*)(lds + wave * 16384);
    bf16_t* WIN = (bf16_t*)(ws + WS_WIN); bf16_t* WOUT = (bf16_t*)(ws + WS_WOUT); bf16_t* W1 = (bf16_t*)(ws + WS_W1); bf16_t* W2 = (bf16_t*)(ws + WS_W2);
    constexpr int I_IN = 16 * 115, I_D = 16 * 2, I_G = 16 * 4, I_V = 16 * 1, I_O = 16 * 32, I_1 = 16 * 128, I_2 = 64 * 32;
    constexpr int I_LO = 2 * I_D + I_G + I_V; constexpr int NITEMS = I_IN + 2 * I_LO + I_O + I_1 + I_2;
    for (int it = gw; it < NITEMS; it += NGW) {
        int r = it;
        if (r < I_IN) { tr_item(P.w_in + (size_t)l * D * 3656, 3656, 3656, D, WIN, 0, scr, r / 115, r % 115, lane, nullptr, 0); continue; } r -= I_IN;
        if (r < 2 * I_LO) { const int md = (r < I_LO) ? 1 : 2; int q = (r < I_LO) ? r : r - I_LO; const int rbase = (md == 1) ? C_P1 : C_P2;
            if (q < I_D) { tr_item(P.decay_a + (size_t)l * D * 64, 64, 64, D, WIN, rbase + 0, scr, q / 2, q % 2, lane, P.mu_lora + (size_t)(l * 3 + 0) * D, md); continue; } q -= I_D;
            if (q < I_D) { tr_item(P.iclr_a + (size_t)l * D * 64, 64, 64, D, WIN, rbase + 64, scr, q / 2, q % 2, lane, P.mu_lora + (size_t)(l * 3 + 1) * D, md); continue; } q -= I_D;
            if (q < I_G) { tr_item(P.gate_a + (size_t)l * D * 128, 128, 128, D, WIN, rbase + 128, scr, q / 4, q % 4, lane, P.mu_lora + (size_t)(l * 3 + 2) * D, md); continue; } q -= I_G;
            if (l >= 1) tr_item(P.vres_a + (size_t)(l - 1) * D * 32, 32, 32, D, WIN, rbase + 256, scr, q, 0, lane, P.vres_mu + (size_t)(l - 1) * D, md);
            continue; }
        r -= 2 * I_LO;
        if (r < I_O) { tr_item(P.w_out + (size_t)l * D * D, D, D, D, WOUT, 0, scr, r / 32, r % 32, lane, nullptr, 0); continue; } r -= I_O;
        if (r < I_1) { tr_item(P.w1 + (size_t)l * D * FF, FF, FF, D, W1, 0, scr, r / 128, r % 128, lane, nullptr, 0); continue; } r -= I_1;
        tr_item(P.w2 + (size_t)l * FF * D, D, D, FF, W2, 0, scr, r / 32, r % 32, lane, nullptr, 0);
    }
    const int gt = vcu * 512 + tid, NGT = G * 512;
    { const int nzr = (NP - C_END) + (l == 0 ? 64 : 0);
      for (int i = gt; i < nzr * 128; i += NGT) { const int zr = i >> 7, ch = i & 127; int row;
          if (zr < NP - C_END) row = C_END + zr; else { const int z2 = zr - (NP - C_END); row = (z2 < 32) ? (C_P1 + 256 + z2) : (C_P2 + 256 + z2 - 32); }
          *(u32x4*)(WIN + (size_t)row * D + ch * 8) = (u32x4){0u, 0u, 0u, 0u}; } }
    { bf16_t* LW = (bf16_t*)(ws + WS_LW);
      for (int i = gt; i < 2048 * 128; i += NGT) { const int n = i >> 7, k = i & 127; float v = 0.f;
          if (n < 512) { if (k < 64) v = P.decay_b[((size_t)l * 64 + k) * 512 + n]; }
          else if (n < 1024) { if (k >= 64) v = P.iclr_b[((size_t)l * 64 + (k - 64)) * 512 + (n - 512)]; }
          else if (n < 1536) { v = P.gate_b[((size_t)l * 128 + k) * 512 + (n - 1024)]; }
          else { if (l >= 1 && k < 32) v = P.vres_b[((size_t)(l - 1) * 32 + k) * 512 + (n - 1536)]; }
          LW[i] = (bf16_t)(pkbf(v, 0.f) & 0xffffu); } }
}

__device__ __forceinline__ void ph_norm(const float* X, const float* g, const float* sh, const float* sc, bf16_t* Hout, int gw, int NGW, int lane) {
    for (int m = gw; m < M; m += NGW) { const int b = m >> 12;
        const f32x4* xr = (const f32x4*)(X + (size_t)m * D) + lane; f32x4 v[4]; float s = 0.f;
#pragma unroll
        for (int j = 0; j < 4; ++j) { v[j] = xr[64 * j]; s += (v[j][0] * v[j][0] + v[j][1] * v[j][1]) + (v[j][2] * v[j][2] + v[j][3] * v[j][3]); }
        const float rstd = rsqrtf(wave_sum(s) * (1.f / D) + 1e-6f);
        u32x2* o8 = (u32x2*)(Hout + (size_t)m * D) + lane;
#pragma unroll
        for (int j = 0; j < 4; ++j) { const int c = 256 * j + 4 * lane;
            const f32x4 gv = *(const f32x4*)(g + c), sv = *(const f32x4*)(sc + (size_t)b * 6144 + c), hv = *(const f32x4*)(sh + (size_t)b * 6144 + c);
            const f32x4 y = v[j] * rstd * gv * (sv + 1.f) + hv;
            u32x2 w; w.x = pkbf(y[0], y[1]); w.y = pkbf(y[2], y[3]); o8[64 * j] = w; } }
}
__device__ __forceinline__ void ph_final_norm(float* X, const float* g, int gw, int NGW, int lane) {
    for (int m = gw; m < M; m += NGW) {
        f32x4* xr = (f32x4*)(X + (size_t)m * D) + lane; f32x4 v[4]; float s = 0.f;
#pragma unroll
        for (int j = 0; j < 4; ++j) { v[j] = xr[64 * j]; s += (v[j][0] * v[j][0] + v[j][1] * v[j][1]) + (v[j][2] * v[j][2] + v[j][3] * v[j][3]); }
        const float rstd = rsqrtf(wave_sum(s) * (1.f / D) + 1e-6f);
#pragma unroll
        for (int j = 0; j < 4; ++j) { const f32x4 gv = *(const f32x4*)(g + 256 * j + 4 * lane); xr[64 * j] = v[j] * rstd * gv; } }
}

__device__ __forceinline__ void ph_lora_act(const bf16_t* PROJ, bf16_t* LACT, bf16_t* VF, const float* mu_v  , bool write_v, int gw, int NGW, int lane) {
    float muv[8];
#pragma unroll
    for (int i = 0; i < 8; ++i) muv[i] = mu_v[lane * 8 + i];
    for (int m = gw; m < M; m += NGW) { const int t = m & (T - 1);
        if (lane < 36) {
            const u32x4 p1 = *(const u32x4*)(PROJ + (size_t)m * NP + C_P1 + lane * 8);
            u32x4 p2 = (u32x4){0u, 0u, 0u, 0u}; if (t > 0) p2 = *(const u32x4*)(PROJ + (size_t)(m - 1) * NP + C_P2 + lane * 8);
            float x[8];
#pragma unroll
            for (int i = 0; i < 4; ++i) { x[2 * i] = bfl(p1[i]) + bfl(p2[i]); x[2 * i + 1] = bfh(p1[i]) + bfh(p2[i]); }
            if (lane < 8) {
#pragma unroll
                for (int i = 0; i < 8; ++i) x[i] = 1.f - 2.f / (__expf(2.f * x[i]) + 1.f);
            } else if (lane >= 16 && lane < 32) {
#pragma unroll
                for (int i = 0; i < 8; ++i) x[i] = 1.f / (1.f + __expf(-x[i]));
            }
            u32x4 w; w.x = pkbf(x[0], x[1]); w.y = pkbf(x[2], x[3]); w.z = pkbf(x[4], x[5]); w.w = pkbf(x[6], x[7]);
            *(u32x4*)(LACT + (size_t)m * LA + lane * 8) = w;
        } else if (lane < 48) { *(u32x4*)(LACT + (size_t)m * LA + lane * 8) = (u32x4){0u, 0u, 0u, 0u}; }
        if (write_v) {
            const u32x4 vc = *(const u32x4*)(PROJ + (size_t)m * NP + C_V + lane * 8);
            u32x4 vp = (u32x4){0u, 0u, 0u, 0u}; if (t > 0) vp = *(const u32x4*)(PROJ + (size_t)(m - 1) * NP + C_V + lane * 8);
            float y[8];
#pragma unroll
            for (int i = 0; i < 4; ++i) { const float c0 = bfl(vc[i]), c1 = bfh(vc[i]); y[2 * i] = c0 + (bfl(vp[i]) - c0) * muv[2 * i]; y[2 * i + 1] = c1 + (bfh(vp[i]) - c1) * muv[2 * i + 1]; }
            u32x4 w; w.x = pkbf(y[0], y[1]); w.y = pkbf(y[2], y[3]); w.z = pkbf(y[4], y[5]); w.w = pkbf(y[6], y[7]);
            *(u32x4*)(VF + (size_t)m * 512 + lane * 8) = w;
        }
    }
}

__device__ __forceinline__ unsigned sortable(float s) { const unsigned u = __float_as_uint(s + 0.f); return u ^ ((u >> 31) ? 0xFFFFFFFFu : 0x80000000u); }
__device__ __forceinline__ void ph_select(const bf16_t* PROJ, unsigned long long* MASK, LAS unsigned char* lds, int vcu, int G, int tid) {
    const int lane = tid & 63, wid = __builtin_amdgcn_readfirstlane(tid >> 6), r32 = lane & 31, hi = lane >> 5;
    LAS unsigned* SC = (LAS unsigned*)lds;
    LAS unsigned* HI = (LAS unsigned*)(lds + HIST_OFF) + wid * 256;
    const float WSC = 0.35355339059f * 0.125f;
    for (int it = 0;; ++it) {
        const int tsk = vcu + it * G; if (tsk >= NB * 512) break;
        const int b = tsk & 7, j = tsk >> 3, base = j & 31, rnd = j >> 5;
        const int q8 = (rnd & 1) ? (32 * rnd + 31 - base) : (32 * rnd + base);
        const int q0 = q8 * 8, nblk = (q0 >> 5) + 1; const size_t rb = (size_t)b * T;
        bf16x8 Af[2][4]; float wv[2][16];
        { const int ql = (r32 >> 4) * 2 + ((r32 >> 2) & 1), hd = (r32 & 3) + 4 * ((r32 >> 3) & 1);
#pragma unroll
          for (int tq = 0; tq < 2; ++tq)
#pragma unroll
              for (int ks = 0; ks < 4; ++ks) Af[tq][ks] = *(const bf16x8*)(PROJ + (rb + q0 + tq * 4 + ql) * NP + C_QI + hd * 64 + ks * 16 + hi * 8);
#pragma unroll
          for (int tq = 0; tq < 2; ++tq)
#pragma unroll
              for (int g = 0; g < 2; ++g) { const u32x4 w8 = *(const u32x4*)(PROJ + (rb + q0 + tq * 4 + 2 * g + hi) * NP + C_WI);
#pragma unroll
                  for (int x = 0; x < 4; ++x) { wv[tq][8 * g + 2 * x] = bfl(w8[x]) * WSC; wv[tq][8 * g + 2 * x + 1] = bfh(w8[x]) * WSC; } } }
        for (int blk = wid; blk < nblk; blk += 8) {
            const int key = blk * 32 + r32; bf16x8 Bf[4];
#pragma unroll
            for (int ks = 0; ks < 4; ++ks) Bf[ks] = *(const bf16x8*)(PROJ + (rb + key) * NP + C_KI + ks * 16 + hi * 8);
#pragma unroll
            for (int tq = 0; tq < 2; ++tq) { f32x16 acc = {};
#pragma unroll
                for (int ks = 0; ks < 4; ++ks) acc = __builtin_amdgcn_mfma_f32_32x32x16_f16(__builtin_bit_cast(pg8::half8, Af[tq][ks]), __builtin_bit_cast(pg8::half8, Bf[ks]), acc, 0, 0, 0);
#pragma unroll
                for (int g = 0; g < 2; ++g) { float s = 0.f;
#pragma unroll
                    for (int x = 0; x < 8; ++x) s += wv[tq][8 * g + x] * fmaxf(acc[8 * g + x], 0.f);
                    const int ql = tq * 4 + 2 * g + hi; const int qp = q0 + ql;
                    SC[ql * 4096 + key] = (key > qp) ? 0u : sortable(s); } }
        }
        __syncthreads();
        {
            const int qp = q0 + wid; unsigned long long myword = 0ull;
            if (qp < 256) { const int lo = lane * 64; myword = (qp >= lo + 63) ? ~0ull : (qp < lo ? 0ull : ((2ull << (qp - lo)) - 1ull)); }
            else {
                LAS unsigned* sc = SC + wid * 4096; const int nscan = nblk * 32;
                unsigned prefix = 0u; int kth = 256;
                for (int p = 0; p < 4; ++p) {
                    const int shift = 24 - 8 * p;
                    HI[lane] = 0u; HI[lane + 64] = 0u; HI[lane + 128] = 0u; HI[lane + 192] = 0u;
                    LDS_WAIT();
                    for (int i = lane; i < nscan; i += 64) { const unsigned v = sc[i]; const bool c = (p == 0) ? true : ((v >> ((shift + 8) & 31)) == prefix);
                        if (c) __hip_atomic_fetch_add(HI + ((v >> shift) & 255u), 1u, __ATOMIC_RELAXED, __HIP_MEMORY_SCOPE_WORKGROUP); }
                    LDS_WAIT();
                    const u32x4 c4 = *(const LAS u32x4*)(HI + 4 * lane);
                    const int s = (int)(c4[0] + c4[1] + c4[2] + c4[3]); int incl = s;
#pragma unroll
                    for (int off = 1; off < 64; off <<= 1) { const int tt = __shfl_down(incl, off); if (lane + off < 64) incl += tt; }
                    const int above = incl - s; const bool hit = (above < kth) && (kth <= incl);
                    int beta = 0, nk = 0;
                    if (hit) { int a = above;
                        if (kth <= a + (int)c4[3]) { beta = 4 * lane + 3; nk = kth - a; } else { a += (int)c4[3];
                        if (kth <= a + (int)c4[2]) { beta = 4 * lane + 2; nk = kth - a; } else { a += (int)c4[2];
                        if (kth <= a + (int)c4[1]) { beta = 4 * lane + 1; nk = kth - a; } else { a += (int)c4[1]; beta = 4 * lane; nk = kth - a; } } } }
                    const unsigned long long hb = __ballot(hit); const int L = (int)__builtin_ctzll(hb | (1ull << 63));
                    beta = __builtin_amdgcn_readlane(beta, L); kth = __builtin_amdgcn_readlane(nk, L);
                    prefix = (prefix << 8) | (unsigned)beta;
                }
                const unsigned Tk = prefix; int eqtaken = 0;
                for (int jt = 0; jt < 64; ++jt) { unsigned long long w = 0ull;
                    if (64 * jt < nscan) { const int idx = 64 * jt + lane; const unsigned v = (idx < nscan) ? sc[idx] : 0u;
                        const bool gt = v > Tk, eq = (v == Tk); const unsigned long long beq = __ballot(eq);
                        const int rank = eqtaken + __builtin_popcountll(beq & ((1ull << lane) - 1ull));
                        w = __ballot(gt || (eq && rank < kth)); eqtaken += __builtin_popcountll(beq); }
                    if (lane == jt) myword = w; }
            }
            MASK[((size_t)b * 64 + lane) * 4096 + qp] = myword;
        }
        __syncthreads();
    }
}

constexpr int SC_BUF = 43008, SC_YB = 2 * SC_BUF, SC_END = SC_YB + 2 * 2048;
static_assert(SC_END <= RING_BYTES, "scan LDS");
struct ScanP { const bf16_t* PROJ; bf16_t* PROJw; const _Float16* E; const _Float16* A; const bf16_t* VF; const float *mu_r, *mu_k, *k_k, *k_a, *r_k; };
__device__ __forceinline__ void scan_unit(const ScanP& P, int b, int h, int q4, LAS unsigned char* lds, int tid) {
    const int wave = __builtin_amdgcn_readfirstlane(tid >> 6), lane = tid & 63;
    const size_t rb = (size_t)b * T;
    if (wave >= 4) {
        const int pt = tid - 256, tl = pt >> 3, cg = pt & 7; const int ch0 = h * 64 + cg * 8;
        float mur[8], muk[8], kkp[8], kap[8], rkp[8];
#pragma unroll
        for (int i = 0; i < 8; ++i) { mur[i] = P.mu_r[ch0 + i]; muk[i] = P.mu_k[ch0 + i]; kkp[i] = P.k_k[ch0 + i]; kap[i] = P.k_a[ch0 + i]; rkp[i] = P.r_k[ch0 + i]; }
        for (int c = -1; c < T / 32; ++c) {
            if (c >= 0) {
                if (c >= 1) { const LAS float* YB = (const LAS float*)(lds + SC_YB + ((c - 1) & 1) * 2048); const int t = (c - 1) * 32 + tl;
                    const float y0 = YB[tl * 16 + 2 * cg], y1 = YB[tl * 16 + 2 * cg + 1];
                    *(unsigned*)(P.PROJw + (rb + t) * NP + C_Y + h * 64 + q4 * 16 + 2 * cg) = pkbf(y0, y1); }
            }
            if (c + 1 < T / 32) {
                const int cn = c + 1; LAS unsigned char* buf = lds + (cn & 1) * SC_BUF; const int t = cn * 32 + tl; const size_t m = rb + t;
                const u32x4 rc = *(const u32x4*)(P.PROJ + m * NP + C_R + ch0), kc = *(const u32x4*)(P.PROJ + m * NP + C_K + ch0);
                u32x4 rp = (u32x4){0u, 0u, 0u, 0u}, kp = (u32x4){0u, 0u, 0u, 0u};
                if (t > 0) { rp = *(const u32x4*)(P.PROJ + (m - 1) * NP + C_R + ch0); kp = *(const u32x4*)(P.PROJ + (m - 1) * NP + C_K + ch0); }
                const u32x4 e8 = *(const u32x4*)(P.E + m * 512 + ch0), a8 = *(const u32x4*)(P.A + m * 512 + ch0);
                const unsigned v2 = *(const unsigned*)(P.VF + m * 512 + h * 64 + q4 * 16 + 2 * cg);
                float r_[8], kl[8], kkv[8], a_[8], e_[8]; float ss = 0.f;
#pragma unroll
                for (int i = 0; i < 8; ++i) { const unsigned wr_ = rc[i >> 1], wrp = rp[i >> 1], wk_ = kc[i >> 1], wkp = kp[i >> 1];
                    const float xr = (i & 1) ? bfh(wr_) : bfl(wr_), xrp = (i & 1) ? bfh(wrp) : bfl(wrp), xk = (i & 1) ? bfh(wk_) : bfl(wk_), xkp = (i & 1) ? bfh(wkp) : bfl(wkp);
                    r_[i] = xr + (xrp - xr) * mur[i]; kl[i] = xk + (xkp - xk) * muk[i]; kkv[i] = kl[i] * kkp[i]; ss += kkv[i] * kkv[i];
                    const pg8::f16x2_t eh = __builtin_bit_cast(pg8::f16x2_t, e8[i >> 1]), ah = __builtin_bit_cast(pg8::f16x2_t, a8[i >> 1]);
                    e_[i] = -0.60653065971f * pg8::sigmoidf_((float)eh[i & 1]); a_[i] = pg8::sigmoidf_((float)ah[i & 1]); }
                ss = allsum8(ss);
                const float inv = 1.0f / fmaxf(sqrtf(ss), 1e-12f);
                float kp_[8], kk_[8], nb_[8], dc_[8]; float rk = 0.f;
#pragma unroll
                for (int i = 0; i < 8; ++i) { kk_[i] = kkv[i] * inv; kp_[i] = kl[i] * (1.f + (a_[i] - 1.f) * kap[i]); nb_[i] = -kk_[i] * a_[i]; dc_[i] = __expf(e_[i]); rk += r_[i] * kp_[i] * rkp[i]; }
                rk = allsum8(rk);
                LAS float* Rb = (LAS float*)buf + tl * 64 + cg * 8;
                *(LAS f32x4*)(Rb) = (f32x4){r_[0], r_[1], r_[2], r_[3]}; *(LAS f32x4*)(Rb + 4) = (f32x4){r_[4], r_[5], r_[6], r_[7]};
                *(LAS f32x4*)(Rb + 2048) = (f32x4){dc_[0], dc_[1], dc_[2], dc_[3]}; *(LAS f32x4*)(Rb + 2048 + 4) = (f32x4){dc_[4], dc_[5], dc_[6], dc_[7]};
                *(LAS f32x4*)(Rb + 4096) = (f32x4){kp_[0], kp_[1], kp_[2], kp_[3]}; *(LAS f32x4*)(Rb + 4096 + 4) = (f32x4){kp_[4], kp_[5], kp_[6], kp_[7]};
                *(LAS f32x4*)(Rb + 6144) = (f32x4){kk_[0], kk_[1], kk_[2], kk_[3]}; *(LAS f32x4*)(Rb + 6144 + 4) = (f32x4){kk_[4], kk_[5], kk_[6], kk_[7]};
                *(LAS f32x4*)(Rb + 8192) = (f32x4){nb_[0], nb_[1], nb_[2], nb_[3]}; *(LAS f32x4*)(Rb + 8192 + 4) = (f32x4){nb_[4], nb_[5], nb_[6], nb_[7]};
                LAS float* VV = (LAS float*)(buf + 40960); VV[tl * 16 + 2 * cg] = bfl(v2); VV[tl * 16 + 2 * cg + 1] = bfh(v2);
                if (q4 == 0 && cg == 0) P.PROJw[m * NP + C_RK + h] = (bf16_t)(pkbf(rk, 0.f) & 0xffffu);
            }
            __syncthreads();
        }
        {
            const int c = T / 32; const LAS float* YB = (const LAS float*)(lds + SC_YB + ((c - 1) & 1) * 2048); const int t = (c - 1) * 32 + tl;
            const float y0 = YB[tl * 16 + 2 * cg], y1 = YB[tl * 16 + 2 * cg + 1];
            *(unsigned*)(P.PROJw + (rb + t) * NP + C_Y + h * 64 + q4 * 16 + 2 * cg) = pkbf(y0, y1);
        }
    } else {
        const int rl = lane >> 4, kg = lane & 15, row = wave * 4 + rl;
        f32x4 S = {0.f, 0.f, 0.f, 0.f};
        __syncthreads();
        for (int c = 0; c < T / 32; ++c) {
            const LAS float* buf = (const LAS float*)(lds + (c & 1) * SC_BUF); LAS float* YB = (LAS float*)(lds + SC_YB + (c & 1) * 2048);
#pragma unroll 4
            for (int t = 0; t < 32; ++t) {
                const f32x4 r4 = *(const LAS f32x4*)(buf + t * 64 + kg * 4), d4 = *(const LAS f32x4*)(buf + 2048 + t * 64 + kg * 4), k4 = *(const LAS f32x4*)(buf + 4096 + t * 64 + kg * 4),
                            q4_ = *(const LAS f32x4*)(buf + 6144 + t * 64 + kg * 4), n4 = *(const LAS f32x4*)(buf + 8192 + t * 64 + kg * 4);
                const float v = buf[10240 + t * 16 + row];
                float sk = (S[0] * q4_[0] + S[1] * q4_[1]) + (S[2] * q4_[2] + S[3] * q4_[3]);
                sk = allsum16(sk);
                S = S * d4 + n4 * sk + k4 * v;
                float y = (S[0] * r4[0] + S[1] * r4[1]) + (S[2] * r4[2] + S[3] * r4[3]);
                y = allsum16(y);
                if (kg == 0) YB[t * 16 + row] = y;
            }
            __syncthreads();
        }
    }
    __syncthreads();
}

__device__ __forceinline__ void ph_scan_naive(const ScanP& P, int gw, int NGW, int lane) {
    for (int task = gw; task < 4096; task += NGW) { const int b = task >> 9, h = (task >> 6) & 7, row = task & 63; const int ch = h * 64 + lane;
        const float mur = P.mu_r[ch], muk = P.mu_k[ch], kkp = P.k_k[ch], kap = P.k_a[ch], rkp = P.r_k[ch];
        float S = 0.f, rprev = 0.f, kprev = 0.f;
        for (int t = 0; t < T; ++t) { const size_t m = (size_t)b * 4096 + t;
            const float rc = bf1(P.PROJ[m * NP + C_R + ch]), kc = bf1(P.PROJ[m * NP + C_K + ch]);
            const float r = rc + (rprev - rc) * mur, kl = kc + (kprev - kc) * muk; rprev = rc; kprev = kc;
            const float a = pg8::sigmoidf_((float)P.A[m * 512 + ch]); const float dec = __expf(-0.60653065971f * pg8::sigmoidf_((float)P.E[m * 512 + ch]));
            const float kkv = kl * kkp; const float ss = wave_sum(kkv * kkv); const float kk = kkv / fmaxf(sqrtf(ss), 1e-12f);
            const float kp = kl * (1.f + (a - 1.f) * kap); const float v = bf1(P.VF[m * 512 + h * 64 + row]);
            const float sk = wave_sum(S * kk); S = S * dec - sk * kk * a + v * kp; const float y = wave_sum(S * r);
            if (lane == 0) P.PROJw[m * NP + C_Y + h * 64 + row] = (bf16_t)(pkbf(y, 0.f) & 0xffffu);
            if (row == 0) { const float rk = wave_sum(r * kp * rkp); if (lane == 0) P.PROJw[m * NP + C_RK + h] = (bf16_t)(pkbf(rk, 0.f) & 0xffffu); } } }
}

__device__ __forceinline__ void ph_rwkv_post(const bf16_t* PROJ, const bf16_t* VF, bf16_t* MIX, const float* lnx_g, const float* lnx_b, int gw, int NGW, int lane) {
    float lg[8], lb[8];
#pragma unroll
    for (int i = 0; i < 8; ++i) { lg[i] = lnx_g[lane * 8 + i]; lb[i] = lnx_b[lane * 8 + i]; }
    for (int m = gw; m < M; m += NGW) {
        const u32x4 y8 = *(const u32x4*)(PROJ + (size_t)m * NP + C_Y + lane * 8), v8 = *(const u32x4*)(VF + (size_t)m * 512 + lane * 8), g8 = *(const u32x4*)(MIX + (size_t)m * D + lane * 8);
        const float rk = bf1(PROJ[(size_t)m * NP + C_RK + (lane >> 3)]);
        float y[8]; float s = 0.f;
#pragma unroll
        for (int i = 0; i < 4; ++i) { y[2 * i] = bfl(y8[i]); y[2 * i + 1] = bfh(y8[i]); s += y[2 * i] + y[2 * i + 1]; }
        const float mean = allsum8(s) * (1.f / 64.f); float q = 0.f;
#pragma unroll
        for (int i = 0; i < 8; ++i) { y[i] -= mean; q += y[i] * y[i]; }
        const float rstd = rsqrtf(allsum8(q) * (1.f / 64.f) + 64e-5f);
        float o[8];
#pragma unroll
        for (int i = 0; i < 8; ++i) { const float vv = (i & 1) ? bfh(v8[i >> 1]) : bfl(v8[i >> 1]), gg = (i & 1) ? bfh(g8[i >> 1]) : bfl(g8[i >> 1]);
            o[i] = (y[i] * rstd * lg[i] + lb[i] + rk * vv) * gg; }
        u32x4 w; w.x = pkbf(o[0], o[1]); w.y = pkbf(o[2], o[3]); w.z = pkbf(o[4], o[5]); w.w = pkbf(o[6], o[7]);
        *(u32x4*)(MIX + (size_t)m * D + lane * 8) = w;
    }
}

#ifndef MK_PER_PHASE
#define MK_PER_PHASE 0
#endif
constexpr int N_PHASES = 22;
struct Args { const float* in[32]; float* out; unsigned char* ws; int ph_lo, ph_hi, li, pad; };
__device__ __forceinline__ int opq(int k) { asm volatile("" : "+s"(k)); return k; }
#define INP(k) (args.in[opq(k)])
#define WSP(T_, off) ((T_*)(wsl + (off)))
#define LAUNDER_WS() unsigned char* wsl = args.ws; asm volatile("" : "+s"(wsl)); int wave = wave_s; asm volatile("" : "+s"(wave)); \
    unsigned ones_ = ~0u; asm volatile("" : "+s"(ones_)); int tid = wave * 64 + (int)__builtin_amdgcn_mbcnt_hi(ones_, __builtin_amdgcn_mbcnt_lo(ones_, 0u)); asm volatile("" : "+v"(tid)); int G = gridDim.x, bx = blockIdx.x; asm volatile("" : "+s"(G), "+s"(bx)); \
    const int lane = tid & 63; const int vcu = (G % 8 == 0) ? (bx % 8) * (G / 8) + bx / 8 : bx; const int gw = vcu * NWAVES + wave, NGW = G * NWAVES; (void)lane; (void)gw; (void)NGW; (void)vcu
#ifndef PH_MASK
#define PH_MASK 0xFFFFu
#endif
#define PHBIT(k) ((k) == 0 ? 0 : ((k) == 21 ? 11 : (((k) - 1) % 10) + 1))
#define IN(k) (((PH_MASK >> PHBIT(k)) & 1u) && lo <= (k) && (k) < hi)
#define SEAM(k) do { if (IN(k) && IN((k) + 1)) { XcdBarrier b2_ = bar; asm volatile("" : "+s"(b2_.bar), "+s"(b2_.x)); xcd_barrier(b2_); } } while (0)
template <int l> __device__ __forceinline__ void layer_body(const Args& args, LAS unsigned char* lds, const XcdBarrier& bar, float* X, const int lo, const int hi, const int wave_s) {
        const int pb = 1 + 10 * l;
        if (IN(pb + 0)) { LAUNDER_WS();
            WPtrs P; P.w_in = INP(6); P.decay_a = INP(10); P.iclr_a = INP(13); P.gate_a = INP(15); P.vres_a = INP(24); P.mu_lora = INP(8); P.vres_mu = INP(22);
            P.w_out = INP(28); P.w1 = INP(29); P.w2 = INP(30); P.decay_b = INP(11); P.iclr_b = INP(14); P.gate_b = INP(16); P.vres_b = INP(25);
            ph_weights(P, l, wsl, lds, vcu, G, tid);
            const float* MODl = WSP(float, WS_MOD) + (size_t)l * 8 * 6144;
            ph_norm((l == 0) ? INP(0) : (const float*)X, INP(4) + (size_t)l * D, MODl + 0 * D, MODl + 1 * D, WSP(bf16_t, WS_H), gw, NGW, lane);
        }
        SEAM(pb + 0);
        if (IN(pb + 1)) { LAUNDER_WS();
            pg8::Gemm g{WSP(bf16_t, WS_H), WSP(bf16_t, WS_WIN), M, NP, D, D, D}; pg8::StaticOrder S; S.init(M, NP, G, bx);
            pg8::EpiBf<0> E{WSP(bf16_t, WS_PROJ), NP, C_QA / 256, C_KA / 256, att::C2};
            pg8::gemm_phase<pg8::EpiBf<0>, pg8::StaticOrder, true, true>(lds, g, S, E, tid);
        }
        SEAM(pb + 1);
        if (IN(pb + 2)) { LAUNDER_WS();
            ph_lora_act(WSP(bf16_t, WS_PROJ), WSP(bf16_t, WS_LACT), WSP(bf16_t, WS_VF), INP(7) + (size_t)(l * 3 + 2) * 512, l == 0, gw, NGW, lane);
            ph_select(WSP(bf16_t, WS_PROJ), WSP(unsigned long long, WS_MASK), lds, vcu, G, tid);
        }
        SEAM(pb + 2);
        if (IN(pb + 3)) {
            { LAUNDER_WS(); pg8::Gemm g{WSP(bf16_t, WS_LACT), WSP(bf16_t, WS_LW), M, 1024, 128, LA, 128}; pg8::StaticOrder S; S.init(M, 1024, G, bx);
              pg8::EpiDecIclr E{WSP(_Float16, WS_H), WSP(_Float16, WS_H + 32 * MiB), INP(9) + (size_t)l * 512, INP(12) + (size_t)l * 512};
              pg8::gemm_phase<pg8::EpiDecIclr, pg8::StaticOrder, true, true>(lds, g, S, E, tid); }
            __syncthreads();
            { LAUNDER_WS(); pg8::Gemm g{WSP(bf16_t, WS_LACT) + 128, WSP(bf16_t, WS_LW) + 1024 * 128, M, 512, 128, LA, 128}; pg8::StaticOrder S; S.init(M, 512, G, bx);
              pg8::EpiBf<0> E{WSP(bf16_t, WS_MIX), D, 0, 0, 1.f};
              pg8::gemm_phase<pg8::EpiBf<0>, pg8::StaticOrder, true, true>(lds, g, S, E, tid); }
            __syncthreads();
            if (l >= 1) { LAUNDER_WS(); pg8::Gemm g{WSP(bf16_t, WS_LACT) + 256, WSP(bf16_t, WS_LW) + 1536 * 128, M, 512, 128, LA, 128}; pg8::StaticOrder S; S.init(M, 512, G, bx);
              pg8::EpiVres E{WSP(bf16_t, WS_PROJ) + C_V, NP, WSP(bf16_t, WS_VF), INP(23) + (size_t)(l - 1) * 512, INP(7) + (size_t)(l * 3 + 2) * 512};
              pg8::gemm_phase<pg8::EpiVres, pg8::StaticOrder, true, true>(lds, g, S, E, tid); }
        }
        SEAM(pb + 3);
        if (IN(pb + 4)) {
            { LAUNDER_WS();
              ScanP P; P.PROJ = WSP(bf16_t, WS_PROJ); P.PROJw = WSP(bf16_t, WS_PROJ); P.E = WSP(_Float16, WS_H); P.A = WSP(_Float16, WS_H + 32 * MiB); P.VF = WSP(bf16_t, WS_VF);
              P.mu_r = INP(7) + (size_t)(l * 3 + 0) * 512; P.mu_k = INP(7) + (size_t)(l * 3 + 1) * 512;
              P.k_k = INP(17) + (size_t)l * 512; P.k_a = INP(18) + (size_t)l * 512; P.r_k = INP(19) + (size_t)l * 512;
#ifdef SCAN_FAST
              for (int u = vcu; u < 256; u += G) scan_unit(P, u >> 5, (u >> 2) & 7, u & 3, lds, tid); }
#else
              ph_scan_naive(P, gw, NGW, lane); }
#endif
            __syncthreads();
            { LAUNDER_WS();
              att::build_bias_table(INP(27), (LAS char*)lds, tid);
              __syncthreads();
              const float* gain = INP(26) + (size_t)l * 512;
              for (int v = vcu; v < 256; v += G) { const int bh = v >> 2, s = v & 3;
                  for (int i = 0; i < 4; ++i) { const int qb = (i == 0) ? s : (i == 1) ? 7 - s : (i == 2) ? 8 + s : 15 - s;
                      att::attn_unit(bh >> 3, bh & 7, qb, WSP(bf16_t, WS_PROJ), WSP(unsigned long long, WS_MASK), WSP(bf16_t, WS_MIX), gain, (LAS char*)lds, tid); } } }
        }
        SEAM(pb + 4);
        if (IN(pb + 5)) { LAUNDER_WS(); ph_rwkv_post(WSP(bf16_t, WS_PROJ), WSP(bf16_t, WS_VF), WSP(bf16_t, WS_MIX), INP(20) + (size_t)l * 512, INP(21) + (size_t)l * 512, gw, NGW, lane); }
        SEAM(pb + 5);
        if (IN(pb + 6)) { LAUNDER_WS();
            pg8::Gemm g{WSP(bf16_t, WS_MIX), WSP(bf16_t, WS_WOUT), M, D, D, D, D}; pg8::StaticOrder S; S.init(M, D, G, bx);
            pg8::EpiResid E{(l == 0) ? INP(0) : (const float*)X, X, WSP(float, WS_MOD) + (size_t)l * 8 * 6144 + 2 * D, D};
            pg8::gemm_phase<pg8::EpiResid, pg8::StaticOrder, true, true>(lds, g, S, E, tid);
        }
        SEAM(pb + 6);
        if (IN(pb + 7)) { LAUNDER_WS(); const float* MODl = WSP(float, WS_MOD) + (size_t)l * 8 * 6144;
            ph_norm(X, INP(5) + (size_t)l * D, MODl + 3 * D, MODl + 4 * D, WSP(bf16_t, WS_H), gw, NGW, lane); }
        SEAM(pb + 7);
        if (IN(pb + 8)) { LAUNDER_WS();
            pg8::Gemm g{WSP(bf16_t, WS_H), WSP(bf16_t, WS_W1), M, FF, D, D, D}; pg8::StaticOrder S; S.init(M, FF, G, bx);
            pg8::EpiBf<1> E{WSP(bf16_t, WS_PROJ), FF, 0, 0, 1.f};
            pg8::gemm_phase<pg8::EpiBf<1>, pg8::StaticOrder, true, true>(lds, g, S, E, tid);
        }
        SEAM(pb + 8);
        if (IN(pb + 9)) { LAUNDER_WS();
            pg8::Gemm g{WSP(bf16_t, WS_PROJ), WSP(bf16_t, WS_W2), M, D, FF, FF, FF}; pg8::StaticOrder S; S.init(M, D, G, bx);
            pg8::EpiResid E{X, X, WSP(float, WS_MOD) + (size_t)l * 8 * 6144 + 5 * D, D};
            pg8::gemm_phase<pg8::EpiResid, pg8::StaticOrder, true, true>(lds, g, S, E, tid);
        }
        SEAM(pb + 9);
}
__global__ void __launch_bounds__(NWAVES * 64, 2) trunk_fwd(Args args) {
    extern __shared__ __attribute__((aligned(16))) unsigned char lds_raw[];
    LAS unsigned char* lds = (LAS unsigned char*)lds_raw;
    volatile LAS unsigned* MISC = (volatile LAS unsigned*)(lds + MISC_OFF);
    unsigned* ctl = (unsigned*)(args.ws + WS_CTL);
    for (int u = threadIdx.x; u < (LDS_BYTES - LDSCTL_OFF) / 4; u += NWAVES * 64) ((LAS unsigned*)(lds + LDSCTL_OFF))[u] = 0u;
    __syncthreads();
    XcdBarrier bar = xcd_barrier_post(ctl + CW_BAR + args.li * XCD_BAR_WORDS, MISC + 8);
    const int lo = args.ph_lo, hi = args.ph_hi; const int wave_s = __builtin_amdgcn_readfirstlane((int)threadIdx.x >> 6);
    float* X = args.out;

    if (IN(0)) { LAUNDER_WS(); ph_mod(INP(1), INP(2), INP(3), WSP(float, WS_MOD), lds, vcu, G, tid); }
    SEAM(0);

    layer_body<0>(args, lds, bar, X, lo, hi, wave_s);
    layer_body<1>(args, lds, bar, X, lo, hi, wave_s);
    if (IN(21)) { LAUNDER_WS(); (void)wsl; ph_final_norm(X, INP(31), gw, NGW, lane); }
#undef IN
#undef SEAM
}

extern "C" void kernel_launch(void* const* d_in, const int* in_sizes, int n_in, void* d_out, int out_size, void* d_ws, size_t ws_size, hipStream_t stream) {
    static int grid = 0;
    if (grid == 0) {
        if (n_in != 32 || in_sizes[0] != M * D || out_size != M * D || ws_size < WS_END) { fprintf(stderr, "kernel_launch: unexpected problem: n_in %d in0 %d out %d ws %zu (need %zu)\n", n_in, n_in > 0 ? in_sizes[0] : -1, out_size, ws_size, (size_t)WS_END); grid = -1; return; }
        int dev = 0, cus = 0, per_cu = 0;
        if (hipGetDevice(&dev) != hipSuccess || hipDeviceGetAttribute(&cus, hipDeviceAttributeMultiprocessorCount, dev) != hipSuccess) { grid = -1; return; }
        if (hipFuncSetAttribute((const void*)trunk_fwd, hipFuncAttributeMaxDynamicSharedMemorySize, LDS_BYTES) != hipSuccess) { fprintf(stderr, "kernel_launch: hipFuncSetAttribute failed\n"); grid = -1; return; }
        if (hipOccupancyMaxActiveBlocksPerMultiprocessor(&per_cu, (const void*)trunk_fwd, NWAVES * 64, LDS_BYTES) != hipSuccess || per_cu < 1) { fprintf(stderr, "kernel_launch: occupancy query reports %d workgroups per CU\n", per_cu); }
        (void)hipGetLastError();
        grid = cus;
        if (grid > 256) grid = 256;
    }
    if (grid < 0) return;
    if (hipMemsetAsync((char*)d_ws + WS_CTL, 0, CTL_ZERO_BYTES, stream) != hipSuccess) return;
    Args a{};
    for (int i = 0; i < 32; ++i) a.in[i] = (const float*)d_in[i];
    a.out = (float*)d_out; a.ws = (unsigned char*)d_ws; a.pad = 0;
#if MK_PER_PHASE
    for (int p = 0; p < N_PHASES; ++p) { a.ph_lo = p; a.ph_hi = p + 1; a.li = 0;
        hipLaunchKernelGGL(trunk_fwd, dim3(grid), dim3(NWAVES * 64), LDS_BYTES, stream, a); }
#else
    a.ph_lo = 0; a.ph_hi = N_PHASES; a.li = 0;
    hipLaunchKernelGGL(trunk_fwd, dim3(grid), dim3(NWAVES * 64), LDS_BYTES, stream, a);
#endif
}
```

```cpp
#define SCAN_FAST 1
#include <hip/hip_runtime.h>
#include <hip/hip_bf16.h>
#include <cstdio>
#include <cstdint>
#include <cmath>
namespace pg8 {
#define PG8_LAS __attribute__((address_space(3)))
typedef unsigned short bf16_t;
typedef short bf16x8 __attribute__((ext_vector_type(8)));
typedef float f32x4 __attribute__((ext_vector_type(4)));
typedef unsigned u32x4 __attribute__((ext_vector_type(4)));
constexpr int BM = 256, BK = 64, HALF = 128, HTB = HALF * BK * 2  , STAGE_BYTES = 8 * HTB, NXCD = 8, WGM = 8;

__host__ __device__ __forceinline__ int lds_byte(int r, int c) { const int st = (r >> 4) * 2 + (c >> 5), rr = r & 15, cc = c & 31, ob = rr * 64 + cc * 2; return st * 1024 + (ob ^ (((ob >> 9) & 1) << 5)); }
__host__ __device__ __forceinline__ void stage_rc(int b, int& R, int& C) { const int st = b / 1024, sb = b % 1024, swz = sb ^ (((sb >> 9) & 1) << 5); R = (st >> 1) * 16 + swz / 64; C = (st & 1) * 32 + (swz % 64) / 2; }
__host__ __device__ __forceinline__ int perm32(int rho) { const int n = rho >> 4, i = rho & 15; return 8 * (i >> 2) + 4 * n + (i & 3); }

struct Unit { int pm, pn; };
struct Gemm { const bf16_t* A; const bf16_t* Bt; int M, N, K, lda, ldb; };

struct StaticOrder {
    int nM, nN, nwg, G, c;
    __host__ __device__ void init(int M, int N, int G_, int c_) { nM = M / BM; nN = N / BM; nwg = nM * nN; G = G_; c = c_; }
    __host__ __device__ bool next(int i, Unit& u) const {
        const long L = (long)i * G + c; if (L >= nwg) return false;
        int wgid = (int)L; { const int q = nwg / NXCD, r = nwg % NXCD, xcd = wgid % NXCD, off = wgid / NXCD; wgid = (xcd < r ? xcd * (q + 1) : r * (q + 1) + (xcd - r) * q) + off; }
        const int nig = WGM * nN, gid = wgid / nig, fm = gid * WGM, gsz = (nM - fm) < WGM ? (nM - fm) : WGM;
        u.pm = fm + ((wgid % nig) % gsz); u.pn = (wgid % nig) / gsz; return true;
    }
    __device__ __forceinline__ void a_ready(const Unit&) const {}
    __device__ __forceinline__ void done(const Unit&) const {}
};

typedef _Float16 f16x2_t __attribute__((ext_vector_type(2)));
typedef _Float16 half8 __attribute__((ext_vector_type(8)));
__device__ __forceinline__ unsigned cvt_pk_bf16(float lo, float hi) { f16x2_t h = {(_Float16)lo, (_Float16)hi}; return __builtin_bit_cast(unsigned, h); }
__device__ __forceinline__ unsigned cvt_pk_f16(float lo, float hi) { f16x2_t h = {(_Float16)lo, (_Float16)hi}; return __builtin_bit_cast(unsigned, h); }
__device__ __forceinline__ float bf_lo(unsigned w) { return (float)__builtin_bit_cast(_Float16, (unsigned short)(w & 0xffffu)); }
__device__ __forceinline__ float bf_hi(unsigned w) { return (float)__builtin_bit_cast(_Float16, (unsigned short)(w >> 16)); }
__device__ __forceinline__ float sigmoidf_(float x) { return __builtin_amdgcn_rcpf(1.0f + __expf(-x)); }

template <int MODE> struct EpiBf {
    static constexpr bool PERM = true, AFTER_DRAIN = false;
    bf16_t* O; int ldc; int qlo, qhi; float qscale;
    __device__ __forceinline__ void operator()(const f32x4 (&acc)[2][2][4][2], const Unit& u, int wr, int wc, int fr, int fq) const {
        const int row0 = u.pm * BM + wr * 64 + fr, col0 = u.pn * BM + wc * 32 + 8 * fq;
        const float sc = (MODE == 0 && u.pn >= qlo && u.pn < qhi) ? qscale : 1.f;
#pragma unroll
        for (int ai = 0; ai < 2; ++ai)
#pragma unroll
            for (int m = 0; m < 4; ++m) { bf16_t* rowp = O + (size_t)(row0 + ai * HALF + m * 16) * ldc + col0;
#pragma unroll
                for (int bj = 0; bj < 2; ++bj) { f32x4 v0 = acc[ai][bj][m][0], v1 = acc[ai][bj][m][1];
                    if (MODE == 1) { v0 = __builtin_elementwise_max(v0, (f32x4){0.f, 0.f, 0.f, 0.f}); v1 = __builtin_elementwise_max(v1, (f32x4){0.f, 0.f, 0.f, 0.f}); v0 = v0 * v0; v1 = v1 * v1; }
                    else { v0 = v0 * sc; v1 = v1 * sc; }
                    u32x4 w; w.x = cvt_pk_bf16(v0[0], v0[1]); w.y = cvt_pk_bf16(v0[2], v0[3]); w.z = cvt_pk_bf16(v1[0], v1[1]); w.w = cvt_pk_bf16(v1[2], v1[3]);
                    *(u32x4*)(rowp + bj * HALF) = w; } }
    }
};
struct EpiResid {
    static constexpr bool PERM = false, AFTER_DRAIN = false;
    const float* base; float* out; const float* gate; int ldc;
    __device__ __forceinline__ void operator()(const f32x4 (&acc)[2][2][4][2], const Unit& u, int wr, int wc, int fr, int fq) const {
        const int row0 = u.pm * BM + wr * 64 + fr, col0 = u.pn * BM + wc * 32 + 4 * fq;
        const float* gp = gate + (size_t)((u.pm * BM) >> 12) * 6144 + col0;
#pragma unroll
        for (int bj = 0; bj < 2; ++bj)
#pragma unroll
            for (int n = 0; n < 2; ++n) { const f32x4 gv = *(const f32x4*)(gp + bj * HALF + n * 16);
#pragma unroll
                for (int ai = 0; ai < 2; ++ai)
#pragma unroll
                    for (int m = 0; m < 4; ++m) { const size_t off = (size_t)(row0 + ai * HALF + m * 16) * ldc + col0 + bj * HALF + n * 16;
                        const f32x4 bs = *(const f32x4*)(base + off); *(f32x4*)(out + off) = bs + gv * acc[ai][bj][m][n]; } }
    }
};
struct EpiDecIclr {
    static constexpr bool PERM = true, AFTER_DRAIN = false;
    _Float16* E; _Float16* A; const float* w0; const float* a0;
    __device__ __forceinline__ void operator()(const f32x4 (&acc)[2][2][4][2], const Unit& u, int wr, int wc, int fr, int fq) const {
        const int row0 = u.pm * BM + wr * 64 + fr; const int kind = u.pn >> 1; const int c0 = (u.pn & 1) * BM + wc * 32 + 8 * fq;
        _Float16* O = kind ? A : E; const float* bp = kind ? a0 : w0;
#pragma unroll
        for (int bj = 0; bj < 2; ++bj) { const f32x4 bv0 = *(const f32x4*)(bp + c0 + bj * HALF), bv1 = *(const f32x4*)(bp + c0 + bj * HALF + 4);
#pragma unroll
            for (int ai = 0; ai < 2; ++ai)
#pragma unroll
                for (int m = 0; m < 4; ++m) { _Float16* rowp = O + (size_t)(row0 + ai * HALF + m * 16) * 512 + c0 + bj * HALF;
                    const f32x4 v0 = acc[ai][bj][m][0] + bv0, v1 = acc[ai][bj][m][1] + bv1;
                    u32x4 w; w.x = cvt_pk_f16(v0[0], v0[1]); w.y = cvt_pk_f16(v0[2], v0[3]); w.z = cvt_pk_f16(v1[0], v1[1]); w.w = cvt_pk_f16(v1[2], v1[3]);
                    *(u32x4*)rowp = w; asm volatile("" ::: "memory"); } }
    }
};
struct EpiVres {
    static constexpr bool PERM = true, AFTER_DRAIN = false;
    const bf16_t* PV; int ldp; bf16_t* VF; const float* v0; const float* muv;
    __device__ __forceinline__ void operator()(const f32x4 (&acc)[2][2][4][2], const Unit& u, int wr, int wc, int fr, int fq) const {
        const int row0 = u.pm * BM + wr * 64 + fr; const int c0 = u.pn * BM + wc * 32 + 8 * fq;
#pragma unroll
        for (int bj = 0; bj < 2; ++bj) { const int c = c0 + bj * HALF;
            float b8[8], m8[8];
#pragma unroll
            for (int i = 0; i < 8; ++i) { b8[i] = v0[c + i]; m8[i] = muv[c + i]; }
#pragma unroll
            for (int ai = 0; ai < 2; ++ai)
#pragma unroll
                for (int m = 0; m < 4; ++m) { const int row = row0 + ai * HALF + m * 16;
                    const u32x4 vc = *(const u32x4*)(PV + (size_t)row * ldp + c);
                    u32x4 vp = (u32x4){0u, 0u, 0u, 0u}; if ((row & 4095) != 0) vp = *(const u32x4*)(PV + (size_t)(row - 1) * ldp + c);
                    const u32x4 vf = *(const u32x4*)(VF + (size_t)row * 512 + c);
                    float o[8];
#pragma unroll
                    for (int i = 0; i < 8; ++i) { const unsigned wc_ = vc[i >> 1], wp_ = vp[i >> 1], wf_ = vf[i >> 1];
                        const float xc = (i & 1) ? bf_hi(wc_) : bf_lo(wc_), xp = (i & 1) ? bf_hi(wp_) : bf_lo(wp_), xf = (i & 1) ? bf_hi(wf_) : bf_lo(wf_);
                        const float a = (i < 4) ? acc[ai][bj][m][0][i & 3] : acc[ai][bj][m][1][i & 3];
                        const float vl = xc + (xp - xc) * m8[i]; const float g = sigmoidf_(b8[i] + a); o[i] = vl + (xf - vl) * g; }
                    u32x4 w; w.x = cvt_pk_bf16(o[0], o[1]); w.y = cvt_pk_bf16(o[2], o[3]); w.z = cvt_pk_bf16(o[4], o[5]); w.w = cvt_pk_bf16(o[6], o[7]);
                    *(u32x4*)(VF + (size_t)row * 512 + c) = w; asm volatile("" ::: "memory"); } }
    }
};

template <class Epi, class Sched, bool ALIGN_EPI = false, bool SP2 = false>
__device__ __forceinline__ void gemm_phase(PG8_LAS unsigned char* lds, const Gemm g, const Sched& S, const Epi& E, const int tid) {
    const int wid = __builtin_amdgcn_readfirstlane(tid >> 6), lane = tid & 63, wr = wid >> 2, wc = wid & 3, fr = lane & 15, fq = lane >> 4;
    const int K = g.K, nt = K / BK;
    unsigned voffA[2], voffB[2];
#pragma unroll
    for (int i = 0; i < 2; ++i) { int R, C; stage_rc(tid * 16 + i * 8192, R, C); const int Rb = Epi::PERM ? ((R & ~31) + perm32(R & 31)) : R;
        voffA[i] = (unsigned)(R * g.lda + C) * 2u; voffB[i] = (unsigned)(Rb * g.ldb + C) * 2u; }
    const size_t kstep = (size_t)(BK * 2);
    const size_t hstepA = (size_t)HALF * g.lda * 2, hstepB = (size_t)HALF * g.ldb * 2;
    const size_t tstepA = 2 * hstepA, tstepB = 2 * hstepB;
    const unsigned ldsw = (unsigned)wid * 1024u;
    const int aoff = lds_byte(wr * 64 + fr, fq * 8), boff = lds_byte(wc * 32 + fr, fq * 8);
#define PG8_SA(b, h) (((b) * 2 + (h)) * HTB)
#define PG8_SB(b, h) ((4 + (b) * 2 + (h)) * HTB)
#define PG8_STAGE(bufoff, gbase, voff) do { _Pragma("unroll") for (int _i = 0; _i < 2; ++_i) \
        __builtin_amdgcn_global_load_lds((const unsigned*)((const char*)(gbase) + (voff)[_i]), (PG8_LAS unsigned*)(lds + (bufoff) + ldsw + _i * 8192), 16, 0, 0); } while (0)
#define PG8_LDA(dst, b, h) do { _Pragma("unroll") for (int m = 0; m < 4; ++m) _Pragma("unroll") for (int k = 0; k < 2; ++k) dst[m][k] = *(const PG8_LAS bf16x8*)(lds + PG8_SA(b, h) + aoff + m * 2048 + k * 1024); } while (0)
#define PG8_LDB(dst, b, h) do { _Pragma("unroll") for (int n = 0; n < 2; ++n) _Pragma("unroll") for (int k = 0; k < 2; ++k) dst[n][k] = *(const PG8_LAS bf16x8*)(lds + PG8_SB(b, h) + boff + n * 2048 + k * 1024); } while (0)
#define PG8_MMA(ai, bj, At, Bt) do { __builtin_amdgcn_s_setprio(1); _Pragma("unroll") for (int m = 0; m < 4; ++m) _Pragma("unroll") for (int n = 0; n < 2; ++n) _Pragma("unroll") for (int k = 0; k < 2; ++k) \
        acc[ai][bj][m][n] = __builtin_amdgcn_mfma_f32_16x16x32_f16(__builtin_bit_cast(half8, Bt[n][k]), __builtin_bit_cast(half8, At[m][k]), acc[ai][bj][m][n], 0, 0, 0); __builtin_amdgcn_s_setprio(0); } while (0)
#define PG8_WAIT_V(n) asm volatile("s_waitcnt vmcnt(" #n ")" ::: "memory")
#define PG8_WAIT_L(n) asm volatile("s_waitcnt lgkmcnt(" #n ")" ::: "memory")
#define PG8_BAR __builtin_amdgcn_s_barrier()
#define PG8_SCHED __builtin_amdgcn_sched_barrier(0)
    Unit cur, nxt; int ui = 0;
    if (!S.next(0, cur)) return;
    f32x4 acc[2][2][4][2];
#pragma unroll
    for (int a = 0; a < 2; ++a)
#pragma unroll
        for (int b = 0; b < 2; ++b)
#pragma unroll
            for (int m = 0; m < 4; ++m)
#pragma unroll
                for (int n = 0; n < 2; ++n) acc[a][b][m][n] = (f32x4){0.f, 0.f, 0.f, 0.f};
    bf16x8 At[4][2], B0[2][2], B1[2][2];
    const char* cA = (const char*)g.A + (size_t)cur.pm * tstepA; const char* cB = (const char*)g.Bt + (size_t)cur.pn * tstepB;
    S.a_ready(cur);
    if constexpr (SP2) {
        PG8_STAGE(PG8_SB(0, 0), cB, voffB); PG8_STAGE(PG8_SB(0, 1), cB + hstepB, voffB); PG8_STAGE(PG8_SA(0, 0), cA, voffA); PG8_STAGE(PG8_SA(0, 1), cA + hstepA, voffA);
        if (wr == 1) PG8_BAR;
        PG8_WAIT_V(2); PG8_BAR;
        PG8_STAGE(PG8_SB(1, 0), cB + kstep, voffB); PG8_STAGE(PG8_SA(1, 0), cA + kstep, voffA); PG8_STAGE(PG8_SB(1, 1), cB + hstepB + kstep, voffB);
        PG8_WAIT_V(6); PG8_BAR;
    } else {
        PG8_STAGE(PG8_SB(0, 0), cB, voffB); PG8_STAGE(PG8_SA(0, 0), cA, voffA); PG8_STAGE(PG8_SB(0, 1), cB + hstepB, voffB); PG8_STAGE(PG8_SA(0, 1), cA + hstepA, voffA);
        if (wr == 1) PG8_BAR;
        PG8_WAIT_V(4); PG8_BAR;
        PG8_STAGE(PG8_SB(1, 0), cB + kstep, voffB); PG8_STAGE(PG8_SA(1, 0), cA + kstep, voffA); PG8_STAGE(PG8_SB(1, 1), cB + hstepB + kstep, voffB);
        PG8_WAIT_V(6); PG8_BAR;
    }
    for (;;) {
        const bool has_next = S.next(ui + 1, nxt);
        const char* nA = has_next ? (const char*)g.A + (size_t)nxt.pm * tstepA : cA; const char* nB = has_next ? (const char*)g.Bt + (size_t)nxt.pn * tstepB : cB;
        for (int t = 0; t < nt; t += 2) {
            const bool last = (t == nt - 2);
            const char* a1 = cA + (size_t)(t + 1) * kstep;
            const char* a2 = last ? nA : cA + (size_t)(t + 2) * kstep; const char* b2 = last ? nB : cB + (size_t)(t + 2) * kstep;
            const char* a3 = a2 + kstep; const char* b3 = b2 + kstep;
            if (last && has_next) S.a_ready(nxt);
            if constexpr (SP2) {
            PG8_LDB(B0, 0, 0); PG8_LDB(B1, 0, 1); PG8_SCHED; PG8_LDA(At, 0, 0); PG8_STAGE(PG8_SA(1, 1), a1 + hstepA, voffA);
            PG8_WAIT_V(8); PG8_WAIT_L(0); PG8_BAR; PG8_MMA(0, 0, At, B0); PG8_MMA(0, 1, At, B1); PG8_BAR; PG8_SCHED;
            PG8_LDA(At, 0, 1); PG8_STAGE(PG8_SB(0, 0), b2, voffB); PG8_STAGE(PG8_SB(0, 1), b2 + hstepB, voffB); PG8_STAGE(PG8_SA(0, 0), a2, voffA);
            PG8_WAIT_V(8); PG8_WAIT_L(0); PG8_BAR; PG8_MMA(1, 0, At, B0); PG8_MMA(1, 1, At, B1); PG8_BAR; PG8_SCHED;
            PG8_LDB(B0, 1, 0); PG8_LDB(B1, 1, 1); PG8_SCHED; PG8_LDA(At, 1, 0); PG8_STAGE(PG8_SA(0, 1), a2 + hstepA, voffA);
            PG8_WAIT_V(8); PG8_WAIT_L(0); PG8_BAR; PG8_MMA(0, 0, At, B0); PG8_MMA(0, 1, At, B1); PG8_BAR; PG8_SCHED;
            PG8_LDA(At, 1, 1); PG8_STAGE(PG8_SB(1, 0), b3, voffB); PG8_STAGE(PG8_SB(1, 1), b3 + hstepB, voffB); PG8_STAGE(PG8_SA(1, 0), a3, voffA);
            PG8_WAIT_V(8); PG8_WAIT_L(0); PG8_BAR; PG8_MMA(1, 0, At, B0); PG8_MMA(1, 1, At, B1); PG8_BAR; PG8_SCHED;
            } else {
            PG8_LDB(B0, 0, 0); PG8_SCHED; PG8_LDA(At, 0, 0); PG8_STAGE(PG8_SA(1, 1), a1 + hstepA, voffA);
            PG8_WAIT_L(8); PG8_BAR; PG8_WAIT_L(0); PG8_MMA(0, 0, At, B0); PG8_BAR; PG8_SCHED;
            PG8_LDB(B1, 0, 1); PG8_STAGE(PG8_SB(0, 0), b2, voffB);
            PG8_BAR; PG8_WAIT_L(0); PG8_MMA(0, 1, At, B1); PG8_BAR;
            PG8_LDA(At, 0, 1); PG8_STAGE(PG8_SA(0, 0), a2, voffA);
            PG8_BAR; PG8_WAIT_L(0); PG8_MMA(1, 0, At, B0); PG8_BAR; PG8_SCHED;
            PG8_STAGE(PG8_SB(0, 1), b2 + hstepB, voffB);
            PG8_WAIT_V(6); PG8_BAR; PG8_MMA(1, 1, At, B1); PG8_BAR;
            PG8_LDB(B0, 1, 0); PG8_SCHED; PG8_LDA(At, 1, 0); PG8_STAGE(PG8_SA(0, 1), a2 + hstepA, voffA);
            PG8_WAIT_L(8); PG8_BAR; PG8_WAIT_L(0); PG8_MMA(0, 0, At, B0); PG8_BAR; PG8_SCHED;
            PG8_LDB(B1, 1, 1); PG8_STAGE(PG8_SB(1, 0), b3, voffB);
            PG8_BAR; PG8_WAIT_L(0); PG8_MMA(0, 1, At, B1); PG8_BAR;
            PG8_LDA(At, 1, 1); PG8_STAGE(PG8_SA(1, 0), a3, voffA);
            PG8_BAR; PG8_WAIT_L(0); PG8_MMA(1, 0, At, B0); PG8_BAR; PG8_SCHED;
            PG8_STAGE(PG8_SB(1, 1), b3 + hstepB, voffB);
            PG8_WAIT_V(6); PG8_BAR; PG8_MMA(1, 1, At, B1); PG8_BAR;
            }
        }
        if constexpr (ALIGN_EPI) { if (wr == 0) PG8_BAR; }
        if constexpr (!Epi::AFTER_DRAIN) { E(acc, cur, wr, wc, fr, fq); S.done(cur); }
        if (!has_next) break;
#pragma unroll
        for (int a = 0; a < 2; ++a)
#pragma unroll
            for (int b = 0; b < 2; ++b)
#pragma unroll
                for (int m = 0; m < 4; ++m)
#pragma unroll
                    for (int n = 0; n < 2; ++n) acc[a][b][m][n] = (f32x4){0.f, 0.f, 0.f, 0.f};
        cur = nxt; cA = nA; cB = nB; ++ui;
        if constexpr (ALIGN_EPI) { if (wr == 1) PG8_BAR; }
    }
    PG8_WAIT_V(0);
    if constexpr (!ALIGN_EPI) { if (wr == 0) PG8_BAR; }
    PG8_BAR;
    if constexpr (Epi::AFTER_DRAIN) { E.fused(acc, cur, wr, wc, fr, fq, lds, wid, lane); S.done(cur); }
#undef PG8_SA
#undef PG8_SB
#undef PG8_STAGE
#undef PG8_LDA
#undef PG8_LDB
#undef PG8_MMA
#undef PG8_WAIT_V
#undef PG8_WAIT_L
#undef PG8_BAR
#undef PG8_SCHED
}
}
constexpr int NB = 8, T = 4096, D = 1024, M = NB * T, NP = 4352, FF = 4096, LA = 384;
constexpr int C_R = 0, C_K = 512, C_V = 1024, C_QA = 1536, C_KA = 2048, C_VA = 2560, C_QI = 3072, C_KI = 3584, C_WI = 3648, C_P1 = 3656, C_P2 = 3944, C_END = 4232, C_Y = 3656, C_RK = 4168;
#define GAS __attribute__((address_space(1)))
#define LAS __attribute__((address_space(3)))
typedef unsigned short bf16_t;
typedef short bf16x8 __attribute__((ext_vector_type(8)));
typedef float f32x4 __attribute__((ext_vector_type(4)));
typedef float f32x16 __attribute__((ext_vector_type(16)));
typedef unsigned u32x4 __attribute__((ext_vector_type(4)));
typedef unsigned u32x2 __attribute__((ext_vector_type(2)));
typedef short s16x4 __attribute__((ext_vector_type(4)));
#define LDS_WAIT() asm volatile("s_waitcnt lgkmcnt(0)" ::: "memory")
#define VM_WAIT() asm volatile("s_waitcnt vmcnt(0)" ::: "memory")
__device__ __forceinline__ float bfl(unsigned w) { return (float)__builtin_bit_cast(_Float16, (unsigned short)(w & 0xffffu)); }
__device__ __forceinline__ float bfh(unsigned w) { return (float)__builtin_bit_cast(_Float16, (unsigned short)(w >> 16)); }
__device__ __forceinline__ float bf1(bf16_t v) { return (float)__builtin_bit_cast(_Float16, v); }
__device__ __forceinline__ unsigned pkbf(float lo, float hi) { return pg8::cvt_pk_bf16(lo, hi); }
template <int CTRL> __device__ __forceinline__ float dpp_f(float x) { return __builtin_bit_cast(float, __builtin_amdgcn_update_dpp(0, __builtin_bit_cast(int, x), CTRL, 0xf, 0xf, true)); }
__device__ __forceinline__ float allsum8(float x) { x += dpp_f<0xB1>(x); x += dpp_f<0x4E>(x); x += dpp_f<0x141>(x); return x; }
__device__ __forceinline__ float allsum16(float x) { x = allsum8(x); x += dpp_f<0x140>(x); return x; }
template <int CTRL> __device__ __forceinline__ int dpp_i(int x) { return __builtin_amdgcn_update_dpp(0, x, CTRL, 0xf, 0xf, true); }
__device__ __forceinline__ int wave_sum_i(int x) {
    x += dpp_i<0xB1>(x); x += dpp_i<0x4E>(x); x += dpp_i<0x141>(x); x += dpp_i<0x140>(x);
    return __builtin_amdgcn_readlane(x, 0) + __builtin_amdgcn_readlane(x, 16) + __builtin_amdgcn_readlane(x, 32) + __builtin_amdgcn_readlane(x, 48); }
__device__ __forceinline__ unsigned wave_max_u(unsigned x) {
    x = max(x, (unsigned)dpp_i<0xB1>((int)x)); x = max(x, (unsigned)dpp_i<0x4E>((int)x)); x = max(x, (unsigned)dpp_i<0x141>((int)x)); x = max(x, (unsigned)dpp_i<0x140>((int)x));
    return max(max((unsigned)__builtin_amdgcn_readlane((int)x, 0), (unsigned)__builtin_amdgcn_readlane((int)x, 16)), max((unsigned)__builtin_amdgcn_readlane((int)x, 32), (unsigned)__builtin_amdgcn_readlane((int)x, 48))); }
__device__ __forceinline__ unsigned wave_min_u(unsigned x) { return ~wave_max_u(~x); }
__device__ __forceinline__ float wave_sum(float v) {
    v += dpp_f<0xB1>(v); v += dpp_f<0x4E>(v); v += dpp_f<0x141>(v); v += dpp_f<0x140>(v);
    const float r0 = __builtin_bit_cast(float, __builtin_amdgcn_readlane(__builtin_bit_cast(int, v), 0)), r1 = __builtin_bit_cast(float, __builtin_amdgcn_readlane(__builtin_bit_cast(int, v), 16)),
                r2 = __builtin_bit_cast(float, __builtin_amdgcn_readlane(__builtin_bit_cast(int, v), 32)), r3 = __builtin_bit_cast(float, __builtin_amdgcn_readlane(__builtin_bit_cast(int, v), 48));
    return (r0 + r1) + (r2 + r3);
}

namespace att {
__device__ __forceinline__ int crow(int r, int hi) { return (r & 3) + 8 * (r >> 2) + 4 * hi; }
#define SBAR() __builtin_amdgcn_sched_barrier(0)
__device__ __forceinline__ void glds16(const void* gsrc, unsigned lds_dst) { unsigned keep;
    asm volatile("s_mov_b32 %0, m0\n\ts_mov_b32 m0, %2\n\ts_nop 0\n\tglobal_load_lds_dwordx4 %1, off\n\ts_mov_b32 m0, %0" : "=&s"(keep) : "v"(gsrc), "s"(lds_dst) : "memory"); }
typedef LAS const char* lds_cptr;
__device__ __forceinline__ void qkt(f32x16& p0, f32x16& p1, lds_cptr kb, const bf16x8* qr, const f32x16& z) {
#pragma unroll
    for (int d0 = 0; d0 < 4; ++d0) {
        const bf16x8 b0 = *(const LAS bf16x8*)(kb + d0 * 2048);
        const bf16x8 b1 = *(const LAS bf16x8*)(kb + d0 * 2048 + 512);
        if (d0 == 0) { p0 = __builtin_amdgcn_mfma_f32_32x32x16_f16(__builtin_bit_cast(pg8::half8, b0), __builtin_bit_cast(pg8::half8, qr[0]), z, 0, 0, 0); p1 = __builtin_amdgcn_mfma_f32_32x32x16_f16(__builtin_bit_cast(pg8::half8, b1), __builtin_bit_cast(pg8::half8, qr[0]), z, 0, 0, 0); }
        else { p0 = __builtin_amdgcn_mfma_f32_32x32x16_f16(__builtin_bit_cast(pg8::half8, b0), __builtin_bit_cast(pg8::half8, qr[d0]), p0, 0, 0, 0); p1 = __builtin_amdgcn_mfma_f32_32x32x16_f16(__builtin_bit_cast(pg8::half8, b1), __builtin_bit_cast(pg8::half8, qr[d0]), p1, 0, 0, 0); } }
}
__device__ __forceinline__ void pv(f32x16* o, int vb, bf16x8 pa0, bf16x8 pa1, bf16x8 pa2, bf16x8 pa3) {
#pragma unroll
    for (int d0 = 0; d0 < 2; ++d0) { s16x4 lo[4], hi[4];
#pragma unroll
        for (int ks = 0; ks < 4; ++ks) {
            asm volatile("ds_read_b64_tr_b16 %0,%1 offset:%c2" : "=&v"(lo[ks]) : "v"(vb), "i"(d0 * 4096 + ks * 1024) : "memory");
            asm volatile("ds_read_b64_tr_b16 %0,%1 offset:%c2" : "=&v"(hi[ks]) : "v"(vb), "i"(d0 * 4096 + ks * 1024 + 512) : "memory"); }
        asm volatile("s_waitcnt lgkmcnt(0)" ::: "memory"); SBAR();
#define PK(k) (bf16x8){lo[k][0], lo[k][1], lo[k][2], lo[k][3], hi[k][0], hi[k][1], hi[k][2], hi[k][3]}
        o[d0] = __builtin_amdgcn_mfma_f32_32x32x16_f16(__builtin_bit_cast(pg8::half8, pa0), __builtin_bit_cast(pg8::half8, PK(0)), o[d0], 0, 0, 0);
        o[d0] = __builtin_amdgcn_mfma_f32_32x32x16_f16(__builtin_bit_cast(pg8::half8, pa1), __builtin_bit_cast(pg8::half8, PK(1)), o[d0], 0, 0, 0);
        o[d0] = __builtin_amdgcn_mfma_f32_32x32x16_f16(__builtin_bit_cast(pg8::half8, pa2), __builtin_bit_cast(pg8::half8, PK(2)), o[d0], 0, 0, 0);
        o[d0] = __builtin_amdgcn_mfma_f32_32x32x16_f16(__builtin_bit_cast(pg8::half8, pa3), __builtin_bit_cast(pg8::half8, PK(3)), o[d0], 0, 0, 0);
#undef PK
    }
}
constexpr int SLOTB = 8192;
constexpr int L_K = 0, L_V = 3 * SLOTB, L_WS = 7 * SLOTB, L_OST = L_WS + 8 * 64 * 4, L_BT = L_OST + 8 * 8192, L_END = L_BT + 8 * 129 * 4;
constexpr float C2 = 0.125f * 1.4426950408889634f;

__device__ __forceinline__ int t5_bucket(int n) {
    if (n < 16) return n;
    const int thr[15] = {19, 21, 24, 27, 31, 35, 40, 46, 52, 59, 67, 77, 87, 99, 113};
    int b = 16;
#pragma unroll
    for (int i = 0; i < 15; ++i) b += (n >= thr[i]) ? 1 : 0;
    return b;
}
__device__ __forceinline__ void build_bias_table(const float* rel_bias, LAS char* shm, int tid) {
    LAS float* BT = (LAS float*)(shm + L_BT);
    for (int i = tid; i < 8 * 129; i += 512) { const int h = i / 129, d = i % 129;
        BT[i] = (d >= 128) ? 0.f : (rel_bias[t5_bucket(d) * 8 + h] - rel_bias[31 * 8 + h]) * 1.4426950408889634f; }
}

__device__ __forceinline__ void attn_unit(int b, int h, int qb, const bf16_t* PROJ, const unsigned long long* MASK, bf16_t* MIX, const float* gain, LAS char* shm, const int tid) {
    const int lane = tid & 63, r32 = lane & 31, hi = lane >> 5; const int wid = __builtin_amdgcn_readfirstlane(tid >> 6);
    const long rowbase = (long)b * T; const int q0 = qb * 256;
    const bf16_t* Qw = PROJ + (rowbase + q0 + wid * 32) * NP + C_QA + h * 64;
    const bf16_t* Kh = PROJ + rowbase * NP + C_KA + h * 64; const bf16_t* Vh = PROJ + rowbase * NP + C_VA + h * 64;
    const unsigned lds0 = (unsigned)(uintptr_t)shm;
    LAS float* wsf = (LAS float*)(shm + L_WS) + wid * 64;
    const LAS float* BT = (const LAS float*)(shm + L_BT) + h * 129;
    const bf16_t* ksrc = Kh + (long)lane * NP + wid * 8;
    const bf16_t* vsrc = Vh + (long)(16 * (wid & 3) + (lane >> 2)) * NP + (wid >> 2) * 32 + (lane & 3) * 8;
    const unsigned kdst = lds0 + L_K + wid * 1024, vdst = lds0 + L_V + wid * 1024;
#define DMA_K(t, slot) glds16(ksrc + (long)(t) * 64 * NP, (unsigned)__builtin_amdgcn_readfirstlane(kdst + (slot)))
#define DMA_V(t, slot) glds16(vsrc + (long)(t) * 64 * NP, (unsigned)__builtin_amdgcn_readfirstlane(vdst + (slot)))
    const int vb0 = (int)(lds0 + L_V) + ((lane >> 4) & 1) * 32 + (lane & 3) * 8 + (4 * hi + ((lane & 15) >> 2)) * 64;
    const lds_cptr kp0 = (lds_cptr)shm + L_K + hi * 1024 + r32 * 16;
    const int NT = (q0 + 256) / 64;
    const int qabs = q0 + wid * 32 + r32;
    const unsigned long long* mp = MASK + ((size_t)b * 4096 + qabs) * 64;
    unsigned long long mw_next = 0ull;
#define MASK_LD(t) asm volatile("global_load_dwordx2 %0, %1, off" : "+v"(mw_next) : "v"(mp + (t)) : "memory")
    MASK_LD(0); DMA_K(0, 0); DMA_V(0, 0); DMA_K(1, SLOTB); DMA_V(1, SLOTB);
    bf16x8 qr[4];
#pragma unroll
    for (int d0 = 0; d0 < 4; ++d0) qr[d0] = *(const bf16x8*)(Qw + (long)r32 * NP + d0 * 16 + hi * 8);
    float m_run = 0.f, l_run = 0.f; f32x16 o[2]; o[0] = f32x16{}; o[1] = f32x16{}; f32x16 negm = f32x16{}; asm volatile("" : "+v"(negm));
    int slot = 0, slot2 = 2 * SLOTB;
    int vs = 0, vsp = 3 * SLOTB, vs2 = 2 * SLOTB;
    u32x4 pw0 = {0u, 0u, 0u, 0u}, pw1 = pw0, pw2 = pw0, pw3 = pw0;
    for (int t = 0; t < NT; ++t) {
        if (t + 1 < NT) asm volatile("s_waitcnt vmcnt(2) lgkmcnt(0)\n\ts_barrier" : "+v"(mw_next) :: "memory");
        else asm volatile("s_waitcnt vmcnt(0) lgkmcnt(0)\n\ts_barrier" : "+v"(mw_next) :: "memory");
        const unsigned long long mw = mw_next;
        asm volatile("" : "+v"(mw_next));
        if (t + 1 < NT) MASK_LD(t + 1);
        if (t + 2 < NT) { DMA_K(t + 2, slot2); DMA_V(t + 2, vs2); }
        f32x16 p0, p1; qkt(p0, p1, kp0 + slot, qr, negm);
        if (t > 0) pv(o, vb0 + vsp, __builtin_bit_cast(bf16x8, pw0), __builtin_bit_cast(bf16x8, pw1), __builtin_bit_cast(bf16x8, pw2), __builtin_bit_cast(bf16x8, pw3));
        if (64 * t + 191 > q0 + 32 * wid) {
#pragma unroll
            for (int r = 0; r < 16; ++r) { const int d0_ = qabs - (64 * t + crow(r, hi));
                const int i0 = d0_ < 0 ? 0 : (d0_ > 128 ? 128 : d0_); const int d1_ = d0_ - 32; const int i1 = d1_ < 0 ? 0 : (d1_ > 128 ? 128 : d1_);
                p0[r] += BT[i0]; p1[r] += BT[i1]; }
        }
        { const int mlo = (int)((unsigned)mw >> (4 * hi)), mhi = (int)((unsigned)(mw >> 32) >> (4 * hi)); const int NEGB = (int)0xff800000u;
#pragma unroll
          for (int r = 0; r < 16; ++r) { const int bit = (r & 3) + 8 * (r >> 2);
              const int t0 = __builtin_amdgcn_sbfe(mlo, bit, 1), t1 = __builtin_amdgcn_sbfe(mhi, bit, 1);
              { const float x0 = p0[r]; p0[r] = __int_as_float((__float_as_int(x0) & t0) | (NEGB & ~t0)); }
              { const float x1 = p1[r]; p1[r] = __int_as_float((__float_as_int(x1) & t1) | (NEGB & ~t1)); } } }
        float rm;
        { float a = __builtin_fmaxf(__builtin_fmaxf(p0[0], p0[1]), p1[0]), b2 = __builtin_fmaxf(__builtin_fmaxf(p0[2], p0[3]), p1[1]); a = __builtin_fmaxf(__builtin_fmaxf(a, p1[2]), p1[3]);
#pragma unroll
          for (int r = 4; r < 16; r += 4) { a = __builtin_fmaxf(__builtin_fmaxf(a, p0[r]), p0[r + 1]); b2 = __builtin_fmaxf(__builtin_fmaxf(b2, p0[r + 2]), p0[r + 3]); a = __builtin_fmaxf(__builtin_fmaxf(a, p1[r]), p1[r + 1]); b2 = __builtin_fmaxf(__builtin_fmaxf(b2, p1[r + 2]), p1[r + 3]); }
          rm = __builtin_fmaxf(a, b2); }
        { auto rr = __builtin_amdgcn_permlane32_swap(__float_as_uint(rm), __float_as_uint(rm), false, false); rm = fmaxf(__uint_as_float(rr[0]), __uint_as_float(rr[1])); }
        const float dl = (t == 0) ? ((rm == -INFINITY) ? 0.f : rm) : fmaxf(rm, 0.f);
        if (__ballot(dl != 0.f)) {
            m_run += dl;
#pragma unroll
            for (int r = 0; r < 16; ++r) { p0[r] -= dl; p1[r] -= dl; }
            const float f = __builtin_amdgcn_exp2f(-dl); l_run *= f;
#pragma unroll
            for (int r = 0; r < 16; ++r) negm[r] = -m_run;
            asm volatile("" : "+v"(negm));
            if (hi == 0) wsf[r32] = f;
            LDS_WAIT();
#pragma unroll
            for (int r = 0; r < 16; ++r) { const float fr_ = wsf[crow(r, hi)]; o[0][r] *= fr_; o[1][r] *= fr_; }
        }
        float sacc = 0.f;
#pragma unroll
        for (int r = 0; r < 16; ++r) { p0[r] = __builtin_amdgcn_exp2f(p0[r]); p1[r] = __builtin_amdgcn_exp2f(p1[r]); sacc += p0[r] + p1[r]; }
        l_run += sacc;
#define PKW(P, B) __builtin_bit_cast(unsigned, __builtin_amdgcn_cvt_pkrtz(P[B], P[B + 1]))
        pw0 = (u32x4){PKW(p0, 0), PKW(p0, 2), PKW(p0, 4), PKW(p0, 6)}; pw1 = (u32x4){PKW(p0, 8), PKW(p0, 10), PKW(p0, 12), PKW(p0, 14)};
        pw2 = (u32x4){PKW(p1, 0), PKW(p1, 2), PKW(p1, 4), PKW(p1, 6)}; pw3 = (u32x4){PKW(p1, 8), PKW(p1, 10), PKW(p1, 12), PKW(p1, 14)};
#undef PKW
        { const int old_ = slot; slot = (slot == 2 * SLOTB) ? 0 : slot + SLOTB; slot2 = old_; }
        { vsp = vs; vs = (vs == 3 * SLOTB) ? 0 : vs + SLOTB; vs2 = (vs2 == 3 * SLOTB) ? 0 : vs2 + SLOTB; }
    }
    LDS_WAIT(); SBAR();
    pv(o, vb0 + vsp, __builtin_bit_cast(bf16x8, pw0), __builtin_bit_cast(bf16x8, pw1), __builtin_bit_cast(bf16x8, pw2), __builtin_bit_cast(bf16x8, pw3));
    { auto rr = __builtin_amdgcn_permlane32_swap(__float_as_uint(l_run), __float_as_uint(l_run), false, false); l_run = __uint_as_float(rr[0]) + __uint_as_float(rr[1]); }
    LDS_WAIT();
    if (hi == 0) wsf[32 + r32] = l_run;
    LDS_WAIT();
    LAS float* stg = (LAS float*)(shm + L_OST) + wid * 2048;
#pragma unroll
    for (int r = 0; r < 16; ++r) { const int orow = crow(r, hi); const float rl = 1.0f / wsf[32 + orow];
#pragma unroll
        for (int d0 = 0; d0 < 2; ++d0) stg[orow * 64 + d0 * 32 + r32] = o[d0][r] * rl; }
    LDS_WAIT();
    bf16_t* Ow = MIX + (rowbase + q0 + wid * 32) * 1024 + 512 + h * 64;
#pragma unroll
    for (int i = 0; i < 4; ++i) { const int row = i * 8 + (lane >> 3), ch = lane & 7;
        const f32x4 a = *(const LAS f32x4*)(stg + row * 64 + ch * 8), c = *(const LAS f32x4*)(stg + row * 64 + ch * 8 + 4);
        float ss = (a[0] * a[0] + a[1] * a[1]) + (a[2] * a[2] + a[3] * a[3]) + (c[0] * c[0] + c[1] * c[1]) + (c[2] * c[2] + c[3] * c[3]);
        ss = allsum8(ss);
        const float rs = rsqrtf(ss * (1.0f / 64.0f) + 1e-6f);
        const f32x4 g0 = *(const f32x4*)(gain + h * 64 + ch * 8), g1 = *(const f32x4*)(gain + h * 64 + ch * 8 + 4);
        u32x4 w; w.x = pkbf(a[0] * rs * g0[0], a[1] * rs * g0[1]); w.y = pkbf(a[2] * rs * g0[2], a[3] * rs * g0[3]); w.z = pkbf(c[0] * rs * g1[0], c[1] * rs * g1[1]); w.w = pkbf(c[2] * rs * g1[2], c[3] * rs * g1[3]);
        *(u32x4*)(Ow + (long)row * 1024 + ch * 8) = w; }
    asm volatile("s_waitcnt lgkmcnt(0)\n\ts_barrier" ::: "memory");
#undef DMA_K
#undef DMA_V
#undef MASK_LD
}
#undef SBAR
}

#define GAS __attribute__((address_space(1)))
#define LAS __attribute__((address_space(3)))
typedef unsigned short bf16;
typedef unsigned v4u __attribute__((ext_vector_type(4)));
typedef float f32x4 __attribute__((ext_vector_type(4)));
typedef short bf16x8 __attribute__((ext_vector_type(8)));
typedef GAS unsigned gu32;
typedef GAS unsigned long long gu64;
#define RLX_AGENT __ATOMIC_RELAXED, __HIP_MEMORY_SCOPE_AGENT
#define LDS_WAIT() asm volatile("s_waitcnt lgkmcnt(0)" ::: "memory")
#define VM_WAIT() asm volatile("s_waitcnt vmcnt(0)" ::: "memory")
__device__ __forceinline__ unsigned long long rt() { return __builtin_amdgcn_s_memrealtime(); }
__device__ __forceinline__ unsigned f2bf(float f) { unsigned u = __builtin_bit_cast(unsigned, f); return (u + 0x7fffu + ((u >> 16) & 1u)) >> 16; }
__device__ __forceinline__ unsigned pk2(float lo, float hi) { return f2bf(lo) | (f2bf(hi) << 16); }

#define XB_TMO      128
#define XB_XCNT(j)  (256  + 64 * (j))
#define XB_XSUB(j)  (1280 + 64 * (j))
#define XB_XGEN(j)  (2304 + 64 * (j))
#define XB_TOP      3328
#define XB_TOPGEN   3392
#define XCD_BAR_WORDS 3456
#define XB_SPIN_CAP (1u << 22)

__device__ __forceinline__ unsigned xb_ld(unsigned* p)              { return __hip_atomic_load(p, __ATOMIC_RELAXED, __HIP_MEMORY_SCOPE_AGENT); }
__device__ __forceinline__ unsigned xb_add(unsigned* p, unsigned v) { return __hip_atomic_fetch_add(p, v, __ATOMIC_RELAXED, __HIP_MEMORY_SCOPE_AGENT); }
__device__ __forceinline__ unsigned xb_xcc_id() { return (unsigned)__builtin_amdgcn_s_getreg((3 << 11) | 20) & 0xFu; }
#define XB_SPIN(cond, bar) do { unsigned _sp = 0; while (cond) { __builtin_amdgcn_s_sleep(1); \
    if ((++_sp & 255u) == 0u) { if (xb_ld(&(bar)[XB_TMO])) break; if (_sp > XB_SPIN_CAP) { atomicAdd(&(bar)[XB_TMO], 1u); break; } } } } while (0)

struct XcdBarrier {
    unsigned* bar; unsigned x;
    volatile LAS unsigned* st;
};

__device__ __forceinline__ XcdBarrier xcd_barrier_post(unsigned* bar, volatile LAS unsigned* st) {
    XcdBarrier b; b.bar = bar; b.x = xb_xcc_id(); b.st = st;
    if (threadIdx.x == 0) (void)xb_add(&bar[XB_XCNT(b.x)], 1u);
    return b;
}
__device__ __forceinline__ void xcd_barrier_complete(unsigned* bar, unsigned x, unsigned& nloc, unsigned& nx) {
    const unsigned G = gridDim.x * gridDim.y * gridDim.z;
    unsigned sum, cnt, mine, sp = 0u;
    for (;;) {
        sum = 0u; cnt = 0u; mine = 0u;
#pragma unroll
        for (unsigned j = 0; j < 16; ++j) { const unsigned c = xb_ld(&bar[XB_XCNT(j)]); sum += c; cnt += (c > 0u) ? 1u : 0u; mine = (j == x) ? c : mine; }
        if (sum == G) break;
        __builtin_amdgcn_s_sleep(1);
        if ((++sp & 255u) == 0u) { if (xb_ld(&bar[XB_TMO])) break; if (sp > XB_SPIN_CAP) { atomicAdd(&bar[XB_TMO], 1u); break; } }
    }
    nloc = mine > 0u ? mine : 1u; nx = cnt > 0u ? cnt : 1u;
}

__device__ __forceinline__ void xcd_barrier(const XcdBarrier& b) {
    asm volatile("s_waitcnt vmcnt(0)" ::: "memory");
    __syncthreads();
    if (threadIdx.x == 0) {
        unsigned* bar = b.bar;
        __builtin_amdgcn_s_waitcnt(0);
        unsigned nloc = b.st[0], nx = b.st[1];
        if (nloc == 0u) { xcd_barrier_complete(bar, b.x, nloc, nx); b.st[0] = nloc; b.st[1] = nx; }
        const unsigned old = xb_add(&bar[XB_XSUB(b.x)], 1u);
        const unsigned gen = old / nloc;
        if (old + 1u == (gen + 1u) * nloc) {
            __builtin_amdgcn_fence(__ATOMIC_RELEASE, "agent");
            asm volatile("s_waitcnt vmcnt(0)" ::: "memory");
            const unsigned og = xb_add(&bar[XB_TOP], 1u);
            const unsigned tg = og / nx;
            if (og + 1u == (tg + 1u) * nx) xb_add(&bar[XB_TOPGEN], 1u);
            else XB_SPIN(xb_ld(&bar[XB_TOPGEN]) == tg, bar);
            __builtin_amdgcn_fence(__ATOMIC_ACQUIRE, "agent");
            xb_add(&bar[XB_XGEN(b.x)], 1u);
            asm volatile("s_waitcnt vmcnt(0)" ::: "memory");
        } else {
            XB_SPIN(xb_ld(&bar[XB_XGEN(b.x)]) == gen, bar);
            __builtin_amdgcn_fence(__ATOMIC_ACQUIRE, "agent");
            asm volatile("s_waitcnt vmcnt(0)" ::: "memory");
        }
    }
    __syncthreads();
}
constexpr size_t MiB = 1u << 20;
constexpr size_t WS_CTL = 0, CTL_ZERO_BYTES = 1 * MiB;
constexpr size_t WS_MOD = 1 * MiB;
constexpr size_t WS_LW = 2 * MiB;
constexpr size_t WS_WIN = 3 * MiB, WS_WOUT = 12 * MiB, WS_W1 = 14 * MiB, WS_W2 = 22 * MiB;
constexpr size_t WS_LACT = 30 * MiB;
constexpr size_t WS_MASK = 54 * MiB;
constexpr size_t WS_VF = 70 * MiB;
constexpr size_t WS_H = 102 * MiB;
constexpr size_t WS_MIX = 166 * MiB;
constexpr size_t WS_PROJ = 230 * MiB;
constexpr size_t WS_END = 502 * MiB;
static_assert(WS_WIN + (size_t)NP * D * 2 <= WS_WOUT && WS_W2 + (size_t)D * FF * 2 <= WS_LACT && WS_LACT + (size_t)M * LA * 2 <= WS_MASK && WS_MASK + (size_t)NB * 64 * 4096 * 8 <= WS_VF &&
              WS_VF + (size_t)M * 512 * 2 <= WS_H && WS_H + (size_t)M * D * 2 <= WS_MIX && WS_MIX + (size_t)M * D * 2 <= WS_PROJ && WS_PROJ + (size_t)M * NP * 2 <= WS_END, "d_ws map");
constexpr int CW_BAR = 4096;
constexpr int RING_BYTES = 131072, HIST_OFF = 131072, LDSCTL_OFF = 131072 + 8192, MISC_OFF = LDSCTL_OFF + 320, LDS_BYTES = 147456;
static_assert(att::L_END <= RING_BYTES && MISC_OFF + 128 <= LDS_BYTES, "LDS map");
constexpr int NWAVES = 8;

__device__ __forceinline__ void ph_mod(const float* c, const float* w_ada, const float* b_ada, float* MOD, LAS unsigned char* lds, int vcu, int G, int tid) {
    LAS float* ca = (LAS float*)lds; LAS float* part = (LAS float*)(lds + 32768);
    for (int i = tid; i < NB * D; i += 512) { const float v = c[i]; ca[i] = v / (1.f + __expf(-v)); }
    __syncthreads();
    const int wave = tid >> 6, lane = tid & 63;
    for (int task = vcu; task < 192; task += G) {
        const int l = task / 96, j0 = (task % 96) * 64;
        float acc[8];
#pragma unroll
        for (int b = 0; b < 8; ++b) acc[b] = 0.f;
        const float* wp = w_ada + ((size_t)l * D + wave * 128) * 6144 + j0 + lane;
#pragma unroll 8
        for (int k = 0; k < 128; ++k) { const float w = wp[(size_t)k * 6144];
#pragma unroll
            for (int b = 0; b < 8; ++b) acc[b] += ca[b * D + wave * 128 + k] * w; }
#pragma unroll
        for (int b = 0; b < 8; ++b) part[(wave * 8 + b) * 64 + lane] = acc[b];
        __syncthreads();
        { float s = 0.f;
#pragma unroll
          for (int w = 0; w < 8; ++w) s += part[(w * 8 + wave) * 64 + lane];
          MOD[((size_t)l * 8 + wave) * 6144 + j0 + lane] = s + b_ada[l * 6144 + j0 + lane]; }
        __syncthreads();
    }
}

__device__ __forceinline__ void tr_item(const float* W, int ldw, int nvalid, int K, bf16_t* WT, int row_off, LAS float* scr, int kb, int nb, int lane, const float* mu, int mode) {
    const int k0 = 64 * kb, n0 = 32 * nb; const int n = n0 + (lane & 31);
#pragma unroll 8
    for (int i = 0; i < 32; ++i) { const int kk = 2 * i + (lane >> 5); float v = (n < nvalid) ? W[(size_t)(k0 + kk) * ldw + n] : 0.f;
        if (mode) { const float m = mu[k0 + kk]; v *= (mode == 1) ? (1.f - m) : m; }
        scr[kk * 33 + (lane & 31)] = v; }
    LDS_WAIT(); asm volatile("" ::: "memory");
    const int c = lane & 7;
#pragma unroll
    for (int j = 0; j < 4; ++j) { const int nn = (lane >> 3) + 8 * j; const LAS float* s = scr + (8 * c) * 33 + nn;
        u32x4 o; o.x = pkbf(s[0 * 33], s[1 * 33]); o.y = pkbf(s[2 * 33], s[3 * 33]); o.z = pkbf(s[4 * 33], s[5 * 33]); o.w = pkbf(s[6 * 33], s[7 * 33]);
        if (n0 + nn < nvalid) *(u32x4*)(WT + (size_t)(row_off + n0 + nn) * K + k0 + 8 * c) = o; }
    LDS_WAIT(); asm volatile("" ::: "memory");
}
struct WPtrs { const float *w_in, *decay_a, *iclr_a, *gate_a, *vres_a, *mu_lora, *vres_mu, *w_out, *w1, *w2, *decay_b, *iclr_b, *gate_b, *vres_b; };
__device__ __forceinline__ void ph_weights(const WPtrs& P, int l, unsigned char* ws, LAS unsigned char* lds, int vcu, int G, int tid) {
    const int wave = tid >> 6, lane = tid & 63; const int gw = vcu * NWAVES + wave, NGW = G * NWAVES;
    LAS float* scr = (LAS float*)(lds + wave * 16384);
    bf16_t* WIN = (bf16_t*)(ws + WS_WIN); bf16_t* WOUT = (bf16_t*)(ws + WS_WOUT); bf16_t* W1 = (bf16_t*)(ws + WS_W1); bf16_t* W2 = (bf16_t*)(ws + WS_W2);
    constexpr int I_IN = 16 * 115, I_D = 16 * 2, I_G = 16 * 4, I_V = 16 * 1, I_O = 16 * 32, I_1 = 16 * 128, I_2 = 64 * 32;
    constexpr int I_LO = 2 * I_D + I_G + I_V; constexpr int NITEMS = I_IN + 2 * I_LO + I_O + I_1 + I_2;
    for (int it = gw; it < NITEMS; it += NGW) {
        int r = it;
        if (r < I_IN) { tr_item(P.w_in + (size_t)l * D * 3656, 3656, 3656, D, WIN, 0, scr, r / 115, r % 115, lane, nullptr, 0); continue; } r -= I_IN;
        if (r < 2 * I_LO) { const int md = (r < I_LO) ? 1 : 2; int q = (r < I_LO) ? r : r - I_LO; const int rbase = (md == 1) ? C_P1 : C_P2;
            if (q < I_D) { tr_item(P.decay_a + (size_t)l * D * 64, 64, 64, D, WIN, rbase + 0, scr, q / 2, q % 2, lane, P.mu_lora + (size_t)(l * 3 + 0) * D, md); continue; } q -= I_D;
            if (q < I_D) { tr_item(P.iclr_a + (size_t)l * D * 64, 64, 64, D, WIN, rbase + 64, scr, q / 2, q % 2, lane, P.mu_lora + (size_t)(l * 3 + 1) * D, md); continue; } q -= I_D;
            if (q < I_G) { tr_item(P.gate_a + (size_t)l * D * 128, 128, 128, D, WIN, rbase + 128, scr, q / 4, q % 4, lane, P.mu_lora + (size_t)(l * 3 + 2) * D, md); continue; } q -= I_G;
            if (l >= 1) tr_item(P.vres_a + (size_t)(l - 1) * D * 32, 32, 32, D, WIN, rbase + 256, scr, q, 0, lane, P.vres_mu + (size_t)(l - 1) * D, md);
            continue; }
        r -= 2 * I_LO;
        if (r < I_O) { tr_item(P.w_out + (size_t)l * D * D, D, D, D, WOUT, 0, scr, r / 32, r % 32, lane, nullptr, 0); continue; } r -= I_O;
        if (r < I_1) { tr_item(P.w1 + (size_t)l * D * FF, FF, FF, D, W1, 0, scr, r / 128, r % 128, lane, nullptr, 0); continue; } r -= I_1;
        tr_item(P.w2 + (size_t)l * FF * D, D, D, FF, W2, 0, scr, r / 32, r % 32, lane, nullptr, 0);
    }
    const int gt = vcu * 512 + tid, NGT = G * 512;
    { const int nzr = (NP - C_END) + (l == 0 ? 64 : 0);
      for (int i = gt; i < nzr * 128; i += NGT) { const int zr = i >> 7, ch = i & 127; int row;
          if (zr < NP - C_END) row = C_END + zr; else { const int z2 = zr - (NP - C_END); row = (z2 < 32) ? (C_P1 + 256 + z2) : (C_P2 + 256 + z2 - 32); }
          *(u32x4*)(WIN + (size_t)row * D + ch * 8) = (u32x4){0u, 0u, 0u, 0u}; } }
    { bf16_t* LW = (bf16_t*)(ws + WS_LW);
      for (int i = gt; i < 2048 * 128; i += NGT) { const int n = i >> 7, k = i & 127; float v = 0.f;
          if (n < 512) { if (k < 64) v = P.decay_b[((size_t)l * 64 + k) * 512 + n]; }
          else if (n < 1024) { if (k >= 64) v = P.iclr_b[((size_t)l * 64 + (k - 64)) * 512 + (n - 512)]; }
          else if (n < 1536) { v = P.gate_b[((size_t)l * 128 + k) * 512 + (n - 1024)]; }
          else { if (l >= 1 && k < 32) v = P.vres_b[((size_t)(l - 1) * 32 + k) * 512 + (n - 1536)]; }
          LW[i] = (bf16_t)(pkbf(v, 0.f) & 0xffffu); } }
}

__device__ __forceinline__ void ph_norm(const float* X, const float* g, const float* sh, const float* sc, bf16_t* Hout, int gw, int NGW, int lane) {
    for (int m0 = gw; m0 < M; m0 += 2 * NGW) {
        f32x4 v[2][4]; float s[2] = {0.f, 0.f};
#pragma unroll
        for (int q = 0; q < 2; ++q) { const f32x4* xr = (const f32x4*)(X + (size_t)(m0 + q * NGW) * D) + lane;
#pragma unroll
            for (int j = 0; j < 4; ++j) v[q][j] = xr[64 * j]; }
#pragma unroll
        for (int q = 0; q < 2; ++q)
#pragma unroll
            for (int j = 0; j < 4; ++j) s[q] += (v[q][j][0] * v[q][j][0] + v[q][j][1] * v[q][j][1]) + (v[q][j][2] * v[q][j][2] + v[q][j][3] * v[q][j][3]);
#pragma unroll
        for (int q = 0; q < 2; ++q) { const int m = m0 + q * NGW; const int b = m >> 12;
            const float rstd = rsqrtf(wave_sum(s[q]) * (1.f / D) + 1e-6f);
            u32x2* o8 = (u32x2*)(Hout + (size_t)m * D) + lane;
#pragma unroll
            for (int j = 0; j < 4; ++j) { const int c = 256 * j + 4 * lane;
                const f32x4 gv = *(const f32x4*)(g + c), sv = *(const f32x4*)(sc + (size_t)b * 6144 + c), hv = *(const f32x4*)(sh + (size_t)b * 6144 + c);
                const f32x4 y = v[q][j] * rstd * gv * (sv + 1.f) + hv;
                u32x2 w; w.x = pkbf(y[0], y[1]); w.y = pkbf(y[2], y[3]); o8[64 * j] = w; } } }
}
__device__ __forceinline__ void ph_final_norm(float* X, const float* g, int gw, int NGW, int lane) {
    for (int m = gw; m < M; m += NGW) {
        f32x4* xr = (f32x4*)(X + (size_t)m * D) + lane; f32x4 v[4]; float s = 0.f;
#pragma unroll
        for (int j = 0; j < 4; ++j) { v[j] = xr[64 * j]; s += (v[j][0] * v[j][0] + v[j][1] * v[j][1]) + (v[j][2] * v[j][2] + v[j][3] * v[j][3]); }
        const float rstd = rsqrtf(wave_sum(s) * (1.f / D) + 1e-6f);
#pragma unroll
        for (int j = 0; j < 4; ++j) { const f32x4 gv = *(const f32x4*)(g + 256 * j + 4 * lane); xr[64 * j] = v[j] * rstd * gv; } }
}

__device__ __forceinline__ void ph_lora_act(const bf16_t* PROJ, bf16_t* LACT, bf16_t* VF, const float* mu_v  , bool write_v, int gw, int NGW, int lane) {
    float muv[8];
#pragma unroll
    for (int i = 0; i < 8; ++i) muv[i] = mu_v[lane * 8 + i];
    for (int m = gw; m < M; m += NGW) { const int t = m & (T - 1);
        if (lane < 36) {
            const u32x4 p1 = *(const u32x4*)(PROJ + (size_t)m * NP + C_P1 + lane * 8);
            u32x4 p2 = (u32x4){0u, 0u, 0u, 0u}; if (t > 0) p2 = *(const u32x4*)(PROJ + (size_t)(m - 1) * NP + C_P2 + lane * 8);
            float x[8];
#pragma unroll
            for (int i = 0; i < 4; ++i) { x[2 * i] = bfl(p1[i]) + bfl(p2[i]); x[2 * i + 1] = bfh(p1[i]) + bfh(p2[i]); }
            if (lane < 8) {
#pragma unroll
                for (int i = 0; i < 8; ++i) x[i] = 1.f - 2.f / (__expf(2.f * x[i]) + 1.f);
            } else if (lane >= 16 && lane < 32) {
#pragma unroll
                for (int i = 0; i < 8; ++i) x[i] = 1.f / (1.f + __expf(-x[i]));
            }
            u32x4 w; w.x = pkbf(x[0], x[1]); w.y = pkbf(x[2], x[3]); w.z = pkbf(x[4], x[5]); w.w = pkbf(x[6], x[7]);
            *(u32x4*)(LACT + (size_t)m * LA + lane * 8) = w;
        } else if (lane < 48) { *(u32x4*)(LACT + (size_t)m * LA + lane * 8) = (u32x4){0u, 0u, 0u, 0u}; }
        if (write_v) {
            const u32x4 vc = *(const u32x4*)(PROJ + (size_t)m * NP + C_V + lane * 8);
            u32x4 vp = (u32x4){0u, 0u, 0u, 0u}; if (t > 0) vp = *(const u32x4*)(PROJ + (size_t)(m - 1) * NP + C_V + lane * 8);
            float y[8];
#pragma unroll
            for (int i = 0; i < 4; ++i) { const float c0 = bfl(vc[i]), c1 = bfh(vc[i]); y[2 * i] = c0 + (bfl(vp[i]) - c0) * muv[2 * i]; y[2 * i + 1] = c1 + (bfh(vp[i]) - c1) * muv[2 * i + 1]; }
            u32x4 w; w.x = pkbf(y[0], y[1]); w.y = pkbf(y[2], y[3]); w.z = pkbf(y[4], y[5]); w.w = pkbf(y[6], y[7]);
            *(u32x4*)(VF + (size_t)m * 512 + lane * 8) = w;
        }
    }
}

#ifndef DUP_MASK
#define DUP_MASK 0
#endif
__device__ __forceinline__ unsigned sortable(float s) { const unsigned u = __float_as_uint(s + 0.f); return u ^ ((u >> 31) ? 0xFFFFFFFFu : 0x80000000u); }
__device__ __forceinline__ void ph_select(const bf16_t* PROJ, unsigned long long* MASK, LAS unsigned char* lds, int vcu, int G, int tid) {
    const int lane = tid & 63, wid = __builtin_amdgcn_readfirstlane(tid >> 6), r32 = lane & 31, hi = lane >> 5;
    LAS unsigned* SC = (LAS unsigned*)lds;
    LAS unsigned* HI = (LAS unsigned*)(lds + HIST_OFF) + wid * 256;
    const float WSC = 0.35355339059f * 0.125f;
    bf16x8 AfN[2][4]; u32x4 wN[2][2]; bf16x8 BfN[4];
    const int ql_ = (r32 >> 4) * 2 + ((r32 >> 2) & 1), hd_ = (r32 & 3) + 4 * ((r32 >> 3) & 1);
#define SEL_LOAD(q0_, nblk_, rb_) do { \
        _Pragma("unroll") for (int tq = 0; tq < 2; ++tq) _Pragma("unroll") for (int ks = 0; ks < 4; ++ks) AfN[tq][ks] = *(const bf16x8*)(PROJ + (rb_ + q0_ + tq * 4 + ql_) * NP + C_QI + hd_ * 64 + ks * 16 + hi * 8); \
        _Pragma("unroll") for (int tq = 0; tq < 2; ++tq) _Pragma("unroll") for (int g = 0; g < 2; ++g) wN[tq][g] = *(const u32x4*)(PROJ + (rb_ + q0_ + tq * 4 + 2 * g + hi) * NP + C_WI); \
        if (wid < nblk_) { _Pragma("unroll") for (int ks = 0; ks < 4; ++ks) BfN[ks] = *(const bf16x8*)(PROJ + (rb_ + wid * 32 + r32) * NP + C_KI + ks * 16 + hi * 8); } } while (0)
    if (vcu < NB * 512) { const int bn = vcu & 7, jn = vcu >> 3, basen = jn & 31, rndn = jn >> 5;
        const int q8n = (rndn & 1) ? (32 * rndn + 31 - basen) : (32 * rndn + basen); const int q0n = q8n * 8, nblkn = (q0n >> 5) + 1; const size_t rbn = (size_t)bn * T;
        SEL_LOAD(q0n, nblkn, rbn); }
    for (int it = 0;; ++it) {
        const int tsk = vcu + it * G; if (tsk >= NB * 512) break;
        const int b = tsk & 7, j = tsk >> 3, base = j & 31, rnd = j >> 5;
        const int q8 = (rnd & 1) ? (32 * rnd + 31 - base) : (32 * rnd + base);
        const int q0 = q8 * 8, nblk = (q0 >> 5) + 1; const size_t rb = (size_t)b * T;
        bf16x8 Af[2][4]; float wv[2][16]; bf16x8 Bf[4], Bn[4];
#pragma unroll
        for (int tq = 0; tq < 2; ++tq) {
#pragma unroll
            for (int ks = 0; ks < 4; ++ks) Af[tq][ks] = AfN[tq][ks];
#pragma unroll
            for (int g = 0; g < 2; ++g) { const u32x4 w8 = wN[tq][g];
#pragma unroll
                for (int x = 0; x < 4; ++x) { wv[tq][8 * g + 2 * x] = bfl(w8[x]) * WSC; wv[tq][8 * g + 2 * x + 1] = bfh(w8[x]) * WSC; } } }
#pragma unroll
        for (int ks = 0; ks < 4; ++ks) Bf[ks] = BfN[ks];
        for (int blk = wid; blk < nblk; blk += 8) {
            const int key = blk * 32 + r32;
            if (blk + 8 < nblk) {
#pragma unroll
                for (int ks = 0; ks < 4; ++ks) Bn[ks] = *(const bf16x8*)(PROJ + (rb + key + 256) * NP + C_KI + ks * 16 + hi * 8);
            }
#pragma unroll
            for (int tq = 0; tq < 2; ++tq) { f32x16 acc = {};
#pragma unroll
                for (int ks = 0; ks < 4; ++ks) acc = __builtin_amdgcn_mfma_f32_32x32x16_f16(__builtin_bit_cast(pg8::half8, Af[tq][ks]), __builtin_bit_cast(pg8::half8, Bf[ks]), acc, 0, 0, 0);
#pragma unroll
                for (int g = 0; g < 2; ++g) { float s = 0.f;
#pragma unroll
                    for (int x = 0; x < 8; ++x) s += wv[tq][8 * g + x] * fmaxf(acc[8 * g + x], 0.f);
                    const int ql = tq * 4 + 2 * g + hi; const int qp = q0 + ql;
                    SC[ql * 4096 + key] = (key > qp) ? 0u : sortable(s); } }
#pragma unroll
            for (int ks = 0; ks < 4; ++ks) Bf[ks] = Bn[ks];
        }
        if (tsk + G < NB * 512) { const int tn = tsk + G; const int bn = tn & 7, jn = tn >> 3, basen = jn & 31, rndn = jn >> 5;
            const int q8n = (rndn & 1) ? (32 * rndn + 31 - basen) : (32 * rndn + basen); const int q0n = q8n * 8, nblkn = (q0n >> 5) + 1; const size_t rbn = (size_t)bn * T;
            SEL_LOAD(q0n, nblkn, rbn); }
        __syncthreads();
        for (int rep_r = 0; rep_r < (int)((DUP_MASK >> 14) & 1) + 1; ++rep_r)
        {
            const int qp = q0 + wid; unsigned long long myword = 0ull;
            if (qp < 256) { const int lo = lane * 64; myword = (qp >= lo + 63) ? ~0ull : (qp < lo ? 0ull : ((2ull << (qp - lo)) - 1ull)); }
            else {
                int lane_t = lane; asm volatile("" : "+v"(lane_t));
                const LAS unsigned* scl = SC + wid * 4096 + lane_t; const int nscan = nblk * 32;
                unsigned u[64]; const int nreg = (nscan + 63) >> 6;
#pragma unroll
                for (int j4 = 0; j4 < 64; ++j4) { if ((j4 & ~15) < nreg) { const unsigned v_ = scl[64 * j4]; u[j4] = (lane_t < nscan - 64 * j4) ? v_ : 0u; } else u[j4] = 0u; }
                unsigned umax = 0u, umin = 0xFFFFFFFFu;
#pragma unroll
                for (int j4 = 0; j4 < 64; ++j4) { if ((j4 & ~15) < nreg) { umax = max(umax, u[j4]); umin = min(umin, u[j4] ? u[j4] : 0xFFFFFFFFu); } }
                umax = wave_max_u(umax); umin = wave_min_u(umin);
                unsigned lo = umin, hi = umax + 1u; int c_lo = qp + 1, c_hi = 0;
                while (c_lo - c_hi > 64 && hi - lo > 1u) {
                    const unsigned hm = hi - 1u;
                    const float lf = __uint_as_float((lo & 0x80000000u) ? (lo ^ 0x80000000u) : ~lo), hf = __uint_as_float((hm & 0x80000000u) ? (hm ^ 0x80000000u) : ~hm);
                    unsigned mid = sortable(0.5f * lf + 0.5f * hf);
                    mid = (mid <= lo) ? lo + 1u : ((mid >= hi) ? hi - 1u : mid);
                    int cl = 0;
#pragma unroll
                    for (int j4 = 0; j4 < 64; ++j4) { if ((j4 & ~15) < nreg) cl += (u[j4] >= mid) ? 1 : 0; }
                    const int c = wave_sum_i(cl);
                    if (c >= 256) { lo = mid; c_lo = c; } else { hi = mid; c_hi = c; }
                }
                unsigned Tk; int kth, neq;
                if (hi - lo == 1u) { Tk = lo; kth = 256 - c_hi; neq = c_lo - c_hi; }
                else {
                    LAS unsigned* CAND = HI; int pos = 0;
#pragma unroll
                    for (int j4 = 0; j4 < 64; ++j4) { if ((j4 & ~15) < nreg) { const bool in_ = (u[j4] >= lo) && (u[j4] < hi); const unsigned long long bm = __ballot(in_);
                        if (bm) { if (in_) CAND[pos + __builtin_popcountll(bm & ((1ull << lane_t) - 1ull))] = u[j4]; pos += __builtin_popcountll(bm); } } }
                    LDS_WAIT();
                    const int m_ = pos; const unsigned mine = (lane_t < m_) ? CAND[lane_t] : 0u;
                    int rg = 0, re = 0;
                    for (int x = 0; x < m_; ++x) { const unsigned v_ = __builtin_amdgcn_readlane(mine, x); rg += (v_ > mine) ? 1 : 0; re += (v_ == mine) ? 1 : 0; }
                    const int need = 256 - c_hi;
                    const bool is_t = (lane_t < m_) && (rg < need) && (need <= rg + re);
                    const unsigned long long bt = __ballot(is_t); const int Lt = (int)__builtin_ctzll(bt | (1ull << 63));
                    Tk = __builtin_amdgcn_readlane(mine, Lt); kth = need - __builtin_amdgcn_readlane(rg, Lt); neq = __builtin_amdgcn_readlane(re, Lt);
                }
                int eqtaken = 0; unsigned mw_lo = 0u, mw_hi = 0u;
                if (kth == neq) {
#pragma unroll
                    for (int jt = 0; jt < 64; ++jt) { if ((jt & ~15) < nreg) { const unsigned long long w = __ballot(u[jt] >= Tk); if (lane_t == jt) { mw_lo = (unsigned)w; mw_hi = (unsigned)(w >> 32); } } }
                } else
#pragma unroll
                for (int jt = 0; jt < 64; ++jt) { if ((jt & ~15) < nreg) { const bool gt = u[jt] > Tk, eq = (u[jt] == Tk); const unsigned long long beq = __ballot(eq);
                    const int rank = eqtaken + __builtin_popcountll(beq & ((1ull << lane_t) - 1ull));
                    const unsigned long long w = __ballot(gt || (eq && rank < kth)); eqtaken += __builtin_popcountll(beq);
                    if (lane_t == jt) { mw_lo = (unsigned)w; mw_hi = (unsigned)(w >> 32); } asm volatile("" : "+s"(eqtaken)); } }
                myword = ((unsigned long long)mw_hi << 32) | mw_lo;
            }
            MASK[((size_t)b * 4096 + qp) * 64 + lane] = myword;
        }
        __syncthreads();
    }
#undef SEL_LOAD
}

constexpr int SC_BUF = 43008, SC_YB = 2 * SC_BUF, SC_END = SC_YB + 2 * 2048;
static_assert(SC_END <= RING_BYTES, "scan LDS");
struct ScanP { const bf16_t* PROJ; bf16_t* PROJw; const _Float16* E; const _Float16* A; const bf16_t* VF; const float *mu_r, *mu_k, *k_k, *k_a, *r_k; };
__device__ __forceinline__ void scan_unit(const ScanP& P, int b, int h, int q4, LAS unsigned char* lds, int tid) {
    const int wave = __builtin_amdgcn_readfirstlane(tid >> 6), lane = tid & 63;
    const size_t rb = (size_t)b * T;
    if (wave >= 4) {
        const int pt = tid - 256, tl = pt >> 3, cg = pt & 7; const int ch0 = h * 64 + cg * 8;
        float mur[8], muk[8], kkp[8], kap[8], rkp[8];
#pragma unroll
        for (int i = 0; i < 8; ++i) { mur[i] = P.mu_r[ch0 + i]; muk[i] = P.mu_k[ch0 + i]; kkp[i] = P.k_k[ch0 + i]; kap[i] = P.k_a[ch0 + i]; rkp[i] = P.r_k[ch0 + i]; }
        u32x4 rc, kc, rp, kp, e8, a8; unsigned v2;
#define P_LOAD(cn) do { const int t_ = (cn) * 32 + tl; const size_t m_ = rb + t_; \
            rc = *(const u32x4*)(P.PROJ + m_ * NP + C_R + ch0); kc = *(const u32x4*)(P.PROJ + m_ * NP + C_K + ch0); rp = (u32x4){0u, 0u, 0u, 0u}; kp = (u32x4){0u, 0u, 0u, 0u}; \
            if (t_ > 0) { rp = *(const u32x4*)(P.PROJ + (m_ - 1) * NP + C_R + ch0); kp = *(const u32x4*)(P.PROJ + (m_ - 1) * NP + C_K + ch0); } \
            e8 = *(const u32x4*)(P.E + m_ * 512 + ch0); a8 = *(const u32x4*)(P.A + m_ * 512 + ch0); v2 = *(const unsigned*)(P.VF + m_ * 512 + h * 64 + q4 * 16 + 2 * cg); } while (0)
#define P_COMPUTE(cn) do { LAS unsigned char* buf = lds + ((cn) & 1) * SC_BUF; const size_t m = rb + (cn) * 32 + tl; \
            float r_[8], kl[8], kkv[8], a_[8], e_[8]; float ss = 0.f; \
            _Pragma("unroll") for (int i = 0; i < 8; ++i) { const unsigned wr_ = rc[i >> 1], wrp = rp[i >> 1], wk_ = kc[i >> 1], wkp = kp[i >> 1]; \
                const float xr = (i & 1) ? bfh(wr_) : bfl(wr_), xrp = (i & 1) ? bfh(wrp) : bfl(wrp), xk = (i & 1) ? bfh(wk_) : bfl(wk_), xkp = (i & 1) ? bfh(wkp) : bfl(wkp); \
                r_[i] = xr + (xrp - xr) * mur[i]; kl[i] = xk + (xkp - xk) * muk[i]; kkv[i] = kl[i] * kkp[i]; ss += kkv[i] * kkv[i]; \
                const unsigned we_ = e8[i >> 1], wa_ = a8[i >> 1]; const float el = (i & 1) ? bfh(we_) : bfl(we_), al = (i & 1) ? bfh(wa_) : bfl(wa_); \
                e_[i] = -0.60653065971f * pg8::sigmoidf_(el); a_[i] = pg8::sigmoidf_(al); } \
            ss = allsum8(ss); const float inv = 1.0f / fmaxf(sqrtf(ss), 1e-12f); \
            float kp_[8], kk_[8], nb_[8], dc_[8]; float rk = 0.f; \
            _Pragma("unroll") for (int i = 0; i < 8; ++i) { kk_[i] = kkv[i] * inv; kp_[i] = kl[i] * (1.f + (a_[i] - 1.f) * kap[i]); nb_[i] = -kk_[i] * a_[i]; dc_[i] = __expf(e_[i]); rk += r_[i] * kp_[i] * rkp[i]; } \
            rk = allsum8(rk); \
              \
            const bool wh = (tl & 1) != 0; const int pr = tl >> 1; \
            float rA[8], rB[8]; \
            _Pragma("unroll") for (int i = 0; i < 8; ++i) { rA[i] = dpp_f<0x128>(wh ? dc_[i] : nb_[i]); rB[i] = dpp_f<0x128>(wh ? kk_[i] : kp_[i]); }     \
            float o0[8], o1[8], o2[8], o3[8]; float sa = 0.f, sb = 0.f; \
            _Pragma("unroll") for (int i = 0; i < 8; ++i) { const float dA = dc_[i] * rA[i], dB = dc_[i] * rB[i]; \
                o0[i] = wh ? dA : kk_[i];            \
                o1[i] = dB;                          \
                o2[i] = wh ? nb_[i] : dc_[i] * r_[i];     \
                o3[i] = wh ? kp_[i] : dA;            \
                sa += wh ? rA[i] * kk_[i] : nb_[i] * r_[i];      \
                sb += wh ? rB[i] * kk_[i] : kp_[i] * r_[i]; }    \
            sa = allsum8(sa); sb = allsum8(sb); \
            LAS float* Ob = (LAS float*)buf + (wh ? 4096 : 0) + pr * 64 + cg * 8;            \
            *(LAS f32x4*)(Ob) = (f32x4){o0[0], o0[1], o0[2], o0[3]}; *(LAS f32x4*)(Ob + 4) = (f32x4){o0[4], o0[5], o0[6], o0[7]}; \
            *(LAS f32x4*)(Ob + 1024) = (f32x4){o1[0], o1[1], o1[2], o1[3]}; *(LAS f32x4*)(Ob + 1024 + 4) = (f32x4){o1[4], o1[5], o1[6], o1[7]}; \
            *(LAS f32x4*)(Ob + 2048) = (f32x4){o2[0], o2[1], o2[2], o2[3]}; *(LAS f32x4*)(Ob + 2048 + 4) = (f32x4){o2[4], o2[5], o2[6], o2[7]}; \
            *(LAS f32x4*)(Ob + 3072) = (f32x4){o3[0], o3[1], o3[2], o3[3]}; *(LAS f32x4*)(Ob + 3072 + 4) = (f32x4){o3[4], o3[5], o3[6], o3[7]}; \
            if (wh) { *(LAS f32x4*)(Ob + 4096) = (f32x4){r_[0], r_[1], r_[2], r_[3]}; *(LAS f32x4*)(Ob + 4096 + 4) = (f32x4){r_[4], r_[5], r_[6], r_[7]}; } \
            if (cg == 0) { LAS float* SCL = (LAS float*)buf + 9216 + pr * 4 + (wh ? 0 : 2); SCL[0] = sa; SCL[1] = sb; }       \
            LAS float* VV = (LAS float*)buf + 9280; VV[tl * 16 + 2 * cg] = bfl(v2); VV[tl * 16 + 2 * cg + 1] = bfh(v2); \
            if (q4 == 0 && cg == 0) P.PROJw[m * NP + C_RK + h] = (bf16_t)(pkbf(rk, 0.f) & 0xffffu); } while (0)
        P_LOAD(0); P_COMPUTE(0); P_LOAD(1);
        __syncthreads();
        for (int c = 0; c < T / 32; ++c) {
            if (c >= 1) { const LAS float* YB = (const LAS float*)(lds + SC_YB + ((c - 1) & 1) * 2048); const int t = (c - 1) * 32 + tl;
                const float y0 = YB[tl * 16 + 2 * cg], y1 = YB[tl * 16 + 2 * cg + 1];
                *(unsigned*)(P.PROJw + (rb + t) * NP + C_Y + h * 64 + q4 * 16 + 2 * cg) = pkbf(y0, y1); }
            if (c + 1 < T / 32) { P_COMPUTE(c + 1); if (c + 2 < T / 32) P_LOAD(c + 2); }
            __syncthreads();
        }
#undef P_LOAD
#undef P_COMPUTE
        {
            const int c = T / 32; const LAS float* YB = (const LAS float*)(lds + SC_YB + ((c - 1) & 1) * 2048); const int t = (c - 1) * 32 + tl;
            const float y0 = YB[tl * 16 + 2 * cg], y1 = YB[tl * 16 + 2 * cg + 1];
            *(unsigned*)(P.PROJw + (rb + t) * NP + C_Y + h * 64 + q4 * 16 + 2 * cg) = pkbf(y0, y1);
        }
    } else {
        const int rl = lane >> 4, kg = lane & 15, row = wave * 4 + rl;
        f32x4 S = {0.f, 0.f, 0.f, 0.f};
#ifdef SCAN_DUP_CONS
        f32x4 S2 = {0.f, 0.f, 0.f, 0.f}; float ydump = 0.f;
#endif
        __syncthreads();
        for (int c = 0; c < T / 32; ++c) {
            const LAS float* buf = (const LAS float*)(lds + (c & 1) * SC_BUF); LAS float* YB = (LAS float*)(lds + SC_YB + (c & 1) * 2048);
            struct PairOps { f32x4 kk1, wkk2, wr1, w12, n1, k1, nb2, k2, r2, sc; float v1, v2; };
#define SC_LOADP(O, pp) do { const LAS float* b_ = buf + (pp) * 64 + kg * 4; O.kk1 = *(const LAS f32x4*)(b_); O.wkk2 = *(const LAS f32x4*)(b_ + 1024); O.wr1 = *(const LAS f32x4*)(b_ + 2048); O.w12 = *(const LAS f32x4*)(b_ + 3072); \
                O.n1 = *(const LAS f32x4*)(b_ + 4096); O.k1 = *(const LAS f32x4*)(b_ + 5120); O.nb2 = *(const LAS f32x4*)(b_ + 6144); O.k2 = *(const LAS f32x4*)(b_ + 7168); O.r2 = *(const LAS f32x4*)(b_ + 8192); \
                O.sc = *(const LAS f32x4*)(buf + 9216 + (pp) * 4); O.v1 = buf[9280 + (2 * (pp)) * 16 + row]; O.v2 = buf[9280 + (2 * (pp) + 1) * 16 + row]; } while (0)
#define SC_DOT(A, B) ((A[0] * B[0] + A[1] * B[1]) + (A[2] * B[2] + A[3] * B[3]))
#define SC_STEPP(O, pp) do { float d1 = SC_DOT(S, O.kk1), d2 = SC_DOT(S, O.wkk2), d3 = SC_DOT(S, O.wr1); d1 = allsum16(d1); d2 = allsum16(d2); d3 = allsum16(d3); \
                const float s1 = d1, s2 = d2 + s1 * O.sc[0] + O.v1 * O.sc[1], y1 = d3 + s1 * O.sc[2] + O.v1 * O.sc[3]; \
                S = (S * O.w12 + (O.n1 * s1 + O.k1 * O.v1)) + (O.nb2 * s2 + O.k2 * O.v2); \
                float y2 = SC_DOT(S, O.r2); y2 = allsum16(y2); if (kg == 0) { YB[(2 * (pp)) * 16 + row] = y1; YB[(2 * (pp) + 1) * 16 + row] = y2; } } while (0)
            PairOps oA, oB;
            SC_LOADP(oA, 0);
#pragma unroll 2
            for (int pp = 0; pp < 16; pp += 2) {
                SC_LOADP(oB, pp + 1);
                SC_STEPP(oA, pp);
                if (pp + 2 < 16) SC_LOADP(oA, pp + 2);
                SC_STEPP(oB, pp + 1);
            }
#undef SC_LOADP
#undef SC_DOT
#undef SC_STEPP
            __syncthreads();
        }
#ifdef SCAN_DUP_CONS
        asm volatile("" :: "v"(ydump));
#endif
    }
    __syncthreads();
}

__device__ __forceinline__ void ph_scan_naive(const ScanP& P, int gw, int NGW, int lane) {
    for (int task = gw; task < 4096; task += NGW) { const int b = task >> 9, h = (task >> 6) & 7, row = task & 63; const int ch = h * 64 + lane;
        const float mur = P.mu_r[ch], muk = P.mu_k[ch], kkp = P.k_k[ch], kap = P.k_a[ch], rkp = P.r_k[ch];
        float S = 0.f, rprev = 0.f, kprev = 0.f;
        for (int t = 0; t < T; ++t) { const size_t m = (size_t)b * 4096 + t;
            const float rc = bf1(P.PROJ[m * NP + C_R + ch]), kc = bf1(P.PROJ[m * NP + C_K + ch]);
            const float r = rc + (rprev - rc) * mur, kl = kc + (kprev - kc) * muk; rprev = rc; kprev = kc;
            const float a = pg8::sigmoidf_((float)P.A[m * 512 + ch]); const float dec = __expf(-0.60653065971f * pg8::sigmoidf_((float)P.E[m * 512 + ch]));
            const float kkv = kl * kkp; const float ss = wave_sum(kkv * kkv); const float kk = kkv / fmaxf(sqrtf(ss), 1e-12f);
            const float kp = kl * (1.f + (a - 1.f) * kap); const float v = bf1(P.VF[m * 512 + h * 64 + row]);
            const float sk = wave_sum(S * kk); S = S * dec - sk * kk * a + v * kp; const float y = wave_sum(S * r);
            if (lane == 0) P.PROJw[m * NP + C_Y + h * 64 + row] = (bf16_t)(pkbf(y, 0.f) & 0xffffu);
            if (row == 0) { const float rk = wave_sum(r * kp * rkp); if (lane == 0) P.PROJw[m * NP + C_RK + h] = (bf16_t)(pkbf(rk, 0.f) & 0xffffu); } } }
}

__device__ __forceinline__ void ph_rwkv_post(const bf16_t* PROJ, const bf16_t* VF, bf16_t* MIX, const float* lnx_g, const float* lnx_b, int gw, int NGW, int lane) {
    float lg[8], lb[8];
#pragma unroll
    for (int i = 0; i < 8; ++i) { lg[i] = lnx_g[lane * 8 + i]; lb[i] = lnx_b[lane * 8 + i]; }
    for (int m = gw; m < M; m += NGW) {
        const u32x4 y8 = *(const u32x4*)(PROJ + (size_t)m * NP + C_Y + lane * 8), v8 = *(const u32x4*)(VF + (size_t)m * 512 + lane * 8), g8 = *(const u32x4*)(MIX + (size_t)m * D + lane * 8);
        const float rk = bf1(PROJ[(size_t)m * NP + C_RK + (lane >> 3)]);
        float y[8]; float s = 0.f;
#pragma unroll
        for (int i = 0; i < 4; ++i) { y[2 * i] = bfl(y8[i]); y[2 * i + 1] = bfh(y8[i]); s += y[2 * i] + y[2 * i + 1]; }
        const float mean = allsum8(s) * (1.f / 64.f); float q = 0.f;
#pragma unroll
        for (int i = 0; i < 8; ++i) { y[i] -= mean; q += y[i] * y[i]; }
        const float rstd = rsqrtf(allsum8(q) * (1.f / 64.f) + 64e-5f);
        float o[8];
#pragma unroll
        for (int i = 0; i < 8; ++i) { const float vv = (i & 1) ? bfh(v8[i >> 1]) : bfl(v8[i >> 1]), gg = (i & 1) ? bfh(g8[i >> 1]) : bfl(g8[i >> 1]);
            o[i] = (y[i] * rstd * lg[i] + lb[i] + rk * vv) * gg; }
        u32x4 w; w.x = pkbf(o[0], o[1]); w.y = pkbf(o[2], o[3]); w.z = pkbf(o[4], o[5]); w.w = pkbf(o[6], o[7]);
        *(u32x4*)(MIX + (size_t)m * D + lane * 8) = w;
    }
}

#ifndef MK_PER_PHASE
#define MK_PER_PHASE 0
#endif
constexpr int N_PHASES = 22;
struct Args { const float* in[32]; float* out; unsigned char* ws; int ph_lo, ph_hi, li, pad; };
__device__ __forceinline__ int opq(int k) { asm volatile("" : "+s"(k)); return k; }
#define INP(k) ((const float*)(const GAS float*)args.in[opq(k)])
#define WSP(T_, off) ((T_*)(wsl + (off)))
#define LAUNDER_WS() GAS unsigned char* wsl = (GAS unsigned char*)args.ws; asm volatile("" : "+s"(wsl)); GAS float* Xg = (GAS float*)Xp_; asm volatile("" : "+s"(Xg)); float* X = (float*)Xg; (void)X; int wave = wave_s; asm volatile("" : "+s"(wave)); \
    unsigned ones_ = ~0u; asm volatile("" : "+s"(ones_)); int tid = wave * 64 + (int)__builtin_amdgcn_mbcnt_hi(ones_, __builtin_amdgcn_mbcnt_lo(ones_, 0u)); asm volatile("" : "+v"(tid)); int G = gridDim.x, bx = blockIdx.x; asm volatile("" : "+s"(G), "+s"(bx)); \
    const int lane = tid & 63; const int vcu = (G % 8 == 0) ? (bx % 8) * (G / 8) + bx / 8 : bx; const int gw = vcu * NWAVES + wave, NGW = G * NWAVES; (void)lane; (void)gw; (void)NGW; (void)vcu
#ifndef PH_MASK
#define PH_MASK 0xFFFFu
#endif
#define PHBIT(k) ((k) == 0 ? 0 : ((k) == 21 ? 11 : (((k) - 1) % 10) + 1))
#define IN(k) (((PH_MASK >> PHBIT(k)) & 1u) && lo <= (k) && (k) < hi)
#ifndef DUP_MASK
#define DUP_MASK 0
#endif
#define DUPN(j) for (int rep_ = 0; rep_ < (int)((DUP_MASK >> (j)) & 1) + 1; ++rep_)
#define SEAM(k) do { if (IN(k) && IN((k) + 1)) { XcdBarrier b2_ = bar; asm volatile("" : "+s"(b2_.bar), "+s"(b2_.x)); xcd_barrier(b2_); } } while (0)
template <int l> __device__ __forceinline__ void layer_body(const Args& args, LAS unsigned char* lds, const XcdBarrier& bar, float* Xp_, const int lo, const int hi, const int wave_s) {
        const int pb = 1 + 10 * l;
        if (IN(pb + 0)) DUPN(0) { LAUNDER_WS();
            WPtrs P; P.w_in = INP(6); P.decay_a = INP(10); P.iclr_a = INP(13); P.gate_a = INP(15); P.vres_a = INP(24); P.mu_lora = INP(8); P.vres_mu = INP(22);
            P.w_out = INP(28); P.w1 = INP(29); P.w2 = INP(30); P.decay_b = INP(11); P.iclr_b = INP(14); P.gate_b = INP(16); P.vres_b = INP(25);
            if (l != 0) ph_weights(P, l, (unsigned char*)wsl, lds, vcu, G, tid);
            const float* MODl = WSP(float, WS_MOD) + (size_t)l * 8 * 6144;
            ph_norm((l == 0) ? INP(0) : (const float*)X, INP(4) + (size_t)l * D, MODl + 0 * D, MODl + 1 * D, WSP(bf16_t, WS_H), gw, NGW, lane);
        }
        SEAM(pb + 0);
        if (IN(pb + 1)) DUPN(1) { LAUNDER_WS();
            pg8::Gemm g{WSP(bf16_t, WS_H), WSP(bf16_t, WS_WIN), M, NP, D, D, D}; pg8::StaticOrder S; S.init(M, NP, G, bx);
            pg8::EpiBf<0> E{WSP(bf16_t, WS_PROJ), NP, C_QA / 256, C_KA / 256, att::C2};
            pg8::gemm_phase<pg8::EpiBf<0>, pg8::StaticOrder, true, true>(lds, g, S, E, tid);
        }
        SEAM(pb + 1);
        if (IN(pb + 2)) DUPN(2) { LAUNDER_WS();
            for (int rep_l = 0; rep_l < (int)((DUP_MASK >> 12) & 1) + 1; ++rep_l)
            ph_lora_act(WSP(bf16_t, WS_PROJ), WSP(bf16_t, WS_LACT), WSP(bf16_t, WS_VF), INP(7) + (size_t)(l * 3 + 2) * 512, l == 0, gw, NGW, lane);
            ph_select(WSP(bf16_t, WS_PROJ), WSP(unsigned long long, WS_MASK), lds, vcu, G, tid);
        }
        SEAM(pb + 2);
        if (IN(pb + 3)) {
            DUPN(3) { LAUNDER_WS(); pg8::Gemm g{WSP(bf16_t, WS_LACT), WSP(bf16_t, WS_LW), M, 1024, 128, LA, 128}; pg8::StaticOrder S; S.init(M, 1024, G, bx);
              pg8::EpiDecIclr E{WSP(_Float16, WS_H), WSP(_Float16, WS_H + 32 * MiB), INP(9) + (size_t)l * 512, INP(12) + (size_t)l * 512};
              pg8::gemm_phase<pg8::EpiDecIclr, pg8::StaticOrder, true, true>(lds, g, S, E, tid); }
            __syncthreads();
            DUPN(3) { LAUNDER_WS(); pg8::Gemm g{WSP(bf16_t, WS_LACT) + 128, WSP(bf16_t, WS_LW) + 1024 * 128, M, 512, 128, LA, 128}; pg8::StaticOrder S; S.init(M, 512, G, bx);
              pg8::EpiBf<0> E{WSP(bf16_t, WS_MIX), D, 0, 0, 1.f};
              pg8::gemm_phase<pg8::EpiBf<0>, pg8::StaticOrder, true, true>(lds, g, S, E, tid); }
            __syncthreads();
            if (l >= 1) { LAUNDER_WS(); pg8::Gemm g{WSP(bf16_t, WS_LACT) + 256, WSP(bf16_t, WS_LW) + 1536 * 128, M, 512, 128, LA, 128}; pg8::StaticOrder S; S.init(M, 512, G, bx);
              pg8::EpiVres E{WSP(bf16_t, WS_PROJ) + C_V, NP, WSP(bf16_t, WS_VF), INP(23) + (size_t)(l - 1) * 512, INP(7) + (size_t)(l * 3 + 2) * 512};
              pg8::gemm_phase<pg8::EpiVres, pg8::StaticOrder, true, true>(lds, g, S, E, tid); }
        }
        SEAM(pb + 3);
        if (IN(pb + 4)) {
            DUPN(4) { LAUNDER_WS();
              ScanP P; P.PROJ = WSP(bf16_t, WS_PROJ); P.PROJw = WSP(bf16_t, WS_PROJ); P.E = WSP(_Float16, WS_H); P.A = WSP(_Float16, WS_H + 32 * MiB); P.VF = WSP(bf16_t, WS_VF);
              P.mu_r = INP(7) + (size_t)(l * 3 + 0) * 512; P.mu_k = INP(7) + (size_t)(l * 3 + 1) * 512;
              P.k_k = INP(17) + (size_t)l * 512; P.k_a = INP(18) + (size_t)l * 512; P.r_k = INP(19) + (size_t)l * 512;
#ifdef SCAN_FAST
              for (int u = vcu; u < 256; u += G) scan_unit(P, u >> 5, (u >> 2) & 7, u & 3, lds, tid); }
#else
              ph_scan_naive(P, gw, NGW, lane); }
#endif
            __syncthreads();
            DUPN(11) { LAUNDER_WS();
              att::build_bias_table(INP(27), (LAS char*)lds, tid);
              __syncthreads();
              const float* gain = INP(26) + (size_t)l * 512;
              for (int v = vcu; v < 256; v += G) { const int bh = v >> 2, s = v & 3;
                  for (int i = 0; i < 4; ++i) { const int qb = (i == 0) ? s : (i == 1) ? 7 - s : (i == 2) ? 8 + s : 15 - s;
                      att::attn_unit(bh >> 3, bh & 7, qb, WSP(bf16_t, WS_PROJ), WSP(unsigned long long, WS_MASK), WSP(bf16_t, WS_MIX), gain, (LAS char*)lds, tid); } } }
        }
        SEAM(pb + 4);
        if (IN(pb + 5)) { LAUNDER_WS(); ph_rwkv_post(WSP(bf16_t, WS_PROJ), WSP(bf16_t, WS_VF), WSP(bf16_t, WS_MIX), INP(20) + (size_t)l * 512, INP(21) + (size_t)l * 512, gw, NGW, lane); }
        SEAM(pb + 5);
        if (IN(pb + 6)) { LAUNDER_WS();
            pg8::Gemm g{WSP(bf16_t, WS_MIX), WSP(bf16_t, WS_WOUT), M, D, D, D, D}; pg8::StaticOrder S; S.init(M, D, G, bx);
            pg8::EpiResid E{(l == 0) ? INP(0) : (const float*)X, X, WSP(float, WS_MOD) + (size_t)l * 8 * 6144 + 2 * D, D};
            pg8::gemm_phase<pg8::EpiResid, pg8::StaticOrder, true, true>(lds, g, S, E, tid);
        }
        SEAM(pb + 6);
        if (IN(pb + 7)) DUPN(7) { LAUNDER_WS(); const float* MODl = WSP(float, WS_MOD) + (size_t)l * 8 * 6144;
            ph_norm(X, INP(5) + (size_t)l * D, MODl + 3 * D, MODl + 4 * D, WSP(bf16_t, WS_H), gw, NGW, lane); }
        SEAM(pb + 7);
        if (IN(pb + 8)) DUPN(8) { LAUNDER_WS();
            pg8::Gemm g{WSP(bf16_t, WS_H), WSP(bf16_t, WS_W1), M, FF, D, D, D}; pg8::StaticOrder S; S.init(M, FF, G, bx);
            pg8::EpiBf<1> E{WSP(bf16_t, WS_PROJ), FF, 0, 0, 1.f};
            pg8::gemm_phase<pg8::EpiBf<1>, pg8::StaticOrder, true, true>(lds, g, S, E, tid);
        }
        SEAM(pb + 8);
        if (IN(pb + 9)) { LAUNDER_WS();
            pg8::Gemm g{WSP(bf16_t, WS_PROJ), WSP(bf16_t, WS_W2), M, D, FF, FF, FF}; pg8::StaticOrder S; S.init(M, D, G, bx);
            pg8::EpiResid E{X, X, WSP(float, WS_MOD) + (size_t)l * 8 * 6144 + 5 * D, D};
            pg8::gemm_phase<pg8::EpiResid, pg8::StaticOrder, true, true>(lds, g, S, E, tid);
        }
        SEAM(pb + 9);
}
__global__ void __launch_bounds__(NWAVES * 64, 2) trunk_fwd(Args args) {
    extern __shared__ __attribute__((aligned(16))) unsigned char lds_raw[];
    LAS unsigned char* lds = (LAS unsigned char*)lds_raw;
    volatile LAS unsigned* MISC = (volatile LAS unsigned*)(lds + MISC_OFF);
    unsigned* ctl = (unsigned*)(args.ws + WS_CTL);
    for (int u = threadIdx.x; u < (LDS_BYTES - LDSCTL_OFF) / 4; u += NWAVES * 64) ((LAS unsigned*)(lds + LDSCTL_OFF))[u] = 0u;
    __syncthreads();
    XcdBarrier bar = xcd_barrier_post(ctl + CW_BAR + args.li * XCD_BAR_WORDS, MISC + 8);
    const int lo = args.ph_lo, hi = args.ph_hi; const int wave_s = __builtin_amdgcn_readfirstlane((int)threadIdx.x >> 6);
    float* Xp_ = args.out;

    if (IN(0)) { LAUNDER_WS(); ph_mod(INP(1), INP(2), INP(3), WSP(float, WS_MOD), lds, vcu, G, tid);
        WPtrs P; P.w_in = INP(6); P.decay_a = INP(10); P.iclr_a = INP(13); P.gate_a = INP(15); P.vres_a = INP(24); P.mu_lora = INP(8); P.vres_mu = INP(22);
        P.w_out = INP(28); P.w1 = INP(29); P.w2 = INP(30); P.decay_b = INP(11); P.iclr_b = INP(14); P.gate_b = INP(16); P.vres_b = INP(25);
        __syncthreads();
        ph_weights(P, 0, (unsigned char*)wsl, lds, vcu, G, tid); }
    SEAM(0);

    layer_body<0>(args, lds, bar, Xp_, lo, hi, wave_s);
    layer_body<1>(args, lds, bar, Xp_, lo, hi, wave_s);
    if (IN(21)) { LAUNDER_WS(); (void)wsl; ph_final_norm(X, INP(31), gw, NGW, lane); }
#undef IN
#undef SEAM
}

extern "C" void kernel_launch(void* const* d_in, const int* in_sizes, int n_in, void* d_out, int out_size, void* d_ws, size_t ws_size, hipStream_t stream) {
    static int grid = 0;
    if (grid == 0) {
        if (n_in != 32 || in_sizes[0] != M * D || out_size != M * D || ws_size < WS_END) { fprintf(stderr, "kernel_launch: unexpected problem: n_in %d in0 %d out %d ws %zu (need %zu)\n", n_in, n_in > 0 ? in_sizes[0] : -1, out_size, ws_size, (size_t)WS_END); grid = -1; return; }
        int dev = 0, cus = 0, per_cu = 0;
        if (hipGetDevice(&dev) != hipSuccess || hipDeviceGetAttribute(&cus, hipDeviceAttributeMultiprocessorCount, dev) != hipSuccess) { grid = -1; return; }
        if (hipFuncSetAttribute((const void*)trunk_fwd, hipFuncAttributeMaxDynamicSharedMemorySize, LDS_BYTES) != hipSuccess) { fprintf(stderr, "kernel_launch: hipFuncSetAttribute failed\n"); grid = -1; return; }
        if (hipOccupancyMaxActiveBlocksPerMultiprocessor(&per_cu, (const void*)trunk_fwd, NWAVES * 64, LDS_BYTES) != hipSuccess || per_cu < 1) { fprintf(stderr, "kernel_launch: occupancy query reports %d workgroups per CU\n", per_cu); }
        (void)hipGetLastError();
        grid = cus;
        if (grid > 256) grid = 256;
    }
    if (grid < 0) return;
    if (hipMemsetAsync((char*)d_ws + WS_CTL, 0, CTL_ZERO_BYTES, stream) != hipSuccess) return;
    Args a{};
    for (int i = 0; i < 32; ++i) a.in[i] = (const float*)d_in[i];
    a.out = (float*)d_out; a.ws = (unsigned char*)d_ws; a.pad = 0;
#if MK_PER_PHASE
    for (int p = 0; p < N_PHASES; ++p) { a.ph_lo = p; a.ph_hi = p + 1; a.li = 0;
        hipLaunchKernelGGL(trunk_fwd, dim3(grid), dim3(NWAVES * 64), LDS_BYTES, stream, a); }
#else
    a.ph_lo = 0; a.ph_hi = N_PHASES; a.li = 0;
    hipLaunchKernelGGL(trunk_fwd, dim3(grid), dim3(NWAVES * 64), LDS_BYTES, stream, a);
#endif
}
```

```cpp
#define SCAN_FAST 1
#include <hip/hip_runtime.h>
#include <hip/hip_bf16.h>
#include <cstdio>
#include <cstdint>
#include <cmath>
namespace pg8 {
#define PG8_LAS __attribute__((address_space(3)))
typedef unsigned short bf16_t;
typedef short bf16x8 __attribute__((ext_vector_type(8)));
typedef float f32x4 __attribute__((ext_vector_type(4)));
typedef unsigned u32x4 __attribute__((ext_vector_type(4)));
constexpr int BM = 256, BK = 64, HALF = 128, HTB = HALF * BK * 2  , STAGE_BYTES = 8 * HTB, NXCD = 8, WGM = 8;

__host__ __device__ __forceinline__ int lds_byte(int r, int c) { const int st = (r >> 4) * 2 + (c >> 5), rr = r & 15, cc = c & 31, ob = rr * 64 + cc * 2; return st * 1024 + (ob ^ (((ob >> 9) & 1) << 5)); }
__host__ __device__ __forceinline__ void stage_rc(int b, int& R, int& C) { const int st = b / 1024, sb = b % 1024, swz = sb ^ (((sb >> 9) & 1) << 5); R = (st >> 1) * 16 + swz / 64; C = (st & 1) * 32 + (swz % 64) / 2; }
__host__ __device__ __forceinline__ int perm32(int rho) { const int n = rho >> 4, i = rho & 15; return 8 * (i >> 2) + 4 * n + (i & 3); }

struct Unit { int pm, pn; };
struct Gemm { const bf16_t* A; const bf16_t* Bt; int M, N, K, lda, ldb; };

struct StaticOrder {
    int nM, nN, nwg, G, c;
    __host__ __device__ void init(int M, int N, int G_, int c_) { nM = M / BM; nN = N / BM; nwg = nM * nN; G = G_; c = c_; }
    __host__ __device__ bool next(int i, Unit& u) const {
        const long L = (long)i * G + c; if (L >= nwg) return false;
        int wgid = (int)L; { const int q = nwg / NXCD, r = nwg % NXCD, xcd = wgid % NXCD, off = wgid / NXCD; wgid = (xcd < r ? xcd * (q + 1) : r * (q + 1) + (xcd - r) * q) + off; }
        const int nig = WGM * nN, gid = wgid / nig, fm = gid * WGM, gsz = (nM - fm) < WGM ? (nM - fm) : WGM;
        u.pm = fm + ((wgid % nig) % gsz); u.pn = (wgid % nig) / gsz; return true;
    }
    __device__ __forceinline__ void a_ready(const Unit&) const {}
    __device__ __forceinline__ void done(const Unit&) const {}
};

typedef _Float16 f16x2_t __attribute__((ext_vector_type(2)));
typedef _Float16 half8 __attribute__((ext_vector_type(8)));
__device__ __forceinline__ unsigned cvt_pk_bf16(float lo, float hi) { f16x2_t h = {(_Float16)lo, (_Float16)hi}; return __builtin_bit_cast(unsigned, h); }
__device__ __forceinline__ unsigned cvt_pk_f16(float lo, float hi) { f16x2_t h = {(_Float16)lo, (_Float16)hi}; return __builtin_bit_cast(unsigned, h); }
__device__ __forceinline__ float bf_lo(unsigned w) { return (float)__builtin_bit_cast(_Float16, (unsigned short)(w & 0xffffu)); }
__device__ __forceinline__ float bf_hi(unsigned w) { return (float)__builtin_bit_cast(_Float16, (unsigned short)(w >> 16)); }
__device__ __forceinline__ float sigmoidf_(float x) { return __builtin_amdgcn_rcpf(1.0f + __expf(-x)); }

template <int MODE> struct EpiBf {
    static constexpr bool PERM = true, AFTER_DRAIN = false;
    bf16_t* O; int ldc; int qlo, qhi; float qscale;
    __device__ __forceinline__ void operator()(const f32x4 (&acc)[2][2][4][2], const Unit& u, int wr, int wc, int fr, int fq) const {
        const int row0 = u.pm * BM + wr * 64 + fr, col0 = u.pn * BM + wc * 32 + 8 * fq;
        const float sc = (MODE == 0 && u.pn >= qlo && u.pn < qhi) ? qscale : 1.f;
#pragma unroll
        for (int ai = 0; ai < 2; ++ai)
#pragma unroll
            for (int m = 0; m < 4; ++m) { bf16_t* rowp = O + (size_t)(row0 + ai * HALF + m * 16) * ldc + col0;
#pragma unroll
                for (int bj = 0; bj < 2; ++bj) { f32x4 v0 = acc[ai][bj][m][0], v1 = acc[ai][bj][m][1];
                    if (MODE == 1) { v0 = __builtin_elementwise_max(v0, (f32x4){0.f, 0.f, 0.f, 0.f}); v1 = __builtin_elementwise_max(v1, (f32x4){0.f, 0.f, 0.f, 0.f}); v0 = v0 * v0; v1 = v1 * v1; }
                    else { v0 = v0 * sc; v1 = v1 * sc; }
                    u32x4 w; w.x = cvt_pk_bf16(v0[0], v0[1]); w.y = cvt_pk_bf16(v0[2], v0[3]); w.z = cvt_pk_bf16(v1[0], v1[1]); w.w = cvt_pk_bf16(v1[2], v1[3]);
                    *(u32x4*)(rowp + bj * HALF) = w; } }
    }
};
struct EpiResid {
    static constexpr bool PERM = false, AFTER_DRAIN = false;
    const float* base; float* out; const float* gate; int ldc;
    __device__ __forceinline__ void operator()(const f32x4 (&acc)[2][2][4][2], const Unit& u, int wr, int wc, int fr, int fq) const {
        const int row0 = u.pm * BM + wr * 64 + fr, col0 = u.pn * BM + wc * 32 + 4 * fq;
        const float* gp = gate + (size_t)((u.pm * BM) >> 12) * 6144 + col0;
#pragma unroll
        for (int bj = 0; bj < 2; ++bj)
#pragma unroll
            for (int n = 0; n < 2; ++n) { const f32x4 gv = *(const f32x4*)(gp + bj * HALF + n * 16);
#pragma unroll
                for (int ai = 0; ai < 2; ++ai)
#pragma unroll
                    for (int m = 0; m < 4; ++m) { const size_t off = (size_t)(row0 + ai * HALF + m * 16) * ldc + col0 + bj * HALF + n * 16;
                        const f32x4 bs = *(const f32x4*)(base + off); *(f32x4*)(out + off) = bs + gv * acc[ai][bj][m][n]; } }
    }
};
struct EpiDecIclr {
    static constexpr bool PERM = true, AFTER_DRAIN = false;
    _Float16* E; _Float16* A; const float* w0; const float* a0;
    __device__ __forceinline__ void operator()(const f32x4 (&acc)[2][2][4][2], const Unit& u, int wr, int wc, int fr, int fq) const {
        const int row0 = u.pm * BM + wr * 64 + fr; const int kind = u.pn >> 1; const int c0 = (u.pn & 1) * BM + wc * 32 + 8 * fq;
        _Float16* O = kind ? A : E; const float* bp = kind ? a0 : w0;
#pragma unroll
        for (int bj = 0; bj < 2; ++bj) { const f32x4 bv0 = *(const f32x4*)(bp + c0 + bj * HALF), bv1 = *(const f32x4*)(bp + c0 + bj * HALF + 4);
#pragma unroll
            for (int ai = 0; ai < 2; ++ai)
#pragma unroll
                for (int m = 0; m < 4; ++m) { _Float16* rowp = O + (size_t)(row0 + ai * HALF + m * 16) * 512 + c0 + bj * HALF;
                    const f32x4 v0 = acc[ai][bj][m][0] + bv0, v1 = acc[ai][bj][m][1] + bv1;
                    u32x4 w; w.x = cvt_pk_f16(v0[0], v0[1]); w.y = cvt_pk_f16(v0[2], v0[3]); w.z = cvt_pk_f16(v1[0], v1[1]); w.w = cvt_pk_f16(v1[2], v1[3]);
                    *(u32x4*)rowp = w; asm volatile("" ::: "memory"); } }
    }
};
struct EpiVres {
    static constexpr bool PERM = true, AFTER_DRAIN = false;
    const bf16_t* PV; int ldp; bf16_t* VF; const float* v0; const float* muv;
    __device__ __forceinline__ void operator()(const f32x4 (&acc)[2][2][4][2], const Unit& u, int wr, int wc, int fr, int fq) const {
        const int row0 = u.pm * BM + wr * 64 + fr; const int c0 = u.pn * BM + wc * 32 + 8 * fq;
#pragma unroll
        for (int bj = 0; bj < 2; ++bj) { const int c = c0 + bj * HALF;
            float b8[8], m8[8];
#pragma unroll
            for (int i = 0; i < 8; ++i) { b8[i] = v0[c + i]; m8[i] = muv[c + i]; }
#pragma unroll
            for (int ai = 0; ai < 2; ++ai)
#pragma unroll
                for (int m = 0; m < 4; ++m) { const int row = row0 + ai * HALF + m * 16;
                    const u32x4 vc = *(const u32x4*)(PV + (size_t)row * ldp + c);
                    u32x4 vp = (u32x4){0u, 0u, 0u, 0u}; if ((row & 4095) != 0) vp = *(const u32x4*)(PV + (size_t)(row - 1) * ldp + c);
                    const u32x4 vf = *(const u32x4*)(VF + (size_t)row * 512 + c);
                    float o[8];
#pragma unroll
                    for (int i = 0; i < 8; ++i) { const unsigned wc_ = vc[i >> 1], wp_ = vp[i >> 1], wf_ = vf[i >> 1];
                        const float xc = (i & 1) ? bf_hi(wc_) : bf_lo(wc_), xp = (i & 1) ? bf_hi(wp_) : bf_lo(wp_), xf = (i & 1) ? bf_hi(wf_) : bf_lo(wf_);
                        const float a = (i < 4) ? acc[ai][bj][m][0][i & 3] : acc[ai][bj][m][1][i & 3];
                        const float vl = xc + (xp - xc) * m8[i]; const float g = sigmoidf_(b8[i] + a); o[i] = vl + (xf - vl) * g; }
                    u32x4 w; w.x = cvt_pk_bf16(o[0], o[1]); w.y = cvt_pk_bf16(o[2], o[3]); w.z = cvt_pk_bf16(o[4], o[5]); w.w = cvt_pk_bf16(o[6], o[7]);
                    *(u32x4*)(VF + (size_t)row * 512 + c) = w; asm volatile("" ::: "memory"); } }
    }
};

template <class Epi, class Sched, bool ALIGN_EPI = false, bool SP2 = false>
__device__ __forceinline__ void gemm_phase(PG8_LAS unsigned char* lds, const Gemm g, const Sched& S, const Epi& E, const int tid) {
    const int wid = __builtin_amdgcn_readfirstlane(tid >> 6), lane = tid & 63, wr = wid >> 2, wc = wid & 3, fr = lane & 15, fq = lane >> 4;
    const int K = g.K, nt = K / BK;
    unsigned voffA[2], voffB[2];
#pragma unroll
    for (int i = 0; i < 2; ++i) { int R, C; stage_rc(tid * 16 + i * 8192, R, C); const int Rb = Epi::PERM ? ((R & ~31) + perm32(R & 31)) : R;
        voffA[i] = (unsigned)(R * g.lda + C) * 2u; voffB[i] = (unsigned)(Rb * g.ldb + C) * 2u; }
    const size_t kstep = (size_t)(BK * 2);
    const size_t hstepA = (size_t)HALF * g.lda * 2, hstepB = (size_t)HALF * g.ldb * 2;
    const size_t tstepA = 2 * hstepA, tstepB = 2 * hstepB;
    const unsigned ldsw = (unsigned)wid * 1024u;
    const int aoff = lds_byte(wr * 64 + fr, fq * 8), boff = lds_byte(wc * 32 + fr, fq * 8);
#define PG8_SA(b, h) (((b) * 2 + (h)) * HTB)
#define PG8_SB(b, h) ((4 + (b) * 2 + (h)) * HTB)
#define PG8_STAGE(bufoff, gbase, voff) do { _Pragma("unroll") for (int _i = 0; _i < 2; ++_i) \
        __builtin_amdgcn_global_load_lds((const unsigned*)((const char*)(gbase) + (voff)[_i]), (PG8_LAS unsigned*)(lds + (bufoff) + ldsw + _i * 8192), 16, 0, 0); } while (0)
#define PG8_LDA(dst, b, h) do { _Pragma("unroll") for (int m = 0; m < 4; ++m) _Pragma("unroll") for (int k = 0; k < 2; ++k) dst[m][k] = *(const PG8_LAS bf16x8*)(lds + PG8_SA(b, h) + aoff + m * 2048 + k * 1024); } while (0)
#define PG8_LDB(dst, b, h) do { _Pragma("unroll") for (int n = 0; n < 2; ++n) _Pragma("unroll") for (int k = 0; k < 2; ++k) dst[n][k] = *(const PG8_LAS bf16x8*)(lds + PG8_SB(b, h) + boff + n * 2048 + k * 1024); } while (0)
#define PG8_MMA(ai, bj, At, Bt) do { __builtin_amdgcn_s_setprio(1); _Pragma("unroll") for (int m = 0; m < 4; ++m) _Pragma("unroll") for (int n = 0; n < 2; ++n) _Pragma("unroll") for (int k = 0; k < 2; ++k) \
        acc[ai][bj][m][n] = __builtin_amdgcn_mfma_f32_16x16x32_f16(__builtin_bit_cast(half8, Bt[n][k]), __builtin_bit_cast(half8, At[m][k]), acc[ai][bj][m][n], 0, 0, 0); __builtin_amdgcn_s_setprio(0); } while (0)
#define PG8_WAIT_V(n) asm volatile("s_waitcnt vmcnt(" #n ")" ::: "memory")
#define PG8_WAIT_L(n) asm volatile("s_waitcnt lgkmcnt(" #n ")" ::: "memory")
#define PG8_BAR __builtin_amdgcn_s_barrier()
#define PG8_SCHED __builtin_amdgcn_sched_barrier(0)
    Unit cur, nxt; int ui = 0;
    if (!S.next(0, cur)) return;
    f32x4 acc[2][2][4][2];
#pragma unroll
    for (int a = 0; a < 2; ++a)
#pragma unroll
        for (int b = 0; b < 2; ++b)
#pragma unroll
            for (int m = 0; m < 4; ++m)
#pragma unroll
                for (int n = 0; n < 2; ++n) acc[a][b][m][n] = (f32x4){0.f, 0.f, 0.f, 0.f};
    bf16x8 At[4][2], B0[2][2], B1[2][2];
    const char* cA = (const char*)g.A + (size_t)cur.pm * tstepA; const char* cB = (const char*)g.Bt + (size_t)cur.pn * tstepB;
    S.a_ready(cur);
    if constexpr (SP2) {
        PG8_STAGE(PG8_SB(0, 0), cB, voffB); PG8_STAGE(PG8_SB(0, 1), cB + hstepB, voffB); PG8_STAGE(PG8_SA(0, 0), cA, voffA); PG8_STAGE(PG8_SA(0, 1), cA + hstepA, voffA);
        if (wr == 1) PG8_BAR;
        PG8_WAIT_V(2); PG8_BAR;
        PG8_STAGE(PG8_SB(1, 0), cB + kstep, voffB); PG8_STAGE(PG8_SA(1, 0), cA + kstep, voffA); PG8_STAGE(PG8_SB(1, 1), cB + hstepB + kstep, voffB);
        PG8_WAIT_V(6); PG8_BAR;
    } else {
        PG8_STAGE(PG8_SB(0, 0), cB, voffB); PG8_STAGE(PG8_SA(0, 0), cA, voffA); PG8_STAGE(PG8_SB(0, 1), cB + hstepB, voffB); PG8_STAGE(PG8_SA(0, 1), cA + hstepA, voffA);
        if (wr == 1) PG8_BAR;
        PG8_WAIT_V(4); PG8_BAR;
        PG8_STAGE(PG8_SB(1, 0), cB + kstep, voffB); PG8_STAGE(PG8_SA(1, 0), cA + kstep, voffA); PG8_STAGE(PG8_SB(1, 1), cB + hstepB + kstep, voffB);
        PG8_WAIT_V(6); PG8_BAR;
    }
    for (;;) {
        const bool has_next = S.next(ui + 1, nxt);
        const char* nA = has_next ? (const char*)g.A + (size_t)nxt.pm * tstepA : cA; const char* nB = has_next ? (const char*)g.Bt + (size_t)nxt.pn * tstepB : cB;
        for (int t = 0; t < nt; t += 2) {
            const bool last = (t == nt - 2);
            const char* a1 = cA + (size_t)(t + 1) * kstep;
            const char* a2 = last ? nA : cA + (size_t)(t + 2) * kstep; const char* b2 = last ? nB : cB + (size_t)(t + 2) * kstep;
            const char* a3 = a2 + kstep; const char* b3 = b2 + kstep;
            if (last && has_next) S.a_ready(nxt);
            if constexpr (SP2) {
            PG8_LDB(B0, 0, 0); PG8_LDB(B1, 0, 1); PG8_SCHED; PG8_LDA(At, 0, 0); PG8_STAGE(PG8_SA(1, 1), a1 + hstepA, voffA);
            PG8_WAIT_V(8); PG8_WAIT_L(0); PG8_BAR; PG8_MMA(0, 0, At, B0); PG8_MMA(0, 1, At, B1); PG8_BAR; PG8_SCHED;
            PG8_LDA(At, 0, 1); PG8_STAGE(PG8_SB(0, 0), b2, voffB); PG8_STAGE(PG8_SB(0, 1), b2 + hstepB, voffB); PG8_STAGE(PG8_SA(0, 0), a2, voffA);
            PG8_WAIT_V(8); PG8_WAIT_L(0); PG8_BAR; PG8_MMA(1, 0, At, B0); PG8_MMA(1, 1, At, B1); PG8_BAR; PG8_SCHED;
            PG8_LDB(B0, 1, 0); PG8_LDB(B1, 1, 1); PG8_SCHED; PG8_LDA(At, 1, 0); PG8_STAGE(PG8_SA(0, 1), a2 + hstepA, voffA);
            PG8_WAIT_V(8); PG8_WAIT_L(0); PG8_BAR; PG8_MMA(0, 0, At, B0); PG8_MMA(0, 1, At, B1); PG8_BAR; PG8_SCHED;
            PG8_LDA(At, 1, 1); PG8_STAGE(PG8_SB(1, 0), b3, voffB); PG8_STAGE(PG8_SB(1, 1), b3 + hstepB, voffB); PG8_STAGE(PG8_SA(1, 0), a3, voffA);
            PG8_WAIT_V(8); PG8_WAIT_L(0); PG8_BAR; PG8_MMA(1, 0, At, B0); PG8_MMA(1, 1, At, B1); PG8_BAR; PG8_SCHED;
            } else {
            PG8_LDB(B0, 0, 0); PG8_SCHED; PG8_LDA(At, 0, 0); PG8_STAGE(PG8_SA(1, 1), a1 + hstepA, voffA);
            PG8_WAIT_L(8); PG8_BAR; PG8_WAIT_L(0); PG8_MMA(0, 0, At, B0); PG8_BAR; PG8_SCHED;
            PG8_LDB(B1, 0, 1); PG8_STAGE(PG8_SB(0, 0), b2, voffB);
            PG8_BAR; PG8_WAIT_L(0); PG8_MMA(0, 1, At, B1); PG8_BAR;
            PG8_LDA(At, 0, 1); PG8_STAGE(PG8_SA(0, 0), a2, voffA);
            PG8_BAR; PG8_WAIT_L(0); PG8_MMA(1, 0, At, B0); PG8_BAR; PG8_SCHED;
            PG8_STAGE(PG8_SB(0, 1), b2 + hstepB, voffB);
            PG8_WAIT_V(6); PG8_BAR; PG8_MMA(1, 1, At, B1); PG8_BAR;
            PG8_LDB(B0, 1, 0); PG8_SCHED; PG8_LDA(At, 1, 0); PG8_STAGE(PG8_SA(0, 1), a2 + hstepA, voffA);
            PG8_WAIT_L(8); PG8_BAR; PG8_WAIT_L(0); PG8_MMA(0, 0, At, B0); PG8_BAR; PG8_SCHED;
            PG8_LDB(B1, 1, 1); PG8_STAGE(PG8_SB(1, 0), b3, voffB);
            PG8_BAR; PG8_WAIT_L(0); PG8_MMA(0, 1, At, B1); PG8_BAR;
            PG8_LDA(At, 1, 1); PG8_STAGE(PG8_SA(1, 0), a3, voffA);
            PG8_BAR; PG8_WAIT_L(0); PG8_MMA(1, 0, At, B0); PG8_BAR; PG8_SCHED;
            PG8_STAGE(PG8_SB(1, 1), b3 + hstepB, voffB);
            PG8_WAIT_V(6); PG8_BAR; PG8_MMA(1, 1, At, B1); PG8_BAR;
            }
        }
        if constexpr (ALIGN_EPI) { if (wr == 0) PG8_BAR; }
        if constexpr (!Epi::AFTER_DRAIN) { E(acc, cur, wr, wc, fr, fq); S.done(cur); }
        if (!has_next) break;
#pragma unroll
        for (int a = 0; a < 2; ++a)
#pragma unroll
            for (int b = 0; b < 2; ++b)
#pragma unroll
                for (int m = 0; m < 4; ++m)
#pragma unroll
                    for (int n = 0; n < 2; ++n) acc[a][b][m][n] = (f32x4){0.f, 0.f, 0.f, 0.f};
        cur = nxt; cA = nA; cB = nB; ++ui;
        if constexpr (ALIGN_EPI) { if (wr == 1) PG8_BAR; }
    }
    PG8_WAIT_V(0);
    if constexpr (!ALIGN_EPI) { if (wr == 0) PG8_BAR; }
    PG8_BAR;
    if constexpr (Epi::AFTER_DRAIN) { E.fused(acc, cur, wr, wc, fr, fq, lds, wid, lane); S.done(cur); }
#undef PG8_SA
#undef PG8_SB
#undef PG8_STAGE
#undef PG8_LDA
#undef PG8_LDB
#undef PG8_MMA
#undef PG8_WAIT_V
#undef PG8_WAIT_L
#undef PG8_BAR
#undef PG8_SCHED
}
}
constexpr int NB = 8, T = 4096, D = 1024, M = NB * T, NP = 4352, FF = 4096, LA = 384;
constexpr int C_R = 0, C_K = 512, C_V = 1024, C_QA = 1536, C_KA = 2048, C_VA = 2560, C_QI = 3072, C_KI = 3584, C_WI = 3648, C_P1 = 3656, C_P2 = 3944, C_END = 4232, C_Y = 3656, C_RK = 4168;
#define GAS __attribute__((address_space(1)))
#define LAS __attribute__((address_space(3)))
typedef unsigned short bf16_t;
typedef short bf16x8 __attribute__((ext_vector_type(8)));
typedef float f32x4 __attribute__((ext_vector_type(4)));
typedef float f32x16 __attribute__((ext_vector_type(16)));
typedef unsigned u32x4 __attribute__((ext_vector_type(4)));
typedef unsigned u32x2 __attribute__((ext_vector_type(2)));
typedef short s16x4 __attribute__((ext_vector_type(4)));
#define LDS_WAIT() asm volatile("s_waitcnt lgkmcnt(0)" ::: "memory")
#define VM_WAIT() asm volatile("s_waitcnt vmcnt(0)" ::: "memory")
__device__ __forceinline__ float bfl(unsigned w) { return (float)__builtin_bit_cast(_Float16, (unsigned short)(w & 0xffffu)); }
__device__ __forceinline__ float bfh(unsigned w) { return (float)__builtin_bit_cast(_Float16, (unsigned short)(w >> 16)); }
__device__ __forceinline__ float bf1(bf16_t v) { return (float)__builtin_bit_cast(_Float16, v); }
__device__ __forceinline__ unsigned pkbf(float lo, float hi) { return pg8::cvt_pk_bf16(lo, hi); }
template <int CTRL> __device__ __forceinline__ float dpp_f(float x) { return __builtin_bit_cast(float, __builtin_amdgcn_update_dpp(0, __builtin_bit_cast(int, x), CTRL, 0xf, 0xf, true)); }
__device__ __forceinline__ float allsum8(float x) { x += dpp_f<0xB1>(x); x += dpp_f<0x4E>(x); x += dpp_f<0x141>(x); return x; }
__device__ __forceinline__ float allsum16(float x) { x = allsum8(x); x += dpp_f<0x140>(x); return x; }
template <int CTRL> __device__ __forceinline__ int dpp_i(int x) { return __builtin_amdgcn_update_dpp(0, x, CTRL, 0xf, 0xf, true); }
__device__ __forceinline__ int wave_sum_i(int x) {
    x += dpp_i<0xB1>(x); x += dpp_i<0x4E>(x); x += dpp_i<0x141>(x); x += dpp_i<0x140>(x);
    return __builtin_amdgcn_readlane(x, 0) + __builtin_amdgcn_readlane(x, 16) + __builtin_amdgcn_readlane(x, 32) + __builtin_amdgcn_readlane(x, 48); }
__device__ __forceinline__ unsigned wave_max_u(unsigned x) {
    x = max(x, (unsigned)dpp_i<0xB1>((int)x)); x = max(x, (unsigned)dpp_i<0x4E>((int)x)); x = max(x, (unsigned)dpp_i<0x141>((int)x)); x = max(x, (unsigned)dpp_i<0x140>((int)x));
    return max(max((unsigned)__builtin_amdgcn_readlane((int)x, 0), (unsigned)__builtin_amdgcn_readlane((int)x, 16)), max((unsigned)__builtin_amdgcn_readlane((int)x, 32), (unsigned)__builtin_amdgcn_readlane((int)x, 48))); }
__device__ __forceinline__ unsigned wave_min_u(unsigned x) { return ~wave_max_u(~x); }
__device__ __forceinline__ float wave_sum(float v) {
    v += dpp_f<0xB1>(v); v += dpp_f<0x4E>(v); v += dpp_f<0x141>(v); v += dpp_f<0x140>(v);
    const float r0 = __builtin_bit_cast(float, __builtin_amdgcn_readlane(__builtin_bit_cast(int, v), 0)), r1 = __builtin_bit_cast(float, __builtin_amdgcn_readlane(__builtin_bit_cast(int, v), 16)),
                r2 = __builtin_bit_cast(float, __builtin_amdgcn_readlane(__builtin_bit_cast(int, v), 32)), r3 = __builtin_bit_cast(float, __builtin_amdgcn_readlane(__builtin_bit_cast(int, v), 48));
    return (r0 + r1) + (r2 + r3);
}

namespace att {
__device__ __forceinline__ int crow(int r, int hi) { return (r & 3) + 8 * (r >> 2) + 4 * hi; }
#define SBAR() __builtin_amdgcn_sched_barrier(0)
__device__ __forceinline__ void glds16(const void* gsrc, unsigned lds_dst) { unsigned keep;
    asm volatile("s_mov_b32 %0, m0\n\ts_mov_b32 m0, %2\n\ts_nop 0\n\tglobal_load_lds_dwordx4 %1, off\n\ts_mov_b32 m0, %0" : "=&s"(keep) : "v"(gsrc), "s"(lds_dst) : "memory"); }
typedef LAS const char* lds_cptr;
__device__ __forceinline__ void qkt(f32x16& p0, f32x16& p1, lds_cptr kb, const bf16x8* qr, const f32x16& z) {
#pragma unroll
    for (int d0 = 0; d0 < 4; ++d0) {
        const bf16x8 b0 = *(const LAS bf16x8*)(kb + d0 * 2048);
        const bf16x8 b1 = *(const LAS bf16x8*)(kb + d0 * 2048 + 512);
        if (d0 == 0) { p0 = __builtin_amdgcn_mfma_f32_32x32x16_f16(__builtin_bit_cast(pg8::half8, b0), __builtin_bit_cast(pg8::half8, qr[0]), z, 0, 0, 0); p1 = __builtin_amdgcn_mfma_f32_32x32x16_f16(__builtin_bit_cast(pg8::half8, b1), __builtin_bit_cast(pg8::half8, qr[0]), z, 0, 0, 0); }
        else { p0 = __builtin_amdgcn_mfma_f32_32x32x16_f16(__builtin_bit_cast(pg8::half8, b0), __builtin_bit_cast(pg8::half8, qr[d0]), p0, 0, 0, 0); p1 = __builtin_amdgcn_mfma_f32_32x32x16_f16(__builtin_bit_cast(pg8::half8, b1), __builtin_bit_cast(pg8::half8, qr[d0]), p1, 0, 0, 0); } }
}
__device__ __forceinline__ void pv(f32x16* o, int vb, bf16x8 pa0, bf16x8 pa1, bf16x8 pa2, bf16x8 pa3) {
#pragma unroll
    for (int d0 = 0; d0 < 2; ++d0) { s16x4 lo[4], hi[4];
#pragma unroll
        for (int ks = 0; ks < 4; ++ks) {
            asm volatile("ds_read_b64_tr_b16 %0,%1 offset:%c2" : "=&v"(lo[ks]) : "v"(vb), "i"(d0 * 4096 + ks * 1024) : "memory");
            asm volatile("ds_read_b64_tr_b16 %0,%1 offset:%c2" : "=&v"(hi[ks]) : "v"(vb), "i"(d0 * 4096 + ks * 1024 + 512) : "memory"); }
        asm volatile("s_waitcnt lgkmcnt(0)" ::: "memory"); SBAR();
#define PK(k) (bf16x8){lo[k][0], lo[k][1], lo[k][2], lo[k][3], hi[k][0], hi[k][1], hi[k][2], hi[k][3]}
        o[d0] = __builtin_amdgcn_mfma_f32_32x32x16_f16(__builtin_bit_cast(pg8::half8, pa0), __builtin_bit_cast(pg8::half8, PK(0)), o[d0], 0, 0, 0);
        o[d0] = __builtin_amdgcn_mfma_f32_32x32x16_f16(__builtin_bit_cast(pg8::half8, pa1), __builtin_bit_cast(pg8::half8, PK(1)), o[d0], 0, 0, 0);
        o[d0] = __builtin_amdgcn_mfma_f32_32x32x16_f16(__builtin_bit_cast(pg8::half8, pa2), __builtin_bit_cast(pg8::half8, PK(2)), o[d0], 0, 0, 0);
        o[d0] = __builtin_amdgcn_mfma_f32_32x32x16_f16(__builtin_bit_cast(pg8::half8, pa3), __builtin_bit_cast(pg8::half8, PK(3)), o[d0], 0, 0, 0);
#undef PK
    }
}
constexpr int SLOTB = 8192;
constexpr int L_K = 0, L_V = 3 * SLOTB, L_WS = 7 * SLOTB, L_OST = L_WS + 8 * 64 * 4, L_BT = L_OST + 8 * 8192, L_END = L_BT + 8 * 129 * 4;
constexpr float C2 = 0.125f * 1.4426950408889634f;

__device__ __forceinline__ int t5_bucket(int n) {
    if (n < 16) return n;
    const int thr[15] = {19, 21, 24, 27, 31, 35, 40, 46, 52, 59, 67, 77, 87, 99, 113};
    int b = 16;
#pragma unroll
    for (int i = 0; i < 15; ++i) b += (n >= thr[i]) ? 1 : 0;
    return b;
}
__device__ __forceinline__ void build_bias_table(const float* rel_bias, LAS char* shm, int tid) {
    LAS float* BT = (LAS float*)(shm + L_BT);
    for (int i = tid; i < 8 * 129; i += 512) { const int h = i / 129, d = i % 129;
        BT[i] = (d >= 128) ? 0.f : (rel_bias[t5_bucket(d) * 8 + h] - rel_bias[31 * 8 + h]) * 1.4426950408889634f; }
}

__device__ __forceinline__ void attn_unit(int b, int h, int qb, const bf16_t* PROJ, const unsigned long long* MASK, bf16_t* MIX, const float* gain, LAS char* shm, const int tid) {
    const int lane = tid & 63, r32 = lane & 31, hi = lane >> 5; const int wid = __builtin_amdgcn_readfirstlane(tid >> 6);
    const long rowbase = (long)b * T; const int q0 = qb * 256;
    const bf16_t* Qw = PROJ + (rowbase + q0 + wid * 32) * NP + C_QA + h * 64;
    const bf16_t* Kh = PROJ + rowbase * NP + C_KA + h * 64; const bf16_t* Vh = PROJ + rowbase * NP + C_VA + h * 64;
    const unsigned lds0 = (unsigned)(uintptr_t)shm;
    LAS float* wsf = (LAS float*)(shm + L_WS) + wid * 64;
    const LAS float* BT = (const LAS float*)(shm + L_BT) + h * 129;
    const bf16_t* ksrc = Kh + (long)lane * NP + wid * 8;
    const bf16_t* vsrc = Vh + (long)(16 * (wid & 3) + (lane >> 2)) * NP + (wid >> 2) * 32 + (lane & 3) * 8;
    const unsigned kdst = lds0 + L_K + wid * 1024, vdst = lds0 + L_V + wid * 1024;
#define DMA_K(t, slot) glds16(ksrc + (long)(t) * 64 * NP, (unsigned)__builtin_amdgcn_readfirstlane(kdst + (slot)))
#define DMA_V(t, slot) glds16(vsrc + (long)(t) * 64 * NP, (unsigned)__builtin_amdgcn_readfirstlane(vdst + (slot)))
    const int vb0 = (int)(lds0 + L_V) + ((lane >> 4) & 1) * 32 + (lane & 3) * 8 + (4 * hi + ((lane & 15) >> 2)) * 64;
    const lds_cptr kp0 = (lds_cptr)shm + L_K + hi * 1024 + r32 * 16;
    const int NT = (q0 + 256) / 64;
    const int qabs = q0 + wid * 32 + r32;
    const unsigned long long* mp = MASK + ((size_t)b * 4096 + qabs) * 64;
    unsigned long long mw_next = 0ull;
#define MASK_LD(t) asm volatile("global_load_dwordx2 %0, %1, off" : "+v"(mw_next) : "v"(mp + (t)) : "memory")
    MASK_LD(0); DMA_K(0, 0); DMA_V(0, 0); DMA_K(1, SLOTB); DMA_V(1, SLOTB);
    bf16x8 qr[4];
#pragma unroll
    for (int d0 = 0; d0 < 4; ++d0) qr[d0] = *(const bf16x8*)(Qw + (long)r32 * NP + d0 * 16 + hi * 8);
    float m_run = 0.f, l_run = 0.f; f32x16 o[2]; o[0] = f32x16{}; o[1] = f32x16{}; f32x16 negm = f32x16{}; asm volatile("" : "+v"(negm));
    int slot = 0, slot2 = 2 * SLOTB;
    int vs = 0, vsp = 3 * SLOTB, vs2 = 2 * SLOTB;
    u32x4 pw0 = {0u, 0u, 0u, 0u}, pw1 = pw0, pw2 = pw0, pw3 = pw0;
    for (int t = 0; t < NT; ++t) {
        if (t + 1 < NT) asm volatile("s_waitcnt vmcnt(2) lgkmcnt(0)\n\ts_barrier" : "+v"(mw_next) :: "memory");
        else asm volatile("s_waitcnt vmcnt(0) lgkmcnt(0)\n\ts_barrier" : "+v"(mw_next) :: "memory");
        const unsigned long long mw = mw_next;
        asm volatile("" : "+v"(mw_next));
        if (t + 1 < NT) MASK_LD(t + 1);
        if (t + 2 < NT) { DMA_K(t + 2, slot2); DMA_V(t + 2, vs2); }
        f32x16 p0, p1; qkt(p0, p1, kp0 + slot, qr, negm);
        if (t > 0) pv(o, vb0 + vsp, __builtin_bit_cast(bf16x8, pw0), __builtin_bit_cast(bf16x8, pw1), __builtin_bit_cast(bf16x8, pw2), __builtin_bit_cast(bf16x8, pw3));
        if (64 * t + 191 > q0 + 32 * wid) {
#pragma unroll
            for (int r = 0; r < 16; ++r) { const int d0_ = qabs - (64 * t + crow(r, hi));
                const int i0 = d0_ < 0 ? 0 : (d0_ > 128 ? 128 : d0_); const int d1_ = d0_ - 32; const int i1 = d1_ < 0 ? 0 : (d1_ > 128 ? 128 : d1_);
                p0[r] += BT[i0]; p1[r] += BT[i1]; }
        }
        { const int mlo = (int)((unsigned)mw >> (4 * hi)), mhi = (int)((unsigned)(mw >> 32) >> (4 * hi)); const int NEGB = (int)0xff800000u;
#pragma unroll
          for (int r = 0; r < 16; ++r) { const int bit = (r & 3) + 8 * (r >> 2);
              const int t0 = __builtin_amdgcn_sbfe(mlo, bit, 1), t1 = __builtin_amdgcn_sbfe(mhi, bit, 1);
              { const float x0 = p0[r]; p0[r] = __int_as_float((__float_as_int(x0) & t0) | (NEGB & ~t0)); }
              { const float x1 = p1[r]; p1[r] = __int_as_float((__float_as_int(x1) & t1) | (NEGB & ~t1)); } } }
        float rm;
        { float a = __builtin_fmaxf(__builtin_fmaxf(p0[0], p0[1]), p1[0]), b2 = __builtin_fmaxf(__builtin_fmaxf(p0[2], p0[3]), p1[1]); a = __builtin_fmaxf(__builtin_fmaxf(a, p1[2]), p1[3]);
#pragma unroll
          for (int r = 4; r < 16; r += 4) { a = __builtin_fmaxf(__builtin_fmaxf(a, p0[r]), p0[r + 1]); b2 = __builtin_fmaxf(__builtin_fmaxf(b2, p0[r + 2]), p0[r + 3]); a = __builtin_fmaxf(__builtin_fmaxf(a, p1[r]), p1[r + 1]); b2 = __builtin_fmaxf(__builtin_fmaxf(b2, p1[r + 2]), p1[r + 3]); }
          rm = __builtin_fmaxf(a, b2); }
        { auto rr = __builtin_amdgcn_permlane32_swap(__float_as_uint(rm), __float_as_uint(rm), false, false); rm = fmaxf(__uint_as_float(rr[0]), __uint_as_float(rr[1])); }
        const float dl = (t == 0) ? ((rm == -INFINITY) ? 0.f : rm) : fmaxf(rm, 0.f);
        if (__ballot(dl != 0.f)) {
            m_run += dl;
#pragma unroll
            for (int r = 0; r < 16; ++r) { p0[r] -= dl; p1[r] -= dl; }
            const float f = __builtin_amdgcn_exp2f(-dl); l_run *= f;
#pragma unroll
            for (int r = 0; r < 16; ++r) negm[r] = -m_run;
            asm volatile("" : "+v"(negm));
            if (hi == 0) wsf[r32] = f;
            LDS_WAIT();
#pragma unroll
            for (int r = 0; r < 16; ++r) { const float fr_ = wsf[crow(r, hi)]; o[0][r] *= fr_; o[1][r] *= fr_; }
        }
        float sacc = 0.f;
#pragma unroll
        for (int r = 0; r < 16; ++r) { p0[r] = __builtin_amdgcn_exp2f(p0[r]); p1[r] = __builtin_amdgcn_exp2f(p1[r]); sacc += p0[r] + p1[r]; }
        l_run += sacc;
#define PKW(P, B) __builtin_bit_cast(unsigned, __builtin_amdgcn_cvt_pkrtz(P[B], P[B + 1]))
        pw0 = (u32x4){PKW(p0, 0), PKW(p0, 2), PKW(p0, 4), PKW(p0, 6)}; pw1 = (u32x4){PKW(p0, 8), PKW(p0, 10), PKW(p0, 12), PKW(p0, 14)};
        pw2 = (u32x4){PKW(p1, 0), PKW(p1, 2), PKW(p1, 4), PKW(p1, 6)}; pw3 = (u32x4){PKW(p1, 8), PKW(p1, 10), PKW(p1, 12), PKW(p1, 14)};
#undef PKW
        { const int old_ = slot; slot = (slot == 2 * SLOTB) ? 0 : slot + SLOTB; slot2 = old_; }
        { vsp = vs; vs = (vs == 3 * SLOTB) ? 0 : vs + SLOTB; vs2 = (vs2 == 3 * SLOTB) ? 0 : vs2 + SLOTB; }
    }
    LDS_WAIT(); SBAR();
    pv(o, vb0 + vsp, __builtin_bit_cast(bf16x8, pw0), __builtin_bit_cast(bf16x8, pw1), __builtin_bit_cast(bf16x8, pw2), __builtin_bit_cast(bf16x8, pw3));
    { auto rr = __builtin_amdgcn_permlane32_swap(__float_as_uint(l_run), __float_as_uint(l_run), false, false); l_run = __uint_as_float(rr[0]) + __uint_as_float(rr[1]); }
    LDS_WAIT();
    if (hi == 0) wsf[32 + r32] = l_run;
    LDS_WAIT();
    LAS float* stg = (LAS float*)(shm + L_OST) + wid * 2048;
#pragma unroll
    for (int r = 0; r < 16; ++r) { const int orow = crow(r, hi); const float rl = 1.0f / wsf[32 + orow];
#pragma unroll
        for (int d0 = 0; d0 < 2; ++d0) stg[orow * 64 + d0 * 32 + r32] = o[d0][r] * rl; }
    LDS_WAIT();
    bf16_t* Ow = MIX + (rowbase + q0 + wid * 32) * 1024 + 512 + h * 64;
#pragma unroll
    for (int i = 0; i < 4; ++i) { const int row = i * 8 + (lane >> 3), ch = lane & 7;
        const f32x4 a = *(const LAS f32x4*)(stg + row * 64 + ch * 8), c = *(const LAS f32x4*)(stg + row * 64 + ch * 8 + 4);
        float ss = (a[0] * a[0] + a[1] * a[1]) + (a[2] * a[2] + a[3] * a[3]) + (c[0] * c[0] + c[1] * c[1]) + (c[2] * c[2] + c[3] * c[3]);
        ss = allsum8(ss);
        const float rs = rsqrtf(ss * (1.0f / 64.0f) + 1e-6f);
        const f32x4 g0 = *(const f32x4*)(gain + h * 64 + ch * 8), g1 = *(const f32x4*)(gain + h * 64 + ch * 8 + 4);
        u32x4 w; w.x = pkbf(a[0] * rs * g0[0], a[1] * rs * g0[1]); w.y = pkbf(a[2] * rs * g0[2], a[3] * rs * g0[3]); w.z = pkbf(c[0] * rs * g1[0], c[1] * rs * g1[1]); w.w = pkbf(c[2] * rs * g1[2], c[3] * rs * g1[3]);
        *(u32x4*)(Ow + (long)row * 1024 + ch * 8) = w; }
    asm volatile("s_waitcnt lgkmcnt(0)\n\ts_barrier" ::: "memory");
#undef DMA_K
#undef DMA_V
#undef MASK_LD
}
#undef SBAR
}

#define GAS __attribute__((address_space(1)))
#define LAS __attribute__((address_space(3)))
typedef unsigned short bf16;
typedef unsigned v4u __attribute__((ext_vector_type(4)));
typedef float f32x4 __attribute__((ext_vector_type(4)));
typedef short bf16x8 __attribute__((ext_vector_type(8)));
typedef GAS unsigned gu32;
typedef GAS unsigned long long gu64;
#define RLX_AGENT __ATOMIC_RELAXED, __HIP_MEMORY_SCOPE_AGENT
#define LDS_WAIT() asm volatile("s_waitcnt lgkmcnt(0)" ::: "memory")
#define VM_WAIT() asm volatile("s_waitcnt vmcnt(0)" ::: "memory")
__device__ __forceinline__ unsigned long long rt() { return __builtin_amdgcn_s_memrealtime(); }
__device__ __forceinline__ unsigned f2bf(float f) { unsigned u = __builtin_bit_cast(unsigned, f); return (u + 0x7fffu + ((u >> 16) & 1u)) >> 16; }
__device__ __forceinline__ unsigned pk2(float lo, float hi) { return f2bf(lo) | (f2bf(hi) << 16); }

#define XB_TMO      128
#define XB_XCNT(j)  (256  + 64 * (j))
#define XB_XSUB(j)  (1280 + 64 * (j))
#define XB_XGEN(j)  (2304 + 64 * (j))
#define XB_TOP      3328
#define XB_TOPGEN   3392
#define XCD_BAR_WORDS 3456
#define XB_SPIN_CAP (1u << 22)

__device__ __forceinline__ unsigned xb_ld(unsigned* p)              { return __hip_atomic_load(p, __ATOMIC_RELAXED, __HIP_MEMORY_SCOPE_AGENT); }
__device__ __forceinline__ unsigned xb_add(unsigned* p, unsigned v) { return __hip_atomic_fetch_add(p, v, __ATOMIC_RELAXED, __HIP_MEMORY_SCOPE_AGENT); }
__device__ __forceinline__ unsigned xb_xcc_id() { return (unsigned)__builtin_amdgcn_s_getreg((3 << 11) | 20) & 0xFu; }
#define XB_SPIN(cond, bar) do { unsigned _sp = 0; while (cond) { __builtin_amdgcn_s_sleep(1); \
    if ((++_sp & 255u) == 0u) { if (xb_ld(&(bar)[XB_TMO])) break; if (_sp > XB_SPIN_CAP) { atomicAdd(&(bar)[XB_TMO], 1u); break; } } } } while (0)

struct XcdBarrier {
    unsigned* bar; unsigned x;
    volatile LAS unsigned* st;
};

__device__ __forceinline__ XcdBarrier xcd_barrier_post(unsigned* bar, volatile LAS unsigned* st) {
    XcdBarrier b; b.bar = bar; b.x = xb_xcc_id(); b.st = st;
    if (threadIdx.x == 0) (void)xb_add(&bar[XB_XCNT(b.x)], 1u);
    return b;
}
__device__ __forceinline__ void xcd_barrier_complete(unsigned* bar, unsigned x, unsigned& nloc, unsigned& nx) {
    const unsigned G = gridDim.x * gridDim.y * gridDim.z;
    unsigned sum, cnt, mine, sp = 0u;
    for (;;) {
        sum = 0u; cnt = 0u; mine = 0u;
#pragma unroll
        for (unsigned j = 0; j < 16; ++j) { const unsigned c = xb_ld(&bar[XB_XCNT(j)]); sum += c; cnt += (c > 0u) ? 1u : 0u; mine = (j == x) ? c : mine; }
        if (sum == G) break;
        __builtin_amdgcn_s_sleep(1);
        if ((++sp & 255u) == 0u) { if (xb_ld(&bar[XB_TMO])) break; if (sp > XB_SPIN_CAP) { atomicAdd(&bar[XB_TMO], 1u); break; } }
    }
    nloc = mine > 0u ? mine : 1u; nx = cnt > 0u ? cnt : 1u;
}

__device__ __forceinline__ void xcd_barrier(const XcdBarrier& b) {
    asm volatile("s_waitcnt vmcnt(0)" ::: "memory");
    __syncthreads();
    if (threadIdx.x == 0) {
        unsigned* bar = b.bar;
        __builtin_amdgcn_s_waitcnt(0);
        unsigned nloc = b.st[0], nx = b.st[1];
        if (nloc == 0u) { xcd_barrier_complete(bar, b.x, nloc, nx); b.st[0] = nloc; b.st[1] = nx; }
        const unsigned old = xb_add(&bar[XB_XSUB(b.x)], 1u);
        const unsigned gen = old / nloc;
        if (old + 1u == (gen + 1u) * nloc) {
            __builtin_amdgcn_fence(__ATOMIC_RELEASE, "agent");
            asm volatile("s_waitcnt vmcnt(0)" ::: "memory");
            const unsigned og = xb_add(&bar[XB_TOP], 1u);
            const unsigned tg = og / nx;
            if (og + 1u == (tg + 1u) * nx) xb_add(&bar[XB_TOPGEN], 1u);
            else XB_SPIN(xb_ld(&bar[XB_TOPGEN]) == tg, bar);
            __builtin_amdgcn_fence(__ATOMIC_ACQUIRE, "agent");
            xb_add(&bar[XB_XGEN(b.x)], 1u);
            asm volatile("s_waitcnt vmcnt(0)" ::: "memory");
        } else {
            XB_SPIN(xb_ld(&bar[XB_XGEN(b.x)]) == gen, bar);
            __builtin_amdgcn_fence(__ATOMIC_ACQUIRE, "agent");
            asm volatile("s_waitcnt vmcnt(0)" ::: "memory");
        }
    }
    __syncthreads();
}
constexpr size_t MiB = 1u << 20;
constexpr size_t WS_CTL = 0, CTL_ZERO_BYTES = 1 * MiB;
constexpr size_t WS_MOD = 1 * MiB;
constexpr size_t WS_LW = 2 * MiB;
constexpr size_t WS_WIN = 3 * MiB, WS_WOUT = 12 * MiB, WS_W1 = 14 * MiB, WS_W2 = 22 * MiB;
constexpr size_t WS_LACT = 30 * MiB;
constexpr size_t WS_MASK = 54 * MiB;
constexpr size_t WS_VF = 70 * MiB;
constexpr size_t WS_H = 102 * MiB;
constexpr size_t WS_MIX = 166 * MiB;
constexpr size_t WS_PROJ = 230 * MiB;
constexpr size_t WS_END = 502 * MiB;
static_assert(WS_WIN + (size_t)NP * D * 2 <= WS_WOUT && WS_W2 + (size_t)D * FF * 2 <= WS_LACT && WS_LACT + (size_t)M * LA * 2 <= WS_MASK && WS_MASK + (size_t)NB * 64 * 4096 * 8 <= WS_VF &&
              WS_VF + (size_t)M * 512 * 2 <= WS_H && WS_H + (size_t)M * D * 2 <= WS_MIX && WS_MIX + (size_t)M * D * 2 <= WS_PROJ && WS_PROJ + (size_t)M * NP * 2 <= WS_END, "d_ws map");
constexpr int CW_BAR = 4096;
constexpr int RING_BYTES = 131072, HIST_OFF = 131072, LDSCTL_OFF = 131072 + 8192, MISC_OFF = LDSCTL_OFF + 320, LDS_BYTES = 147456;
static_assert(att::L_END <= RING_BYTES && MISC_OFF + 128 <= LDS_BYTES, "LDS map");
constexpr int NWAVES = 8;

__device__ __forceinline__ void ph_mod(const float* c, const float* w_ada, const float* b_ada, float* MOD, LAS unsigned char* lds, int vcu, int G, int tid) {
    LAS float* ca = (LAS float*)lds; LAS float* part = (LAS float*)(lds + 32768);
    for (int i = tid; i < NB * D; i += 512) { const float v = c[i]; ca[i] = v / (1.f + __expf(-v)); }
    __syncthreads();
    const int wave = tid >> 6, lane = tid & 63;
    for (int task = vcu; task < 192; task += G) {
        const int l = task / 96, j0 = (task % 96) * 64;
        float acc[8];
#pragma unroll
        for (int b = 0; b < 8; ++b) acc[b] = 0.f;
        const float* wp = w_ada + ((size_t)l * D + wave * 128) * 6144 + j0 + lane;
#pragma unroll 8
        for (int k = 0; k < 128; ++k) { const float w = wp[(size_t)k * 6144];
#pragma unroll
            for (int b = 0; b < 8; ++b) acc[b] += ca[b * D + wave * 128 + k] * w; }
#pragma unroll
        for (int b = 0; b < 8; ++b) part[(wave * 8 + b) * 64 + lane] = acc[b];
        __syncthreads();
        { float s = 0.f;
#pragma unroll
          for (int w = 0; w < 8; ++w) s += part[(w * 8 + wave) * 64 + lane];
          MOD[((size_t)l * 8 + wave) * 6144 + j0 + lane] = s + b_ada[l * 6144 + j0 + lane]; }
        __syncthreads();
    }
}

__device__ __forceinline__ void tr_item(const float* W, int ldw, int nvalid, int K, bf16_t* WT, int row_off, LAS float* scr, int kb, int nb, int lane, const float* mu, int mode) {
    const int k0 = 64 * kb, n0 = 32 * nb; const int n = n0 + (lane & 31);
#pragma unroll 8
    for (int i = 0; i < 32; ++i) { const int kk = 2 * i + (lane >> 5); float v = (n < nvalid) ? W[(size_t)(k0 + kk) * ldw + n] : 0.f;
        if (mode) { const float m = mu[k0 + kk]; v *= (mode == 1) ? (1.f - m) : m; }
        scr[kk * 33 + (lane & 31)] = v; }
    LDS_WAIT(); asm volatile("" ::: "memory");
    const int c = lane & 7;
#pragma unroll
    for (int j = 0; j < 4; ++j) { const int nn = (lane >> 3) + 8 * j; const LAS float* s = scr + (8 * c) * 33 + nn;
        u32x4 o; o.x = pkbf(s[0 * 33], s[1 * 33]); o.y = pkbf(s[2 * 33], s[3 * 33]); o.z = pkbf(s[4 * 33], s[5 * 33]); o.w = pkbf(s[6 * 33], s[7 * 33]);
        if (n0 + nn < nvalid) *(u32x4*)(WT + (size_t)(row_off + n0 + nn) * K + k0 + 8 * c) = o; }
    LDS_WAIT(); asm volatile("" ::: "memory");
}
struct WPtrs { const float *w_in, *decay_a, *iclr_a, *gate_a, *vres_a, *mu_lora, *vres_mu, *w_out, *w1, *w2, *decay_b, *iclr_b, *gate_b, *vres_b; };
__device__ __forceinline__ void ph_weights(const WPtrs& P, int l, unsigned char* ws, LAS unsigned char* lds, int vcu, int G, int tid) {
    const int wave = tid >> 6, lane = tid & 63; const int gw = vcu * NWAVES + wave, NGW = G * NWAVES;
    LAS float* scr = (LAS float*)(lds + wave * 16384);
    bf16_t* WIN = (bf16_t*)(ws + WS_WIN); bf16_t* WOUT = (bf16_t*)(ws + WS_WOUT); bf16_t* W1 = (bf16_t*)(ws + WS_W1); bf16_t* W2 = (bf16_t*)(ws + WS_W2);
    constexpr int I_IN = 16 * 115, I_D = 16 * 2, I_G = 16 * 4, I_V = 16 * 1, I_O = 16 * 32, I_1 = 16 * 128, I_2 = 64 * 32;
    constexpr int I_LO = 2 * I_D + I_G + I_V; constexpr int NITEMS = I_IN + 2 * I_LO + I_O + I_1 + I_2;
    for (int it = gw; it < NITEMS; it += NGW) {
        int r = it;
        if (r < I_IN) { tr_item(P.w_in + (size_t)l * D * 3656, 3656, 3656, D, WIN, 0, scr, r / 115, r % 115, lane, nullptr, 0); continue; } r -= I_IN;
        if (r < 2 * I_LO) { const int md = (r < I_LO) ? 1 : 2; int q = (r < I_LO) ? r : r - I_LO; const int rbase = (md == 1) ? C_P1 : C_P2;
            if (q < I_D) { tr_item(P.decay_a + (size_t)l * D * 64, 64, 64, D, WIN, rbase + 0, scr, q / 2, q % 2, lane, P.mu_lora + (size_t)(l * 3 + 0) * D, md); continue; } q -= I_D;
            if (q < I_D) { tr_item(P.iclr_a + (size_t)l * D * 64, 64, 64, D, WIN, rbase + 64, scr, q / 2, q % 2, lane, P.mu_lora + (size_t)(l * 3 + 1) * D, md); continue; } q -= I_D;
            if (q < I_G) { tr_item(P.gate_a + (size_t)l * D * 128, 128, 128, D, WIN, rbase + 128, scr, q / 4, q % 4, lane, P.mu_lora + (size_t)(l * 3 + 2) * D, md); continue; } q -= I_G;
            if (l >= 1) tr_item(P.vres_a + (size_t)(l - 1) * D * 32, 32, 32, D, WIN, rbase + 256, scr, q, 0, lane, P.vres_mu + (size_t)(l - 1) * D, md);
            continue; }
        r -= 2 * I_LO;
        if (r < I_O) { tr_item(P.w_out + (size_t)l * D * D, D, D, D, WOUT, 0, scr, r / 32, r % 32, lane, nullptr, 0); continue; } r -= I_O;
        if (r < I_1) { tr_item(P.w1 + (size_t)l * D * FF, FF, FF, D, W1, 0, scr, r / 128, r % 128, lane, nullptr, 0); continue; } r -= I_1;
        tr_item(P.w2 + (size_t)l * FF * D, D, D, FF, W2, 0, scr, r / 32, r % 32, lane, nullptr, 0);
    }
    const int gt = vcu * 512 + tid, NGT = G * 512;
    { const int nzr = (NP - C_END) + (l == 0 ? 64 : 0);
      for (int i = gt; i < nzr * 128; i += NGT) { const int zr = i >> 7, ch = i & 127; int row;
          if (zr < NP - C_END) row = C_END + zr; else { const int z2 = zr - (NP - C_END); row = (z2 < 32) ? (C_P1 + 256 + z2) : (C_P2 + 256 + z2 - 32); }
          *(u32x4*)(WIN + (size_t)row * D + ch * 8) = (u32x4){0u, 0u, 0u, 0u}; } }
    { bf16_t* LW = (bf16_t*)(ws + WS_LW);
      for (int i = gt; i < 2048 * 128; i += NGT) { const int n = i >> 7, k = i & 127; float v = 0.f;
          if (n < 512) { if (k < 64) v = P.decay_b[((size_t)l * 64 + k) * 512 + n]; }
          else if (n < 1024) { if (k >= 64) v = P.iclr_b[((size_t)l * 64 + (k - 64)) * 512 + (n - 512)]; }
          else if (n < 1536) { v = P.gate_b[((size_t)l * 128 + k) * 512 + (n - 1024)]; }
          else { if (l >= 1 && k < 32) v = P.vres_b[((size_t)(l - 1) * 32 + k) * 512 + (n - 1536)]; }
          LW[i] = (bf16_t)(pkbf(v, 0.f) & 0xffffu); } }
}

__device__ __forceinline__ void ph_norm(const float* X, const float* g, const float* sh, const float* sc, bf16_t* Hout, int gw, int NGW, int lane) {
    for (int m0 = gw; m0 < M; m0 += 2 * NGW) {
        f32x4 v[2][4]; float s[2] = {0.f, 0.f};
#pragma unroll
        for (int q = 0; q < 2; ++q) { const f32x4* xr = (const f32x4*)(X + (size_t)(m0 + q * NGW) * D) + lane;
#pragma unroll
            for (int j = 0; j < 4; ++j) v[q][j] = xr[64 * j]; }
#pragma unroll
        for (int q = 0; q < 2; ++q)
#pragma unroll
            for (int j = 0; j < 4; ++j) s[q] += (v[q][j][0] * v[q][j][0] + v[q][j][1] * v[q][j][1]) + (v[q][j][2] * v[q][j][2] + v[q][j][3] * v[q][j][3]);
#pragma unroll
        for (int q = 0; q < 2; ++q) { const int m = m0 + q * NGW; const int b = m >> 12;
            const float rstd = rsqrtf(wave_sum(s[q]) * (1.f / D) + 1e-6f);
            u32x2* o8 = (u32x2*)(Hout + (size_t)m * D) + lane;
#pragma unroll
            for (int j = 0; j < 4; ++j) { const int c = 256 * j + 4 * lane;
                const f32x4 gv = *(const f32x4*)(g + c), sv = *(const f32x4*)(sc + (size_t)b * 6144 + c), hv = *(const f32x4*)(sh + (size_t)b * 6144 + c);
                const f32x4 y = v[q][j] * rstd * gv * (sv + 1.f) + hv;
                u32x2 w; w.x = pkbf(y[0], y[1]); w.y = pkbf(y[2], y[3]); o8[64 * j] = w; } } }
}
__device__ __forceinline__ void ph_final_norm(float* X, const float* g, int gw, int NGW, int lane) {
    for (int m = gw; m < M; m += NGW) {
        f32x4* xr = (f32x4*)(X + (size_t)m * D) + lane; f32x4 v[4]; float s = 0.f;
#pragma unroll
        for (int j = 0; j < 4; ++j) { v[j] = xr[64 * j]; s += (v[j][0] * v[j][0] + v[j][1] * v[j][1]) + (v[j][2] * v[j][2] + v[j][3] * v[j][3]); }
        const float rstd = rsqrtf(wave_sum(s) * (1.f / D) + 1e-6f);
#pragma unroll
        for (int j = 0; j < 4; ++j) { const f32x4 gv = *(const f32x4*)(g + 256 * j + 4 * lane); xr[64 * j] = v[j] * rstd * gv; } }
}

__device__ __forceinline__ void ph_lora_act(const bf16_t* PROJ, bf16_t* LACT, bf16_t* VF, const float* mu_v  , bool write_v, int gw, int NGW, int lane) {
    float muv[8];
#pragma unroll
    for (int i = 0; i < 8; ++i) muv[i] = mu_v[lane * 8 + i];
    for (int m = gw; m < M; m += NGW) { const int t = m & (T - 1);
        if (lane < 36) {
            const u32x4 p1 = *(const u32x4*)(PROJ + (size_t)m * NP + C_P1 + lane * 8);
            u32x4 p2 = (u32x4){0u, 0u, 0u, 0u}; if (t > 0) p2 = *(const u32x4*)(PROJ + (size_t)(m - 1) * NP + C_P2 + lane * 8);
            float x[8];
#pragma unroll
            for (int i = 0; i < 4; ++i) { x[2 * i] = bfl(p1[i]) + bfl(p2[i]); x[2 * i + 1] = bfh(p1[i]) + bfh(p2[i]); }
            if (lane < 8) {
#pragma unroll
                for (int i = 0; i < 8; ++i) x[i] = 1.f - 2.f / (__expf(2.f * x[i]) + 1.f);
            } else if (lane >= 16 && lane < 32) {
#pragma unroll
                for (int i = 0; i < 8; ++i) x[i] = 1.f / (1.f + __expf(-x[i]));
            }
            u32x4 w; w.x = pkbf(x[0], x[1]); w.y = pkbf(x[2], x[3]); w.z = pkbf(x[4], x[5]); w.w = pkbf(x[6], x[7]);
            *(u32x4*)(LACT + (size_t)m * LA + lane * 8) = w;
        } else if (lane < 48) { *(u32x4*)(LACT + (size_t)m * LA + lane * 8) = (u32x4){0u, 0u, 0u, 0u}; }
        if (write_v) {
            const u32x4 vc = *(const u32x4*)(PROJ + (size_t)m * NP + C_V + lane * 8);
            u32x4 vp = (u32x4){0u, 0u, 0u, 0u}; if (t > 0) vp = *(const u32x4*)(PROJ + (size_t)(m - 1) * NP + C_V + lane * 8);
            float y[8];
#pragma unroll
            for (int i = 0; i < 4; ++i) { const float c0 = bfl(vc[i]), c1 = bfh(vc[i]); y[2 * i] = c0 + (bfl(vp[i]) - c0) * muv[2 * i]; y[2 * i + 1] = c1 + (bfh(vp[i]) - c1) * muv[2 * i + 1]; }
            u32x4 w; w.x = pkbf(y[0], y[1]); w.y = pkbf(y[2], y[3]); w.z = pkbf(y[4], y[5]); w.w = pkbf(y[6], y[7]);
            *(u32x4*)(VF + (size_t)m * 512 + lane * 8) = w;
        }
    }
}

#ifndef DUP_MASK
#define DUP_MASK 0
#endif
__device__ __forceinline__ unsigned sortable(float s) { const unsigned u = __float_as_uint(s + 0.f); return u ^ ((u >> 31) ? 0xFFFFFFFFu : 0x80000000u); }
__device__ __forceinline__ void ph_select(const bf16_t* PROJ, unsigned long long* MASK, LAS unsigned char* lds, int vcu, int G, int tid) {
    const int lane = tid & 63, wid = __builtin_amdgcn_readfirstlane(tid >> 6), r32 = lane & 31, hi = lane >> 5;
    LAS unsigned* SC = (LAS unsigned*)lds;
    LAS unsigned* HI = (LAS unsigned*)(lds + HIST_OFF) + wid * 256;
    const float WSC = 0.35355339059f * 0.125f;
    bf16x8 AfN[2][4]; u32x4 wN[2][2]; bf16x8 BfN[4];
    const int ql_ = (r32 >> 4) * 2 + ((r32 >> 2) & 1), hd_ = (r32 & 3) + 4 * ((r32 >> 3) & 1);
#define SEL_LOAD(q0_, nblk_, rb_) do { \
        _Pragma("unroll") for (int tq = 0; tq < 2; ++tq) _Pragma("unroll") for (int ks = 0; ks < 4; ++ks) AfN[tq][ks] = *(const bf16x8*)(PROJ + (rb_ + q0_ + tq * 4 + ql_) * NP + C_QI + hd_ * 64 + ks * 16 + hi * 8); \
        _Pragma("unroll") for (int tq = 0; tq < 2; ++tq) _Pragma("unroll") for (int g = 0; g < 2; ++g) wN[tq][g] = *(const u32x4*)(PROJ + (rb_ + q0_ + tq * 4 + 2 * g + hi) * NP + C_WI); \
        if (wid < nblk_) { _Pragma("unroll") for (int ks = 0; ks < 4; ++ks) BfN[ks] = *(const bf16x8*)(PROJ + (rb_ + wid * 32 + r32) * NP + C_KI + ks * 16 + hi * 8); } } while (0)
    if (vcu < NB * 512) { const int bn = vcu & 7, jn = vcu >> 3, basen = jn & 31, rndn = jn >> 5;
        const int q8n = (rndn & 1) ? (32 * rndn + 31 - basen) : (32 * rndn + basen); const int q0n = q8n * 8, nblkn = (q0n >> 5) + 1; const size_t rbn = (size_t)bn * T;
        SEL_LOAD(q0n, nblkn, rbn); }
    for (int it = 0;; ++it) {
        const int tsk = vcu + it * G; if (tsk >= NB * 512) break;
        const int b = tsk & 7, j = tsk >> 3, base = j & 31, rnd = j >> 5;
        const int q8 = (rnd & 1) ? (32 * rnd + 31 - base) : (32 * rnd + base);
        const int q0 = q8 * 8, nblk = (q0 >> 5) + 1; const size_t rb = (size_t)b * T;
        bf16x8 Af[2][4]; float wv[2][16]; bf16x8 Bf[4], Bn[4];
#pragma unroll
        for (int tq = 0; tq < 2; ++tq) {
#pragma unroll
            for (int ks = 0; ks < 4; ++ks) Af[tq][ks] = AfN[tq][ks];
#pragma unroll
            for (int g = 0; g < 2; ++g) { const u32x4 w8 = wN[tq][g];
#pragma unroll
                for (int x = 0; x < 4; ++x) { wv[tq][8 * g + 2 * x] = bfl(w8[x]) * WSC; wv[tq][8 * g + 2 * x + 1] = bfh(w8[x]) * WSC; } } }
#pragma unroll
        for (int ks = 0; ks < 4; ++ks) Bf[ks] = BfN[ks];
        for (int blk = wid; blk < nblk; blk += 8) {
            const int key = blk * 32 + r32;
            if (blk + 8 < nblk) {
#pragma unroll
                for (int ks = 0; ks < 4; ++ks) Bn[ks] = *(const bf16x8*)(PROJ + (rb + key + 256) * NP + C_KI + ks * 16 + hi * 8);
            }
#pragma unroll
            for (int tq = 0; tq < 2; ++tq) { f32x16 acc = {};
#pragma unroll
                for (int ks = 0; ks < 4; ++ks) acc = __builtin_amdgcn_mfma_f32_32x32x16_f16(__builtin_bit_cast(pg8::half8, Af[tq][ks]), __builtin_bit_cast(pg8::half8, Bf[ks]), acc, 0, 0, 0);
#pragma unroll
                for (int g = 0; g < 2; ++g) { float s = 0.f;
#pragma unroll
                    for (int x = 0; x < 8; ++x) s += wv[tq][8 * g + x] * fmaxf(acc[8 * g + x], 0.f);
                    const int ql = tq * 4 + 2 * g + hi; const int qp = q0 + ql;
                    SC[ql * 4096 + key] = (key > qp) ? 0u : sortable(s); } }
#pragma unroll
            for (int ks = 0; ks < 4; ++ks) Bf[ks] = Bn[ks];
        }
        if (tsk + G < NB * 512) { const int tn = tsk + G; const int bn = tn & 7, jn = tn >> 3, basen = jn & 31, rndn = jn >> 5;
            const int q8n = (rndn & 1) ? (32 * rndn + 31 - basen) : (32 * rndn + basen); const int q0n = q8n * 8, nblkn = (q0n >> 5) + 1; const size_t rbn = (size_t)bn * T;
            SEL_LOAD(q0n, nblkn, rbn); }
        __syncthreads();
        for (int rep_r = 0; rep_r < (int)((DUP_MASK >> 14) & 1) + 1; ++rep_r)
        {
            const int qp = q0 + wid; unsigned long long myword = 0ull;
            if (qp < 256) { const int lo = lane * 64; myword = (qp >= lo + 63) ? ~0ull : (qp < lo ? 0ull : ((2ull << (qp - lo)) - 1ull)); }
            else {
                int lane_t = lane; asm volatile("" : "+v"(lane_t));
                const LAS unsigned* scl = SC + wid * 4096 + lane_t; const int nscan = nblk * 32;
                unsigned u[64]; const int nreg = (nscan + 63) >> 6;
#pragma unroll
                for (int j4 = 0; j4 < 64; ++j4) { if ((j4 & ~15) < nreg) { const unsigned v_ = scl[64 * j4]; u[j4] = (lane_t < nscan - 64 * j4) ? v_ : 0u; } else u[j4] = 0u; }
                unsigned umax = 0u, umin = 0xFFFFFFFFu;
#pragma unroll
                for (int j4 = 0; j4 < 64; ++j4) { if ((j4 & ~15) < nreg) { umax = max(umax, u[j4]); umin = min(umin, u[j4] ? u[j4] : 0xFFFFFFFFu); } }
                umax = wave_max_u(umax); umin = wave_min_u(umin);
                unsigned lo = umin, hi = umax + 1u; int c_lo = qp + 1, c_hi = 0;
                while (c_lo - c_hi > 64 && hi - lo > 1u) {
                    const unsigned hm = hi - 1u;
                    const float lf = __uint_as_float((lo & 0x80000000u) ? (lo ^ 0x80000000u) : ~lo), hf = __uint_as_float((hm & 0x80000000u) ? (hm ^ 0x80000000u) : ~hm);
                    unsigned mid = sortable(0.5f * lf + 0.5f * hf);
                    mid = (mid <= lo) ? lo + 1u : ((mid >= hi) ? hi - 1u : mid);
                    int cl = 0;
#pragma unroll
                    for (int j4 = 0; j4 < 64; ++j4) { if ((j4 & ~15) < nreg) cl += (u[j4] >= mid) ? 1 : 0; }
                    const int c = wave_sum_i(cl);
                    if (c >= 256) { lo = mid; c_lo = c; } else { hi = mid; c_hi = c; }
                }
                unsigned Tk; int kth, neq;
                if (hi - lo == 1u) { Tk = lo; kth = 256 - c_hi; neq = c_lo - c_hi; }
                else {
                    LAS unsigned* CAND = HI; int pos = 0;
#pragma unroll
                    for (int j4 = 0; j4 < 64; ++j4) { if ((j4 & ~15) < nreg) { const bool in_ = (u[j4] >= lo) && (u[j4] < hi); const unsigned long long bm = __ballot(in_);
                        if (bm) { if (in_) CAND[pos + __builtin_popcountll(bm & ((1ull << lane_t) - 1ull))] = u[j4]; pos += __builtin_popcountll(bm); } } }
                    LDS_WAIT();
                    const int m_ = pos; const unsigned mine = (lane_t < m_) ? CAND[lane_t] : 0u;
                    int rg = 0, re = 0;
                    for (int x = 0; x < m_; ++x) { const unsigned v_ = __builtin_amdgcn_readlane(mine, x); rg += (v_ > mine) ? 1 : 0; re += (v_ == mine) ? 1 : 0; }
                    const int need = 256 - c_hi;
                    const bool is_t = (lane_t < m_) && (rg < need) && (need <= rg + re);
                    const unsigned long long bt = __ballot(is_t); const int Lt = (int)__builtin_ctzll(bt | (1ull << 63));
                    Tk = __builtin_amdgcn_readlane(mine, Lt); kth = need - __builtin_amdgcn_readlane(rg, Lt); neq = __builtin_amdgcn_readlane(re, Lt);
                }
                int eqtaken = 0; unsigned mw_lo = 0u, mw_hi = 0u;
                if (kth == neq) {
#pragma unroll
                    for (int jt = 0; jt < 64; ++jt) { if ((jt & ~15) < nreg) { const unsigned long long w = __ballot(u[jt] >= Tk); if (lane_t == jt) { mw_lo = (unsigned)w; mw_hi = (unsigned)(w >> 32); } } }
                } else
#pragma unroll
                for (int jt = 0; jt < 64; ++jt) { if ((jt & ~15) < nreg) { const bool gt = u[jt] > Tk, eq = (u[jt] == Tk); const unsigned long long beq = __ballot(eq);
                    const int rank = eqtaken + __builtin_popcountll(beq & ((1ull << lane_t) - 1ull));
                    const unsigned long long w = __ballot(gt || (eq && rank < kth)); eqtaken += __builtin_popcountll(beq);
                    if (lane_t == jt) { mw_lo = (unsigned)w; mw_hi = (unsigned)(w >> 32); } asm volatile("" : "+s"(eqtaken)); } }
                myword = ((unsigned long long)mw_hi << 32) | mw_lo;
            }
            MASK[((size_t)b * 4096 + qp) * 64 + lane] = myword;
        }
        __syncthreads();
    }
#undef SEL_LOAD
}

constexpr int SC_BUF = 43008, SC_YB = 2 * SC_BUF, SC_END = SC_YB + 2 * 2048;
static_assert(SC_END <= RING_BYTES, "scan LDS");
struct ScanP { const bf16_t* PROJ; bf16_t* PROJw; const _Float16* E; const _Float16* A; const bf16_t* VF; const float *mu_r, *mu_k, *k_k, *k_a, *r_k; };
__device__ __forceinline__ void scan_unit(const ScanP& P, int b, int h, int q4, LAS unsigned char* lds, int tid) {
    const int wave = __builtin_amdgcn_readfirstlane(tid >> 6), lane = tid & 63;
    const size_t rb = (size_t)b * T;
    if (wave >= 4) {
        const int pt = tid - 256, tl = pt >> 3, cg = pt & 7; const int ch0 = h * 64 + cg * 8;
        float mur[8], muk[8], kkp[8], kap[8], rkp[8];
#pragma unroll
        for (int i = 0; i < 8; ++i) { mur[i] = P.mu_r[ch0 + i]; muk[i] = P.mu_k[ch0 + i]; kkp[i] = P.k_k[ch0 + i]; kap[i] = P.k_a[ch0 + i]; rkp[i] = P.r_k[ch0 + i]; }
        u32x4 rc, kc, rp, kp, e8, a8; unsigned v2;
#define P_LOAD(cn) do { const int t_ = (cn) * 32 + tl; const size_t m_ = rb + t_; \
            rc = *(const u32x4*)(P.PROJ + m_ * NP + C_R + ch0); kc = *(const u32x4*)(P.PROJ + m_ * NP + C_K + ch0); rp = (u32x4){0u, 0u, 0u, 0u}; kp = (u32x4){0u, 0u, 0u, 0u}; \
            if (t_ > 0) { rp = *(const u32x4*)(P.PROJ + (m_ - 1) * NP + C_R + ch0); kp = *(const u32x4*)(P.PROJ + (m_ - 1) * NP + C_K + ch0); } \
            e8 = *(const u32x4*)(P.E + m_ * 512 + ch0); a8 = *(const u32x4*)(P.A + m_ * 512 + ch0); v2 = *(const unsigned*)(P.VF + m_ * 512 + h * 64 + q4 * 16 + 2 * cg); } while (0)
#define P_COMPUTE(cn) do { LAS unsigned char* buf = lds + ((cn) & 1) * SC_BUF; const size_t m = rb + (cn) * 32 + tl; \
            float r_[8], kl[8], kkv[8], a_[8], e_[8]; float ss = 0.f; \
            _Pragma("unroll") for (int i = 0; i < 8; ++i) { const unsigned wr_ = rc[i >> 1], wrp = rp[i >> 1], wk_ = kc[i >> 1], wkp = kp[i >> 1]; \
                const float xr = (i & 1) ? bfh(wr_) : bfl(wr_), xrp = (i & 1) ? bfh(wrp) : bfl(wrp), xk = (i & 1) ? bfh(wk_) : bfl(wk_), xkp = (i & 1) ? bfh(wkp) : bfl(wkp); \
                r_[i] = xr + (xrp - xr) * mur[i]; kl[i] = xk + (xkp - xk) * muk[i]; kkv[i] = kl[i] * kkp[i]; ss += kkv[i] * kkv[i]; \
                const unsigned we_ = e8[i >> 1], wa_ = a8[i >> 1]; const float el = (i & 1) ? bfh(we_) : bfl(we_), al = (i & 1) ? bfh(wa_) : bfl(wa_); \
                e_[i] = -0.60653065971f * pg8::sigmoidf_(el); a_[i] = pg8::sigmoidf_(al); } \
            ss = allsum8(ss); const float inv = 1.0f / fmaxf(sqrtf(ss), 1e-12f); \
            float kp_[8], kk_[8], nb_[8], dc_[8]; float rk = 0.f; \
            _Pragma("unroll") for (int i = 0; i < 8; ++i) { kk_[i] = kkv[i] * inv; kp_[i] = kl[i] * (1.f + (a_[i] - 1.f) * kap[i]); nb_[i] = -kk_[i] * a_[i]; dc_[i] = __expf(e_[i]); rk += r_[i] * kp_[i] * rkp[i]; } \
            rk = allsum8(rk); \
              \
            const bool wh = (tl & 1) != 0; const int pr = tl >> 1; \
            float rA[8], rB[8]; \
            _Pragma("unroll") for (int i = 0; i < 8; ++i) { rA[i] = dpp_f<0x128>(wh ? dc_[i] : nb_[i]); rB[i] = dpp_f<0x128>(wh ? kk_[i] : kp_[i]); }     \
            float o0[8], o1[8], o2[8], o3[8]; float sa = 0.f, sb = 0.f; \
            _Pragma("unroll") for (int i = 0; i < 8; ++i) { const float dA = dc_[i] * rA[i], dB = dc_[i] * rB[i]; \
                o0[i] = wh ? dA : kk_[i];            \
                o1[i] = dB;                          \
                o2[i] = wh ? nb_[i] : dc_[i] * r_[i];     \
                o3[i] = wh ? kp_[i] : dA;            \
                sa += wh ? rA[i] * kk_[i] : nb_[i] * r_[i];      \
                sb += wh ? rB[i] * kk_[i] : kp_[i] * r_[i]; }    \
            sa = allsum8(sa); sb = allsum8(sb); \
            LAS float* Ob = (LAS float*)buf + (wh ? 4096 : 0) + pr * 64 + cg * 8;            \
            *(LAS f32x4*)(Ob) = (f32x4){o0[0], o0[1], o0[2], o0[3]}; *(LAS f32x4*)(Ob + 4) = (f32x4){o0[4], o0[5], o0[6], o0[7]}; \
            *(LAS f32x4*)(Ob + 1024) = (f32x4){o1[0], o1[1], o1[2], o1[3]}; *(LAS f32x4*)(Ob + 1024 + 4) = (f32x4){o1[4], o1[5], o1[6], o1[7]}; \
            *(LAS f32x4*)(Ob + 2048) = (f32x4){o2[0], o2[1], o2[2], o2[3]}; *(LAS f32x4*)(Ob + 2048 + 4) = (f32x4){o2[4], o2[5], o2[6], o2[7]}; \
            *(LAS f32x4*)(Ob + 3072) = (f32x4){o3[0], o3[1], o3[2], o3[3]}; *(LAS f32x4*)(Ob + 3072 + 4) = (f32x4){o3[4], o3[5], o3[6], o3[7]}; \
            if (wh) { *(LAS f32x4*)(Ob + 4096) = (f32x4){r_[0], r_[1], r_[2], r_[3]}; *(LAS f32x4*)(Ob + 4096 + 4) = (f32x4){r_[4], r_[5], r_[6], r_[7]}; } \
            if (cg == 0) { LAS float* SCL = (LAS float*)buf + 9216 + pr * 4 + (wh ? 0 : 2); SCL[0] = sa; SCL[1] = sb; }       \
            LAS float* VV = (LAS float*)buf + 9280; VV[tl * 16 + 2 * cg] = bfl(v2); VV[tl * 16 + 2 * cg + 1] = bfh(v2); \
            if (q4 == 0 && cg == 0) P.PROJw[m * NP + C_RK + h] = (bf16_t)(pkbf(rk, 0.f) & 0xffffu); } while (0)
        P_LOAD(0); P_COMPUTE(0); P_LOAD(1);
        __syncthreads();
        for (int c = 0; c < T / 32; ++c) {
            if (c >= 1) { const LAS float* YB = (const LAS float*)(lds + SC_YB + ((c - 1) & 1) * 2048); const int t = (c - 1) * 32 + tl;
                const float y0 = YB[tl * 16 + 2 * cg], y1 = YB[tl * 16 + 2 * cg + 1];
                *(unsigned*)(P.PROJw + (rb + t) * NP + C_Y + h * 64 + q4 * 16 + 2 * cg) = pkbf(y0, y1); }
            if (c + 1 < T / 32) { P_COMPUTE(c + 1); if (c + 2 < T / 32) P_LOAD(c + 2); }
            __syncthreads();
        }
#undef P_LOAD
#undef P_COMPUTE
        {
            const int c = T / 32; const LAS float* YB = (const LAS float*)(lds + SC_YB + ((c - 1) & 1) * 2048); const int t = (c - 1) * 32 + tl;
            const float y0 = YB[tl * 16 + 2 * cg], y1 = YB[tl * 16 + 2 * cg + 1];
            *(unsigned*)(P.PROJw + (rb + t) * NP + C_Y + h * 64 + q4 * 16 + 2 * cg) = pkbf(y0, y1);
        }
    } else {
        __builtin_amdgcn_s_setprio(3);
        const int rl = lane >> 4, kg = lane & 15, row = wave * 4 + rl;
        f32x4 S = {0.f, 0.f, 0.f, 0.f};
#ifdef SCAN_DUP_CONS
        f32x4 S2 = {0.f, 0.f, 0.f, 0.f}; float ydump = 0.f;
#endif
        __syncthreads();
        for (int c = 0; c < T / 32; ++c) {
            const LAS float* buf = (const LAS float*)(lds + (c & 1) * SC_BUF); LAS float* YB = (LAS float*)(lds + SC_YB + (c & 1) * 2048);
            struct PairOps { f32x4 kk1, wkk2, wr1, w12, n1, k1, nb2, k2, r2, sc; float v1, v2; };
#define SC_LOADP(O, pp) do { const LAS float* b_ = buf + (pp) * 64 + kg * 4; O.kk1 = *(const LAS f32x4*)(b_); O.wkk2 = *(const LAS f32x4*)(b_ + 1024); O.wr1 = *(const LAS f32x4*)(b_ + 2048); O.w12 = *(const LAS f32x4*)(b_ + 3072); \
                O.n1 = *(const LAS f32x4*)(b_ + 4096); O.k1 = *(const LAS f32x4*)(b_ + 5120); O.nb2 = *(const LAS f32x4*)(b_ + 6144); O.k2 = *(const LAS f32x4*)(b_ + 7168); O.r2 = *(const LAS f32x4*)(b_ + 8192); \
                O.sc = *(const LAS f32x4*)(buf + 9216 + (pp) * 4); O.v1 = buf[9280 + (2 * (pp)) * 16 + row]; O.v2 = buf[9280 + (2 * (pp) + 1) * 16 + row]; } while (0)
#define SC_DOT(A, B) ((A[0] * B[0] + A[1] * B[1]) + (A[2] * B[2] + A[3] * B[3]))
#define SC_STEPP(O, pp) do { float d1 = SC_DOT(S, O.kk1), d2 = SC_DOT(S, O.wkk2), d3 = SC_DOT(S, O.wr1); d1 = allsum16(d1); d2 = allsum16(d2); d3 = allsum16(d3); \
                const float s1 = d1, s2 = d2 + s1 * O.sc[0] + O.v1 * O.sc[1], y1 = d3 + s1 * O.sc[2] + O.v1 * O.sc[3]; \
                S = (S * O.w12 + (O.n1 * s1 + O.k1 * O.v1)) + (O.nb2 * s2 + O.k2 * O.v2); \
                float y2 = SC_DOT(S, O.r2); y2 = allsum16(y2); if (kg == 0) { YB[(2 * (pp)) * 16 + row] = y1; YB[(2 * (pp) + 1) * 16 + row] = y2; } } while (0)
            PairOps oA, oB;
            SC_LOADP(oA, 0);
#pragma unroll 2
            for (int pp = 0; pp < 16; pp += 2) {
                SC_LOADP(oB, pp + 1);
                SC_STEPP(oA, pp);
                if (pp + 2 < 16) SC_LOADP(oA, pp + 2);
                SC_STEPP(oB, pp + 1);
            }
#undef SC_LOADP
#undef SC_DOT
#undef SC_STEPP
            __syncthreads();
        }
        __builtin_amdgcn_s_setprio(0);
    }
    __syncthreads();
}

__device__ __forceinline__ void ph_scan_naive(const ScanP& P, int gw, int NGW, int lane) {
    for (int task = gw; task < 4096; task += NGW) { const int b = task >> 9, h = (task >> 6) & 7, row = task & 63; const int ch = h * 64 + lane;
        const float mur = P.mu_r[ch], muk = P.mu_k[ch], kkp = P.k_k[ch], kap = P.k_a[ch], rkp = P.r_k[ch];
        float S = 0.f, rprev = 0.f, kprev = 0.f;
        for (int t = 0; t < T; ++t) { const size_t m = (size_t)b * 4096 + t;
            const float rc = bf1(P.PROJ[m * NP + C_R + ch]), kc = bf1(P.PROJ[m * NP + C_K + ch]);
            const float r = rc + (rprev - rc) * mur, kl = kc + (kprev - kc) * muk; rprev = rc; kprev = kc;
            const float a = pg8::sigmoidf_((float)P.A[m * 512 + ch]); const float dec = __expf(-0.60653065971f * pg8::sigmoidf_((float)P.E[m * 512 + ch]));
            const float kkv = kl * kkp; const float ss = wave_sum(kkv * kkv); const float kk = kkv / fmaxf(sqrtf(ss), 1e-12f);
            const float kp = kl * (1.f + (a - 1.f) * kap); const float v = bf1(P.VF[m * 512 + h * 64 + row]);
            const float sk = wave_sum(S * kk); S = S * dec - sk * kk * a + v * kp; const float y = wave_sum(S * r);
            if (lane == 0) P.PROJw[m * NP + C_Y + h * 64 + row] = (bf16_t)(pkbf(y, 0.f) & 0xffffu);
            if (row == 0) { const float rk = wave_sum(r * kp * rkp); if (lane == 0) P.PROJw[m * NP + C_RK + h] = (bf16_t)(pkbf(rk, 0.f) & 0xffffu); } } }
}

__device__ __forceinline__ void ph_rwkv_post(const bf16_t* PROJ, const bf16_t* VF, bf16_t* MIX, const float* lnx_g, const float* lnx_b, int gw, int NGW, int lane) {
    float lg[8], lb[8];
#pragma unroll
    for (int i = 0; i < 8; ++i) { lg[i] = lnx_g[lane * 8 + i]; lb[i] = lnx_b[lane * 8 + i]; }
    for (int m = gw; m < M; m += NGW) {
        const u32x4 y8 = *(const u32x4*)(PROJ + (size_t)m * NP + C_Y + lane * 8), v8 = *(const u32x4*)(VF + (size_t)m * 512 + lane * 8), g8 = *(const u32x4*)(MIX + (size_t)m * D + lane * 8);
        const float rk = bf1(PROJ[(size_t)m * NP + C_RK + (lane >> 3)]);
        float y[8]; float s = 0.f;
#pragma unroll
        for (int i = 0; i < 4; ++i) { y[2 * i] = bfl(y8[i]); y[2 * i + 1] = bfh(y8[i]); s += y[2 * i] + y[2 * i + 1]; }
        const float mean = allsum8(s) * (1.f / 64.f); float q = 0.f;
#pragma unroll
        for (int i = 0; i < 8; ++i) { y[i] -= mean; q += y[i] * y[i]; }
        const float rstd = rsqrtf(allsum8(q) * (1.f / 64.f) + 64e-5f);
        float o[8];
#pragma unroll
        for (int i = 0; i < 8; ++i) { const float vv = (i & 1) ? bfh(v8[i >> 1]) : bfl(v8[i >> 1]), gg = (i & 1) ? bfh(g8[i >> 1]) : bfl(g8[i >> 1]);
            o[i] = (y[i] * rstd * lg[i] + lb[i] + rk * vv) * gg; }
        u32x4 w; w.x = pkbf(o[0], o[1]); w.y = pkbf(o[2], o[3]); w.z = pkbf(o[4], o[5]); w.w = pkbf(o[6], o[7]);
        *(u32x4*)(MIX + (size_t)m * D + lane * 8) = w;
    }
}

#ifndef MK_PER_PHASE
#define MK_PER_PHASE 0
#endif
constexpr int N_PHASES = 22;
struct Args { const float* in[32]; float* out; unsigned char* ws; int ph_lo, ph_hi, li, pad; };
__device__ __forceinline__ int opq(int k) { asm volatile("" : "+s"(k)); return k; }
#define INP(k) ((const float*)(const GAS float*)args.in[opq(k)])
#define WSP(T_, off) ((T_*)(wsl + (off)))
#define LAUNDER_WS() GAS unsigned char* wsl = (GAS unsigned char*)args.ws; asm volatile("" : "+s"(wsl)); GAS float* Xg = (GAS float*)Xp_; asm volatile("" : "+s"(Xg)); float* X = (float*)Xg; (void)X; int wave = wave_s; asm volatile("" : "+s"(wave)); \
    unsigned ones_ = ~0u; asm volatile("" : "+s"(ones_)); int tid = wave * 64 + (int)__builtin_amdgcn_mbcnt_hi(ones_, __builtin_amdgcn_mbcnt_lo(ones_, 0u)); asm volatile("" : "+v"(tid)); int G = gridDim.x, bx = blockIdx.x; asm volatile("" : "+s"(G), "+s"(bx)); \
    const int lane = tid & 63; const int vcu = (G % 8 == 0) ? (bx % 8) * (G / 8) + bx / 8 : bx; const int gw = vcu * NWAVES + wave, NGW = G * NWAVES; (void)lane; (void)gw; (void)NGW; (void)vcu
#ifndef PH_MASK
#define PH_MASK 0xFFFFu
#endif
#define PHBIT(k) ((k) == 0 ? 0 : ((k) == 21 ? 11 : (((k) - 1) % 10) + 1))
#define IN(k) (((PH_MASK >> PHBIT(k)) & 1u) && lo <= (k) && (k) < hi)
#ifndef DUP_MASK
#define DUP_MASK 0
#endif
#define DUPN(j) for (int rep_ = 0; rep_ < (int)((DUP_MASK >> (j)) & 1) + 1; ++rep_)
#define SEAM(k) do { if (IN(k) && IN((k) + 1)) { XcdBarrier b2_ = bar; asm volatile("" : "+s"(b2_.bar), "+s"(b2_.x)); xcd_barrier(b2_); } } while (0)
template <int l> __device__ __forceinline__ void layer_body(const Args& args, LAS unsigned char* lds, const XcdBarrier& bar, float* Xp_, const int lo, const int hi, const int wave_s) {
        const int pb = 1 + 10 * l;
        if (IN(pb + 0)) DUPN(0) { LAUNDER_WS();
            WPtrs P; P.w_in = INP(6); P.decay_a = INP(10); P.iclr_a = INP(13); P.gate_a = INP(15); P.vres_a = INP(24); P.mu_lora = INP(8); P.vres_mu = INP(22);
            P.w_out = INP(28); P.w1 = INP(29); P.w2 = INP(30); P.decay_b = INP(11); P.iclr_b = INP(14); P.gate_b = INP(16); P.vres_b = INP(25);
            if (l != 0) ph_weights(P, l, (unsigned char*)wsl, lds, vcu, G, tid);
            const float* MODl = WSP(float, WS_MOD) + (size_t)l * 8 * 6144;
            ph_norm((l == 0) ? INP(0) : (const float*)X, INP(4) + (size_t)l * D, MODl + 0 * D, MODl + 1 * D, WSP(bf16_t, WS_H), gw, NGW, lane);
        }
        SEAM(pb + 0);
        if (IN(pb + 1)) DUPN(1) { LAUNDER_WS();
            pg8::Gemm g{WSP(bf16_t, WS_H), WSP(bf16_t, WS_WIN), M, NP, D, D, D}; pg8::StaticOrder S; S.init(M, NP, G, bx);
            pg8::EpiBf<0> E{WSP(bf16_t, WS_PROJ), NP, C_QA / 256, C_KA / 256, att::C2};
            pg8::gemm_phase<pg8::EpiBf<0>, pg8::StaticOrder, true, true>(lds, g, S, E, tid);
        }
        SEAM(pb + 1);
        if (IN(pb + 2)) DUPN(2) { LAUNDER_WS();
            for (int rep_l = 0; rep_l < (int)((DUP_MASK >> 12) & 1) + 1; ++rep_l)
            ph_lora_act(WSP(bf16_t, WS_PROJ), WSP(bf16_t, WS_LACT), WSP(bf16_t, WS_VF), INP(7) + (size_t)(l * 3 + 2) * 512, l == 0, gw, NGW, lane);
            ph_select(WSP(bf16_t, WS_PROJ), WSP(unsigned long long, WS_MASK), lds, vcu, G, tid);
        }
        SEAM(pb + 2);
        if (IN(pb + 3)) {
            DUPN(3) { LAUNDER_WS(); pg8::Gemm g{WSP(bf16_t, WS_LACT), WSP(bf16_t, WS_LW), M, 1024, 128, LA, 128}; pg8::StaticOrder S; S.init(M, 1024, G, bx);
              pg8::EpiDecIclr E{WSP(_Float16, WS_H), WSP(_Float16, WS_H + 32 * MiB), INP(9) + (size_t)l * 512, INP(12) + (size_t)l * 512};
              pg8::gemm_phase<pg8::EpiDecIclr, pg8::StaticOrder, true, true>(lds, g, S, E, tid); }
            __syncthreads();
            DUPN(3) { LAUNDER_WS(); pg8::Gemm g{WSP(bf16_t, WS_LACT) + 128, WSP(bf16_t, WS_LW) + 1024 * 128, M, 512, 128, LA, 128}; pg8::StaticOrder S; S.init(M, 512, G, bx);
              pg8::EpiBf<0> E{WSP(bf16_t, WS_MIX), D, 0, 0, 1.f};
              pg8::gemm_phase<pg8::EpiBf<0>, pg8::StaticOrder, true, true>(lds, g, S, E, tid); }
            __syncthreads();
            if (l >= 1) { LAUNDER_WS(); pg8::Gemm g{WSP(bf16_t, WS_LACT) + 256, WSP(bf16_t, WS_LW) + 1536 * 128, M, 512, 128, LA, 128}; pg8::StaticOrder S; S.init(M, 512, G, bx);
              pg8::EpiVres E{WSP(bf16_t, WS_PROJ) + C_V, NP, WSP(bf16_t, WS_VF), INP(23) + (size_t)(l - 1) * 512, INP(7) + (size_t)(l * 3 + 2) * 512};
              pg8::gemm_phase<pg8::EpiVres, pg8::StaticOrder, true, true>(lds, g, S, E, tid); }
        }
        SEAM(pb + 3);
        if (IN(pb + 4)) {
            DUPN(4) { LAUNDER_WS();
              ScanP P; P.PROJ = WSP(bf16_t, WS_PROJ); P.PROJw = WSP(bf16_t, WS_PROJ); P.E = WSP(_Float16, WS_H); P.A = WSP(_Float16, WS_H + 32 * MiB); P.VF = WSP(bf16_t, WS_VF);
              P.mu_r = INP(7) + (size_t)(l * 3 + 0) * 512; P.mu_k = INP(7) + (size_t)(l * 3 + 1) * 512;
              P.k_k = INP(17) + (size_t)l * 512; P.k_a = INP(18) + (size_t)l * 512; P.r_k = INP(19) + (size_t)l * 512;
#ifdef SCAN_FAST
              for (int u = vcu; u < 256; u += G) scan_unit(P, u >> 5, (u >> 2) & 7, u & 3, lds, tid); }
#else
              ph_scan_naive(P, gw, NGW, lane); }
#endif
            __syncthreads();
            DUPN(11) { LAUNDER_WS();
              att::build_bias_table(INP(27), (LAS char*)lds, tid);
              __syncthreads();
              const float* gain = INP(26) + (size_t)l * 512;
              for (int v = vcu; v < 256; v += G) { const int bh = v >> 2, s = v & 3;
                  for (int i = 0; i < 4; ++i) { const int qb = (i == 0) ? s : (i == 1) ? 7 - s : (i == 2) ? 8 + s : 15 - s;
                      att::attn_unit(bh >> 3, bh & 7, qb, WSP(bf16_t, WS_PROJ), WSP(unsigned long long, WS_MASK), WSP(bf16_t, WS_MIX), gain, (LAS char*)lds, tid); } } }
        }
        SEAM(pb + 4);
        if (IN(pb + 5)) { LAUNDER_WS(); ph_rwkv_post(WSP(bf16_t, WS_PROJ), WSP(bf16_t, WS_VF), WSP(bf16_t, WS_MIX), INP(20) + (size_t)l * 512, INP(21) + (size_t)l * 512, gw, NGW, lane); }
        SEAM(pb + 5);
        if (IN(pb + 6)) { LAUNDER_WS();
            pg8::Gemm g{WSP(bf16_t, WS_MIX), WSP(bf16_t, WS_WOUT), M, D, D, D, D}; pg8::StaticOrder S; S.init(M, D, G, bx);
            pg8::EpiResid E{(l == 0) ? INP(0) : (const float*)X, X, WSP(float, WS_MOD) + (size_t)l * 8 * 6144 + 2 * D, D};
            pg8::gemm_phase<pg8::EpiResid, pg8::StaticOrder, true, true>(lds, g, S, E, tid);
        }
        SEAM(pb + 6);
        if (IN(pb + 7)) DUPN(7) { LAUNDER_WS(); const float* MODl = WSP(float, WS_MOD) + (size_t)l * 8 * 6144;
            ph_norm(X, INP(5) + (size_t)l * D, MODl + 3 * D, MODl + 4 * D, WSP(bf16_t, WS_H), gw, NGW, lane); }
        SEAM(pb + 7);
        if (IN(pb + 8)) DUPN(8) { LAUNDER_WS();
            pg8::Gemm g{WSP(bf16_t, WS_H), WSP(bf16_t, WS_W1), M, FF, D, D, D}; pg8::StaticOrder S; S.init(M, FF, G, bx);
            pg8::EpiBf<1> E{WSP(bf16_t, WS_PROJ), FF, 0, 0, 1.f};
            pg8::gemm_phase<pg8::EpiBf<1>, pg8::StaticOrder, true, true>(lds, g, S, E, tid);
        }
        SEAM(pb + 8);
        if (IN(pb + 9)) { LAUNDER_WS();
            pg8::Gemm g{WSP(bf16_t, WS_PROJ), WSP(bf16_t, WS_W2), M, D, FF, FF, FF}; pg8::StaticOrder S; S.init(M, D, G, bx);
            pg8::EpiResid E{X, X, WSP(float, WS_MOD) + (size_t)l * 8 * 6144 + 5 * D, D};
            pg8::gemm_phase<pg8::EpiResid, pg8::StaticOrder, true, true>(lds, g, S, E, tid);
        }
        SEAM(pb + 9);
}
__global__ void __launch_bounds__(NWAVES * 64, 2) trunk_fwd(Args args) {
    extern __shared__ __attribute__((aligned(16))) unsigned char lds_raw[];
    LAS unsigned char* lds = (LAS unsigned char*)lds_raw;
    volatile LAS unsigned* MISC = (volatile LAS unsigned*)(lds + MISC_OFF);
    unsigned* ctl = (unsigned*)(args.ws + WS_CTL);
    for (int u = threadIdx.x; u < (LDS_BYTES - LDSCTL_OFF) / 4; u += NWAVES * 64) ((LAS unsigned*)(lds + LDSCTL_OFF))[u] = 0u;
    __syncthreads();
    XcdBarrier bar = xcd_barrier_post(ctl + CW_BAR + args.li * XCD_BAR_WORDS, MISC + 8);
    const int lo = args.ph_lo, hi = args.ph_hi; const int wave_s = __builtin_amdgcn_readfirstlane((int)threadIdx.x >> 6);
    float* Xp_ = args.out;

    if (IN(0)) { LAUNDER_WS(); ph_mod(INP(1), INP(2), INP(3), WSP(float, WS_MOD), lds, vcu, G, tid);
        WPtrs P; P.w_in = INP(6); P.decay_a = INP(10); P.iclr_a = INP(13); P.gate_a = INP(15); P.vres_a = INP(24); P.mu_lora = INP(8); P.vres_mu = INP(22);
        P.w_out = INP(28); P.w1 = INP(29); P.w2 = INP(30); P.decay_b = INP(11); P.iclr_b = INP(14); P.gate_b = INP(16); P.vres_b = INP(25);
        __syncthreads();
        ph_weights(P, 0, (unsigned char*)wsl, lds, vcu, G, tid); }
    SEAM(0);

    layer_body<0>(args, lds, bar, Xp_, lo, hi, wave_s);
    layer_body<1>(args, lds, bar, Xp_, lo, hi, wave_s);
    if (IN(21)) { LAUNDER_WS(); (void)wsl; ph_final_norm(X, INP(31), gw, NGW, lane); }
#undef IN
#undef SEAM
}

extern "C" void kernel_launch(void* const* d_in, const int* in_sizes, int n_in, void* d_out, int out_size, void* d_ws, size_t ws_size, hipStream_t stream) {
    static int grid = 0;
    if (grid == 0) {
        if (n_in != 32 || in_sizes[0] != M * D || out_size != M * D || ws_size < WS_END) { fprintf(stderr, "kernel_launch: unexpected problem: n_in %d in0 %d out %d ws %zu (need %zu)\n", n_in, n_in > 0 ? in_sizes[0] : -1, out_size, ws_size, (size_t)WS_END); grid = -1; return; }
        int dev = 0, cus = 0, per_cu = 0;
        if (hipGetDevice(&dev) != hipSuccess || hipDeviceGetAttribute(&cus, hipDeviceAttributeMultiprocessorCount, dev) != hipSuccess) { grid = -1; return; }
        if (hipFuncSetAttribute((const void*)trunk_fwd, hipFuncAttributeMaxDynamicSharedMemorySize, LDS_BYTES) != hipSuccess) { fprintf(stderr, "kernel_launch: hipFuncSetAttribute failed\n"); grid = -1; return; }
        if (hipOccupancyMaxActiveBlocksPerMultiprocessor(&per_cu, (const void*)trunk_fwd, NWAVES * 64, LDS_BYTES) != hipSuccess || per_cu < 1) { fprintf(stderr, "kernel_launch: occupancy query reports %d workgroups per CU\n", per_cu); }
        (void)hipGetLastError();
        grid = cus;
        if (grid > 256) grid = 256;
    }
    if (grid < 0) return;
    if (hipMemsetAsync((char*)d_ws + WS_CTL, 0, CTL_ZERO_BYTES, stream) != hipSuccess) return;
    Args a{};
    for (int i = 0; i < 32; ++i) a.in[i] = (const float*)d_in[i];
    a.out = (float*)d_out; a.ws = (unsigned char*)d_ws; a.pad = 0;
#if MK_PER_PHASE
    for (int p = 0; p < N_PHASES; ++p) { a.ph_lo = p; a.ph_hi = p + 1; a.li = 0;
        hipLaunchKernelGGL(trunk_fwd, dim3(grid), dim3(NWAVES * 64), LDS_BYTES, stream, a); }
#else
    a.ph_lo = 0; a.ph_hi = N_PHASES; a.li = 0;
    hipLaunchKernelGGL(trunk_fwd, dim3(grid), dim3(NWAVES * 64), LDS_BYTES, stream, a);
#endif
}
```

```cpp
#define SCAN_FAST 1
#define SCAN_CHUNK 1
#define SCAN_SHARE 1
#include <hip/hip_runtime.h>
#include <hip/hip_bf16.h>
#include <cstdio>
#include <cstdint>
#include <cmath>
namespace pg8 {
#define PG8_LAS __attribute__((address_space(3)))
typedef unsigned short bf16_t;
typedef short bf16x8 __attribute__((ext_vector_type(8)));
typedef float f32x4 __attribute__((ext_vector_type(4)));
typedef unsigned u32x4 __attribute__((ext_vector_type(4)));
constexpr int BM = 256, BK = 64, HALF = 128, HTB = HALF * BK * 2  , STAGE_BYTES = 8 * HTB, NXCD = 8, WGM = 8;

__host__ __device__ __forceinline__ int lds_byte(int r, int c) { const int st = (r >> 4) * 2 + (c >> 5), rr = r & 15, cc = c & 31, ob = rr * 64 + cc * 2; return st * 1024 + (ob ^ (((ob >> 9) & 1) << 5)); }
__host__ __device__ __forceinline__ void stage_rc(int b, int& R, int& C) { const int st = b / 1024, sb = b % 1024, swz = sb ^ (((sb >> 9) & 1) << 5); R = (st >> 1) * 16 + swz / 64; C = (st & 1) * 32 + (swz % 64) / 2; }
__host__ __device__ __forceinline__ int perm32(int rho) { const int n = rho >> 4, i = rho & 15; return 8 * (i >> 2) + 4 * n + (i & 3); }

struct Unit { int pm, pn; };
struct Gemm { const bf16_t* A; const bf16_t* Bt; int M, N, K, lda, ldb; };

struct StaticOrder {
    int nM, nN, nwg, G, c;
    __host__ __device__ void init(int M, int N, int G_, int c_) { nM = M / BM; nN = N / BM; nwg = nM * nN; G = G_; c = c_; }
    __host__ __device__ bool next(int i, Unit& u) const {
        const long L = (long)i * G + c; if (L >= nwg) return false;
        int wgid = (int)L; { const int q = nwg / NXCD, r = nwg % NXCD, xcd = wgid % NXCD, off = wgid / NXCD; wgid = (xcd < r ? xcd * (q + 1) : r * (q + 1) + (xcd - r) * q) + off; }
        const int nig = WGM * nN, gid = wgid / nig, fm = gid * WGM, gsz = (nM - fm) < WGM ? (nM - fm) : WGM;
        u.pm = fm + ((wgid % nig) % gsz); u.pn = (wgid % nig) / gsz; return true;
    }
    __device__ __forceinline__ void a_ready(const Unit&) const {}
    __device__ __forceinline__ void done(const Unit&) const {}
};

typedef _Float16 f16x2_t __attribute__((ext_vector_type(2)));
typedef _Float16 half8 __attribute__((ext_vector_type(8)));
__device__ __forceinline__ unsigned cvt_pk_bf16(float lo, float hi) { f16x2_t h = {(_Float16)lo, (_Float16)hi}; return __builtin_bit_cast(unsigned, h); }
__device__ __forceinline__ unsigned cvt_pk_f16(float lo, float hi) { f16x2_t h = {(_Float16)lo, (_Float16)hi}; return __builtin_bit_cast(unsigned, h); }
__device__ __forceinline__ float bf_lo(unsigned w) { return (float)__builtin_bit_cast(_Float16, (unsigned short)(w & 0xffffu)); }
__device__ __forceinline__ float bf_hi(unsigned w) { return (float)__builtin_bit_cast(_Float16, (unsigned short)(w >> 16)); }
__device__ __forceinline__ float sigmoidf_(float x) { return __builtin_amdgcn_rcpf(1.0f + __expf(-x)); }

template <int MODE> struct EpiBf {
    static constexpr bool PERM = true, AFTER_DRAIN = false;
    bf16_t* O; int ldc; int qlo, qhi; float qscale;
    __device__ __forceinline__ void operator()(const f32x4 (&acc)[2][2][4][2], const Unit& u, int wr, int wc, int fr, int fq) const {
        const int row0 = u.pm * BM + wr * 64 + fr, col0 = u.pn * BM + wc * 32 + 8 * fq;
        const float sc = (MODE == 0 && u.pn >= qlo && u.pn < qhi) ? qscale : 1.f;
#pragma unroll
        for (int ai = 0; ai < 2; ++ai)
#pragma unroll
            for (int m = 0; m < 4; ++m) { bf16_t* rowp = O + (size_t)(row0 + ai * HALF + m * 16) * ldc + col0;
#pragma unroll
                for (int bj = 0; bj < 2; ++bj) { f32x4 v0 = acc[ai][bj][m][0], v1 = acc[ai][bj][m][1];
                    if (MODE == 1) { v0 = __builtin_elementwise_max(v0, (f32x4){0.f, 0.f, 0.f, 0.f}); v1 = __builtin_elementwise_max(v1, (f32x4){0.f, 0.f, 0.f, 0.f}); v0 = v0 * v0; v1 = v1 * v1; }
                    else { v0 = v0 * sc; v1 = v1 * sc; }
                    u32x4 w; w.x = cvt_pk_bf16(v0[0], v0[1]); w.y = cvt_pk_bf16(v0[2], v0[3]); w.z = cvt_pk_bf16(v1[0], v1[1]); w.w = cvt_pk_bf16(v1[2], v1[3]);
                    *(u32x4*)(rowp + bj * HALF) = w; } }
    }
};
struct EpiResid {
    static constexpr bool PERM = false, AFTER_DRAIN = false;
    const float* base; float* out; const float* gate; int ldc;
    __device__ __forceinline__ void operator()(const f32x4 (&acc)[2][2][4][2], const Unit& u, int wr, int wc, int fr, int fq) const {
        const int row0 = u.pm * BM + wr * 64 + fr, col0 = u.pn * BM + wc * 32 + 4 * fq;
        const float* gp = gate + (size_t)((u.pm * BM) >> 12) * 6144 + col0;
#pragma unroll
        for (int bj = 0; bj < 2; ++bj)
#pragma unroll
            for (int n = 0; n < 2; ++n) { const f32x4 gv = *(const f32x4*)(gp + bj * HALF + n * 16);
#pragma unroll
                for (int ai = 0; ai < 2; ++ai)
#pragma unroll
                    for (int m = 0; m < 4; ++m) { const size_t off = (size_t)(row0 + ai * HALF + m * 16) * ldc + col0 + bj * HALF + n * 16;
                        const f32x4 bs = *(const f32x4*)(base + off); *(f32x4*)(out + off) = bs + gv * acc[ai][bj][m][n]; } }
    }
};
struct EpiDecIclr {
    static constexpr bool PERM = true, AFTER_DRAIN = false;
    _Float16* E; _Float16* A; const float* w0; const float* a0;
    __device__ __forceinline__ void operator()(const f32x4 (&acc)[2][2][4][2], const Unit& u, int wr, int wc, int fr, int fq) const {
        asm volatile("" : "+v"(fr), "+v"(fq));
        const int row0 = u.pm * BM + wr * 64 + fr; const int kind = u.pn >> 1; const int c0 = (u.pn & 1) * BM + wc * 32 + 8 * fq;
        _Float16* O = kind ? A : E; const float* bp = kind ? a0 : w0;
#pragma unroll
        for (int bj = 0; bj < 2; ++bj) { const f32x4 bv0 = *(const f32x4*)(bp + c0 + bj * HALF), bv1 = *(const f32x4*)(bp + c0 + bj * HALF + 4);
#pragma unroll
            for (int ai = 0; ai < 2; ++ai)
#pragma unroll
                for (int m = 0; m < 4; ++m) { _Float16* rowp = O + (size_t)(row0 + ai * HALF + m * 16) * 512 + c0 + bj * HALF;
                    f32x4 v0 = acc[ai][bj][m][0] + bv0, v1 = acc[ai][bj][m][1] + bv1;
#ifdef SCAN_CHUNK
                    const float mul_ = kind ? 1.0f : (-0.60653065971f * 1.4426950408889634f);
                    unsigned wx, wy, wz, ww;
                    asm volatile("" : "+v"(v0));
                    wx = cvt_pk_f16(mul_ * sigmoidf_(v0[0]), mul_ * sigmoidf_(v0[1])); wy = cvt_pk_f16(mul_ * sigmoidf_(v0[2]), mul_ * sigmoidf_(v0[3]));
                    asm volatile("" : "+v"(wx), "+v"(wy), "+v"(v1));
                    wz = cvt_pk_f16(mul_ * sigmoidf_(v1[0]), mul_ * sigmoidf_(v1[1])); ww = cvt_pk_f16(mul_ * sigmoidf_(v1[2]), mul_ * sigmoidf_(v1[3]));
                    asm volatile("" : "+v"(wz), "+v"(ww));
                    u32x4 w; w.x = wx; w.y = wy; w.z = wz; w.w = ww;
#else
                    u32x4 w; w.x = cvt_pk_f16(v0[0], v0[1]); w.y = cvt_pk_f16(v0[2], v0[3]); w.z = cvt_pk_f16(v1[0], v1[1]); w.w = cvt_pk_f16(v1[2], v1[3]);
#endif
                    *(u32x4*)rowp = w; asm volatile("" ::: "memory"); } }
    }
};
struct EpiVres {
    static constexpr bool PERM = true, AFTER_DRAIN = false;
    const bf16_t* PV; int ldp; bf16_t* VF; const float* v0; const float* muv;
    __device__ __forceinline__ void operator()(const f32x4 (&acc)[2][2][4][2], const Unit& u, int wr, int wc, int fr, int fq) const {
        const int row0 = u.pm * BM + wr * 64 + fr; const int c0 = u.pn * BM + wc * 32 + 8 * fq;
#pragma unroll
        for (int bj = 0; bj < 2; ++bj) { const int c = c0 + bj * HALF;
            float b8[8], m8[8];
#pragma unroll
            for (int i = 0; i < 8; ++i) { b8[i] = v0[c + i]; m8[i] = muv[c + i]; }
#pragma unroll
            for (int ai = 0; ai < 2; ++ai)
#pragma unroll
                for (int m = 0; m < 4; ++m) { const int row = row0 + ai * HALF + m * 16;
                    const u32x4 vc = *(const u32x4*)(PV + (size_t)row * ldp + c);
                    u32x4 vp = (u32x4){0u, 0u, 0u, 0u}; if ((row & 4095) != 0) vp = *(const u32x4*)(PV + (size_t)(row - 1) * ldp + c);
                    const u32x4 vf = *(const u32x4*)(VF + (size_t)row * 512 + c);
                    float o[8];
#pragma unroll
                    for (int i = 0; i < 8; ++i) { const unsigned wc_ = vc[i >> 1], wp_ = vp[i >> 1], wf_ = vf[i >> 1];
                        const float xc = (i & 1) ? bf_hi(wc_) : bf_lo(wc_), xp = (i & 1) ? bf_hi(wp_) : bf_lo(wp_), xf = (i & 1) ? bf_hi(wf_) : bf_lo(wf_);
                        const float a = (i < 4) ? acc[ai][bj][m][0][i & 3] : acc[ai][bj][m][1][i & 3];
                        const float vl = xc + (xp - xc) * m8[i]; const float g = sigmoidf_(b8[i] + a); o[i] = vl + (xf - vl) * g; }
                    u32x4 w; w.x = cvt_pk_bf16(o[0], o[1]); w.y = cvt_pk_bf16(o[2], o[3]); w.z = cvt_pk_bf16(o[4], o[5]); w.w = cvt_pk_bf16(o[6], o[7]);
                    *(u32x4*)(VF + (size_t)row * 512 + c) = w; asm volatile("" ::: "memory"); } }
    }
};

template <class Epi, class Sched, bool ALIGN_EPI = false, bool SP2 = false>
__device__ __forceinline__ void gemm_phase(PG8_LAS unsigned char* lds, const Gemm g, const Sched& S, const Epi& E, const int tid) {
    const int wid = __builtin_amdgcn_readfirstlane(tid >> 6), lane = tid & 63, wr = wid >> 2, wc = wid & 3, fr = lane & 15, fq = lane >> 4;
    const int K = g.K, nt = K / BK;
    unsigned voffA[2], voffB[2];
#pragma unroll
    for (int i = 0; i < 2; ++i) { int R, C; stage_rc(tid * 16 + i * 8192, R, C); const int Rb = Epi::PERM ? ((R & ~31) + perm32(R & 31)) : R;
        voffA[i] = (unsigned)(R * g.lda + C) * 2u; voffB[i] = (unsigned)(Rb * g.ldb + C) * 2u; }
    const size_t kstep = (size_t)(BK * 2);
    const size_t hstepA = (size_t)HALF * g.lda * 2, hstepB = (size_t)HALF * g.ldb * 2;
    const size_t tstepA = 2 * hstepA, tstepB = 2 * hstepB;
    const unsigned ldsw = (unsigned)wid * 1024u;
    const int aoff = lds_byte(wr * 64 + fr, fq * 8), boff = lds_byte(wc * 32 + fr, fq * 8);
#define PG8_SA(b, h) (((b) * 2 + (h)) * HTB)
#define PG8_SB(b, h) ((4 + (b) * 2 + (h)) * HTB)
#define PG8_STAGE(bufoff, gbase, voff) do { _Pragma("unroll") for (int _i = 0; _i < 2; ++_i) \
        __builtin_amdgcn_global_load_lds((const unsigned*)((const char*)(gbase) + (voff)[_i]), (PG8_LAS unsigned*)(lds + (bufoff) + ldsw + _i * 8192), 16, 0, 0); } while (0)
#define PG8_LDA(dst, b, h) do { _Pragma("unroll") for (int m = 0; m < 4; ++m) _Pragma("unroll") for (int k = 0; k < 2; ++k) dst[m][k] = *(const PG8_LAS bf16x8*)(lds + PG8_SA(b, h) + aoff + m * 2048 + k * 1024); } while (0)
#define PG8_LDB(dst, b, h) do { _Pragma("unroll") for (int n = 0; n < 2; ++n) _Pragma("unroll") for (int k = 0; k < 2; ++k) dst[n][k] = *(const PG8_LAS bf16x8*)(lds + PG8_SB(b, h) + boff + n * 2048 + k * 1024); } while (0)
#define PG8_MMA(ai, bj, At, Bt) do { __builtin_amdgcn_s_setprio(1); _Pragma("unroll") for (int m = 0; m < 4; ++m) _Pragma("unroll") for (int n = 0; n < 2; ++n) _Pragma("unroll") for (int k = 0; k < 2; ++k) \
        acc[ai][bj][m][n] = __builtin_amdgcn_mfma_f32_16x16x32_f16(__builtin_bit_cast(half8, Bt[n][k]), __builtin_bit_cast(half8, At[m][k]), acc[ai][bj][m][n], 0, 0, 0); __builtin_amdgcn_s_setprio(0); } while (0)
#define PG8_WAIT_V(n) asm volatile("s_waitcnt vmcnt(" #n ")" ::: "memory")
#define PG8_WAIT_L(n) asm volatile("s_waitcnt lgkmcnt(" #n ")" ::: "memory")
#define PG8_BAR __builtin_amdgcn_s_barrier()
#define PG8_SCHED __builtin_amdgcn_sched_barrier(0)
    Unit cur, nxt; int ui = 0;
    if (!S.next(0, cur)) return;
    f32x4 acc[2][2][4][2];
#pragma unroll
    for (int a = 0; a < 2; ++a)
#pragma unroll
        for (int b = 0; b < 2; ++b)
#pragma unroll
            for (int m = 0; m < 4; ++m)
#pragma unroll
                for (int n = 0; n < 2; ++n) acc[a][b][m][n] = (f32x4){0.f, 0.f, 0.f, 0.f};
    bf16x8 At[4][2], B0[2][2], B1[2][2];
    const char* cA = (const char*)g.A + (size_t)cur.pm * tstepA; const char* cB = (const char*)g.Bt + (size_t)cur.pn * tstepB;
    S.a_ready(cur);
    if constexpr (SP2) {
        PG8_STAGE(PG8_SB(0, 0), cB, voffB); PG8_STAGE(PG8_SB(0, 1), cB + hstepB, voffB); PG8_STAGE(PG8_SA(0, 0), cA, voffA); PG8_STAGE(PG8_SA(0, 1), cA + hstepA, voffA);
        if (wr == 1) PG8_BAR;
        PG8_WAIT_V(2); PG8_BAR;
        PG8_STAGE(PG8_SB(1, 0), cB + kstep, voffB); PG8_STAGE(PG8_SA(1, 0), cA + kstep, voffA); PG8_STAGE(PG8_SB(1, 1), cB + hstepB + kstep, voffB);
        PG8_WAIT_V(6); PG8_BAR;
    } else {
        PG8_STAGE(PG8_SB(0, 0), cB, voffB); PG8_STAGE(PG8_SA(0, 0), cA, voffA); PG8_STAGE(PG8_SB(0, 1), cB + hstepB, voffB); PG8_STAGE(PG8_SA(0, 1), cA + hstepA, voffA);
        if (wr == 1) PG8_BAR;
        PG8_WAIT_V(4); PG8_BAR;
        PG8_STAGE(PG8_SB(1, 0), cB + kstep, voffB); PG8_STAGE(PG8_SA(1, 0), cA + kstep, voffA); PG8_STAGE(PG8_SB(1, 1), cB + hstepB + kstep, voffB);
        PG8_WAIT_V(6); PG8_BAR;
    }
    for (;;) {
        const bool has_next = S.next(ui + 1, nxt);
        const char* nA = has_next ? (const char*)g.A + (size_t)nxt.pm * tstepA : cA; const char* nB = has_next ? (const char*)g.Bt + (size_t)nxt.pn * tstepB : cB;
        for (int t = 0; t < nt; t += 2) {
            const bool last = (t == nt - 2);
            const char* a1 = cA + (size_t)(t + 1) * kstep;
            const char* a2 = last ? nA : cA + (size_t)(t + 2) * kstep; const char* b2 = last ? nB : cB + (size_t)(t + 2) * kstep;
            const char* a3 = a2 + kstep; const char* b3 = b2 + kstep;
            if (last && has_next) S.a_ready(nxt);
            if constexpr (SP2) {
            PG8_LDB(B0, 0, 0); PG8_LDB(B1, 0, 1); PG8_SCHED; PG8_LDA(At, 0, 0); PG8_STAGE(PG8_SA(1, 1), a1 + hstepA, voffA);
            PG8_WAIT_V(8); PG8_WAIT_L(0); PG8_BAR; PG8_MMA(0, 0, At, B0); PG8_MMA(0, 1, At, B1); PG8_BAR; PG8_SCHED;
            PG8_LDA(At, 0, 1); PG8_STAGE(PG8_SB(0, 0), b2, voffB); PG8_STAGE(PG8_SB(0, 1), b2 + hstepB, voffB); PG8_STAGE(PG8_SA(0, 0), a2, voffA);
            PG8_WAIT_V(8); PG8_WAIT_L(0); PG8_BAR; PG8_MMA(1, 0, At, B0); PG8_MMA(1, 1, At, B1); PG8_BAR; PG8_SCHED;
            PG8_LDB(B0, 1, 0); PG8_LDB(B1, 1, 1); PG8_SCHED; PG8_LDA(At, 1, 0); PG8_STAGE(PG8_SA(0, 1), a2 + hstepA, voffA);
            PG8_WAIT_V(8); PG8_WAIT_L(0); PG8_BAR; PG8_MMA(0, 0, At, B0); PG8_MMA(0, 1, At, B1); PG8_BAR; PG8_SCHED;
            PG8_LDA(At, 1, 1); PG8_STAGE(PG8_SB(1, 0), b3, voffB); PG8_STAGE(PG8_SB(1, 1), b3 + hstepB, voffB); PG8_STAGE(PG8_SA(1, 0), a3, voffA);
            PG8_WAIT_V(8); PG8_WAIT_L(0); PG8_BAR; PG8_MMA(1, 0, At, B0); PG8_MMA(1, 1, At, B1); PG8_BAR; PG8_SCHED;
            } else {
            PG8_LDB(B0, 0, 0); PG8_SCHED; PG8_LDA(At, 0, 0); PG8_STAGE(PG8_SA(1, 1), a1 + hstepA, voffA);
            PG8_WAIT_L(8); PG8_BAR; PG8_WAIT_L(0); PG8_MMA(0, 0, At, B0); PG8_BAR; PG8_SCHED;
            PG8_LDB(B1, 0, 1); PG8_STAGE(PG8_SB(0, 0), b2, voffB);
            PG8_BAR; PG8_WAIT_L(0); PG8_MMA(0, 1, At, B1); PG8_BAR;
            PG8_LDA(At, 0, 1); PG8_STAGE(PG8_SA(0, 0), a2, voffA);
            PG8_BAR; PG8_WAIT_L(0); PG8_MMA(1, 0, At, B0); PG8_BAR; PG8_SCHED;
            PG8_STAGE(PG8_SB(0, 1), b2 + hstepB, voffB);
            PG8_WAIT_V(6); PG8_BAR; PG8_MMA(1, 1, At, B1); PG8_BAR;
            PG8_LDB(B0, 1, 0); PG8_SCHED; PG8_LDA(At, 1, 0); PG8_STAGE(PG8_SA(0, 1), a2 + hstepA, voffA);
            PG8_WAIT_L(8); PG8_BAR; PG8_WAIT_L(0); PG8_MMA(0, 0, At, B0); PG8_BAR; PG8_SCHED;
            PG8_LDB(B1, 1, 1); PG8_STAGE(PG8_SB(1, 0), b3, voffB);
            PG8_BAR; PG8_WAIT_L(0); PG8_MMA(0, 1, At, B1); PG8_BAR;
            PG8_LDA(At, 1, 1); PG8_STAGE(PG8_SA(1, 0), a3, voffA);
            PG8_BAR; PG8_WAIT_L(0); PG8_MMA(1, 0, At, B0); PG8_BAR; PG8_SCHED;
            PG8_STAGE(PG8_SB(1, 1), b3 + hstepB, voffB);
            PG8_WAIT_V(6); PG8_BAR; PG8_MMA(1, 1, At, B1); PG8_BAR;
            }
        }
        if constexpr (ALIGN_EPI) { if (wr == 0) PG8_BAR; }
        if constexpr (!Epi::AFTER_DRAIN) { E(acc, cur, wr, wc, fr, fq); S.done(cur); }
        if (!has_next) break;
#pragma unroll
        for (int a = 0; a < 2; ++a)
#pragma unroll
            for (int b = 0; b < 2; ++b)
#pragma unroll
                for (int m = 0; m < 4; ++m)
#pragma unroll
                    for (int n = 0; n < 2; ++n) acc[a][b][m][n] = (f32x4){0.f, 0.f, 0.f, 0.f};
        cur = nxt; cA = nA; cB = nB; ++ui;
        if constexpr (ALIGN_EPI) { if (wr == 1) PG8_BAR; }
    }
    PG8_WAIT_V(0);
    if constexpr (!ALIGN_EPI) { if (wr == 0) PG8_BAR; }
    PG8_BAR;
    if constexpr (Epi::AFTER_DRAIN) { E.fused(acc, cur, wr, wc, fr, fq, lds, wid, lane); S.done(cur); }
#undef PG8_SA
#undef PG8_SB
#undef PG8_STAGE
#undef PG8_LDA
#undef PG8_LDB
#undef PG8_MMA
#undef PG8_WAIT_V
#undef PG8_WAIT_L
#undef PG8_BAR
#undef PG8_SCHED
}
}
constexpr int NB = 8, T = 4096, D = 1024, M = NB * T, NP = 4352, FF = 4096, LA = 384;
constexpr int C_R = 0, C_K = 512, C_V = 1024, C_QA = 1536, C_KA = 2048, C_VA = 2560, C_QI = 3072, C_KI = 3584, C_WI = 3648, C_P1 = 3656, C_P2 = 3944, C_END = 4232, C_Y = 3656, C_RK = 4168;
#define GAS __attribute__((address_space(1)))
#define LAS __attribute__((address_space(3)))
typedef unsigned short bf16_t;
typedef short bf16x8 __attribute__((ext_vector_type(8)));
typedef float f32x4 __attribute__((ext_vector_type(4)));
typedef float f32x16 __attribute__((ext_vector_type(16)));
typedef unsigned u32x4 __attribute__((ext_vector_type(4)));
typedef unsigned u32x2 __attribute__((ext_vector_type(2)));
typedef short s16x4 __attribute__((ext_vector_type(4)));
#define LDS_WAIT() asm volatile("s_waitcnt lgkmcnt(0)" ::: "memory")
#define VM_WAIT() asm volatile("s_waitcnt vmcnt(0)" ::: "memory")
__device__ __forceinline__ float bfl(unsigned w) { return (float)__builtin_bit_cast(_Float16, (unsigned short)(w & 0xffffu)); }
__device__ __forceinline__ float bfh(unsigned w) { return (float)__builtin_bit_cast(_Float16, (unsigned short)(w >> 16)); }
__device__ __forceinline__ float bf1(bf16_t v) { return (float)__builtin_bit_cast(_Float16, v); }
__device__ __forceinline__ unsigned pkbf(float lo, float hi) { return pg8::cvt_pk_bf16(lo, hi); }
template <int CTRL> __device__ __forceinline__ float dpp_f(float x) { return __builtin_bit_cast(float, __builtin_amdgcn_update_dpp(0, __builtin_bit_cast(int, x), CTRL, 0xf, 0xf, true)); }
__device__ __forceinline__ float allsum8(float x) { x += dpp_f<0xB1>(x); x += dpp_f<0x4E>(x); x += dpp_f<0x141>(x); return x; }
__device__ __forceinline__ float allsum16(float x) { x = allsum8(x); x += dpp_f<0x140>(x); return x; }
template <int CTRL> __device__ __forceinline__ int dpp_i(int x) { return __builtin_amdgcn_update_dpp(0, x, CTRL, 0xf, 0xf, true); }
__device__ __forceinline__ int wave_sum_i(int x) {
    x += dpp_i<0xB1>(x); x += dpp_i<0x4E>(x); x += dpp_i<0x141>(x); x += dpp_i<0x140>(x);
    return __builtin_amdgcn_readlane(x, 0) + __builtin_amdgcn_readlane(x, 16) + __builtin_amdgcn_readlane(x, 32) + __builtin_amdgcn_readlane(x, 48); }
__device__ __forceinline__ unsigned wave_max_u(unsigned x) {
    x = max(x, (unsigned)dpp_i<0xB1>((int)x)); x = max(x, (unsigned)dpp_i<0x4E>((int)x)); x = max(x, (unsigned)dpp_i<0x141>((int)x)); x = max(x, (unsigned)dpp_i<0x140>((int)x));
    return max(max((unsigned)__builtin_amdgcn_readlane((int)x, 0), (unsigned)__builtin_amdgcn_readlane((int)x, 16)), max((unsigned)__builtin_amdgcn_readlane((int)x, 32), (unsigned)__builtin_amdgcn_readlane((int)x, 48))); }
__device__ __forceinline__ unsigned wave_min_u(unsigned x) { return ~wave_max_u(~x); }
__device__ __forceinline__ float wave_sum(float v) {
    v += dpp_f<0xB1>(v); v += dpp_f<0x4E>(v); v += dpp_f<0x141>(v); v += dpp_f<0x140>(v);
    const float r0 = __builtin_bit_cast(float, __builtin_amdgcn_readlane(__builtin_bit_cast(int, v), 0)), r1 = __builtin_bit_cast(float, __builtin_amdgcn_readlane(__builtin_bit_cast(int, v), 16)),
                r2 = __builtin_bit_cast(float, __builtin_amdgcn_readlane(__builtin_bit_cast(int, v), 32)), r3 = __builtin_bit_cast(float, __builtin_amdgcn_readlane(__builtin_bit_cast(int, v), 48));
    return (r0 + r1) + (r2 + r3);
}

namespace att {
__device__ __forceinline__ int crow(int r, int hi) { return (r & 3) + 8 * (r >> 2) + 4 * hi; }
#define SBAR() __builtin_amdgcn_sched_barrier(0)
__device__ __forceinline__ void glds16(const void* gsrc, unsigned lds_dst) { unsigned keep;
    asm volatile("s_mov_b32 %0, m0\n\ts_mov_b32 m0, %2\n\ts_nop 0\n\tglobal_load_lds_dwordx4 %1, off\n\ts_mov_b32 m0, %0" : "=&s"(keep) : "v"(gsrc), "s"(lds_dst) : "memory"); }
typedef LAS const char* lds_cptr;
__device__ __forceinline__ void qkt(f32x16& p0, f32x16& p1, lds_cptr kb, const bf16x8* qr, const f32x16& z) {
#pragma unroll
    for (int d0 = 0; d0 < 4; ++d0) {
        const bf16x8 b0 = *(const LAS bf16x8*)(kb + d0 * 2048);
        const bf16x8 b1 = *(const LAS bf16x8*)(kb + d0 * 2048 + 512);
        if (d0 == 0) { p0 = __builtin_amdgcn_mfma_f32_32x32x16_f16(__builtin_bit_cast(pg8::half8, b0), __builtin_bit_cast(pg8::half8, qr[0]), z, 0, 0, 0); p1 = __builtin_amdgcn_mfma_f32_32x32x16_f16(__builtin_bit_cast(pg8::half8, b1), __builtin_bit_cast(pg8::half8, qr[0]), z, 0, 0, 0); }
        else { p0 = __builtin_amdgcn_mfma_f32_32x32x16_f16(__builtin_bit_cast(pg8::half8, b0), __builtin_bit_cast(pg8::half8, qr[d0]), p0, 0, 0, 0); p1 = __builtin_amdgcn_mfma_f32_32x32x16_f16(__builtin_bit_cast(pg8::half8, b1), __builtin_bit_cast(pg8::half8, qr[d0]), p1, 0, 0, 0); } }
}
__device__ __forceinline__ void pv(f32x16* o, int vb, bf16x8 pa0, bf16x8 pa1, bf16x8 pa2, bf16x8 pa3) {
#pragma unroll
    for (int d0 = 0; d0 < 2; ++d0) { s16x4 lo[4], hi[4];
#pragma unroll
        for (int ks = 0; ks < 4; ++ks) {
            asm volatile("ds_read_b64_tr_b16 %0,%1 offset:%c2" : "=&v"(lo[ks]) : "v"(vb), "i"(d0 * 4096 + ks * 1024) : "memory");
            asm volatile("ds_read_b64_tr_b16 %0,%1 offset:%c2" : "=&v"(hi[ks]) : "v"(vb), "i"(d0 * 4096 + ks * 1024 + 512) : "memory"); }
        asm volatile("s_waitcnt lgkmcnt(0)" ::: "memory"); SBAR();
#define PK(k) (bf16x8){lo[k][0], lo[k][1], lo[k][2], lo[k][3], hi[k][0], hi[k][1], hi[k][2], hi[k][3]}
        o[d0] = __builtin_amdgcn_mfma_f32_32x32x16_f16(__builtin_bit_cast(pg8::half8, pa0), __builtin_bit_cast(pg8::half8, PK(0)), o[d0], 0, 0, 0);
        o[d0] = __builtin_amdgcn_mfma_f32_32x32x16_f16(__builtin_bit_cast(pg8::half8, pa1), __builtin_bit_cast(pg8::half8, PK(1)), o[d0], 0, 0, 0);
        o[d0] = __builtin_amdgcn_mfma_f32_32x32x16_f16(__builtin_bit_cast(pg8::half8, pa2), __builtin_bit_cast(pg8::half8, PK(2)), o[d0], 0, 0, 0);
        o[d0] = __builtin_amdgcn_mfma_f32_32x32x16_f16(__builtin_bit_cast(pg8::half8, pa3), __builtin_bit_cast(pg8::half8, PK(3)), o[d0], 0, 0, 0);
#undef PK
    }
}
constexpr int SLOTB = 8192;
constexpr int L_K = 0, L_V = 3 * SLOTB, L_WS = 7 * SLOTB, L_OST = L_WS + 8 * 64 * 4, L_BT = L_OST + 8 * 8192, L_END = L_BT + 8 * 129 * 4;
constexpr float C2 = 0.125f * 1.4426950408889634f;

__device__ __forceinline__ int t5_bucket(int n) {
    if (n < 16) return n;
    const int thr[15] = {19, 21, 24, 27, 31, 35, 40, 46, 52, 59, 67, 77, 87, 99, 113};
    int b = 16;
#pragma unroll
    for (int i = 0; i < 15; ++i) b += (n >= thr[i]) ? 1 : 0;
    return b;
}
__device__ __forceinline__ void build_bias_table(const float* rel_bias, LAS char* shm, int tid) {
    LAS float* BT = (LAS float*)(shm + L_BT);
    for (int i = tid; i < 8 * 129; i += 512) { const int h = i / 129, d = i % 129;
        BT[i] = (d >= 128) ? 0.f : (rel_bias[t5_bucket(d) * 8 + h] - rel_bias[31 * 8 + h]) * 1.4426950408889634f; }
}

__device__ __forceinline__ void attn_unit(int b, int h, int qb, const bf16_t* PROJ, const unsigned long long* MASK, bf16_t* MIX, const float* gain, LAS char* shm, const int tid) {
    const int lane = tid & 63, r32 = lane & 31, hi = lane >> 5; const int wid = __builtin_amdgcn_readfirstlane(tid >> 6);
    const long rowbase = (long)b * T; const int q0 = qb * 256;
    const bf16_t* Qw = PROJ + (rowbase + q0 + wid * 32) * NP + C_QA + h * 64;
    const bf16_t* Kh = PROJ + rowbase * NP + C_KA + h * 64; const bf16_t* Vh = PROJ + rowbase * NP + C_VA + h * 64;
    const unsigned lds0 = (unsigned)(uintptr_t)shm;
    LAS float* wsf = (LAS float*)(shm + L_WS) + wid * 64;
    const LAS float* BT = (const LAS float*)(shm + L_BT) + h * 129;
    const bf16_t* ksrc = Kh + (long)lane * NP + wid * 8;
    const bf16_t* vsrc = Vh + (long)(16 * (wid & 3) + (lane >> 2)) * NP + (wid >> 2) * 32 + (lane & 3) * 8;
    const unsigned kdst = lds0 + L_K + wid * 1024, vdst = lds0 + L_V + wid * 1024;
#define DMA_K(t, slot) glds16(ksrc + (long)(t) * 64 * NP, (unsigned)__builtin_amdgcn_readfirstlane(kdst + (slot)))
#define DMA_V(t, slot) glds16(vsrc + (long)(t) * 64 * NP, (unsigned)__builtin_amdgcn_readfirstlane(vdst + (slot)))
    const int vb0 = (int)(lds0 + L_V) + ((lane >> 4) & 1) * 32 + (lane & 3) * 8 + (4 * hi + ((lane & 15) >> 2)) * 64;
    const lds_cptr kp0 = (lds_cptr)shm + L_K + hi * 1024 + r32 * 16;
    const int NT = (q0 + 256) / 64;
    const int qabs = q0 + wid * 32 + r32;
    const unsigned long long* mp = MASK + ((size_t)b * 4096 + qabs) * 64;
    unsigned long long mw_next = 0ull;
#define MASK_LD(t) asm volatile("global_load_dwordx2 %0, %1, off" : "+v"(mw_next) : "v"(mp + (t)) : "memory")
    MASK_LD(0); DMA_K(0, 0); DMA_V(0, 0); DMA_K(1, SLOTB); DMA_V(1, SLOTB);
    bf16x8 qr[4];
#pragma unroll
    for (int d0 = 0; d0 < 4; ++d0) qr[d0] = *(const bf16x8*)(Qw + (long)r32 * NP + d0 * 16 + hi * 8);
    float m_run = 0.f, l_run = 0.f; f32x16 o[2]; o[0] = f32x16{}; o[1] = f32x16{}; f32x16 negm = f32x16{}; asm volatile("" : "+v"(negm));
    int slot = 0, slot2 = 2 * SLOTB;
    int vs = 0, vsp = 3 * SLOTB, vs2 = 2 * SLOTB;
    u32x4 pw0 = {0u, 0u, 0u, 0u}, pw1 = pw0, pw2 = pw0, pw3 = pw0;
    for (int t = 0; t < NT; ++t) {
        if (t + 1 < NT) asm volatile("s_waitcnt vmcnt(2) lgkmcnt(0)\n\ts_barrier" : "+v"(mw_next) :: "memory");
        else asm volatile("s_waitcnt vmcnt(0) lgkmcnt(0)\n\ts_barrier" : "+v"(mw_next) :: "memory");
        const unsigned long long mw = mw_next;
        asm volatile("" : "+v"(mw_next));
        if (t + 1 < NT) MASK_LD(t + 1);
        if (t + 2 < NT) { DMA_K(t + 2, slot2); DMA_V(t + 2, vs2); }
        f32x16 p0, p1; qkt(p0, p1, kp0 + slot, qr, negm);
        if (t > 0) pv(o, vb0 + vsp, __builtin_bit_cast(bf16x8, pw0), __builtin_bit_cast(bf16x8, pw1), __builtin_bit_cast(bf16x8, pw2), __builtin_bit_cast(bf16x8, pw3));
        if (64 * t + 191 > q0 + 32 * wid) {
#pragma unroll
            for (int r = 0; r < 16; ++r) { const int d0_ = qabs - (64 * t + crow(r, hi));
                const int i0 = d0_ < 0 ? 0 : (d0_ > 128 ? 128 : d0_); const int d1_ = d0_ - 32; const int i1 = d1_ < 0 ? 0 : (d1_ > 128 ? 128 : d1_);
                p0[r] += BT[i0]; p1[r] += BT[i1]; }
        }
        { const int mlo = (int)((unsigned)mw >> (4 * hi)), mhi = (int)((unsigned)(mw >> 32) >> (4 * hi)); const int NEGB = (int)0xff800000u;
#pragma unroll
          for (int r = 0; r < 16; ++r) { const int bit = (r & 3) + 8 * (r >> 2);
              const int t0 = __builtin_amdgcn_sbfe(mlo, bit, 1), t1 = __builtin_amdgcn_sbfe(mhi, bit, 1);
              { const float x0 = p0[r]; p0[r] = __int_as_float((__float_as_int(x0) & t0) | (NEGB & ~t0)); }
              { const float x1 = p1[r]; p1[r] = __int_as_float((__float_as_int(x1) & t1) | (NEGB & ~t1)); } } }
        float rm;
        { float a = __builtin_fmaxf(__builtin_fmaxf(p0[0], p0[1]), p1[0]), b2 = __builtin_fmaxf(__builtin_fmaxf(p0[2], p0[3]), p1[1]); a = __builtin_fmaxf(__builtin_fmaxf(a, p1[2]), p1[3]);
#pragma unroll
          for (int r = 4; r < 16; r += 4) { a = __builtin_fmaxf(__builtin_fmaxf(a, p0[r]), p0[r + 1]); b2 = __builtin_fmaxf(__builtin_fmaxf(b2, p0[r + 2]), p0[r + 3]); a = __builtin_fmaxf(__builtin_fmaxf(a, p1[r]), p1[r + 1]); b2 = __builtin_fmaxf(__builtin_fmaxf(b2, p1[r + 2]), p1[r + 3]); }
          rm = __builtin_fmaxf(a, b2); }
        { auto rr = __builtin_amdgcn_permlane32_swap(__float_as_uint(rm), __float_as_uint(rm), false, false); rm = fmaxf(__uint_as_float(rr[0]), __uint_as_float(rr[1])); }
        const float dl = (t == 0) ? ((rm == -INFINITY) ? 0.f : rm) : fmaxf(rm, 0.f);
        if (__ballot(dl != 0.f)) {
            m_run += dl;
#pragma unroll
            for (int r = 0; r < 16; ++r) { p0[r] -= dl; p1[r] -= dl; }
            const float f = __builtin_amdgcn_exp2f(-dl); l_run *= f;
#pragma unroll
            for (int r = 0; r < 16; ++r) negm[r] = -m_run;
            asm volatile("" : "+v"(negm));
            if (hi == 0) wsf[r32] = f;
            LDS_WAIT();
#pragma unroll
            for (int r = 0; r < 16; ++r) { const float fr_ = wsf[crow(r, hi)]; o[0][r] *= fr_; o[1][r] *= fr_; }
        }
        float sacc = 0.f;
#pragma unroll
        for (int r = 0; r < 16; ++r) { p0[r] = __builtin_amdgcn_exp2f(p0[r]); p1[r] = __builtin_amdgcn_exp2f(p1[r]); sacc += p0[r] + p1[r]; }
        l_run += sacc;
#define PKW(P, B) __builtin_bit_cast(unsigned, __builtin_amdgcn_cvt_pkrtz(P[B], P[B + 1]))
        pw0 = (u32x4){PKW(p0, 0), PKW(p0, 2), PKW(p0, 4), PKW(p0, 6)}; pw1 = (u32x4){PKW(p0, 8), PKW(p0, 10), PKW(p0, 12), PKW(p0, 14)};
        pw2 = (u32x4){PKW(p1, 0), PKW(p1, 2), PKW(p1, 4), PKW(p1, 6)}; pw3 = (u32x4){PKW(p1, 8), PKW(p1, 10), PKW(p1, 12), PKW(p1, 14)};
#undef PKW
        { const int old_ = slot; slot = (slot == 2 * SLOTB) ? 0 : slot + SLOTB; slot2 = old_; }
        { vsp = vs; vs = (vs == 3 * SLOTB) ? 0 : vs + SLOTB; vs2 = (vs2 == 3 * SLOTB) ? 0 : vs2 + SLOTB; }
    }
    LDS_WAIT(); SBAR();
    pv(o, vb0 + vsp, __builtin_bit_cast(bf16x8, pw0), __builtin_bit_cast(bf16x8, pw1), __builtin_bit_cast(bf16x8, pw2), __builtin_bit_cast(bf16x8, pw3));
    { auto rr = __builtin_amdgcn_permlane32_swap(__float_as_uint(l_run), __float_as_uint(l_run), false, false); l_run = __uint_as_float(rr[0]) + __uint_as_float(rr[1]); }
    LDS_WAIT();
    if (hi == 0) wsf[32 + r32] = l_run;
    LDS_WAIT();
    LAS float* stg = (LAS float*)(shm + L_OST) + wid * 2048;
#pragma unroll
    for (int r = 0; r < 16; ++r) { const int orow = crow(r, hi); const float rl = 1.0f / wsf[32 + orow];
#pragma unroll
        for (int d0 = 0; d0 < 2; ++d0) stg[orow * 64 + d0 * 32 + r32] = o[d0][r] * rl; }
    LDS_WAIT();
    bf16_t* Ow = MIX + (rowbase + q0 + wid * 32) * 1024 + 512 + h * 64;
#pragma unroll
    for (int i = 0; i < 4; ++i) { const int row = i * 8 + (lane >> 3), ch = lane & 7;
        const f32x4 a = *(const LAS f32x4*)(stg + row * 64 + ch * 8), c = *(const LAS f32x4*)(stg + row * 64 + ch * 8 + 4);
        float ss = (a[0] * a[0] + a[1] * a[1]) + (a[2] * a[2] + a[3] * a[3]) + (c[0] * c[0] + c[1] * c[1]) + (c[2] * c[2] + c[3] * c[3]);
        ss = allsum8(ss);
        const float rs = rsqrtf(ss * (1.0f / 64.0f) + 1e-6f);
        const f32x4 g0 = *(const f32x4*)(gain + h * 64 + ch * 8), g1 = *(const f32x4*)(gain + h * 64 + ch * 8 + 4);
        u32x4 w; w.x = pkbf(a[0] * rs * g0[0], a[1] * rs * g0[1]); w.y = pkbf(a[2] * rs * g0[2], a[3] * rs * g0[3]); w.z = pkbf(c[0] * rs * g1[0], c[1] * rs * g1[1]); w.w = pkbf(c[2] * rs * g1[2], c[3] * rs * g1[3]);
        *(u32x4*)(Ow + (long)row * 1024 + ch * 8) = w; }
    asm volatile("s_waitcnt lgkmcnt(0)\n\ts_barrier" ::: "memory");
#undef DMA_K
#undef DMA_V
#undef MASK_LD
}
#undef SBAR
}

#define GAS __attribute__((address_space(1)))
#define LAS __attribute__((address_space(3)))
typedef unsigned short bf16;
typedef unsigned v4u __attribute__((ext_vector_type(4)));
typedef float f32x4 __attribute__((ext_vector_type(4)));
typedef short bf16x8 __attribute__((ext_vector_type(8)));
typedef GAS unsigned gu32;
typedef GAS unsigned long long gu64;
#define RLX_AGENT __ATOMIC_RELAXED, __HIP_MEMORY_SCOPE_AGENT
#define LDS_WAIT() asm volatile("s_waitcnt lgkmcnt(0)" ::: "memory")
#define VM_WAIT() asm volatile("s_waitcnt vmcnt(0)" ::: "memory")
__device__ __forceinline__ unsigned long long rt() { return __builtin_amdgcn_s_memrealtime(); }
__device__ __forceinline__ unsigned f2bf(float f) { unsigned u = __builtin_bit_cast(unsigned, f); return (u + 0x7fffu + ((u >> 16) & 1u)) >> 16; }
__device__ __forceinline__ unsigned pk2(float lo, float hi) { return f2bf(lo) | (f2bf(hi) << 16); }

#define XB_TMO      128
#define XB_XCNT(j)  (256  + 64 * (j))
#define XB_XSUB(j)  (1280 + 64 * (j))
#define XB_XGEN(j)  (2304 + 64 * (j))
#define XB_TOP      3328
#define XB_TOPGEN   3392
#define XCD_BAR_WORDS 3456
#define XB_SPIN_CAP (1u << 22)

__device__ __forceinline__ unsigned xb_ld(unsigned* p)              { return __hip_atomic_load(p, __ATOMIC_RELAXED, __HIP_MEMORY_SCOPE_AGENT); }
__device__ __forceinline__ unsigned xb_add(unsigned* p, unsigned v) { return __hip_atomic_fetch_add(p, v, __ATOMIC_RELAXED, __HIP_MEMORY_SCOPE_AGENT); }
__device__ __forceinline__ unsigned xb_xcc_id() { return (unsigned)__builtin_amdgcn_s_getreg((3 << 11) | 20) & 0xFu; }
#define XB_SPIN(cond, bar) do { unsigned _sp = 0; while (cond) { __builtin_amdgcn_s_sleep(1); \
    if ((++_sp & 255u) == 0u) { if (xb_ld(&(bar)[XB_TMO])) break; if (_sp > XB_SPIN_CAP) { atomicAdd(&(bar)[XB_TMO], 1u); break; } } } } while (0)

struct XcdBarrier {
    unsigned* bar; unsigned x;
    volatile LAS unsigned* st;
};

__device__ __forceinline__ XcdBarrier xcd_barrier_post(unsigned* bar, volatile LAS unsigned* st) {
    XcdBarrier b; b.bar = bar; b.x = xb_xcc_id(); b.st = st;
    if (threadIdx.x == 0) (void)xb_add(&bar[XB_XCNT(b.x)], 1u);
    return b;
}
__device__ __forceinline__ void xcd_barrier_complete(unsigned* bar, unsigned x, unsigned& nloc, unsigned& nx) {
    const unsigned G = gridDim.x * gridDim.y * gridDim.z;
    unsigned sum, cnt, mine, sp = 0u;
    for (;;) {
        sum = 0u; cnt = 0u; mine = 0u;
#pragma unroll
        for (unsigned j = 0; j < 16; ++j) { const unsigned c = xb_ld(&bar[XB_XCNT(j)]); sum += c; cnt += (c > 0u) ? 1u : 0u; mine = (j == x) ? c : mine; }
        if (sum == G) break;
        __builtin_amdgcn_s_sleep(1);
        if ((++sp & 255u) == 0u) { if (xb_ld(&bar[XB_TMO])) break; if (sp > XB_SPIN_CAP) { atomicAdd(&bar[XB_TMO], 1u); break; } }
    }
    nloc = mine > 0u ? mine : 1u; nx = cnt > 0u ? cnt : 1u;
}

__device__ __forceinline__ void xcd_barrier(const XcdBarrier& b) {
    asm volatile("s_waitcnt vmcnt(0)" ::: "memory");
    __syncthreads();
    if (threadIdx.x == 0) {
        unsigned* bar = b.bar;
        __builtin_amdgcn_s_waitcnt(0);
        unsigned nloc = b.st[0], nx = b.st[1];
        if (nloc == 0u) { xcd_barrier_complete(bar, b.x, nloc, nx); b.st[0] = nloc; b.st[1] = nx; }
        const unsigned old = xb_add(&bar[XB_XSUB(b.x)], 1u);
        const unsigned gen = old / nloc;
        if (old + 1u == (gen + 1u) * nloc) {
            __builtin_amdgcn_fence(__ATOMIC_RELEASE, "agent");
            asm volatile("s_waitcnt vmcnt(0)" ::: "memory");
            const unsigned og = xb_add(&bar[XB_TOP], 1u);
            const unsigned tg = og / nx;
            if (og + 1u == (tg + 1u) * nx) xb_add(&bar[XB_TOPGEN], 1u);
            else XB_SPIN(xb_ld(&bar[XB_TOPGEN]) == tg, bar);
            __builtin_amdgcn_fence(__ATOMIC_ACQUIRE, "agent");
            xb_add(&bar[XB_XGEN(b.x)], 1u);
            asm volatile("s_waitcnt vmcnt(0)" ::: "memory");
        } else {
            XB_SPIN(xb_ld(&bar[XB_XGEN(b.x)]) == gen, bar);
            __builtin_amdgcn_fence(__ATOMIC_ACQUIRE, "agent");
            asm volatile("s_waitcnt vmcnt(0)" ::: "memory");
        }
    }
    __syncthreads();
}
constexpr size_t MiB = 1u << 20;
constexpr size_t WS_CTL = 0, CTL_ZERO_BYTES = 1 * MiB;
constexpr size_t WS_MOD = 1 * MiB;
constexpr size_t WS_LW = 2 * MiB;
constexpr size_t WS_WIN = 3 * MiB, WS_WOUT = 12 * MiB, WS_W1 = 14 * MiB, WS_W2 = 22 * MiB;
constexpr size_t WS_LACT = 30 * MiB;
constexpr size_t WS_MASK = 54 * MiB;
constexpr size_t WS_VF = 70 * MiB;
constexpr size_t WS_H = 102 * MiB;
constexpr size_t WS_MIX = 166 * MiB;
constexpr size_t WS_PROJ = 230 * MiB;
constexpr size_t WS_END = 502 * MiB;
static_assert(WS_WIN + (size_t)NP * D * 2 <= WS_WOUT && WS_W2 + (size_t)D * FF * 2 <= WS_LACT && WS_LACT + (size_t)M * LA * 2 <= WS_MASK && WS_MASK + (size_t)NB * 64 * 4096 * 8 <= WS_VF &&
              WS_VF + (size_t)M * 512 * 2 <= WS_H && WS_H + (size_t)M * D * 2 <= WS_MIX && WS_MIX + (size_t)M * D * 2 <= WS_PROJ && WS_PROJ + (size_t)M * NP * 2 <= WS_END, "d_ws map");
constexpr int CW_BAR = 4096;
constexpr int RING_BYTES = 131072, HIST_OFF = 131072, LDSCTL_OFF = 131072 + 8192, MISC_OFF = LDSCTL_OFF + 320, LDS_BYTES = 147456;
static_assert(att::L_END <= RING_BYTES && MISC_OFF + 128 <= LDS_BYTES, "LDS map");
constexpr int NWAVES = 8;

__device__ __forceinline__ void ph_mod(const float* c, const float* w_ada, const float* b_ada, float* MOD, LAS unsigned char* lds, int vcu, int G, int tid) {
    LAS float* ca = (LAS float*)lds; LAS float* part = (LAS float*)(lds + 32768);
    for (int i = tid; i < NB * D; i += 512) { const float v = c[i]; ca[i] = v / (1.f + __expf(-v)); }
    __syncthreads();
    const int wave = tid >> 6, lane = tid & 63;
    for (int task = vcu; task < 192; task += G) {
        const int l = task / 96, j0 = (task % 96) * 64;
        float acc[8];
#pragma unroll
        for (int b = 0; b < 8; ++b) acc[b] = 0.f;
        const float* wp = w_ada + ((size_t)l * D + wave * 128) * 6144 + j0 + lane;
#pragma unroll 8
        for (int k = 0; k < 128; ++k) { const float w = wp[(size_t)k * 6144];
#pragma unroll
            for (int b = 0; b < 8; ++b) acc[b] += ca[b * D + wave * 128 + k] * w; }
#pragma unroll
        for (int b = 0; b < 8; ++b) part[(wave * 8 + b) * 64 + lane] = acc[b];
        __syncthreads();
        { float s = 0.f;
#pragma unroll
          for (int w = 0; w < 8; ++w) s += part[(w * 8 + wave) * 64 + lane];
          MOD[((size_t)l * 8 + wave) * 6144 + j0 + lane] = s + b_ada[l * 6144 + j0 + lane]; }
        __syncthreads();
    }
}

__device__ __forceinline__ void tr_item(const float* W, int ldw, int nvalid, int K, bf16_t* WT, int row_off, LAS float* scr, int kb, int nb, int lane, const float* mu, int mode) {
    const int k0 = 64 * kb, n0 = 32 * nb; const int n = n0 + (lane & 31);
#pragma unroll 8
    for (int i = 0; i < 32; ++i) { const int kk = 2 * i + (lane >> 5); float v = (n < nvalid) ? W[(size_t)(k0 + kk) * ldw + n] : 0.f;
        if (mode) { const float m = mu[k0 + kk]; v *= (mode == 1) ? (1.f - m) : m; }
        scr[kk * 33 + (lane & 31)] = v; }
    LDS_WAIT(); asm volatile("" ::: "memory");
    const int c = lane & 7;
#pragma unroll
    for (int j = 0; j < 4; ++j) { const int nn = (lane >> 3) + 8 * j; const LAS float* s = scr + (8 * c) * 33 + nn;
        u32x4 o; o.x = pkbf(s[0 * 33], s[1 * 33]); o.y = pkbf(s[2 * 33], s[3 * 33]); o.z = pkbf(s[4 * 33], s[5 * 33]); o.w = pkbf(s[6 * 33], s[7 * 33]);
        if (n0 + nn < nvalid) *(u32x4*)(WT + (size_t)(row_off + n0 + nn) * K + k0 + 8 * c) = o; }
    LDS_WAIT(); asm volatile("" ::: "memory");
}
struct WPtrs { const float *w_in, *decay_a, *iclr_a, *gate_a, *vres_a, *mu_lora, *vres_mu, *w_out, *w1, *w2, *decay_b, *iclr_b, *gate_b, *vres_b; };
__device__ __forceinline__ void ph_weights(const WPtrs& P, int l, unsigned char* ws, LAS unsigned char* lds, int vcu, int G, int tid) {
    const int wave = tid >> 6, lane = tid & 63; const int gw = vcu * NWAVES + wave, NGW = G * NWAVES;
    LAS float* scr = (LAS float*)(lds + wave * 16384);
    bf16_t* WIN = (bf16_t*)(ws + WS_WIN); bf16_t* WOUT = (bf16_t*)(ws + WS_WOUT); bf16_t* W1 = (bf16_t*)(ws + WS_W1); bf16_t* W2 = (bf16_t*)(ws + WS_W2);
    constexpr int I_IN = 16 * 115, I_D = 16 * 2, I_G = 16 * 4, I_V = 16 * 1, I_O = 16 * 32, I_1 = 16 * 128, I_2 = 64 * 32;
    constexpr int I_LO = 2 * I_D + I_G + I_V; constexpr int NITEMS = I_IN + 2 * I_LO + I_O + I_1 + I_2;
    for (int it = gw; it < NITEMS; it += NGW) {
        int r = it;
        if (r < I_IN) { tr_item(P.w_in + (size_t)l * D * 3656, 3656, 3656, D, WIN, 0, scr, r / 115, r % 115, lane, nullptr, 0); continue; } r -= I_IN;
        if (r < 2 * I_LO) { const int md = (r < I_LO) ? 1 : 2; int q = (r < I_LO) ? r : r - I_LO; const int rbase = (md == 1) ? C_P1 : C_P2;
            if (q < I_D) { tr_item(P.decay_a + (size_t)l * D * 64, 64, 64, D, WIN, rbase + 0, scr, q / 2, q % 2, lane, P.mu_lora + (size_t)(l * 3 + 0) * D, md); continue; } q -= I_D;
            if (q < I_D) { tr_item(P.iclr_a + (size_t)l * D * 64, 64, 64, D, WIN, rbase + 64, scr, q / 2, q % 2, lane, P.mu_lora + (size_t)(l * 3 + 1) * D, md); continue; } q -= I_D;
            if (q < I_G) { tr_item(P.gate_a + (size_t)l * D * 128, 128, 128, D, WIN, rbase + 128, scr, q / 4, q % 4, lane, P.mu_lora + (size_t)(l * 3 + 2) * D, md); continue; } q -= I_G;
            if (l >= 1) tr_item(P.vres_a + (size_t)(l - 1) * D * 32, 32, 32, D, WIN, rbase + 256, scr, q, 0, lane, P.vres_mu + (size_t)(l - 1) * D, md);
            continue; }
        r -= 2 * I_LO;
        if (r < I_O) { tr_item(P.w_out + (size_t)l * D * D, D, D, D, WOUT, 0, scr, r / 32, r % 32, lane, nullptr, 0); continue; } r -= I_O;
        if (r < I_1) { tr_item(P.w1 + (size_t)l * D * FF, FF, FF, D, W1, 0, scr, r / 128, r % 128, lane, nullptr, 0); continue; } r -= I_1;
        tr_item(P.w2 + (size_t)l * FF * D, D, D, FF, W2, 0, scr, r / 32, r % 32, lane, nullptr, 0);
    }
    const int gt = vcu * 512 + tid, NGT = G * 512;
    { const int nzr = (NP - C_END) + (l == 0 ? 64 : 0);
      for (int i = gt; i < nzr * 128; i += NGT) { const int zr = i >> 7, ch = i & 127; int row;
          if (zr < NP - C_END) row = C_END + zr; else { const int z2 = zr - (NP - C_END); row = (z2 < 32) ? (C_P1 + 256 + z2) : (C_P2 + 256 + z2 - 32); }
          *(u32x4*)(WIN + (size_t)row * D + ch * 8) = (u32x4){0u, 0u, 0u, 0u}; } }
    { bf16_t* LW = (bf16_t*)(ws + WS_LW);
      for (int i = gt; i < 2048 * 128; i += NGT) { const int n = i >> 7, k = i & 127; float v = 0.f;
          if (n < 512) { if (k < 64) v = P.decay_b[((size_t)l * 64 + k) * 512 + n]; }
          else if (n < 1024) { if (k >= 64) v = P.iclr_b[((size_t)l * 64 + (k - 64)) * 512 + (n - 512)]; }
          else if (n < 1536) { v = P.gate_b[((size_t)l * 128 + k) * 512 + (n - 1024)]; }
          else { if (l >= 1 && k < 32) v = P.vres_b[((size_t)(l - 1) * 32 + k) * 512 + (n - 1536)]; }
          LW[i] = (bf16_t)(pkbf(v, 0.f) & 0xffffu); } }
}

__device__ __forceinline__ void ph_norm(const float* X, const float* g, const float* sh, const float* sc, bf16_t* Hout, int gw, int NGW, int lane) {
    for (int m0 = gw; m0 < M; m0 += 2 * NGW) {
        f32x4 v[2][4]; float s[2] = {0.f, 0.f};
#pragma unroll
        for (int q = 0; q < 2; ++q) { const f32x4* xr = (const f32x4*)(X + (size_t)(m0 + q * NGW) * D) + lane;
#pragma unroll
            for (int j = 0; j < 4; ++j) v[q][j] = xr[64 * j]; }
#pragma unroll
        for (int q = 0; q < 2; ++q)
#pragma unroll
            for (int j = 0; j < 4; ++j) s[q] += (v[q][j][0] * v[q][j][0] + v[q][j][1] * v[q][j][1]) + (v[q][j][2] * v[q][j][2] + v[q][j][3] * v[q][j][3]);
#pragma unroll
        for (int q = 0; q < 2; ++q) { const int m = m0 + q * NGW; const int b = m >> 12;
            const float rstd = rsqrtf(wave_sum(s[q]) * (1.f / D) + 1e-6f);
            u32x2* o8 = (u32x2*)(Hout + (size_t)m * D) + lane;
#pragma unroll
            for (int j = 0; j < 4; ++j) { const int c = 256 * j + 4 * lane;
                const f32x4 gv = *(const f32x4*)(g + c), sv = *(const f32x4*)(sc + (size_t)b * 6144 + c), hv = *(const f32x4*)(sh + (size_t)b * 6144 + c);
                const f32x4 y = v[q][j] * rstd * gv * (sv + 1.f) + hv;
                u32x2 w; w.x = pkbf(y[0], y[1]); w.y = pkbf(y[2], y[3]); o8[64 * j] = w; } } }
}
__device__ __forceinline__ void ph_final_norm(float* X, const float* g, int gw, int NGW, int lane) {
    for (int m = gw; m < M; m += NGW) {
        f32x4* xr = (f32x4*)(X + (size_t)m * D) + lane; f32x4 v[4]; float s = 0.f;
#pragma unroll
        for (int j = 0; j < 4; ++j) { v[j] = xr[64 * j]; s += (v[j][0] * v[j][0] + v[j][1] * v[j][1]) + (v[j][2] * v[j][2] + v[j][3] * v[j][3]); }
        const float rstd = rsqrtf(wave_sum(s) * (1.f / D) + 1e-6f);
#pragma unroll
        for (int j = 0; j < 4; ++j) { const f32x4 gv = *(const f32x4*)(g + 256 * j + 4 * lane); xr[64 * j] = v[j] * rstd * gv; } }
}

__device__ __forceinline__ void ph_lora_act(const bf16_t* PROJ, bf16_t* LACT, bf16_t* VF, const float* mu_v  , bool write_v, int gw, int NGW, int lane) {
    float muv[8];
#pragma unroll
    for (int i = 0; i < 8; ++i) muv[i] = mu_v[lane * 8 + i];
    for (int m = gw; m < M; m += NGW) { const int t = m & (T - 1);
        if (lane < 36) {
            const u32x4 p1 = *(const u32x4*)(PROJ + (size_t)m * NP + C_P1 + lane * 8);
            u32x4 p2 = (u32x4){0u, 0u, 0u, 0u}; if (t > 0) p2 = *(const u32x4*)(PROJ + (size_t)(m - 1) * NP + C_P2 + lane * 8);
            float x[8];
#pragma unroll
            for (int i = 0; i < 4; ++i) { x[2 * i] = bfl(p1[i]) + bfl(p2[i]); x[2 * i + 1] = bfh(p1[i]) + bfh(p2[i]); }
            if (lane < 8) {
#pragma unroll
                for (int i = 0; i < 8; ++i) x[i] = 1.f - 2.f / (__expf(2.f * x[i]) + 1.f);
            } else if (lane >= 16 && lane < 32) {
#pragma unroll
                for (int i = 0; i < 8; ++i) x[i] = 1.f / (1.f + __expf(-x[i]));
            }
            u32x4 w; w.x = pkbf(x[0], x[1]); w.y = pkbf(x[2], x[3]); w.z = pkbf(x[4], x[5]); w.w = pkbf(x[6], x[7]);
            *(u32x4*)(LACT + (size_t)m * LA + lane * 8) = w;
        } else if (lane < 48) { *(u32x4*)(LACT + (size_t)m * LA + lane * 8) = (u32x4){0u, 0u, 0u, 0u}; }
        if (write_v) {
            const u32x4 vc = *(const u32x4*)(PROJ + (size_t)m * NP + C_V + lane * 8);
            u32x4 vp = (u32x4){0u, 0u, 0u, 0u}; if (t > 0) vp = *(const u32x4*)(PROJ + (size_t)(m - 1) * NP + C_V + lane * 8);
            float y[8];
#pragma unroll
            for (int i = 0; i < 4; ++i) { const float c0 = bfl(vc[i]), c1 = bfh(vc[i]); y[2 * i] = c0 + (bfl(vp[i]) - c0) * muv[2 * i]; y[2 * i + 1] = c1 + (bfh(vp[i]) - c1) * muv[2 * i + 1]; }
            u32x4 w; w.x = pkbf(y[0], y[1]); w.y = pkbf(y[2], y[3]); w.z = pkbf(y[4], y[5]); w.w = pkbf(y[6], y[7]);
            *(u32x4*)(VF + (size_t)m * 512 + lane * 8) = w;
        }
    }
}

#ifndef DUP_MASK
#define DUP_MASK 0
#endif
__device__ __forceinline__ unsigned sortable(float s) { const unsigned u = __float_as_uint(s + 0.f); return u ^ ((u >> 31) ? 0xFFFFFFFFu : 0x80000000u); }
__device__ __forceinline__ void ph_select(const bf16_t* PROJ, unsigned long long* MASK, LAS unsigned char* lds, int vcu, int G, int tid) {
    const int lane = tid & 63, wid = __builtin_amdgcn_readfirstlane(tid >> 6), r32 = lane & 31, hi = lane >> 5;
    LAS unsigned* SC = (LAS unsigned*)lds;
    LAS unsigned* HI = (LAS unsigned*)(lds + HIST_OFF) + wid * 256;
    const float WSC = 0.35355339059f * 0.125f;
    bf16x8 AfN[2][4]; u32x4 wN[2][2]; bf16x8 BfN[4];
    const int ql_ = (r32 >> 4) * 2 + ((r32 >> 2) & 1), hd_ = (r32 & 3) + 4 * ((r32 >> 3) & 1);
#define SEL_LOAD(q0_, nblk_, rb_) do { \
        _Pragma("unroll") for (int tq = 0; tq < 2; ++tq) _Pragma("unroll") for (int ks = 0; ks < 4; ++ks) AfN[tq][ks] = *(const bf16x8*)(PROJ + (rb_ + q0_ + tq * 4 + ql_) * NP + C_QI + hd_ * 64 + ks * 16 + hi * 8); \
        _Pragma("unroll") for (int tq = 0; tq < 2; ++tq) _Pragma("unroll") for (int g = 0; g < 2; ++g) wN[tq][g] = *(const u32x4*)(PROJ + (rb_ + q0_ + tq * 4 + 2 * g + hi) * NP + C_WI); \
        if (wid < nblk_) { _Pragma("unroll") for (int ks = 0; ks < 4; ++ks) BfN[ks] = *(const bf16x8*)(PROJ + (rb_ + wid * 32 + r32) * NP + C_KI + ks * 16 + hi * 8); } } while (0)
    if (vcu < NB * 512) { const int bn = vcu & 7, jn = vcu >> 3, basen = jn & 31, rndn = jn >> 5;
        const int q8n = (rndn & 1) ? (32 * rndn + 31 - basen) : (32 * rndn + basen); const int q0n = q8n * 8, nblkn = (q0n >> 5) + 1; const size_t rbn = (size_t)bn * T;
        SEL_LOAD(q0n, nblkn, rbn); }
    for (int it = 0;; ++it) {
        const int tsk = vcu + it * G; if (tsk >= NB * 512) break;
        const int b = tsk & 7, j = tsk >> 3, base = j & 31, rnd = j >> 5;
        const int q8 = (rnd & 1) ? (32 * rnd + 31 - base) : (32 * rnd + base);
        const int q0 = q8 * 8, nblk = (q0 >> 5) + 1; const size_t rb = (size_t)b * T;
        bf16x8 Af[2][4]; float wv[2][16]; bf16x8 Bf[4], Bn[4];
#pragma unroll
        for (int tq = 0; tq < 2; ++tq) {
#pragma unroll
            for (int ks = 0; ks < 4; ++ks) Af[tq][ks] = AfN[tq][ks];
#pragma unroll
            for (int g = 0; g < 2; ++g) { const u32x4 w8 = wN[tq][g];
#pragma unroll
                for (int x = 0; x < 4; ++x) { wv[tq][8 * g + 2 * x] = bfl(w8[x]) * WSC; wv[tq][8 * g + 2 * x + 1] = bfh(w8[x]) * WSC; } } }
#pragma unroll
        for (int ks = 0; ks < 4; ++ks) Bf[ks] = BfN[ks];
        for (int blk = wid; blk < nblk; blk += 8) {
            const int key = blk * 32 + r32;
            if (blk + 8 < nblk) {
#pragma unroll
                for (int ks = 0; ks < 4; ++ks) Bn[ks] = *(const bf16x8*)(PROJ + (rb + key + 256) * NP + C_KI + ks * 16 + hi * 8);
            }
#pragma unroll
            for (int tq = 0; tq < 2; ++tq) { f32x16 acc = {};
#pragma unroll
                for (int ks = 0; ks < 4; ++ks) acc = __builtin_amdgcn_mfma_f32_32x32x16_f16(__builtin_bit_cast(pg8::half8, Af[tq][ks]), __builtin_bit_cast(pg8::half8, Bf[ks]), acc, 0, 0, 0);
#pragma unroll
                for (int g = 0; g < 2; ++g) { float s = 0.f;
#pragma unroll
                    for (int x = 0; x < 8; ++x) s += wv[tq][8 * g + x] * fmaxf(acc[8 * g + x], 0.f);
                    const int ql = tq * 4 + 2 * g + hi; const int qp = q0 + ql;
                    SC[ql * 4096 + key] = (key > qp) ? 0u : sortable(s); } }
#pragma unroll
            for (int ks = 0; ks < 4; ++ks) Bf[ks] = Bn[ks];
        }
        if (tsk + G < NB * 512) { const int tn = tsk + G; const int bn = tn & 7, jn = tn >> 3, basen = jn & 31, rndn = jn >> 5;
            const int q8n = (rndn & 1) ? (32 * rndn + 31 - basen) : (32 * rndn + basen); const int q0n = q8n * 8, nblkn = (q0n >> 5) + 1; const size_t rbn = (size_t)bn * T;
            SEL_LOAD(q0n, nblkn, rbn); }
        __syncthreads();
        for (int rep_r = 0; rep_r < (int)((DUP_MASK >> 14) & 1) + 1; ++rep_r)
        {
            const int qp = q0 + wid; unsigned long long myword = 0ull;
            if (qp < 256) { const int lo = lane * 64; myword = (qp >= lo + 63) ? ~0ull : (qp < lo ? 0ull : ((2ull << (qp - lo)) - 1ull)); }
            else {
                int lane_t = lane; asm volatile("" : "+v"(lane_t));
                const LAS unsigned* scl = SC + wid * 4096 + lane_t; const int nscan = nblk * 32;
                unsigned u[64]; const int nreg = (nscan + 63) >> 6;
#pragma unroll
                for (int j4 = 0; j4 < 64; ++j4) { if ((j4 & ~15) < nreg) { const unsigned v_ = scl[64 * j4]; u[j4] = (lane_t < nscan - 64 * j4) ? v_ : 0u; } else u[j4] = 0u; }
                unsigned umax = 0u, umin = 0xFFFFFFFFu;
#pragma unroll
                for (int j4 = 0; j4 < 64; ++j4) { if ((j4 & ~15) < nreg) { umax = max(umax, u[j4]); umin = min(umin, u[j4] ? u[j4] : 0xFFFFFFFFu); } }
                umax = wave_max_u(umax); umin = wave_min_u(umin);
                unsigned lo = umin, hi = umax + 1u; int c_lo = qp + 1, c_hi = 0;
                while (c_lo - c_hi > 64 && hi - lo > 1u) {
                    const unsigned hm = hi - 1u;
                    const float lf = __uint_as_float((lo & 0x80000000u) ? (lo ^ 0x80000000u) : ~lo), hf = __uint_as_float((hm & 0x80000000u) ? (hm ^ 0x80000000u) : ~hm);
                    unsigned mid = sortable(0.5f * lf + 0.5f * hf);
                    mid = (mid <= lo) ? lo + 1u : ((mid >= hi) ? hi - 1u : mid);
                    int cl = 0;
#pragma unroll
                    for (int j4 = 0; j4 < 64; ++j4) { if ((j4 & ~15) < nreg) cl += (u[j4] >= mid) ? 1 : 0; }
                    const int c = wave_sum_i(cl);
                    if (c >= 256) { lo = mid; c_lo = c; } else { hi = mid; c_hi = c; }
                }
                unsigned Tk; int kth, neq;
                if (hi - lo == 1u) { Tk = lo; kth = 256 - c_hi; neq = c_lo - c_hi; }
                else {
                    LAS unsigned* CAND = HI; int pos = 0;
#pragma unroll
                    for (int j4 = 0; j4 < 64; ++j4) { if ((j4 & ~15) < nreg) { const bool in_ = (u[j4] >= lo) && (u[j4] < hi); const unsigned long long bm = __ballot(in_);
                        if (bm) { if (in_) CAND[pos + __builtin_popcountll(bm & ((1ull << lane_t) - 1ull))] = u[j4]; pos += __builtin_popcountll(bm); } } }
                    LDS_WAIT();
                    const int m_ = pos; const unsigned mine = (lane_t < m_) ? CAND[lane_t] : 0u;
                    int rg = 0, re = 0;
                    for (int x = 0; x < m_; ++x) { const unsigned v_ = __builtin_amdgcn_readlane(mine, x); rg += (v_ > mine) ? 1 : 0; re += (v_ == mine) ? 1 : 0; }
                    const int need = 256 - c_hi;
                    const bool is_t = (lane_t < m_) && (rg < need) && (need <= rg + re);
                    const unsigned long long bt = __ballot(is_t); const int Lt = (int)__builtin_ctzll(bt | (1ull << 63));
                    Tk = __builtin_amdgcn_readlane(mine, Lt); kth = need - __builtin_amdgcn_readlane(rg, Lt); neq = __builtin_amdgcn_readlane(re, Lt);
                }
                int eqtaken = 0; unsigned mw_lo = 0u, mw_hi = 0u;
                if (kth == neq) {
#pragma unroll
                    for (int jt = 0; jt < 64; ++jt) { if ((jt & ~15) < nreg) { const unsigned long long w = __ballot(u[jt] >= Tk); if (lane_t == jt) { mw_lo = (unsigned)w; mw_hi = (unsigned)(w >> 32); } } }
                } else
#pragma unroll
                for (int jt = 0; jt < 64; ++jt) { if ((jt & ~15) < nreg) { const bool gt = u[jt] > Tk, eq = (u[jt] == Tk); const unsigned long long beq = __ballot(eq);
                    const int rank = eqtaken + __builtin_popcountll(beq & ((1ull << lane_t) - 1ull));
                    const unsigned long long w = __ballot(gt || (eq && rank < kth)); eqtaken += __builtin_popcountll(beq);
                    if (lane_t == jt) { mw_lo = (unsigned)w; mw_hi = (unsigned)(w >> 32); } asm volatile("" : "+s"(eqtaken)); } }
                myword = ((unsigned long long)mw_hi << 32) | mw_lo;
            }
            MASK[((size_t)b * 4096 + qp) * 64 + lane] = myword;
        }
        __syncthreads();
    }
#undef SEL_LOAD
}

constexpr int SC_BUF = 43008, SC_YB = 2 * SC_BUF, SC_END = SC_YB + 2 * 2048;
static_assert(SC_END <= RING_BYTES, "scan LDS");
struct ScanP { const bf16_t* PROJ; bf16_t* PROJw; const _Float16* E; const _Float16* A; const bf16_t* VF; const float *mu_r, *mu_k, *k_k, *k_a, *r_k; };
__device__ __forceinline__ void scan_unit(const ScanP& P, int b, int h, int q4, LAS unsigned char* lds, int tid) {
    const int wave = __builtin_amdgcn_readfirstlane(tid >> 6), lane = tid & 63;
    const size_t rb = (size_t)b * T;
    if (wave >= 4) {
        const int pt = tid - 256, tl = pt >> 3, cg = pt & 7; const int ch0 = h * 64 + cg * 8;
        float mur[8], muk[8], kkp[8], kap[8], rkp[8];
#pragma unroll
        for (int i = 0; i < 8; ++i) { mur[i] = P.mu_r[ch0 + i]; muk[i] = P.mu_k[ch0 + i]; kkp[i] = P.k_k[ch0 + i]; kap[i] = P.k_a[ch0 + i]; rkp[i] = P.r_k[ch0 + i]; }
        u32x4 rc, kc, rp, kp, e8, a8; unsigned v2;
#define P_LOAD(cn) do { const int t_ = (cn) * 32 + tl; const size_t m_ = rb + t_; \
            rc = *(const u32x4*)(P.PROJ + m_ * NP + C_R + ch0); kc = *(const u32x4*)(P.PROJ + m_ * NP + C_K + ch0); rp = (u32x4){0u, 0u, 0u, 0u}; kp = (u32x4){0u, 0u, 0u, 0u}; \
            if (t_ > 0) { rp = *(const u32x4*)(P.PROJ + (m_ - 1) * NP + C_R + ch0); kp = *(const u32x4*)(P.PROJ + (m_ - 1) * NP + C_K + ch0); } \
            e8 = *(const u32x4*)(P.E + m_ * 512 + ch0); a8 = *(const u32x4*)(P.A + m_ * 512 + ch0); v2 = *(const unsigned*)(P.VF + m_ * 512 + h * 64 + q4 * 16 + 2 * cg); } while (0)
#define P_COMPUTE(cn) do { LAS unsigned char* buf = lds + ((cn) & 1) * SC_BUF; const size_t m = rb + (cn) * 32 + tl; \
            float r_[8], kl[8], kkv[8], a_[8], e_[8]; float ss = 0.f; \
            _Pragma("unroll") for (int i = 0; i < 8; ++i) { const unsigned wr_ = rc[i >> 1], wrp = rp[i >> 1], wk_ = kc[i >> 1], wkp = kp[i >> 1]; \
                const float xr = (i & 1) ? bfh(wr_) : bfl(wr_), xrp = (i & 1) ? bfh(wrp) : bfl(wrp), xk = (i & 1) ? bfh(wk_) : bfl(wk_), xkp = (i & 1) ? bfh(wkp) : bfl(wkp); \
                r_[i] = xr + (xrp - xr) * mur[i]; kl[i] = xk + (xkp - xk) * muk[i]; kkv[i] = kl[i] * kkp[i]; ss += kkv[i] * kkv[i]; \
                const unsigned we_ = e8[i >> 1], wa_ = a8[i >> 1]; const float el = (i & 1) ? bfh(we_) : bfl(we_), al = (i & 1) ? bfh(wa_) : bfl(wa_); \
                e_[i] = -0.60653065971f * pg8::sigmoidf_(el); a_[i] = pg8::sigmoidf_(al); } \
            ss = allsum8(ss); const float inv = 1.0f / fmaxf(sqrtf(ss), 1e-12f); \
            float kp_[8], kk_[8], nb_[8], dc_[8]; float rk = 0.f; \
            _Pragma("unroll") for (int i = 0; i < 8; ++i) { kk_[i] = kkv[i] * inv; kp_[i] = kl[i] * (1.f + (a_[i] - 1.f) * kap[i]); nb_[i] = -kk_[i] * a_[i]; dc_[i] = __expf(e_[i]); rk += r_[i] * kp_[i] * rkp[i]; } \
            rk = allsum8(rk); \
              \
            const bool wh = (tl & 1) != 0; const int pr = tl >> 1; \
            float rA[8], rB[8]; \
            _Pragma("unroll") for (int i = 0; i < 8; ++i) { rA[i] = dpp_f<0x128>(wh ? dc_[i] : nb_[i]); rB[i] = dpp_f<0x128>(wh ? kk_[i] : kp_[i]); }     \
            float o0[8], o1[8], o2[8], o3[8]; float sa = 0.f, sb = 0.f; \
            _Pragma("unroll") for (int i = 0; i < 8; ++i) { const float dA = dc_[i] * rA[i], dB = dc_[i] * rB[i]; \
                o0[i] = wh ? dA : kk_[i];            \
                o1[i] = dB;                          \
                o2[i] = wh ? nb_[i] : dc_[i] * r_[i];     \
                o3[i] = wh ? kp_[i] : dA;            \
                sa += wh ? rA[i] * kk_[i] : nb_[i] * r_[i];      \
                sb += wh ? rB[i] * kk_[i] : kp_[i] * r_[i]; }    \
            sa = allsum8(sa); sb = allsum8(sb); \
            LAS float* Ob = (LAS float*)buf + (wh ? 4096 : 0) + pr * 64 + cg * 8;            \
            *(LAS f32x4*)(Ob) = (f32x4){o0[0], o0[1], o0[2], o0[3]}; *(LAS f32x4*)(Ob + 4) = (f32x4){o0[4], o0[5], o0[6], o0[7]}; \
            *(LAS f32x4*)(Ob + 1024) = (f32x4){o1[0], o1[1], o1[2], o1[3]}; *(LAS f32x4*)(Ob + 1024 + 4) = (f32x4){o1[4], o1[5], o1[6], o1[7]}; \
            *(LAS f32x4*)(Ob + 2048) = (f32x4){o2[0], o2[1], o2[2], o2[3]}; *(LAS f32x4*)(Ob + 2048 + 4) = (f32x4){o2[4], o2[5], o2[6], o2[7]}; \
            *(LAS f32x4*)(Ob + 3072) = (f32x4){o3[0], o3[1], o3[2], o3[3]}; *(LAS f32x4*)(Ob + 3072 + 4) = (f32x4){o3[4], o3[5], o3[6], o3[7]}; \
            if (wh) { *(LAS f32x4*)(Ob + 4096) = (f32x4){r_[0], r_[1], r_[2], r_[3]}; *(LAS f32x4*)(Ob + 4096 + 4) = (f32x4){r_[4], r_[5], r_[6], r_[7]}; } \
            if (cg == 0) { LAS float* SCL = (LAS float*)buf + 9216 + pr * 4 + (wh ? 0 : 2); SCL[0] = sa; SCL[1] = sb; }       \
            LAS float* VV = (LAS float*)buf + 9280; VV[tl * 16 + 2 * cg] = bfl(v2); VV[tl * 16 + 2 * cg + 1] = bfh(v2); \
            if (q4 == 0 && cg == 0) P.PROJw[m * NP + C_RK + h] = (bf16_t)(pkbf(rk, 0.f) & 0xffffu); } while (0)
        P_LOAD(0); P_COMPUTE(0); P_LOAD(1);
        __syncthreads();
        for (int c = 0; c < T / 32; ++c) {
            if (c >= 1) { const LAS float* YB = (const LAS float*)(lds + SC_YB + ((c - 1) & 1) * 2048); const int t = (c - 1) * 32 + tl;
                const float y0 = YB[tl * 16 + 2 * cg], y1 = YB[tl * 16 + 2 * cg + 1];
                *(unsigned*)(P.PROJw + (rb + t) * NP + C_Y + h * 64 + q4 * 16 + 2 * cg) = pkbf(y0, y1); }
            if (c + 1 < T / 32) { P_COMPUTE(c + 1); if (c + 2 < T / 32) P_LOAD(c + 2); }
            __syncthreads();
        }
#undef P_LOAD
#undef P_COMPUTE
        {
            const int c = T / 32; const LAS float* YB = (const LAS float*)(lds + SC_YB + ((c - 1) & 1) * 2048); const int t = (c - 1) * 32 + tl;
            const float y0 = YB[tl * 16 + 2 * cg], y1 = YB[tl * 16 + 2 * cg + 1];
            *(unsigned*)(P.PROJw + (rb + t) * NP + C_Y + h * 64 + q4 * 16 + 2 * cg) = pkbf(y0, y1);
        }
    } else {
        __builtin_amdgcn_s_setprio(3);
        const int rl = lane >> 4, kg = lane & 15, row = wave * 4 + rl;
        f32x4 S = {0.f, 0.f, 0.f, 0.f};
#ifdef SCAN_DUP_CONS
        f32x4 S2 = {0.f, 0.f, 0.f, 0.f}; float ydump = 0.f;
#endif
        __syncthreads();
        for (int c = 0; c < T / 32; ++c) {
            const LAS float* buf = (const LAS float*)(lds + (c & 1) * SC_BUF); LAS float* YB = (LAS float*)(lds + SC_YB + (c & 1) * 2048);
            struct PairOps { f32x4 kk1, wkk2, wr1, w12, n1, k1, nb2, k2, r2, sc; float v1, v2; };
#define SC_LOADP(O, pp) do { const LAS float* b_ = buf + (pp) * 64 + kg * 4; O.kk1 = *(const LAS f32x4*)(b_); O.wkk2 = *(const LAS f32x4*)(b_ + 1024); O.wr1 = *(const LAS f32x4*)(b_ + 2048); O.w12 = *(const LAS f32x4*)(b_ + 3072); \
                O.n1 = *(const LAS f32x4*)(b_ + 4096); O.k1 = *(const LAS f32x4*)(b_ + 5120); O.nb2 = *(const LAS f32x4*)(b_ + 6144); O.k2 = *(const LAS f32x4*)(b_ + 7168); O.r2 = *(const LAS f32x4*)(b_ + 8192); \
                O.sc = *(const LAS f32x4*)(buf + 9216 + (pp) * 4); O.v1 = buf[9280 + (2 * (pp)) * 16 + row]; O.v2 = buf[9280 + (2 * (pp) + 1) * 16 + row]; } while (0)
#define SC_DOT(A, B) ((A[0] * B[0] + A[1] * B[1]) + (A[2] * B[2] + A[3] * B[3]))
#define SC_STEPP(O, pp) do { float d1 = SC_DOT(S, O.kk1), d2 = SC_DOT(S, O.wkk2), d3 = SC_DOT(S, O.wr1); d1 = allsum16(d1); d2 = allsum16(d2); d3 = allsum16(d3); \
                const float s1 = d1, s2 = d2 + s1 * O.sc[0] + O.v1 * O.sc[1], y1 = d3 + s1 * O.sc[2] + O.v1 * O.sc[3]; \
                S = (S * O.w12 + (O.n1 * s1 + O.k1 * O.v1)) + (O.nb2 * s2 + O.k2 * O.v2); \
                float y2 = SC_DOT(S, O.r2); y2 = allsum16(y2); if (kg == 0) { YB[(2 * (pp)) * 16 + row] = y1; YB[(2 * (pp) + 1) * 16 + row] = y2; } } while (0)
            PairOps oA, oB;
            SC_LOADP(oA, 0);
#pragma unroll 2
            for (int pp = 0; pp < 16; pp += 2) {
                SC_LOADP(oB, pp + 1);
                SC_STEPP(oA, pp);
                if (pp + 2 < 16) SC_LOADP(oA, pp + 2);
                SC_STEPP(oB, pp + 1);
            }
#undef SC_LOADP
#undef SC_DOT
#undef SC_STEPP
            __syncthreads();
        }
        __builtin_amdgcn_s_setprio(0);
    }
    __syncthreads();
}

namespace sck {
typedef float f32x2v __attribute__((ext_vector_type(2)));
constexpr int SLOT = 10496, GBUF = 4 * SLOT;
constexpr int PS_OFF = 2 * GBUF, PS_SZ = 4608;
constexpr int CS_OFF = PS_OFF + 4 * PS_SZ;
constexpr int YB_OFF = CS_OFF + 3072, CST_OFF = YB_OFF + 2 * 4096, END = CST_OFF + 5 * 256;
static_assert(END <= 131072, "chunked scan LDS");
__device__ __forceinline__ f32x4 mf(u32x4 a, u32x4 b, f32x4 c) { return __builtin_amdgcn_mfma_f32_16x16x32_f16(__builtin_bit_cast(pg8::half8, a), __builtin_bit_cast(pg8::half8, b), c, 0, 0, 0); }
__device__ __forceinline__ u32x4 pack8(const float* x) { u32x4 w; w.x = pkbf(x[0], x[1]); w.y = pkbf(x[2], x[3]); w.z = pkbf(x[4], x[5]); w.w = pkbf(x[6], x[7]); return w; }
__device__ __forceinline__ u32x2 pack4(f32x4 v) { u32x2 w; w.x = pkbf(v[0], v[1]); w.y = pkbf(v[2], v[3]); return w; }
__device__ __forceinline__ f32x4 unpack4(u32x2 w) { return (f32x4){bfl(w.x), bfh(w.x), bfl(w.y), bfh(w.y)}; }
__device__ __forceinline__ void sth(LAS bf16_t* p, float v) { *p = (bf16_t)(pkbf(v, 0.f) & 0xffffu); }
}

__device__ __forceinline__ void scan_unit_chunk(const ScanP& P, int b, int h, int q4, LAS unsigned char* lds, int tid) {
    using namespace sck;
    const int wave = __builtin_amdgcn_readfirstlane(tid >> 6), lane = tid & 63;
    const int n16 = lane & 15, g = lane >> 4;
    const size_t rb = (size_t)b * T;
    constexpr int NG = T / 64;
    if (tid < 64) { LAS float* cst = (LAS float*)(lds + CST_OFF); const int ch = h * 64 + tid; cst[tid] = P.mu_r[ch]; cst[64 + tid] = P.mu_k[ch]; cst[128 + tid] = P.k_k[ch]; cst[192 + tid] = P.k_a[ch]; cst[256 + tid] = P.r_k[ch]; }
    __syncthreads();
    if (wave >= 4) {
        const int p = wave - 4;
        LAS unsigned char* ps = lds + PS_OFF + p * PS_SZ;
        LAS float* LAB = (LAS float*)ps; LAS bf16_t* LAK = (LAS bf16_t*)(ps + 1024); LAS bf16_t* MRK = (LAS bf16_t*)(ps + 1536); LAS bf16_t* VT = (LAS bf16_t*)(ps + 2048); LAS bf16_t* K2T = (LAS bf16_t*)(ps + 2560);
        const LAS float* CST = (const LAS float*)(lds + CST_OFF);
        u32x4 rc[2], kc[2], rp[2], kp[2], e8[2], a8[2]; u32x2 v4;
#define CK_LOAD(gi) do { const int t_ = (gi) * 64 + p * 16 + n16; const size_t m_ = rb + t_; \
            _Pragma("unroll") for (int s = 0; s < 2; ++s) { const int co = h * 64 + 32 * s + 8 * g; \
                rc[s] = *(const u32x4*)(P.PROJ + m_ * NP + C_R + co); kc[s] = *(const u32x4*)(P.PROJ + m_ * NP + C_K + co); rp[s] = (u32x4){0u, 0u, 0u, 0u}; kp[s] = (u32x4){0u, 0u, 0u, 0u}; \
                if (t_ > 0) { rp[s] = *(const u32x4*)(P.PROJ + (m_ - 1) * NP + C_R + co); kp[s] = *(const u32x4*)(P.PROJ + (m_ - 1) * NP + C_K + co); } \
                e8[s] = *(const u32x4*)(P.E + m_ * 512 + co); a8[s] = *(const u32x4*)(P.A + m_ * 512 + co); } \
            v4 = *(const u32x2*)(P.VF + m_ * 512 + h * 64 + q4 * 16 + 4 * g); } while (0)
        CK_LOAD(0);
        for (int gi = 0; gi <= NG; ++gi) {
            if (gi < NG) {
                int n16q_ = n16, gq_ = g; asm volatile("" : "+v"(n16q_), "+v"(gq_));
                { const int n16 = n16q_, g = gq_, lane = gq_ * 16 + n16q_; (void)lane;
                LAS unsigned char* sl = lds + (gi & 1) * GBUF + p * SLOT;
                const size_t m = rb + gi * 64 + p * 16 + n16;
                const LAS float* CSTg = CST + 8 * g; LAS bf16_t* B2Tg = (LAS bf16_t*)(sl + 4096) + (8 * g) * 16 + n16; LAS bf16_t* K2Tg = K2T + (8 * g) * 16 + n16; LAS float* G15g = (LAS float*)(sl + 10240) + 8 * g;
                asm volatile("" : "+v"(CSTg), "+v"(B2Tg), "+v"(K2Tg), "+v"(G15g));
                float ss = 0.f;
#pragma unroll
                for (int s = 0; s < 2; ++s)
#pragma unroll
                    for (int e = 0; e < 8; ++e) { const unsigned wk_ = kc[s][e >> 1], wkp = kp[s][e >> 1]; const float xk = (e & 1) ? bfh(wk_) : bfl(wk_), xkp = (e & 1) ? bfh(wkp) : bfl(wkp);
                        const float kkv = (xk + (xkp - xk) * CSTg[64 + 32 * s + e]) * CSTg[128 + 32 * s + e]; ss += kkv * kkv; }
                ss += __shfl_xor(ss, 16); ss += __shfl_xor(ss, 32);
                const float inv = 1.0f / fmaxf(sqrtf(ss), 1e-12f);
                u32x4 AFf[2], PFf[2], A1f[2], B1f[2], K1f[2], P1f[2]; float rk = 0.f;
#pragma unroll
                for (int s = 0; s < 2; ++s) { float al[8], al1[8], be1[8], ka1[8], rh[8], rh1[8];
#pragma unroll
                    for (int e = 0; e < 8; ++e) { const unsigned wr_ = rc[s][e >> 1], wrp = rp[s][e >> 1], wk_ = kc[s][e >> 1], wkp = kp[s][e >> 1], we_ = e8[s][e >> 1], wa_ = a8[s][e >> 1];
                        const float xr = (e & 1) ? bfh(wr_) : bfl(wr_), xrp = (e & 1) ? bfh(wrp) : bfl(wrp), xk = (e & 1) ? bfh(wk_) : bfl(wk_), xkp = (e & 1) ? bfh(wkp) : bfl(wkp);
                        const float el = (e & 1) ? bfh(we_) : bfl(we_), alg = (e & 1) ? bfh(wa_) : bfl(wa_);
                        constexpr int dummy_ = 0; (void)dummy_; const float rq = xr + (xrp - xr) * CSTg[32 * s + e], kl = xk + (xkp - xk) * CSTg[64 + 32 * s + e]; const float kk = kl * CSTg[128 + 32 * s + e] * inv;
                        const float a_ = alg, ev = el;
                        const float kpv = kl * (1.f + (a_ - 1.f) * CSTg[192 + 32 * s + e]), bb = kk * a_; rk += rq * kpv * CSTg[256 + 32 * s + e];
                        float cum = ev;
                        cum += dpp_f<0x111>(cum); cum += dpp_f<0x112>(cum); cum += dpp_f<0x114>(cum); cum += dpp_f<0x118>(cum);
                        const float cumx = cum - ev; const float c7 = dpp_f<0x157>(cum), c15 = dpp_f<0x15F>(cum);
                        const float GGm = __builtin_amdgcn_exp2f(cum - c7), iGm = __builtin_amdgcn_rcpf(GGm), iW = __builtin_amdgcn_exp2f(-ev), Gm = __builtin_amdgcn_exp2f(c7), Dm = __builtin_amdgcn_exp2f(c15 - c7);
                        const float G = GGm * Gm, GpGm = GGm * iW, Gp = GpGm * Gm, iG15 = Dm * iGm; (void)cumx;
                        al[e] = Gp * kk; al1[e] = GpGm * kk; be1[e] = bb * iGm; ka1[e] = kpv * iGm; rh[e] = G * rq; rh1[e] = GGm * rq;
                        sth(B2Tg + (32 * s + e) * 16, bb * iG15); sth(K2Tg + (32 * s + e) * 16, kpv * iG15);
                        if (n16 == 0) G15g[32 * s + e] = Gm * Dm;
                        asm volatile("" ::: "memory"); }
                    AFf[s] = pack8(al); PFf[s] = pack8(rh); A1f[s] = pack8(al1); B1f[s] = pack8(be1); K1f[s] = pack8(ka1); P1f[s] = pack8(rh1);
                    *(LAS u32x4*)(sl + 0 + n16 * 128 + (32 * s + 8 * g) * 2) = AFf[s]; *(LAS u32x4*)(sl + 2048 + n16 * 128 + (32 * s + 8 * g) * 2) = PFf[s]; }
                rk += __shfl_xor(rk, 16); rk += __shfl_xor(rk, 32);
                if (q4 == 0 && g == 0) P.PROJw[m * NP + C_RK + h] = (bf16_t)(pkbf(rk, 0.f) & 0xffffu);
                const f32x4 z4 = {0.f, 0.f, 0.f, 0.f};
                f32x4 Lab = mf(A1f[1], B1f[1], mf(A1f[0], B1f[0], z4)), Lak = mf(A1f[1], K1f[1], mf(A1f[0], K1f[0], z4)), Mrb = mf(P1f[1], B1f[1], mf(P1f[0], B1f[0], z4)), Mrk = mf(P1f[1], K1f[1], mf(P1f[0], K1f[0], z4));
                { int nm = n16, gm = g; asm volatile("" : "+v"(nm), "+v"(gm));
#pragma unroll
                  for (int x = 0; x < 4; ++x) { const int j = 4 * gm + x; if (!(j > nm)) { Lab[x] = 0.f; Lak[x] = 0.f; } if (!(j >= nm)) { Mrb[x] = 0.f; Mrk[x] = 0.f; } } }
#pragma unroll
                for (int x = 0; x < 4; ++x) { const int j = 4 * g + x; LAB[j * 16 + n16] = Lab[x]; sth(LAK + j * 16 + n16, Lak[x]); sth(MRK + j * 16 + n16, Mrk[x]); sth((LAS bf16_t*)(sl + 6656) + j * 16 + n16, Mrb[x]); }
                { VT[(4 * g + 0) * 16 + n16] = (bf16_t)(v4.x & 0xffffu); VT[(4 * g + 1) * 16 + n16] = (bf16_t)(v4.x >> 16); VT[(4 * g + 2) * 16 + n16] = (bf16_t)(v4.y & 0xffffu); VT[(4 * g + 3) * 16 + n16] = (bf16_t)(v4.y >> 16); }
                LDS_WAIT();
                { float t[16]; int nl = n16; asm volatile("" : "+v"(nl));
#pragma unroll
                  for (int j = 0; j < 16; ++j) { const f32x4 r0 = *(const LAS f32x4*)(LAB + j * 16), r1 = *(const LAS f32x4*)(LAB + j * 16 + 4), r2 = *(const LAS f32x4*)(LAB + j * 16 + 8), r3 = *(const LAS f32x4*)(LAB + j * 16 + 12);
                      const float row[16] = {r0[0], r0[1], r0[2], r0[3], r1[0], r1[1], r1[2], r1[3], r2[0], r2[1], r2[2], r2[3], r3[0], r3[1], r3[2], r3[3]};
                      float acc = (j == nl) ? 1.f : 0.f;
#pragma unroll
                      for (int i = 0; i < 16; ++i) if (i < j) acc -= row[i] * t[i];
                      t[j] = acc; asm volatile("" ::: "memory"); }
                  if (g == 0) {
#pragma unroll
                      for (int j = 0; j < 16; ++j) sth((LAS bf16_t*)(sl + 6144) + j * 16 + n16, t[j]); } }
                { const u32x4 z = {0u, 0u, 0u, 0u};
                  const u32x4 LakF = (g < 2) ? *(const LAS u32x4*)(LAK + n16 * 16 + 8 * g) : z, MrkF = (g < 2) ? *(const LAS u32x4*)(MRK + n16 * 16 + 8 * g) : z, VFr = (g < 2) ? *(const LAS u32x4*)(VT + n16 * 16 + 8 * g) : z;
                  const f32x4 LV = mf(LakF, VFr, z4), YV = mf(MrkF, VFr, z4);
                  *(LAS u32x2*)(sl + 7168 + lane * 8) = pack4(LV); *(LAS u32x2*)(sl + 7680 + lane * 8) = pack4(YV);
#pragma unroll
                  for (int rt = 0; rt < 4; ++rt) { const u32x4 K2F = (g < 2) ? *(const LAS u32x4*)(K2T + (16 * rt + n16) * 16 + 8 * g) : z; const f32x4 KV = mf(K2F, VFr, z4);
                      *(LAS u32x2*)(sl + 8192 + rt * 512 + lane * 8) = pack4(KV); } }
                if (gi + 1 < NG) CK_LOAD(gi + 1);
                }
            }
            __syncthreads();
        }
#undef CK_LOAD
    } else {
        f32x4 S32[4]; S32[0] = S32[1] = S32[2] = S32[3] = (f32x4){0.f, 0.f, 0.f, 0.f};
        LAS unsigned char* cs = lds + CS_OFF;
        if (wave == 0) {
#pragma unroll
            for (int rt = 0; rt < 4; ++rt) *(LAS u32x2*)(cs + 1024 + n16 * 128 + (16 * rt + 4 * g) * 2) = (u32x2){0u, 0u};
        }
        __syncthreads();
        for (int gi = 0; gi < NG; ++gi) {
            if (wave == 0) {
                const u32x4 z = {0u, 0u, 0u, 0u}; const f32x4 z4 = {0.f, 0.f, 0.f, 0.f};
                LAS float* YB = (LAS float*)(lds + YB_OFF + (gi & 1) * 4096);
                for (int pc = 0; pc < 4; ++pc) {
                    int n16q_ = n16, gq_ = g; asm volatile("" : "+v"(n16q_), "+v"(gq_));
                    const int n16 = n16q_, g = gq_, lane = gq_ * 16 + n16q_;
                    const LAS unsigned char* sl = lds + (gi & 1) * GBUF + pc * SLOT;
                    LDS_WAIT();
                    const u32x4 S0 = *(const LAS u32x4*)(cs + 1024 + n16 * 128 + (8 * g) * 2), S1 = *(const LAS u32x4*)(cs + 1024 + n16 * 128 + (32 + 8 * g) * 2);
                    const u32x4 A0 = *(const LAS u32x4*)(sl + n16 * 128 + (8 * g) * 2), A1 = *(const LAS u32x4*)(sl + n16 * 128 + (32 + 8 * g) * 2);
                    const u32x4 P0 = *(const LAS u32x4*)(sl + 2048 + n16 * 128 + (8 * g) * 2), P1 = *(const LAS u32x4*)(sl + 2048 + n16 * 128 + (32 + 8 * g) * 2);
                    const f32x4 LV = unpack4(*(const LAS u32x2*)(sl + 7168 + lane * 8)), YV = unpack4(*(const LAS u32x2*)(sl + 7680 + lane * 8));
                    const f32x4 Ub = mf(A1, S1, mf(A0, S0, LV));
                    *(LAS u32x2*)(cs + 0 + n16 * 32 + (4 * g) * 2) = pack4(Ub);
                    LDS_WAIT();
                    const u32x4 UbF = (g < 2) ? *(const LAS u32x4*)(cs + 0 + n16 * 32 + (8 * g) * 2) : z;
                    const u32x4 TF = (g < 2) ? *(const LAS u32x4*)(sl + 6144 + n16 * 32 + (8 * g) * 2) : z;
                    f32x4 U = mf(TF, UbF, z4); U = -U;
                    *(LAS u32x2*)(cs + 512 + n16 * 32 + (4 * g) * 2) = pack4(U);
                    LDS_WAIT();
                    const u32x4 UF = (g < 2) ? *(const LAS u32x4*)(cs + 512 + n16 * 32 + (8 * g) * 2) : z;
                    const u32x4 MF = (g < 2) ? *(const LAS u32x4*)(sl + 6656 + n16 * 32 + (8 * g) * 2) : z;
                    const f32x4 Y = mf(MF, UF, mf(P1, S1, mf(P0, S0, YV)));
#pragma unroll
                    for (int x = 0; x < 4; ++x) YB[(pc * 16 + 4 * g + x) * 16 + n16] = Y[x];
#pragma unroll
                    for (int rt = 0; rt < 4; ++rt) { const u32x4 BF = (g < 2) ? *(const LAS u32x4*)(sl + 4096 + (16 * rt + n16) * 32 + (8 * g) * 2) : z;
                        const f32x4 KV = unpack4(*(const LAS u32x2*)(sl + 8192 + rt * 512 + lane * 8)); const f32x4 G15 = *(const LAS f32x4*)(sl + 10240 + (16 * rt + 4 * g) * 4);
                        S32[rt] = mf(BF, UF, S32[rt] * G15 + KV);
                        *(LAS u32x2*)(cs + 1024 + n16 * 128 + (16 * rt + 4 * g) * 2) = pack4(S32[rt]); }
                }
            } else if (wave == 1 && gi >= 1) {
                const LAS float* YB = (const LAS float*)(lds + YB_OFF + ((gi - 1) & 1) * 4096) + lane * 16;
                const f32x4 y0 = *(const LAS f32x4*)(YB), y1 = *(const LAS f32x4*)(YB + 4), y2 = *(const LAS f32x4*)(YB + 8), y3 = *(const LAS f32x4*)(YB + 12);
                bf16_t* dst = P.PROJw + (rb + (gi - 1) * 64 + lane) * NP + C_Y + h * 64 + q4 * 16;
                u32x4 w0, w1; w0.x = pkbf(y0[0], y0[1]); w0.y = pkbf(y0[2], y0[3]); w0.z = pkbf(y1[0], y1[1]); w0.w = pkbf(y1[2], y1[3]); w1.x = pkbf(y2[0], y2[1]); w1.y = pkbf(y2[2], y2[3]); w1.z = pkbf(y3[0], y3[1]); w1.w = pkbf(y3[2], y3[3]);
                *(u32x4*)dst = w0; *(u32x4*)(dst + 8) = w1;
            }
            __syncthreads();
        }
        if (wave == 1) {
            const LAS float* YB = (const LAS float*)(lds + YB_OFF + ((NG - 1) & 1) * 4096) + lane * 16;
            const f32x4 y0 = *(const LAS f32x4*)(YB), y1 = *(const LAS f32x4*)(YB + 4), y2 = *(const LAS f32x4*)(YB + 8), y3 = *(const LAS f32x4*)(YB + 12);
            bf16_t* dst = P.PROJw + (rb + (NG - 1) * 64 + lane) * NP + C_Y + h * 64 + q4 * 16;
            u32x4 w0, w1; w0.x = pkbf(y0[0], y0[1]); w0.y = pkbf(y0[2], y0[3]); w0.z = pkbf(y1[0], y1[1]); w0.w = pkbf(y1[2], y1[3]); w1.x = pkbf(y2[0], y2[1]); w1.y = pkbf(y2[2], y2[3]); w1.z = pkbf(y3[0], y3[1]); w1.w = pkbf(y3[2], y3[3]);
            *(u32x4*)dst = w0; *(u32x4*)(dst + 8) = w1;
        }
    }
    __syncthreads();
}

namespace sck2 {
using namespace sck;
constexpr int RG = 6;
constexpr int O_AF = 0, O_PF = 2176, O_B2T = 4352, O_K2T = 6912, O_TT = 9472, O_MRB = 10112, O_LAK = 10752, O_MRK = 11392, O_G15 = 12032, RSLOT = 12288, SA = 136, SB = 40;
constexpr size_t RING_HEAD = (size_t)RG * 4 * RSLOT;
constexpr int PW_SZ = RSLOT + 1024;
constexpr int PCST_OFF = 8 * PW_SZ;
constexpr int GB_SZ = 4 * RSLOT, VT_OFF = 2 * GB_SZ, VT_SZ = 64 * SB, END2 = VT_OFF + 2 * 4 * VT_SZ;
static_assert(PCST_OFF + 1280 <= 131072 && END2 <= 131072 && (size_t)64 * RING_HEAD <= 24 * MiB, "role-split scan: LDS / ring");
constexpr int CW_SCAN = 131072, CW_SCAN_LAYER = 16384;
constexpr unsigned SPIN_CAP = 1u << 21;
__device__ __forceinline__ void spin_ge(unsigned* w, unsigned want, int lane, unsigned* tmo) {
    unsigned sp = 0;
    for (;;) { unsigned v = 0; if (lane == 0) v = __hip_atomic_load(w, __ATOMIC_RELAXED, __HIP_MEMORY_SCOPE_AGENT);
        if ((unsigned)__builtin_amdgcn_readfirstlane(v) >= want) break; __builtin_amdgcn_s_sleep(1);
        if ((++sp & 255u) == 0u) { unsigned t = 0; if (lane == 0) t = __hip_atomic_load(tmo, __ATOMIC_RELAXED, __HIP_MEMORY_SCOPE_AGENT); if (__builtin_amdgcn_readfirstlane(t)) break;
            if (sp > SPIN_CAP) { if (lane == 0) __hip_atomic_store(tmo, 1u, __ATOMIC_RELAXED, __HIP_MEMORY_SCOPE_AGENT); break; } } }
}
__device__ __forceinline__ void spin_min4_ge(unsigned* w, unsigned want, int lane, unsigned* tmo) {
    unsigned sp = 0;
    for (;;) { unsigned v = 0xffffffffu; if (lane < 4) v = __hip_atomic_load(w + lane, __ATOMIC_RELAXED, __HIP_MEMORY_SCOPE_AGENT);
        const unsigned m = min(min((unsigned)__builtin_amdgcn_readlane(v, 0), (unsigned)__builtin_amdgcn_readlane(v, 1)), min((unsigned)__builtin_amdgcn_readlane(v, 2), (unsigned)__builtin_amdgcn_readlane(v, 3)));
        if (m >= want) break; __builtin_amdgcn_s_sleep(1);
        if ((++sp & 255u) == 0u) { unsigned t = 0; if (lane == 0) t = __hip_atomic_load(tmo, __ATOMIC_RELAXED, __HIP_MEMORY_SCOPE_AGENT); if (__builtin_amdgcn_readfirstlane(t)) break;
            if (sp > SPIN_CAP) { if (lane == 0) __hip_atomic_store(tmo, 1u, __ATOMIC_RELAXED, __HIP_MEMORY_SCOPE_AGENT); break; } } }
}
typedef _Float16 half4 __attribute__((ext_vector_type(4)));
__device__ __forceinline__ f32x4 mf16(u32x2 a, u32x2 b, f32x4 c) { return __builtin_amdgcn_mfma_f32_16x16x16f16(__builtin_bit_cast(half4, a), __builtin_bit_cast(half4, b), c, 0, 0, 0); }
__device__ __forceinline__ void store_wt(unsigned char* p, u32x4 v) { asm volatile("global_store_dwordx4 %0, %1, off sc1" :: "v"((GAS unsigned char*)p), "v"(v) : "memory"); }
}

__device__ __forceinline__ void scan_unit_share(const ScanP& P, int b, int h, int role, LAS unsigned char* lds, int tid, unsigned char* ring_all, unsigned* flags) {
    using namespace sck2;
    const int wave = __builtin_amdgcn_readfirstlane(tid >> 6), lane = tid & 63;
    const int n16 = lane & 15, g = lane >> 4;
    const size_t rb = (size_t)b * T;
    constexpr int NG = T / 64, NC = T / 16;
    const int head = b * 8 + h;
    unsigned char* ring = ring_all + (size_t)head * RING_HEAD;
    unsigned* ready = flags + head * 64; unsigned* done = flags + 8192 + head * 64; unsigned* tmo = flags + 16320;
    if (role != 0) {
        if (tid < 64) { LAS float* cst = (LAS float*)(lds + PCST_OFF); const int ch = h * 64 + tid; cst[tid] = P.mu_r[ch]; cst[64 + tid] = P.mu_k[ch]; cst[128 + tid] = P.k_k[ch]; cst[192 + tid] = P.k_a[ch]; cst[256 + tid] = P.r_k[ch]; }
        __syncthreads();
        const int pw = (role - 1) * 8 + wave;
        LAS unsigned char* sl = lds + wave * PW_SZ; LAS float* LAB = (LAS float*)(sl + RSLOT);
        const LAS float* CST = (const LAS float*)(lds + PCST_OFF);
        u32x4 rc[2], kc[2], rp[2], kp[2], e8[2], a8[2];
#define CK_LOAD(cx) do { const int t_ = (cx) * 16 + n16; const size_t m_ = rb + t_; \
            _Pragma("unroll") for (int s = 0; s < 2; ++s) { const int co = h * 64 + 32 * s + 8 * g; \
                rc[s] = *(const u32x4*)(P.PROJ + m_ * NP + C_R + co); kc[s] = *(const u32x4*)(P.PROJ + m_ * NP + C_K + co); rp[s] = (u32x4){0u, 0u, 0u, 0u}; kp[s] = (u32x4){0u, 0u, 0u, 0u}; \
                if (t_ > 0) { rp[s] = *(const u32x4*)(P.PROJ + (m_ - 1) * NP + C_R + co); kp[s] = *(const u32x4*)(P.PROJ + (m_ - 1) * NP + C_K + co); } \
                e8[s] = *(const u32x4*)(P.E + m_ * 512 + co); a8[s] = *(const u32x4*)(P.A + m_ * 512 + co); } } while (0)
        CK_LOAD(pw);
        for (int c = pw; c < NC; c += 24) {
            int n16q_ = n16, gq_ = g; asm volatile("" : "+v"(n16q_), "+v"(gq_));
            { const int n16 = n16q_, g = gq_, lane = gq_ * 16 + n16q_;
            const size_t m = rb + c * 16 + n16;
            const LAS float* CSTg = CST + 8 * g; LAS bf16_t* B2Tg = (LAS bf16_t*)(sl + O_B2T) + (8 * g) * (SB / 2) + n16; LAS bf16_t* K2Tg = (LAS bf16_t*)(sl + O_K2T) + (8 * g) * (SB / 2) + n16; LAS float* G15g = (LAS float*)(sl + O_G15) + 8 * g;
            asm volatile("" : "+v"(CSTg), "+v"(B2Tg), "+v"(K2Tg), "+v"(G15g));
            float ss = 0.f;
#pragma unroll
            for (int s = 0; s < 2; ++s)
#pragma unroll
                for (int e = 0; e < 8; ++e) { const unsigned wk_ = kc[s][e >> 1], wkp = kp[s][e >> 1]; const float xk = (e & 1) ? bfh(wk_) : bfl(wk_), xkp = (e & 1) ? bfh(wkp) : bfl(wkp);
                    const float kkv = (xk + (xkp - xk) * CSTg[64 + 32 * s + e]) * CSTg[128 + 32 * s + e]; ss += kkv * kkv; }
            ss += __shfl_xor(ss, 16); ss += __shfl_xor(ss, 32);
            const float inv = 1.0f / fmaxf(sqrtf(ss), 1e-12f);
            u32x4 A1f[2], B1f[2], K1f[2], P1f[2]; float rk = 0.f;
#pragma unroll
            for (int s = 0; s < 2; ++s) { float al[8], al1[8], be1[8], ka1[8], rh[8], rh1[8];
#pragma unroll
                for (int e = 0; e < 8; ++e) { const unsigned wr_ = rc[s][e >> 1], wrp = rp[s][e >> 1], wk_ = kc[s][e >> 1], wkp = kp[s][e >> 1], we_ = e8[s][e >> 1], wa_ = a8[s][e >> 1];
                    const float xr = (e & 1) ? bfh(wr_) : bfl(wr_), xrp = (e & 1) ? bfh(wrp) : bfl(wrp), xk = (e & 1) ? bfh(wk_) : bfl(wk_), xkp = (e & 1) ? bfh(wkp) : bfl(wkp);
                    const float ev = (e & 1) ? bfh(we_) : bfl(we_), a_ = (e & 1) ? bfh(wa_) : bfl(wa_);
                    const float rq = xr + (xrp - xr) * CSTg[32 * s + e], kl = xk + (xkp - xk) * CSTg[64 + 32 * s + e]; const float kk = kl * CSTg[128 + 32 * s + e] * inv;
                    const float kpv = kl * (1.f + (a_ - 1.f) * CSTg[192 + 32 * s + e]), bb = kk * a_; rk += rq * kpv * CSTg[256 + 32 * s + e];
                    float cum = ev;
                    cum += dpp_f<0x111>(cum); cum += dpp_f<0x112>(cum); cum += dpp_f<0x114>(cum); cum += dpp_f<0x118>(cum);
                    const float c7 = dpp_f<0x157>(cum), c15 = dpp_f<0x15F>(cum);
                    const float GGm = __builtin_amdgcn_exp2f(cum - c7), iGm = __builtin_amdgcn_rcpf(GGm), iW = __builtin_amdgcn_exp2f(-ev), Gm = __builtin_amdgcn_exp2f(c7), Dm = __builtin_amdgcn_exp2f(c15 - c7);
                    const float G = GGm * Gm, GpGm = GGm * iW, Gp = GpGm * Gm, iG15 = Dm * iGm;
                    al[e] = Gp * kk; al1[e] = GpGm * kk; be1[e] = bb * iGm; ka1[e] = kpv * iGm; rh[e] = G * rq; rh1[e] = GGm * rq;
                    sth(B2Tg + (32 * s + e) * (SB / 2), bb * iG15); sth(K2Tg + (32 * s + e) * (SB / 2), kpv * iG15);
                    if (n16 == 0) G15g[32 * s + e] = Gm * Dm;
                    asm volatile("" ::: "memory"); }
                A1f[s] = pack8(al1); B1f[s] = pack8(be1); K1f[s] = pack8(ka1); P1f[s] = pack8(rh1);
                { const u32x4 wa = pack8(al), wp = pack8(rh); LAS unsigned char* ra = sl + n16 * SA + (32 * s + 8 * g) * 2;
                  *(LAS u32x2*)(ra + O_AF) = (u32x2){wa.x, wa.y}; *(LAS u32x2*)(ra + O_AF + 8) = (u32x2){wa.z, wa.w}; *(LAS u32x2*)(ra + O_PF) = (u32x2){wp.x, wp.y}; *(LAS u32x2*)(ra + O_PF + 8) = (u32x2){wp.z, wp.w}; } }
            rk += __shfl_xor(rk, 16); rk += __shfl_xor(rk, 32);
            if (g == 0) P.PROJw[m * NP + C_RK + h] = (bf16_t)(pkbf(rk, 0.f) & 0xffffu);
            const f32x4 z4 = {0.f, 0.f, 0.f, 0.f};
            f32x4 Lab = mf(A1f[1], B1f[1], mf(A1f[0], B1f[0], z4)), Lak = mf(A1f[1], K1f[1], mf(A1f[0], K1f[0], z4)), Mrb = mf(P1f[1], B1f[1], mf(P1f[0], B1f[0], z4)), Mrk = mf(P1f[1], K1f[1], mf(P1f[0], K1f[0], z4));
            { int nm = n16, gm = g; asm volatile("" : "+v"(nm), "+v"(gm));
#pragma unroll
              for (int x = 0; x < 4; ++x) { const int j = 4 * gm + x; if (!(j > nm)) { Lab[x] = 0.f; Lak[x] = 0.f; } if (!(j >= nm)) { Mrb[x] = 0.f; Mrk[x] = 0.f; } } }
#pragma unroll
            for (int x = 0; x < 4; ++x) { const int j = 4 * g + x; LAB[j * 16 + n16] = Lab[x]; sth((LAS bf16_t*)(sl + O_LAK) + j * (SB / 2) + n16, Lak[x]); sth((LAS bf16_t*)(sl + O_MRK) + j * (SB / 2) + n16, Mrk[x]); sth((LAS bf16_t*)(sl + O_MRB) + j * (SB / 2) + n16, Mrb[x]); }
            LDS_WAIT();
            { float t[16]; int nl = n16; asm volatile("" : "+v"(nl));
#pragma unroll
              for (int j = 0; j < 16; ++j) { const f32x4 r0 = *(const LAS f32x4*)(LAB + j * 16), r1 = *(const LAS f32x4*)(LAB + j * 16 + 4), r2 = *(const LAS f32x4*)(LAB + j * 16 + 8), r3 = *(const LAS f32x4*)(LAB + j * 16 + 12);
                  const float row[16] = {r0[0], r0[1], r0[2], r0[3], r1[0], r1[1], r1[2], r1[3], r2[0], r2[1], r2[2], r2[3], r3[0], r3[1], r3[2], r3[3]};
                  float acc = (j == nl) ? 1.f : 0.f;
#pragma unroll
                  for (int i = 0; i < 16; ++i) if (i < j) acc -= row[i] * t[i];
                  t[j] = acc; asm volatile("" ::: "memory"); }
              if (g == 0) {
#pragma unroll
                  for (int j = 0; j < 16; ++j) sth((LAS bf16_t*)(sl + O_TT) + j * (SB / 2) + n16, t[j]); } }
            if (c + 24 < NC) CK_LOAD(c + 24);
            const int gi = c >> 2;
            if (gi >= RG) spin_ge(done, (unsigned)(gi - RG + 1), lane, tmo);
            LDS_WAIT();
            unsigned char* dst = ring + (size_t)((gi % RG) * 4 + (c & 3)) * RSLOT;
#pragma unroll
            for (int i = 0; i < RSLOT / 1024; ++i) store_wt(dst + (i * 64 + lane) * 16, *(const LAS u32x4*)(sl + (i * 64 + lane) * 16));
            VM_WAIT();
            if (lane == 0) (void)__hip_atomic_fetch_add(ready + gi, 1u, __ATOMIC_RELAXED, __HIP_MEMORY_SCOPE_AGENT);
            }
        }
#undef CK_LOAD
    } else {
        if (wave < 4) {
            const int c = wave;
            const f32x4 z4 = {0.f, 0.f, 0.f, 0.f};
            f32x4 S32[4]; S32[0] = S32[1] = S32[2] = S32[3] = z4;
            __syncthreads(); __syncthreads();
            for (int gi = 0; gi < NG; ++gi) {
                int n16q_ = n16, gq_ = g; asm volatile("" : "+v"(n16q_), "+v"(gq_));
                { const int n16 = n16q_, g = gq_;
                const LAS unsigned char* fa = lds + (gi & 1) * GB_SZ + n16 * SA + 8 * g;
                const LAS unsigned char* fb = lds + (gi & 1) * GB_SZ + n16 * SB + 8 * g;
                const LAS unsigned char* fg = lds + (gi & 1) * GB_SZ + O_G15 + 16 * g;
                const LAS unsigned char* fv = lds + VT_OFF + (gi & 1) * 4 * VT_SZ + (16 * c + n16) * SB + 8 * g;
                bf16_t* yp = P.PROJw + (rb + gi * 64 + 4 * g) * NP + C_Y + h * 64 + c * 16 + n16;
#pragma unroll
                for (int pc = 0; pc < 4; ++pc) {
                    const LAS unsigned char* a_ = fa + pc * RSLOT; const LAS unsigned char* b_ = fb + pc * RSLOT; const LAS unsigned char* g_ = fg + pc * RSLOT;
                    const u32x2 Vh = *(const LAS u32x2*)(fv + pc * VT_SZ);
                    u32x2 sB[4];
#pragma unroll
                    for (int rt = 0; rt < 4; ++rt) sB[rt] = pack4(S32[rt]);
                    f32x4 Ub = mf16(*(const LAS u32x2*)(b_ + O_LAK), Vh, z4);
#pragma unroll
                    for (int rt = 0; rt < 4; ++rt) Ub = mf16(*(const LAS u32x2*)(a_ + O_AF + 32 * rt), sB[rt], Ub);
                    f32x4 U = mf16(*(const LAS u32x2*)(b_ + O_TT), pack4(Ub), z4); U = -U;
                    const u32x2 Uh = pack4(U);
                    f32x4 Y = mf16(*(const LAS u32x2*)(b_ + O_MRK), Vh, z4);
#pragma unroll
                    for (int rt = 0; rt < 4; ++rt) Y = mf16(*(const LAS u32x2*)(a_ + O_PF + 32 * rt), sB[rt], Y);
                    Y = mf16(*(const LAS u32x2*)(b_ + O_MRB), Uh, Y);
#pragma unroll
                    for (int x = 0; x < 4; ++x) yp[(size_t)(pc * 16 + x) * NP] = (bf16_t)(pkbf(Y[x], 0.f) & 0xffffu);
#pragma unroll
                    for (int rt = 0; rt < 4; ++rt)
                        S32[rt] = mf16(*(const LAS u32x2*)(b_ + O_B2T + 16 * rt * SB), Uh, mf16(*(const LAS u32x2*)(b_ + O_K2T + 16 * rt * SB), Vh, S32[rt] * *(const LAS f32x4*)(g_ + 64 * rt)));
                }
                }
                __syncthreads();
            }
        } else {
            const int lt = tid - 256;
            u32x4 LR[12], LV2[2];
            const int vtok = lt >> 2, vpart = lt & 3;
#define LD_GROUP(gj) do { spin_ge(ready + (gj), 4u, lane, tmo); __builtin_amdgcn_fence(__ATOMIC_ACQUIRE, "agent"); \
                const unsigned char* sg = ring + (size_t)(((gj) % RG) * 4) * RSLOT + lt * 16; \
                _Pragma("unroll") for (int i = 0; i < 12; ++i) LR[i] = *(const u32x4*)(sg + i * 4096); \
                const bf16_t* vp = P.VF + (rb + (gj) * 64 + vtok) * 512 + h * 64 + vpart * 16; LV2[0] = *(const u32x4*)vp; LV2[1] = *(const u32x4*)(vp + 8); } while (0)
#define ST_GROUP(gj) do { LAS unsigned char* db = lds + ((gj) & 1) * GB_SZ + lt * 16; \
                _Pragma("unroll") for (int i = 0; i < 12; ++i) *(LAS u32x4*)(db + i * 4096) = LR[i]; \
                LAS bf16_t* vt = (LAS bf16_t*)(lds + VT_OFF + (((gj) & 1) * 4 + (vtok >> 4)) * VT_SZ) + (vpart * 16) * (SB / 2) + (vtok & 15); \
                _Pragma("unroll") for (int i = 0; i < 8; ++i) { const unsigned w0_ = LV2[0][i >> 1], w1_ = LV2[1][i >> 1]; \
                    vt[i * (SB / 2)] = (bf16_t)((i & 1) ? (w0_ >> 16) : (w0_ & 0xffffu)); vt[(8 + i) * (SB / 2)] = (bf16_t)((i & 1) ? (w1_ >> 16) : (w1_ & 0xffffu)); } } while (0)
            LD_GROUP(0); ST_GROUP(0); LD_GROUP(1);
            __syncthreads(); __syncthreads();
            for (int gi = 0; gi < NG; ++gi) {
                if (gi + 1 < NG) ST_GROUP(gi + 1);
                if (gi + 2 < NG) LD_GROUP(gi + 2);
                __syncthreads();
                if (tid == 256) __hip_atomic_store(done, (unsigned)min(gi + 2, NG), __ATOMIC_RELAXED, __HIP_MEMORY_SCOPE_AGENT);
            }
#undef LD_GROUP
#undef ST_GROUP
        }
    }
    __syncthreads();
}

__device__ __forceinline__ void ph_scan_naive(const ScanP& P, int gw, int NGW, int lane) {
    for (int task = gw; task < 4096; task += NGW) { const int b = task >> 9, h = (task >> 6) & 7, row = task & 63; const int ch = h * 64 + lane;
        const float mur = P.mu_r[ch], muk = P.mu_k[ch], kkp = P.k_k[ch], kap = P.k_a[ch], rkp = P.r_k[ch];
        float S = 0.f, rprev = 0.f, kprev = 0.f;
        for (int t = 0; t < T; ++t) { const size_t m = (size_t)b * 4096 + t;
            const float rc = bf1(P.PROJ[m * NP + C_R + ch]), kc = bf1(P.PROJ[m * NP + C_K + ch]);
            const float r = rc + (rprev - rc) * mur, kl = kc + (kprev - kc) * muk; rprev = rc; kprev = kc;
            const float a = pg8::sigmoidf_((float)P.A[m * 512 + ch]); const float dec = __expf(-0.60653065971f * pg8::sigmoidf_((float)P.E[m * 512 + ch]));
            const float kkv = kl * kkp; const float ss = wave_sum(kkv * kkv); const float kk = kkv / fmaxf(sqrtf(ss), 1e-12f);
            const float kp = kl * (1.f + (a - 1.f) * kap); const float v = bf1(P.VF[m * 512 + h * 64 + row]);
            const float sk = wave_sum(S * kk); S = S * dec - sk * kk * a + v * kp; const float y = wave_sum(S * r);
            if (lane == 0) P.PROJw[m * NP + C_Y + h * 64 + row] = (bf16_t)(pkbf(y, 0.f) & 0xffffu);
            if (row == 0) { const float rk = wave_sum(r * kp * rkp); if (lane == 0) P.PROJw[m * NP + C_RK + h] = (bf16_t)(pkbf(rk, 0.f) & 0xffffu); } } }
}

__device__ __forceinline__ void ph_rwkv_post(const bf16_t* PROJ, const bf16_t* VF, bf16_t* MIX, const float* lnx_g, const float* lnx_b, int gw, int NGW, int lane) {
    float lg[8], lb[8];
#pragma unroll
    for (int i = 0; i < 8; ++i) { lg[i] = lnx_g[lane * 8 + i]; lb[i] = lnx_b[lane * 8 + i]; }
    for (int m = gw; m < M; m += NGW) {
        const u32x4 y8 = *(const u32x4*)(PROJ + (size_t)m * NP + C_Y + lane * 8), v8 = *(const u32x4*)(VF + (size_t)m * 512 + lane * 8), g8 = *(const u32x4*)(MIX + (size_t)m * D + lane * 8);
        const float rk = bf1(PROJ[(size_t)m * NP + C_RK + (lane >> 3)]);
        float y[8]; float s = 0.f;
#pragma unroll
        for (int i = 0; i < 4; ++i) { y[2 * i] = bfl(y8[i]); y[2 * i + 1] = bfh(y8[i]); s += y[2 * i] + y[2 * i + 1]; }
        const float mean = allsum8(s) * (1.f / 64.f); float q = 0.f;
#pragma unroll
        for (int i = 0; i < 8; ++i) { y[i] -= mean; q += y[i] * y[i]; }
        const float rstd = rsqrtf(allsum8(q) * (1.f / 64.f) + 64e-5f);
        float o[8];
#pragma unroll
        for (int i = 0; i < 8; ++i) { const float vv = (i & 1) ? bfh(v8[i >> 1]) : bfl(v8[i >> 1]), gg = (i & 1) ? bfh(g8[i >> 1]) : bfl(g8[i >> 1]);
            o[i] = (y[i] * rstd * lg[i] + lb[i] + rk * vv) * gg; }
        u32x4 w; w.x = pkbf(o[0], o[1]); w.y = pkbf(o[2], o[3]); w.z = pkbf(o[4], o[5]); w.w = pkbf(o[6], o[7]);
        *(u32x4*)(MIX + (size_t)m * D + lane * 8) = w;
    }
}

#ifndef MK_PER_PHASE
#define MK_PER_PHASE 0
#endif
constexpr int N_PHASES = 22;
struct Args { const float* in[32]; float* out; unsigned char* ws; int ph_lo, ph_hi, li, pad; };
__device__ __forceinline__ int opq(int k) { asm volatile("" : "+s"(k)); return k; }
#define INP(k) ((const float*)(const GAS float*)args.in[opq(k)])
#define WSP(T_, off) ((T_*)(wsl + (off)))
#define LAUNDER_WS() GAS unsigned char* wsl = (GAS unsigned char*)args.ws; asm volatile("" : "+s"(wsl)); GAS float* Xg = (GAS float*)Xp_; asm volatile("" : "+s"(Xg)); float* X = (float*)Xg; (void)X; int wave = wave_s; asm volatile("" : "+s"(wave)); \
    unsigned ones_ = ~0u; asm volatile("" : "+s"(ones_)); int tid = wave * 64 + (int)__builtin_amdgcn_mbcnt_hi(ones_, __builtin_amdgcn_mbcnt_lo(ones_, 0u)); asm volatile("" : "+v"(tid)); int G = gridDim.x, bx = blockIdx.x; asm volatile("" : "+s"(G), "+s"(bx)); \
    const int lane = tid & 63; const int vcu = (G % 8 == 0) ? (bx % 8) * (G / 8) + bx / 8 : bx; const int gw = vcu * NWAVES + wave, NGW = G * NWAVES; (void)lane; (void)gw; (void)NGW; (void)vcu
#ifndef PH_MASK
#define PH_MASK 0xFFFFu
#endif
#define PHBIT(k) ((k) == 0 ? 0 : ((k) == 21 ? 11 : (((k) - 1) % 10) + 1))
#define IN(k) (((PH_MASK >> PHBIT(k)) & 1u) && lo <= (k) && (k) < hi)
#ifndef DUP_MASK
#define DUP_MASK 0
#endif
#define DUPN(j) for (int rep_ = 0; rep_ < (int)((DUP_MASK >> (j)) & 1) + 1; ++rep_)
#define SEAM(k) do { if (IN(k) && IN((k) + 1)) { XcdBarrier b2_ = bar; asm volatile("" : "+s"(b2_.bar), "+s"(b2_.x)); xcd_barrier(b2_); } } while (0)
template <int l> __device__ __forceinline__ void layer_body(const Args& args, LAS unsigned char* lds, const XcdBarrier& bar, float* Xp_, const int lo, const int hi, const int wave_s) {
        const int pb = 1 + 10 * l;
        if (IN(pb + 0)) DUPN(0) { LAUNDER_WS();
            WPtrs P; P.w_in = INP(6); P.decay_a = INP(10); P.iclr_a = INP(13); P.gate_a = INP(15); P.vres_a = INP(24); P.mu_lora = INP(8); P.vres_mu = INP(22);
            P.w_out = INP(28); P.w1 = INP(29); P.w2 = INP(30); P.decay_b = INP(11); P.iclr_b = INP(14); P.gate_b = INP(16); P.vres_b = INP(25);
            if (l != 0) ph_weights(P, l, (unsigned char*)wsl, lds, vcu, G, tid);
            const float* MODl = WSP(float, WS_MOD) + (size_t)l * 8 * 6144;
            ph_norm((l == 0) ? INP(0) : (const float*)X, INP(4) + (size_t)l * D, MODl + 0 * D, MODl + 1 * D, WSP(bf16_t, WS_H), gw, NGW, lane);
        }
        SEAM(pb + 0);
        if (IN(pb + 1)) DUPN(1) { LAUNDER_WS();
            pg8::Gemm g{WSP(bf16_t, WS_H), WSP(bf16_t, WS_WIN), M, NP, D, D, D}; pg8::StaticOrder S; S.init(M, NP, G, bx);
            pg8::EpiBf<0> E{WSP(bf16_t, WS_PROJ), NP, C_QA / 256, C_KA / 256, att::C2};
            pg8::gemm_phase<pg8::EpiBf<0>, pg8::StaticOrder, true, true>(lds, g, S, E, tid);
        }
        SEAM(pb + 1);
        if (IN(pb + 2)) DUPN(2) { LAUNDER_WS();
            for (int rep_l = 0; rep_l < (int)((DUP_MASK >> 12) & 1) + 1; ++rep_l)
            ph_lora_act(WSP(bf16_t, WS_PROJ), WSP(bf16_t, WS_LACT), WSP(bf16_t, WS_VF), INP(7) + (size_t)(l * 3 + 2) * 512, l == 0, gw, NGW, lane);
            ph_select(WSP(bf16_t, WS_PROJ), WSP(unsigned long long, WS_MASK), lds, vcu, G, tid);
        }
        SEAM(pb + 2);
        if (IN(pb + 3)) {
            DUPN(3) { LAUNDER_WS(); pg8::Gemm g{WSP(bf16_t, WS_LACT), WSP(bf16_t, WS_LW), M, 1024, 128, LA, 128}; pg8::StaticOrder S; S.init(M, 1024, G, bx);
              pg8::EpiDecIclr E{WSP(_Float16, WS_H), WSP(_Float16, WS_H + 32 * MiB), INP(9) + (size_t)l * 512, INP(12) + (size_t)l * 512};
              pg8::gemm_phase<pg8::EpiDecIclr, pg8::StaticOrder, true, true>(lds, g, S, E, tid); }
            __syncthreads();
            DUPN(3) { LAUNDER_WS(); pg8::Gemm g{WSP(bf16_t, WS_LACT) + 128, WSP(bf16_t, WS_LW) + 1024 * 128, M, 512, 128, LA, 128}; pg8::StaticOrder S; S.init(M, 512, G, bx);
              pg8::EpiBf<0> E{WSP(bf16_t, WS_MIX), D, 0, 0, 1.f};
              pg8::gemm_phase<pg8::EpiBf<0>, pg8::StaticOrder, true, true>(lds, g, S, E, tid); }
            __syncthreads();
            if (l >= 1) { LAUNDER_WS(); pg8::Gemm g{WSP(bf16_t, WS_LACT) + 256, WSP(bf16_t, WS_LW) + 1536 * 128, M, 512, 128, LA, 128}; pg8::StaticOrder S; S.init(M, 512, G, bx);
              pg8::EpiVres E{WSP(bf16_t, WS_PROJ) + C_V, NP, WSP(bf16_t, WS_VF), INP(23) + (size_t)(l - 1) * 512, INP(7) + (size_t)(l * 3 + 2) * 512};
              pg8::gemm_phase<pg8::EpiVres, pg8::StaticOrder, true, true>(lds, g, S, E, tid); }
        }
        SEAM(pb + 3);
        if (IN(pb + 4)) {
            DUPN(4) { LAUNDER_WS();
              ScanP P; P.PROJ = WSP(bf16_t, WS_PROJ); P.PROJw = WSP(bf16_t, WS_PROJ); P.E = WSP(_Float16, WS_H); P.A = WSP(_Float16, WS_H + 32 * MiB); P.VF = WSP(bf16_t, WS_VF);
              P.mu_r = INP(7) + (size_t)(l * 3 + 0) * 512; P.mu_k = INP(7) + (size_t)(l * 3 + 1) * 512;
              P.k_k = INP(17) + (size_t)l * 512; P.k_a = INP(18) + (size_t)l * 512; P.r_k = INP(19) + (size_t)l * 512;
#if defined(SCAN_SHARE)
              if (G == 256) scan_unit_share(P, vcu >> 5, (vcu >> 2) & 7, vcu & 3, lds, tid, WSP(unsigned char, WS_LACT), WSP(unsigned, WS_CTL) + sck2::CW_SCAN + l * sck2::CW_SCAN_LAYER);
              else for (int u = vcu; u < 256; u += G) scan_unit_chunk(P, u >> 5, (u >> 2) & 7, u & 3, lds, tid); }
#elif defined(SCAN_CHUNK)
              for (int u = vcu; u < 256; u += G) scan_unit_chunk(P, u >> 5, (u >> 2) & 7, u & 3, lds, tid); }
#elif defined(SCAN_FAST)
              for (int u = vcu; u < 256; u += G) scan_unit(P, u >> 5, (u >> 2) & 7, u & 3, lds, tid); }
#else
              ph_scan_naive(P, gw, NGW, lane); }
#endif
            __syncthreads();
            DUPN(11) { LAUNDER_WS();
              att::build_bias_table(INP(27), (LAS char*)lds, tid);
              __syncthreads();
              const float* gain = INP(26) + (size_t)l * 512;
              for (int v = vcu; v < 256; v += G) { const int bh = v >> 2, s = v & 3;
                  for (int i = 0; i < 4; ++i) { const int qb = (i == 0) ? s : (i == 1) ? 7 - s : (i == 2) ? 8 + s : 15 - s;
                      att::attn_unit(bh >> 3, bh & 7, qb, WSP(bf16_t, WS_PROJ), WSP(unsigned long long, WS_MASK), WSP(bf16_t, WS_MIX), gain, (LAS char*)lds, tid); } } }
        }
        SEAM(pb + 4);
        if (IN(pb + 5)) { LAUNDER_WS(); ph_rwkv_post(WSP(bf16_t, WS_PROJ), WSP(bf16_t, WS_VF), WSP(bf16_t, WS_MIX), INP(20) + (size_t)l * 512, INP(21) + (size_t)l * 512, gw, NGW, lane); }
        SEAM(pb + 5);
        if (IN(pb + 6)) { LAUNDER_WS();
            pg8::Gemm g{WSP(bf16_t, WS_MIX), WSP(bf16_t, WS_WOUT), M, D, D, D, D}; pg8::StaticOrder S; S.init(M, D, G, bx);
            pg8::EpiResid E{(l == 0) ? INP(0) : (const float*)X, X, WSP(float, WS_MOD) + (size_t)l * 8 * 6144 + 2 * D, D};
            pg8::gemm_phase<pg8::EpiResid, pg8::StaticOrder, true, true>(lds, g, S, E, tid);
        }
        SEAM(pb + 6);
        if (IN(pb + 7)) DUPN(7) { LAUNDER_WS(); const float* MODl = WSP(float, WS_MOD) + (size_t)l * 8 * 6144;
            ph_norm(X, INP(5) + (size_t)l * D, MODl + 3 * D, MODl + 4 * D, WSP(bf16_t, WS_H), gw, NGW, lane); }
        SEAM(pb + 7);
        if (IN(pb + 8)) DUPN(8) { LAUNDER_WS();
            pg8::Gemm g{WSP(bf16_t, WS_H), WSP(bf16_t, WS_W1), M, FF, D, D, D}; pg8::StaticOrder S; S.init(M, FF, G, bx);
            pg8::EpiBf<1> E{WSP(bf16_t, WS_PROJ), FF, 0, 0, 1.f};
            pg8::gemm_phase<pg8::EpiBf<1>, pg8::StaticOrder, true, true>(lds, g, S, E, tid);
        }
        SEAM(pb + 8);
        if (IN(pb + 9)) { LAUNDER_WS();
            pg8::Gemm g{WSP(bf16_t, WS_PROJ), WSP(bf16_t, WS_W2), M, D, FF, FF, FF}; pg8::StaticOrder S; S.init(M, D, G, bx);
            pg8::EpiResid E{X, X, WSP(float, WS_MOD) + (size_t)l * 8 * 6144 + 5 * D, D};
            pg8::gemm_phase<pg8::EpiResid, pg8::StaticOrder, true, true>(lds, g, S, E, tid);
        }
        SEAM(pb + 9);
}
__global__ void __launch_bounds__(NWAVES * 64, 2) trunk_fwd(Args args) {
    extern __shared__ __attribute__((aligned(16))) unsigned char lds_raw[];
    LAS unsigned char* lds = (LAS unsigned char*)lds_raw;
    volatile LAS unsigned* MISC = (volatile LAS unsigned*)(lds + MISC_OFF);
    unsigned* ctl = (unsigned*)(args.ws + WS_CTL);
    for (int u = threadIdx.x; u < (LDS_BYTES - LDSCTL_OFF) / 4; u += NWAVES * 64) ((LAS unsigned*)(lds + LDSCTL_OFF))[u] = 0u;
    __syncthreads();
    XcdBarrier bar = xcd_barrier_post(ctl + CW_BAR + args.li * XCD_BAR_WORDS, MISC + 8);
    const int lo = args.ph_lo, hi = args.ph_hi; const int wave_s = __builtin_amdgcn_readfirstlane((int)threadIdx.x >> 6);
    float* Xp_ = args.out;

    if (IN(0)) { LAUNDER_WS(); ph_mod(INP(1), INP(2), INP(3), WSP(float, WS_MOD), lds, vcu, G, tid);
        WPtrs P; P.w_in = INP(6); P.decay_a = INP(10); P.iclr_a = INP(13); P.gate_a = INP(15); P.vres_a = INP(24); P.mu_lora = INP(8); P.vres_mu = INP(22);
        P.w_out = INP(28); P.w1 = INP(29); P.w2 = INP(30); P.decay_b = INP(11); P.iclr_b = INP(14); P.gate_b = INP(16); P.vres_b = INP(25);
        __syncthreads();
        ph_weights(P, 0, (unsigned char*)wsl, lds, vcu, G, tid); }
    SEAM(0);

    layer_body<0>(args, lds, bar, Xp_, lo, hi, wave_s);
    layer_body<1>(args, lds, bar, Xp_, lo, hi, wave_s);
    if (IN(21)) { LAUNDER_WS(); (void)wsl; ph_final_norm(X, INP(31), gw, NGW, lane); }
#undef IN
#undef SEAM
}

extern "C" void kernel_launch(void* const* d_in, const int* in_sizes, int n_in, void* d_out, int out_size, void* d_ws, size_t ws_size, hipStream_t stream) {
    static int grid = 0;
    if (grid == 0) {
        if (n_in != 32 || in_sizes[0] != M * D || out_size != M * D || ws_size < WS_END) { fprintf(stderr, "kernel_launch: unexpected problem: n_in %d in0 %d out %d ws %zu (need %zu)\n", n_in, n_in > 0 ? in_sizes[0] : -1, out_size, ws_size, (size_t)WS_END); grid = -1; return; }
        int dev = 0, cus = 0, per_cu = 0;
        if (hipGetDevice(&dev) != hipSuccess || hipDeviceGetAttribute(&cus, hipDeviceAttributeMultiprocessorCount, dev) != hipSuccess) { grid = -1; return; }
        if (hipFuncSetAttribute((const void*)trunk_fwd, hipFuncAttributeMaxDynamicSharedMemorySize, LDS_BYTES) != hipSuccess) { fprintf(stderr, "kernel_launch: hipFuncSetAttribute failed\n"); grid = -1; return; }
        if (hipOccupancyMaxActiveBlocksPerMultiprocessor(&per_cu, (const void*)trunk_fwd, NWAVES * 64, LDS_BYTES) != hipSuccess || per_cu < 1) { fprintf(stderr, "kernel_launch: occupancy query reports %d workgroups per CU\n", per_cu); }
        (void)hipGetLastError();
        grid = cus;
        if (grid > 256) grid = 256;
    }
    if (grid < 0) return;
    if (hipMemsetAsync((char*)d_ws + WS_CTL, 0, CTL_ZERO_BYTES, stream) != hipSuccess) return;
    Args a{};
    for (int i = 0; i < 32; ++i) a.in[i] = (const float*)d_in[i];
    a.out = (float*)d_out; a.ws = (unsigned char*)d_ws; a.pad = 0;
#if MK_PER_PHASE
    for (int p = 0; p < N_PHASES; ++p) { a.ph_lo = p; a.ph_hi = p + 1; a.li = 0;
        hipLaunchKernelGGL(trunk_fwd, dim3(grid), dim3(NWAVES * 64), LDS_BYTES, stream, a); }
#else
    a.ph_lo = 0; a.ph_hi = N_PHASES; a.li = 0;
    hipLaunchKernelGGL(trunk_fwd, dim3(grid), dim3(NWAVES * 64), LDS_BYTES, stream, a);
#endif
}
```

```cpp
#define SCAN_FAST 1
#define SCAN_CHUNK 1
#define SCAN_SHARE 1
#include <hip/hip_runtime.h>
#include <hip/hip_bf16.h>
#include <cstdio>
#include <cstdint>
#include <cmath>
namespace pg8 {
#define PG8_LAS __attribute__((address_space(3)))
typedef unsigned short bf16_t;
typedef short bf16x8 __attribute__((ext_vector_type(8)));
typedef float f32x4 __attribute__((ext_vector_type(4)));
typedef unsigned u32x4 __attribute__((ext_vector_type(4)));
constexpr int BM = 256, BK = 64, HALF = 128, HTB = HALF * BK * 2  , STAGE_BYTES = 8 * HTB, NXCD = 8, WGM = 8;

__host__ __device__ __forceinline__ int lds_byte(int r, int c) { const int st = (r >> 4) * 2 + (c >> 5), rr = r & 15, cc = c & 31, ob = rr * 64 + cc * 2; return st * 1024 + (ob ^ (((ob >> 9) & 1) << 5)); }
__host__ __device__ __forceinline__ void stage_rc(int b, int& R, int& C) { const int st = b / 1024, sb = b % 1024, swz = sb ^ (((sb >> 9) & 1) << 5); R = (st >> 1) * 16 + swz / 64; C = (st & 1) * 32 + (swz % 64) / 2; }
__host__ __device__ __forceinline__ int perm32(int rho) { const int n = rho >> 4, i = rho & 15; return 8 * (i >> 2) + 4 * n + (i & 3); }

struct Unit { int pm, pn; };
struct Gemm { const bf16_t* A; const bf16_t* Bt; int M, N, K, lda, ldb; };

struct StaticOrder {
    int nM, nN, nwg, G, c;
    __host__ __device__ void init(int M, int N, int G_, int c_) { nM = M / BM; nN = N / BM; nwg = nM * nN; G = G_; c = c_; }
    __host__ __device__ bool next(int i, Unit& u) const {
        const long L = (long)i * G + c; if (L >= nwg) return false;
        int wgid = (int)L; { const int q = nwg / NXCD, r = nwg % NXCD, xcd = wgid % NXCD, off = wgid / NXCD; wgid = (xcd < r ? xcd * (q + 1) : r * (q + 1) + (xcd - r) * q) + off; }
        const int nig = WGM * nN, gid = wgid / nig, fm = gid * WGM, gsz = (nM - fm) < WGM ? (nM - fm) : WGM;
        u.pm = fm + ((wgid % nig) % gsz); u.pn = (wgid % nig) / gsz; return true;
    }
    __device__ __forceinline__ void a_ready(const Unit&) const {}
    __device__ __forceinline__ void done(const Unit&) const {}
};

typedef _Float16 f16x2_t __attribute__((ext_vector_type(2)));
typedef _Float16 half8 __attribute__((ext_vector_type(8)));
__device__ __forceinline__ unsigned cvt_pk_bf16(float lo, float hi) { f16x2_t h = {(_Float16)lo, (_Float16)hi}; return __builtin_bit_cast(unsigned, h); }
__device__ __forceinline__ unsigned cvt_pk_f16(float lo, float hi) { f16x2_t h = {(_Float16)lo, (_Float16)hi}; return __builtin_bit_cast(unsigned, h); }
__device__ __forceinline__ float bf_lo(unsigned w) { return (float)__builtin_bit_cast(_Float16, (unsigned short)(w & 0xffffu)); }
__device__ __forceinline__ float bf_hi(unsigned w) { return (float)__builtin_bit_cast(_Float16, (unsigned short)(w >> 16)); }
__device__ __forceinline__ float sigmoidf_(float x) { return __builtin_amdgcn_rcpf(1.0f + __expf(-x)); }

template <int MODE> struct EpiBf {
    static constexpr bool PERM = true, AFTER_DRAIN = false;
    bf16_t* O; int ldc; int qlo, qhi; float qscale;
    __device__ __forceinline__ void operator()(const f32x4 (&acc)[2][2][4][2], const Unit& u, int wr, int wc, int fr, int fq) const {
        const int row0 = u.pm * BM + wr * 64 + fr, col0 = u.pn * BM + wc * 32 + 8 * fq;
        const float sc = (MODE == 0 && u.pn >= qlo && u.pn < qhi) ? qscale : 1.f;
#pragma unroll
        for (int ai = 0; ai < 2; ++ai)
#pragma unroll
            for (int m = 0; m < 4; ++m) { bf16_t* rowp = O + (size_t)(row0 + ai * HALF + m * 16) * ldc + col0;
#pragma unroll
                for (int bj = 0; bj < 2; ++bj) { f32x4 v0 = acc[ai][bj][m][0], v1 = acc[ai][bj][m][1];
                    if (MODE == 1) { v0 = __builtin_elementwise_max(v0, (f32x4){0.f, 0.f, 0.f, 0.f}); v1 = __builtin_elementwise_max(v1, (f32x4){0.f, 0.f, 0.f, 0.f}); v0 = v0 * v0; v1 = v1 * v1; }
                    else { v0 = v0 * sc; v1 = v1 * sc; }
                    u32x4 w; w.x = cvt_pk_bf16(v0[0], v0[1]); w.y = cvt_pk_bf16(v0[2], v0[3]); w.z = cvt_pk_bf16(v1[0], v1[1]); w.w = cvt_pk_bf16(v1[2], v1[3]);
                    *(u32x4*)(rowp + bj * HALF) = w; } }
    }
};
struct EpiResid {
    static constexpr bool PERM = false, AFTER_DRAIN = false;
    const float* base; float* out; const float* gate; int ldc;
    __device__ __forceinline__ void operator()(const f32x4 (&acc)[2][2][4][2], const Unit& u, int wr, int wc, int fr, int fq) const {
        const int row0 = u.pm * BM + wr * 64 + fr, col0 = u.pn * BM + wc * 32 + 4 * fq;
        const float* gp = gate + (size_t)((u.pm * BM) >> 12) * 6144 + col0;
#pragma unroll
        for (int bj = 0; bj < 2; ++bj)
#pragma unroll
            for (int n = 0; n < 2; ++n) { const f32x4 gv = *(const f32x4*)(gp + bj * HALF + n * 16);
#pragma unroll
                for (int ai = 0; ai < 2; ++ai)
#pragma unroll
                    for (int m = 0; m < 4; ++m) { const size_t off = (size_t)(row0 + ai * HALF + m * 16) * ldc + col0 + bj * HALF + n * 16;
                        const f32x4 bs = *(const f32x4*)(base + off); *(f32x4*)(out + off) = bs + gv * acc[ai][bj][m][n]; } }
    }
};
struct EpiDecIclr {
    static constexpr bool PERM = true, AFTER_DRAIN = false;
    _Float16* E; _Float16* A; const float* w0; const float* a0;
    __device__ __forceinline__ void operator()(const f32x4 (&acc)[2][2][4][2], const Unit& u, int wr, int wc, int fr, int fq) const {
        asm volatile("" : "+v"(fr), "+v"(fq));
        const int row0 = u.pm * BM + wr * 64 + fr; const int kind = u.pn >> 1; const int c0 = (u.pn & 1) * BM + wc * 32 + 8 * fq;
        _Float16* O = kind ? A : E; const float* bp = kind ? a0 : w0;
#pragma unroll
        for (int bj = 0; bj < 2; ++bj) { const f32x4 bv0 = *(const f32x4*)(bp + c0 + bj * HALF), bv1 = *(const f32x4*)(bp + c0 + bj * HALF + 4);
#pragma unroll
            for (int ai = 0; ai < 2; ++ai)
#pragma unroll
                for (int m = 0; m < 4; ++m) { _Float16* rowp = O + (size_t)(row0 + ai * HALF + m * 16) * 512 + c0 + bj * HALF;
                    f32x4 v0 = acc[ai][bj][m][0] + bv0, v1 = acc[ai][bj][m][1] + bv1;
#ifdef SCAN_CHUNK
                    const float mul_ = kind ? 1.0f : (-0.60653065971f * 1.4426950408889634f);
                    unsigned wx, wy, wz, ww;
                    asm volatile("" : "+v"(v0));
                    wx = cvt_pk_f16(mul_ * sigmoidf_(v0[0]), mul_ * sigmoidf_(v0[1])); wy = cvt_pk_f16(mul_ * sigmoidf_(v0[2]), mul_ * sigmoidf_(v0[3]));
                    asm volatile("" : "+v"(wx), "+v"(wy), "+v"(v1));
                    wz = cvt_pk_f16(mul_ * sigmoidf_(v1[0]), mul_ * sigmoidf_(v1[1])); ww = cvt_pk_f16(mul_ * sigmoidf_(v1[2]), mul_ * sigmoidf_(v1[3]));
                    asm volatile("" : "+v"(wz), "+v"(ww));
                    u32x4 w; w.x = wx; w.y = wy; w.z = wz; w.w = ww;
#else
                    u32x4 w; w.x = cvt_pk_f16(v0[0], v0[1]); w.y = cvt_pk_f16(v0[2], v0[3]); w.z = cvt_pk_f16(v1[0], v1[1]); w.w = cvt_pk_f16(v1[2], v1[3]);
#endif
                    *(u32x4*)rowp = w; asm volatile("" ::: "memory"); } }
    }
};
struct EpiVres {
    static constexpr bool PERM = true, AFTER_DRAIN = false;
    const bf16_t* PV; int ldp; bf16_t* VF; const float* v0; const float* muv;
    __device__ __forceinline__ void operator()(const f32x4 (&acc)[2][2][4][2], const Unit& u, int wr, int wc, int fr, int fq) const {
        const int row0 = u.pm * BM + wr * 64 + fr; const int c0 = u.pn * BM + wc * 32 + 8 * fq;
#pragma unroll
        for (int bj = 0; bj < 2; ++bj) { const int c = c0 + bj * HALF;
            float b8[8], m8[8];
#pragma unroll
            for (int i = 0; i < 8; ++i) { b8[i] = v0[c + i]; m8[i] = muv[c + i]; }
#pragma unroll
            for (int ai = 0; ai < 2; ++ai)
#pragma unroll
                for (int m = 0; m < 4; ++m) { const int row = row0 + ai * HALF + m * 16;
                    const u32x4 vc = *(const u32x4*)(PV + (size_t)row * ldp + c);
                    u32x4 vp = (u32x4){0u, 0u, 0u, 0u}; if ((row & 4095) != 0) vp = *(const u32x4*)(PV + (size_t)(row - 1) * ldp + c);
                    const u32x4 vf = *(const u32x4*)(VF + (size_t)row * 512 + c);
                    float o[8];
#pragma unroll
                    for (int i = 0; i < 8; ++i) { const unsigned wc_ = vc[i >> 1], wp_ = vp[i >> 1], wf_ = vf[i >> 1];
                        const float xc = (i & 1) ? bf_hi(wc_) : bf_lo(wc_), xp = (i & 1) ? bf_hi(wp_) : bf_lo(wp_), xf = (i & 1) ? bf_hi(wf_) : bf_lo(wf_);
                        const float a = (i < 4) ? acc[ai][bj][m][0][i & 3] : acc[ai][bj][m][1][i & 3];
                        const float vl = xc + (xp - xc) * m8[i]; const float g = sigmoidf_(b8[i] + a); o[i] = vl + (xf - vl) * g; }
                    u32x4 w; w.x = cvt_pk_bf16(o[0], o[1]); w.y = cvt_pk_bf16(o[2], o[3]); w.z = cvt_pk_bf16(o[4], o[5]); w.w = cvt_pk_bf16(o[6], o[7]);
                    *(u32x4*)(VF + (size_t)row * 512 + c) = w; asm volatile("" ::: "memory"); } }
    }
};

template <class Epi, class Sched, bool ALIGN_EPI = false, bool SP2 = false>
__device__ __forceinline__ void gemm_phase(PG8_LAS unsigned char* lds, const Gemm g, const Sched& S, const Epi& E, const int tid) {
    const int wid = __builtin_amdgcn_readfirstlane(tid >> 6), lane = tid & 63, wr = wid >> 2, wc = wid & 3, fr = lane & 15, fq = lane >> 4;
    const int K = g.K, nt = K / BK;
    unsigned voffA[2], voffB[2];
#pragma unroll
    for (int i = 0; i < 2; ++i) { int R, C; stage_rc(tid * 16 + i * 8192, R, C); const int Rb = Epi::PERM ? ((R & ~31) + perm32(R & 31)) : R;
        voffA[i] = (unsigned)(R * g.lda + C) * 2u; voffB[i] = (unsigned)(Rb * g.ldb + C) * 2u; }
    const size_t kstep = (size_t)(BK * 2);
    const size_t hstepA = (size_t)HALF * g.lda * 2, hstepB = (size_t)HALF * g.ldb * 2;
    const size_t tstepA = 2 * hstepA, tstepB = 2 * hstepB;
    const unsigned ldsw = (unsigned)wid * 1024u;
    const int aoff = lds_byte(wr * 64 + fr, fq * 8), boff = lds_byte(wc * 32 + fr, fq * 8);
#define PG8_SA(b, h) (((b) * 2 + (h)) * HTB)
#define PG8_SB(b, h) ((4 + (b) * 2 + (h)) * HTB)
#define PG8_STAGE(bufoff, gbase, voff) do { _Pragma("unroll") for (int _i = 0; _i < 2; ++_i) \
        __builtin_amdgcn_global_load_lds((const unsigned*)((const char*)(gbase) + (voff)[_i]), (PG8_LAS unsigned*)(lds + (bufoff) + ldsw + _i * 8192), 16, 0, 0); } while (0)
#define PG8_LDA(dst, b, h) do { _Pragma("unroll") for (int m = 0; m < 4; ++m) _Pragma("unroll") for (int k = 0; k < 2; ++k) dst[m][k] = *(const PG8_LAS bf16x8*)(lds + PG8_SA(b, h) + aoff + m * 2048 + k * 1024); } while (0)
#define PG8_LDB(dst, b, h) do { _Pragma("unroll") for (int n = 0; n < 2; ++n) _Pragma("unroll") for (int k = 0; k < 2; ++k) dst[n][k] = *(const PG8_LAS bf16x8*)(lds + PG8_SB(b, h) + boff + n * 2048 + k * 1024); } while (0)
#define PG8_MMA(ai, bj, At, Bt) do { __builtin_amdgcn_s_setprio(1); _Pragma("unroll") for (int m = 0; m < 4; ++m) _Pragma("unroll") for (int n = 0; n < 2; ++n) _Pragma("unroll") for (int k = 0; k < 2; ++k) \
        acc[ai][bj][m][n] = __builtin_amdgcn_mfma_f32_16x16x32_f16(__builtin_bit_cast(half8, Bt[n][k]), __builtin_bit_cast(half8, At[m][k]), acc[ai][bj][m][n], 0, 0, 0); __builtin_amdgcn_s_setprio(0); } while (0)
#define PG8_WAIT_V(n) asm volatile("s_waitcnt vmcnt(" #n ")" ::: "memory")
#define PG8_WAIT_L(n) asm volatile("s_waitcnt lgkmcnt(" #n ")" ::: "memory")
#define PG8_BAR __builtin_amdgcn_s_barrier()
#define PG8_SCHED __builtin_amdgcn_sched_barrier(0)
    Unit cur, nxt; int ui = 0;
    if (!S.next(0, cur)) return;
    f32x4 acc[2][2][4][2];
#pragma unroll
    for (int a = 0; a < 2; ++a)
#pragma unroll
        for (int b = 0; b < 2; ++b)
#pragma unroll
            for (int m = 0; m < 4; ++m)
#pragma unroll
                for (int n = 0; n < 2; ++n) acc[a][b][m][n] = (f32x4){0.f, 0.f, 0.f, 0.f};
    bf16x8 At[4][2], B0[2][2], B1[2][2];
    const char* cA = (const char*)g.A + (size_t)cur.pm * tstepA; const char* cB = (const char*)g.Bt + (size_t)cur.pn * tstepB;
    S.a_ready(cur);
    if constexpr (SP2) {
        PG8_STAGE(PG8_SB(0, 0), cB, voffB); PG8_STAGE(PG8_SB(0, 1), cB + hstepB, voffB); PG8_STAGE(PG8_SA(0, 0), cA, voffA); PG8_STAGE(PG8_SA(0, 1), cA + hstepA, voffA);
        if (wr == 1) PG8_BAR;
        PG8_WAIT_V(2); PG8_BAR;
        PG8_STAGE(PG8_SB(1, 0), cB + kstep, voffB); PG8_STAGE(PG8_SA(1, 0), cA + kstep, voffA); PG8_STAGE(PG8_SB(1, 1), cB + hstepB + kstep, voffB);
        PG8_WAIT_V(6); PG8_BAR;
    } else {
        PG8_STAGE(PG8_SB(0, 0), cB, voffB); PG8_STAGE(PG8_SA(0, 0), cA, voffA); PG8_STAGE(PG8_SB(0, 1), cB + hstepB, voffB); PG8_STAGE(PG8_SA(0, 1), cA + hstepA, voffA);
        if (wr == 1) PG8_BAR;
        PG8_WAIT_V(4); PG8_BAR;
        PG8_STAGE(PG8_SB(1, 0), cB + kstep, voffB); PG8_STAGE(PG8_SA(1, 0), cA + kstep, voffA); PG8_STAGE(PG8_SB(1, 1), cB + hstepB + kstep, voffB);
        PG8_WAIT_V(6); PG8_BAR;
    }
    for (;;) {
        const bool has_next = S.next(ui + 1, nxt);
        const char* nA = has_next ? (const char*)g.A + (size_t)nxt.pm * tstepA : cA; const char* nB = has_next ? (const char*)g.Bt + (size_t)nxt.pn * tstepB : cB;
        for (int t = 0; t < nt; t += 2) {
            const bool last = (t == nt - 2);
            const char* a1 = cA + (size_t)(t + 1) * kstep;
            const char* a2 = last ? nA : cA + (size_t)(t + 2) * kstep; const char* b2 = last ? nB : cB + (size_t)(t + 2) * kstep;
            const char* a3 = a2 + kstep; const char* b3 = b2 + kstep;
            if (last && has_next) S.a_ready(nxt);
            if constexpr (SP2) {
            PG8_LDB(B0, 0, 0); PG8_LDB(B1, 0, 1); PG8_SCHED; PG8_LDA(At, 0, 0); PG8_STAGE(PG8_SA(1, 1), a1 + hstepA, voffA);
            PG8_WAIT_V(8); PG8_WAIT_L(0); PG8_BAR; PG8_MMA(0, 0, At, B0); PG8_MMA(0, 1, At, B1); PG8_BAR; PG8_SCHED;
            PG8_LDA(At, 0, 1); PG8_STAGE(PG8_SB(0, 0), b2, voffB); PG8_STAGE(PG8_SB(0, 1), b2 + hstepB, voffB); PG8_STAGE(PG8_SA(0, 0), a2, voffA);
            PG8_WAIT_V(8); PG8_WAIT_L(0); PG8_BAR; PG8_MMA(1, 0, At, B0); PG8_MMA(1, 1, At, B1); PG8_BAR; PG8_SCHED;
            PG8_LDB(B0, 1, 0); PG8_LDB(B1, 1, 1); PG8_SCHED; PG8_LDA(At, 1, 0); PG8_STAGE(PG8_SA(0, 1), a2 + hstepA, voffA);
            PG8_WAIT_V(8); PG8_WAIT_L(0); PG8_BAR; PG8_MMA(0, 0, At, B0); PG8_MMA(0, 1, At, B1); PG8_BAR; PG8_SCHED;
            PG8_LDA(At, 1, 1); PG8_STAGE(PG8_SB(1, 0), b3, voffB); PG8_STAGE(PG8_SB(1, 1), b3 + hstepB, voffB); PG8_STAGE(PG8_SA(1, 0), a3, voffA);
            PG8_WAIT_V(8); PG8_WAIT_L(0); PG8_BAR; PG8_MMA(1, 0, At, B0); PG8_MMA(1, 1, At, B1); PG8_BAR; PG8_SCHED;
            } else {
            PG8_LDB(B0, 0, 0); PG8_SCHED; PG8_LDA(At, 0, 0); PG8_STAGE(PG8_SA(1, 1), a1 + hstepA, voffA);
            PG8_WAIT_L(8); PG8_BAR; PG8_WAIT_L(0); PG8_MMA(0, 0, At, B0); PG8_BAR; PG8_SCHED;
            PG8_LDB(B1, 0, 1); PG8_STAGE(PG8_SB(0, 0), b2, voffB);
            PG8_BAR; PG8_WAIT_L(0); PG8_MMA(0, 1, At, B1); PG8_BAR;
            PG8_LDA(At, 0, 1); PG8_STAGE(PG8_SA(0, 0), a2, voffA);
            PG8_BAR; PG8_WAIT_L(0); PG8_MMA(1, 0, At, B0); PG8_BAR; PG8_SCHED;
            PG8_STAGE(PG8_SB(0, 1), b2 + hstepB, voffB);
            PG8_WAIT_V(6); PG8_BAR; PG8_MMA(1, 1, At, B1); PG8_BAR;
            PG8_LDB(B0, 1, 0); PG8_SCHED; PG8_LDA(At, 1, 0); PG8_STAGE(PG8_SA(0, 1), a2 + hstepA, voffA);
            PG8_WAIT_L(8); PG8_BAR; PG8_WAIT_L(0); PG8_MMA(0, 0, At, B0); PG8_BAR; PG8_SCHED;
            PG8_LDB(B1, 1, 1); PG8_STAGE(PG8_SB(1, 0), b3, voffB);
            PG8_BAR; PG8_WAIT_L(0); PG8_MMA(0, 1, At, B1); PG8_BAR;
            PG8_LDA(At, 1, 1); PG8_STAGE(PG8_SA(1, 0), a3, voffA);
            PG8_BAR; PG8_WAIT_L(0); PG8_MMA(1, 0, At, B0); PG8_BAR; PG8_SCHED;
            PG8_STAGE(PG8_SB(1, 1), b3 + hstepB, voffB);
            PG8_WAIT_V(6); PG8_BAR; PG8_MMA(1, 1, At, B1); PG8_BAR;
            }
        }
        if constexpr (ALIGN_EPI) { if (wr == 0) PG8_BAR; }
        if constexpr (!Epi::AFTER_DRAIN) { E(acc, cur, wr, wc, fr, fq); S.done(cur); }
        if (!has_next) break;
#pragma unroll
        for (int a = 0; a < 2; ++a)
#pragma unroll
            for (int b = 0; b < 2; ++b)
#pragma unroll
                for (int m = 0; m < 4; ++m)
#pragma unroll
                    for (int n = 0; n < 2; ++n) acc[a][b][m][n] = (f32x4){0.f, 0.f, 0.f, 0.f};
        cur = nxt; cA = nA; cB = nB; ++ui;
        if constexpr (ALIGN_EPI) { if (wr == 1) PG8_BAR; }
    }
    PG8_WAIT_V(0);
    if constexpr (!ALIGN_EPI) { if (wr == 0) PG8_BAR; }
    PG8_BAR;
    if constexpr (Epi::AFTER_DRAIN) { E.fused(acc, cur, wr, wc, fr, fq, lds, wid, lane); S.done(cur); }
#undef PG8_SA
#undef PG8_SB
#undef PG8_STAGE
#undef PG8_LDA
#undef PG8_LDB
#undef PG8_MMA
#undef PG8_WAIT_V
#undef PG8_WAIT_L
#undef PG8_BAR
#undef PG8_SCHED
}
}
constexpr int NB = 8, T = 4096, D = 1024, M = NB * T, NP = 4352, FF = 4096, LA = 384;
constexpr int C_R = 0, C_K = 512, C_V = 1024, C_QA = 1536, C_KA = 2048, C_VA = 2560, C_QI = 3072, C_KI = 3584, C_WI = 3648, C_P1 = 3656, C_P2 = 3944, C_END = 4232, C_Y = 3656, C_RK = 4168;
#define GAS __attribute__((address_space(1)))
#define LAS __attribute__((address_space(3)))
typedef unsigned short bf16_t;
typedef short bf16x8 __attribute__((ext_vector_type(8)));
typedef float f32x4 __attribute__((ext_vector_type(4)));
typedef float f32x16 __attribute__((ext_vector_type(16)));
typedef unsigned u32x4 __attribute__((ext_vector_type(4)));
typedef unsigned u32x2 __attribute__((ext_vector_type(2)));
typedef short s16x4 __attribute__((ext_vector_type(4)));
#define LDS_WAIT() asm volatile("s_waitcnt lgkmcnt(0)" ::: "memory")
#define VM_WAIT() asm volatile("s_waitcnt vmcnt(0)" ::: "memory")
__device__ __forceinline__ float bfl(unsigned w) { return (float)__builtin_bit_cast(_Float16, (unsigned short)(w & 0xffffu)); }
__device__ __forceinline__ float bfh(unsigned w) { return (float)__builtin_bit_cast(_Float16, (unsigned short)(w >> 16)); }
__device__ __forceinline__ float bf1(bf16_t v) { return (float)__builtin_bit_cast(_Float16, v); }
__device__ __forceinline__ unsigned pkbf(float lo, float hi) { return pg8::cvt_pk_bf16(lo, hi); }
template <int CTRL> __device__ __forceinline__ float dpp_f(float x) { return __builtin_bit_cast(float, __builtin_amdgcn_update_dpp(0, __builtin_bit_cast(int, x), CTRL, 0xf, 0xf, true)); }
__device__ __forceinline__ float allsum8(float x) { x += dpp_f<0xB1>(x); x += dpp_f<0x4E>(x); x += dpp_f<0x141>(x); return x; }
__device__ __forceinline__ float allsum16(float x) { x = allsum8(x); x += dpp_f<0x140>(x); return x; }
template <int CTRL> __device__ __forceinline__ int dpp_i(int x) { return __builtin_amdgcn_update_dpp(0, x, CTRL, 0xf, 0xf, true); }
__device__ __forceinline__ int wave_sum_i(int x) {
    x += dpp_i<0xB1>(x); x += dpp_i<0x4E>(x); x += dpp_i<0x141>(x); x += dpp_i<0x140>(x);
    return __builtin_amdgcn_readlane(x, 0) + __builtin_amdgcn_readlane(x, 16) + __builtin_amdgcn_readlane(x, 32) + __builtin_amdgcn_readlane(x, 48); }
__device__ __forceinline__ unsigned wave_max_u(unsigned x) {
    x = max(x, (unsigned)dpp_i<0xB1>((int)x)); x = max(x, (unsigned)dpp_i<0x4E>((int)x)); x = max(x, (unsigned)dpp_i<0x141>((int)x)); x = max(x, (unsigned)dpp_i<0x140>((int)x));
    return max(max((unsigned)__builtin_amdgcn_readlane((int)x, 0), (unsigned)__builtin_amdgcn_readlane((int)x, 16)), max((unsigned)__builtin_amdgcn_readlane((int)x, 32), (unsigned)__builtin_amdgcn_readlane((int)x, 48))); }
__device__ __forceinline__ unsigned wave_min_u(unsigned x) { return ~wave_max_u(~x); }
__device__ __forceinline__ float wave_sum(float v) {
    v += dpp_f<0xB1>(v); v += dpp_f<0x4E>(v); v += dpp_f<0x141>(v); v += dpp_f<0x140>(v);
    const float r0 = __builtin_bit_cast(float, __builtin_amdgcn_readlane(__builtin_bit_cast(int, v), 0)), r1 = __builtin_bit_cast(float, __builtin_amdgcn_readlane(__builtin_bit_cast(int, v), 16)),
                r2 = __builtin_bit_cast(float, __builtin_amdgcn_readlane(__builtin_bit_cast(int, v), 32)), r3 = __builtin_bit_cast(float, __builtin_amdgcn_readlane(__builtin_bit_cast(int, v), 48));
    return (r0 + r1) + (r2 + r3);
}

namespace att {
__device__ __forceinline__ int crow(int r, int hi) { return (r & 3) + 8 * (r >> 2) + 4 * hi; }
#define SBAR() __builtin_amdgcn_sched_barrier(0)
__device__ __forceinline__ void glds16(const void* gsrc, unsigned lds_dst) { unsigned keep;
    asm volatile("s_mov_b32 %0, m0\n\ts_mov_b32 m0, %2\n\ts_nop 0\n\tglobal_load_lds_dwordx4 %1, off\n\ts_mov_b32 m0, %0" : "=&s"(keep) : "v"(gsrc), "s"(lds_dst) : "memory"); }
typedef LAS const char* lds_cptr;
__device__ __forceinline__ void qkt(f32x16& p0, f32x16& p1, lds_cptr kb, const bf16x8* qr, const f32x16& z) {
#pragma unroll
    for (int d0 = 0; d0 < 4; ++d0) {
        const bf16x8 b0 = *(const LAS bf16x8*)(kb + d0 * 2048);
        const bf16x8 b1 = *(const LAS bf16x8*)(kb + d0 * 2048 + 512);
        if (d0 == 0) { p0 = __builtin_amdgcn_mfma_f32_32x32x16_f16(__builtin_bit_cast(pg8::half8, b0), __builtin_bit_cast(pg8::half8, qr[0]), z, 0, 0, 0); p1 = __builtin_amdgcn_mfma_f32_32x32x16_f16(__builtin_bit_cast(pg8::half8, b1), __builtin_bit_cast(pg8::half8, qr[0]), z, 0, 0, 0); }
        else { p0 = __builtin_amdgcn_mfma_f32_32x32x16_f16(__builtin_bit_cast(pg8::half8, b0), __builtin_bit_cast(pg8::half8, qr[d0]), p0, 0, 0, 0); p1 = __builtin_amdgcn_mfma_f32_32x32x16_f16(__builtin_bit_cast(pg8::half8, b1), __builtin_bit_cast(pg8::half8, qr[d0]), p1, 0, 0, 0); } }
}
__device__ __forceinline__ void pv(f32x16* o, int vb, bf16x8 pa0, bf16x8 pa1, bf16x8 pa2, bf16x8 pa3) {
#pragma unroll
    for (int d0 = 0; d0 < 2; ++d0) { s16x4 lo[4], hi[4];
#pragma unroll
        for (int ks = 0; ks < 4; ++ks) {
            asm volatile("ds_read_b64_tr_b16 %0,%1 offset:%c2" : "=&v"(lo[ks]) : "v"(vb), "i"(d0 * 4096 + ks * 1024) : "memory");
            asm volatile("ds_read_b64_tr_b16 %0,%1 offset:%c2" : "=&v"(hi[ks]) : "v"(vb), "i"(d0 * 4096 + ks * 1024 + 512) : "memory"); }
        asm volatile("s_waitcnt lgkmcnt(0)" ::: "memory"); SBAR();
#define PK(k) (bf16x8){lo[k][0], lo[k][1], lo[k][2], lo[k][3], hi[k][0], hi[k][1], hi[k][2], hi[k][3]}
        o[d0] = __builtin_amdgcn_mfma_f32_32x32x16_f16(__builtin_bit_cast(pg8::half8, pa0), __builtin_bit_cast(pg8::half8, PK(0)), o[d0], 0, 0, 0);
        o[d0] = __builtin_amdgcn_mfma_f32_32x32x16_f16(__builtin_bit_cast(pg8::half8, pa1), __builtin_bit_cast(pg8::half8, PK(1)), o[d0], 0, 0, 0);
        o[d0] = __builtin_amdgcn_mfma_f32_32x32x16_f16(__builtin_bit_cast(pg8::half8, pa2), __builtin_bit_cast(pg8::half8, PK(2)), o[d0], 0, 0, 0);
        o[d0] = __builtin_amdgcn_mfma_f32_32x32x16_f16(__builtin_bit_cast(pg8::half8, pa3), __builtin_bit_cast(pg8::half8, PK(3)), o[d0], 0, 0, 0);
#undef PK
    }
}
constexpr int SLOTB = 8192;
constexpr int L_K = 0, L_V = 3 * SLOTB, L_WS = 7 * SLOTB, L_OST = L_WS + 8 * 64 * 4, L_BT = L_OST + 8 * 8192, L_END = L_BT + 8 * 129 * 4;
constexpr float C2 = 0.125f * 1.4426950408889634f;

__device__ __forceinline__ int t5_bucket(int n) {
    if (n < 16) return n;
    const int thr[15] = {19, 21, 24, 27, 31, 35, 40, 46, 52, 59, 67, 77, 87, 99, 113};
    int b = 16;
#pragma unroll
    for (int i = 0; i < 15; ++i) b += (n >= thr[i]) ? 1 : 0;
    return b;
}
__device__ __forceinline__ void build_bias_table(const float* rel_bias, LAS char* shm, int tid) {
    LAS float* BT = (LAS float*)(shm + L_BT);
    for (int i = tid; i < 8 * 129; i += 512) { const int h = i / 129, d = i % 129;
        BT[i] = (d >= 128) ? 0.f : (rel_bias[t5_bucket(d) * 8 + h] - rel_bias[31 * 8 + h]) * 1.4426950408889634f; }
}

__device__ __forceinline__ void attn_unit(int b, int h, int qb, const bf16_t* PROJ, const unsigned long long* MASK, bf16_t* MIX, const float* gain, LAS char* shm, const int tid) {
    const int lane = tid & 63, r32 = lane & 31, hi = lane >> 5; const int wid = __builtin_amdgcn_readfirstlane(tid >> 6);
    const long rowbase = (long)b * T; const int q0 = qb * 256;
    const bf16_t* Qw = PROJ + (rowbase + q0 + wid * 32) * NP + C_QA + h * 64;
    const bf16_t* Kh = PROJ + rowbase * NP + C_KA + h * 64; const bf16_t* Vh = PROJ + rowbase * NP + C_VA + h * 64;
    const unsigned lds0 = (unsigned)(uintptr_t)shm;
    LAS float* wsf = (LAS float*)(shm + L_WS) + wid * 64;
    const LAS float* BT = (const LAS float*)(shm + L_BT) + h * 129;
    const bf16_t* ksrc = Kh + (long)lane * NP + wid * 8;
    const bf16_t* vsrc = Vh + (long)(16 * (wid & 3) + (lane >> 2)) * NP + (wid >> 2) * 32 + (lane & 3) * 8;
    const unsigned kdst = lds0 + L_K + wid * 1024, vdst = lds0 + L_V + wid * 1024;
#define DMA_K(t, slot) glds16(ksrc + (long)(t) * 64 * NP, (unsigned)__builtin_amdgcn_readfirstlane(kdst + (slot)))
#define DMA_V(t, slot) glds16(vsrc + (long)(t) * 64 * NP, (unsigned)__builtin_amdgcn_readfirstlane(vdst + (slot)))
    const int vb0 = (int)(lds0 + L_V) + ((lane >> 4) & 1) * 32 + (lane & 3) * 8 + (4 * hi + ((lane & 15) >> 2)) * 64;
    const lds_cptr kp0 = (lds_cptr)shm + L_K + hi * 1024 + r32 * 16;
    const int NT = (q0 + 256) / 64;
    const int qabs = q0 + wid * 32 + r32;
    const unsigned long long* mp = MASK + ((size_t)b * 4096 + qabs) * 64;
    unsigned long long mw_next = 0ull;
#define MASK_LD(t) asm volatile("global_load_dwordx2 %0, %1, off" : "+v"(mw_next) : "v"(mp + (t)) : "memory")
    MASK_LD(0); DMA_K(0, 0); DMA_V(0, 0); DMA_K(1, SLOTB); DMA_V(1, SLOTB);
    bf16x8 qr[4];
#pragma unroll
    for (int d0 = 0; d0 < 4; ++d0) qr[d0] = *(const bf16x8*)(Qw + (long)r32 * NP + d0 * 16 + hi * 8);
    float m_run = 0.f, l_run = 0.f; f32x16 o[2]; o[0] = f32x16{}; o[1] = f32x16{}; f32x16 negm = f32x16{}; asm volatile("" : "+v"(negm));
    int slot = 0, slot2 = 2 * SLOTB;
    int vs = 0, vsp = 3 * SLOTB, vs2 = 2 * SLOTB;
    u32x4 pw0 = {0u, 0u, 0u, 0u}, pw1 = pw0, pw2 = pw0, pw3 = pw0;
    for (int t = 0; t < NT; ++t) {
        if (t + 1 < NT) asm volatile("s_waitcnt vmcnt(2) lgkmcnt(0)\n\ts_barrier" : "+v"(mw_next) :: "memory");
        else asm volatile("s_waitcnt vmcnt(0) lgkmcnt(0)\n\ts_barrier" : "+v"(mw_next) :: "memory");
        const unsigned long long mw = mw_next;
        asm volatile("" : "+v"(mw_next));
        if (t + 1 < NT) MASK_LD(t + 1);
        if (t + 2 < NT) { DMA_K(t + 2, slot2); DMA_V(t + 2, vs2); }
        f32x16 p0, p1; qkt(p0, p1, kp0 + slot, qr, negm);
        if (t > 0) pv(o, vb0 + vsp, __builtin_bit_cast(bf16x8, pw0), __builtin_bit_cast(bf16x8, pw1), __builtin_bit_cast(bf16x8, pw2), __builtin_bit_cast(bf16x8, pw3));
        if (64 * t + 191 > q0 + 32 * wid) {
#pragma unroll
            for (int r = 0; r < 16; ++r) { const int d0_ = qabs - (64 * t + crow(r, hi));
                const int i0 = d0_ < 0 ? 0 : (d0_ > 128 ? 128 : d0_); const int d1_ = d0_ - 32; const int i1 = d1_ < 0 ? 0 : (d1_ > 128 ? 128 : d1_);
                p0[r] += BT[i0]; p1[r] += BT[i1]; }
        }
        { const int mlo = (int)((unsigned)mw >> (4 * hi)), mhi = (int)((unsigned)(mw >> 32) >> (4 * hi)); const int NEGB = (int)0xff800000u;
#pragma unroll
          for (int r = 0; r < 16; ++r) { const int bit = (r & 3) + 8 * (r >> 2);
              const int t0 = __builtin_amdgcn_sbfe(mlo, bit, 1), t1 = __builtin_amdgcn_sbfe(mhi, bit, 1);
              { const float x0 = p0[r]; p0[r] = __int_as_float((__float_as_int(x0) & t0) | (NEGB & ~t0)); }
              { const float x1 = p1[r]; p1[r] = __int_as_float((__float_as_int(x1) & t1) | (NEGB & ~t1)); } } }
        float rm;
        { float a = __builtin_fmaxf(__builtin_fmaxf(p0[0], p0[1]), p1[0]), b2 = __builtin_fmaxf(__builtin_fmaxf(p0[2], p0[3]), p1[1]); a = __builtin_fmaxf(__builtin_fmaxf(a, p1[2]), p1[3]);
#pragma unroll
          for (int r = 4; r < 16; r += 4) { a = __builtin_fmaxf(__builtin_fmaxf(a, p0[r]), p0[r + 1]); b2 = __builtin_fmaxf(__builtin_fmaxf(b2, p0[r + 2]), p0[r + 3]); a = __builtin_fmaxf(__builtin_fmaxf(a, p1[r]), p1[r + 1]); b2 = __builtin_fmaxf(__builtin_fmaxf(b2, p1[r + 2]), p1[r + 3]); }
          rm = __builtin_fmaxf(a, b2); }
        { auto rr = __builtin_amdgcn_permlane32_swap(__float_as_uint(rm), __float_as_uint(rm), false, false); rm = fmaxf(__uint_as_float(rr[0]), __uint_as_float(rr[1])); }
        const float dl = (t == 0) ? ((rm == -INFINITY) ? 0.f : rm) : fmaxf(rm, 0.f);
        if (__ballot(dl != 0.f)) {
            m_run += dl;
#pragma unroll
            for (int r = 0; r < 16; ++r) { p0[r] -= dl; p1[r] -= dl; }
            const float f = __builtin_amdgcn_exp2f(-dl); l_run *= f;
#pragma unroll
            for (int r = 0; r < 16; ++r) negm[r] = -m_run;
            asm volatile("" : "+v"(negm));
            if (hi == 0) wsf[r32] = f;
            LDS_WAIT();
#pragma unroll
            for (int r = 0; r < 16; ++r) { const float fr_ = wsf[crow(r, hi)]; o[0][r] *= fr_; o[1][r] *= fr_; }
        }
        float sacc = 0.f;
#pragma unroll
        for (int r = 0; r < 16; ++r) { p0[r] = __builtin_amdgcn_exp2f(p0[r]); p1[r] = __builtin_amdgcn_exp2f(p1[r]); sacc += p0[r] + p1[r]; }
        l_run += sacc;
#define PKW(P, B) __builtin_bit_cast(unsigned, __builtin_amdgcn_cvt_pkrtz(P[B], P[B + 1]))
        pw0 = (u32x4){PKW(p0, 0), PKW(p0, 2), PKW(p0, 4), PKW(p0, 6)}; pw1 = (u32x4){PKW(p0, 8), PKW(p0, 10), PKW(p0, 12), PKW(p0, 14)};
        pw2 = (u32x4){PKW(p1, 0), PKW(p1, 2), PKW(p1, 4), PKW(p1, 6)}; pw3 = (u32x4){PKW(p1, 8), PKW(p1, 10), PKW(p1, 12), PKW(p1, 14)};
#undef PKW
        { const int old_ = slot; slot = (slot == 2 * SLOTB) ? 0 : slot + SLOTB; slot2 = old_; }
        { vsp = vs; vs = (vs == 3 * SLOTB) ? 0 : vs + SLOTB; vs2 = (vs2 == 3 * SLOTB) ? 0 : vs2 + SLOTB; }
    }
    LDS_WAIT(); SBAR();
    pv(o, vb0 + vsp, __builtin_bit_cast(bf16x8, pw0), __builtin_bit_cast(bf16x8, pw1), __builtin_bit_cast(bf16x8, pw2), __builtin_bit_cast(bf16x8, pw3));
    { auto rr = __builtin_amdgcn_permlane32_swap(__float_as_uint(l_run), __float_as_uint(l_run), false, false); l_run = __uint_as_float(rr[0]) + __uint_as_float(rr[1]); }
    LDS_WAIT();
    if (hi == 0) wsf[32 + r32] = l_run;
    LDS_WAIT();
    LAS float* stg = (LAS float*)(shm + L_OST) + wid * 2048;
#pragma unroll
    for (int r = 0; r < 16; ++r) { const int orow = crow(r, hi); const float rl = 1.0f / wsf[32 + orow];
#pragma unroll
        for (int d0 = 0; d0 < 2; ++d0) stg[orow * 64 + d0 * 32 + r32] = o[d0][r] * rl; }
    LDS_WAIT();
    bf16_t* Ow = MIX + (rowbase + q0 + wid * 32) * 1024 + 512 + h * 64;
#pragma unroll
    for (int i = 0; i < 4; ++i) { const int row = i * 8 + (lane >> 3), ch = lane & 7;
        const f32x4 a = *(const LAS f32x4*)(stg + row * 64 + ch * 8), c = *(const LAS f32x4*)(stg + row * 64 + ch * 8 + 4);
        float ss = (a[0] * a[0] + a[1] * a[1]) + (a[2] * a[2] + a[3] * a[3]) + (c[0] * c[0] + c[1] * c[1]) + (c[2] * c[2] + c[3] * c[3]);
        ss = allsum8(ss);
        const float rs = rsqrtf(ss * (1.0f / 64.0f) + 1e-6f);
        const f32x4 g0 = *(const f32x4*)(gain + h * 64 + ch * 8), g1 = *(const f32x4*)(gain + h * 64 + ch * 8 + 4);
        u32x4 w; w.x = pkbf(a[0] * rs * g0[0], a[1] * rs * g0[1]); w.y = pkbf(a[2] * rs * g0[2], a[3] * rs * g0[3]); w.z = pkbf(c[0] * rs * g1[0], c[1] * rs * g1[1]); w.w = pkbf(c[2] * rs * g1[2], c[3] * rs * g1[3]);
        *(u32x4*)(Ow + (long)row * 1024 + ch * 8) = w; }
    asm volatile("s_waitcnt lgkmcnt(0)\n\ts_barrier" ::: "memory");
#undef DMA_K
#undef DMA_V
#undef MASK_LD
}
#undef SBAR
}

#define GAS __attribute__((address_space(1)))
#define LAS __attribute__((address_space(3)))
typedef unsigned short bf16;
typedef unsigned v4u __attribute__((ext_vector_type(4)));
typedef float f32x4 __attribute__((ext_vector_type(4)));
typedef short bf16x8 __attribute__((ext_vector_type(8)));
typedef GAS unsigned gu32;
typedef GAS unsigned long long gu64;
#define RLX_AGENT __ATOMIC_RELAXED, __HIP_MEMORY_SCOPE_AGENT
#define LDS_WAIT() asm volatile("s_waitcnt lgkmcnt(0)" ::: "memory")
#define VM_WAIT() asm volatile("s_waitcnt vmcnt(0)" ::: "memory")
__device__ __forceinline__ unsigned long long rt() { return __builtin_amdgcn_s_memrealtime(); }
__device__ __forceinline__ unsigned f2bf(float f) { unsigned u = __builtin_bit_cast(unsigned, f); return (u + 0x7fffu + ((u >> 16) & 1u)) >> 16; }
__device__ __forceinline__ unsigned pk2(float lo, float hi) { return f2bf(lo) | (f2bf(hi) << 16); }

#define XB_TMO      128
#define XB_XCNT(j)  (256  + 64 * (j))
#define XB_XSUB(j)  (1280 + 64 * (j))
#define XB_XGEN(j)  (2304 + 64 * (j))
#define XB_TOP      3328
#define XB_TOPGEN   3392
#define XCD_BAR_WORDS 3456
#define XB_SPIN_CAP (1u << 22)

__device__ __forceinline__ unsigned xb_ld(unsigned* p)              { return __hip_atomic_load(p, __ATOMIC_RELAXED, __HIP_MEMORY_SCOPE_AGENT); }
__device__ __forceinline__ unsigned xb_add(unsigned* p, unsigned v) { return __hip_atomic_fetch_add(p, v, __ATOMIC_RELAXED, __HIP_MEMORY_SCOPE_AGENT); }
__device__ __forceinline__ unsigned xb_xcc_id() { return (unsigned)__builtin_amdgcn_s_getreg((3 << 11) | 20) & 0xFu; }
#define XB_SPIN(cond, bar) do { unsigned _sp = 0; while (cond) { __builtin_amdgcn_s_sleep(1); \
    if ((++_sp & 255u) == 0u) { if (xb_ld(&(bar)[XB_TMO])) break; if (_sp > XB_SPIN_CAP) { atomicAdd(&(bar)[XB_TMO], 1u); break; } } } } while (0)

struct XcdBarrier {
    unsigned* bar; unsigned x;
    volatile LAS unsigned* st;
};

__device__ __forceinline__ XcdBarrier xcd_barrier_post(unsigned* bar, volatile LAS unsigned* st) {
    XcdBarrier b; b.bar = bar; b.x = xb_xcc_id(); b.st = st;
    if (threadIdx.x == 0) (void)xb_add(&bar[XB_XCNT(b.x)], 1u);
    return b;
}
__device__ __forceinline__ void xcd_barrier_complete(unsigned* bar, unsigned x, unsigned& nloc, unsigned& nx) {
    const unsigned G = gridDim.x * gridDim.y * gridDim.z;
    unsigned sum, cnt, mine, sp = 0u;
    for (;;) {
        sum = 0u; cnt = 0u; mine = 0u;
#pragma unroll
        for (unsigned j = 0; j < 16; ++j) { const unsigned c = xb_ld(&bar[XB_XCNT(j)]); sum += c; cnt += (c > 0u) ? 1u : 0u; mine = (j == x) ? c : mine; }
        if (sum == G) break;
        __builtin_amdgcn_s_sleep(1);
        if ((++sp & 255u) == 0u) { if (xb_ld(&bar[XB_TMO])) break; if (sp > XB_SPIN_CAP) { atomicAdd(&bar[XB_TMO], 1u); break; } }
    }
    nloc = mine > 0u ? mine : 1u; nx = cnt > 0u ? cnt : 1u;
}

__device__ __forceinline__ void xcd_barrier(const XcdBarrier& b) {
    asm volatile("s_waitcnt vmcnt(0)" ::: "memory");
    __syncthreads();
    if (threadIdx.x == 0) {
        unsigned* bar = b.bar;
        __builtin_amdgcn_s_waitcnt(0);
        unsigned nloc = b.st[0], nx = b.st[1];
        if (nloc == 0u) { xcd_barrier_complete(bar, b.x, nloc, nx); b.st[0] = nloc; b.st[1] = nx; }
        const unsigned old = xb_add(&bar[XB_XSUB(b.x)], 1u);
        const unsigned gen = old / nloc;
        if (old + 1u == (gen + 1u) * nloc) {
            __builtin_amdgcn_fence(__ATOMIC_RELEASE, "agent");
            asm volatile("s_waitcnt vmcnt(0)" ::: "memory");
            const unsigned og = xb_add(&bar[XB_TOP], 1u);
            const unsigned tg = og / nx;
            if (og + 1u == (tg + 1u) * nx) xb_add(&bar[XB_TOPGEN], 1u);
            else XB_SPIN(xb_ld(&bar[XB_TOPGEN]) == tg, bar);
            __builtin_amdgcn_fence(__ATOMIC_ACQUIRE, "agent");
            xb_add(&bar[XB_XGEN(b.x)], 1u);
            asm volatile("s_waitcnt vmcnt(0)" ::: "memory");
        } else {
            XB_SPIN(xb_ld(&bar[XB_XGEN(b.x)]) == gen, bar);
            __builtin_amdgcn_fence(__ATOMIC_ACQUIRE, "agent");
            asm volatile("s_waitcnt vmcnt(0)" ::: "memory");
        }
    }
    __syncthreads();
}
constexpr size_t MiB = 1u << 20;
constexpr size_t WS_CTL = 0, CTL_ZERO_BYTES = 1 * MiB;
constexpr size_t WS_MOD = 1 * MiB;
constexpr size_t WS_LW = 2 * MiB;
constexpr size_t WS_WIN = 3 * MiB, WS_WOUT = 12 * MiB, WS_W1 = 14 * MiB, WS_W2 = 22 * MiB;
constexpr size_t WS_LACT = 30 * MiB;
constexpr size_t WS_MASK = 54 * MiB;
constexpr size_t WS_VF = 70 * MiB;
constexpr size_t WS_H = 102 * MiB;
constexpr size_t WS_MIX = 166 * MiB;
constexpr size_t WS_PROJ = 230 * MiB;
constexpr size_t WS_END = 502 * MiB;
static_assert(WS_WIN + (size_t)NP * D * 2 <= WS_WOUT && WS_W2 + (size_t)D * FF * 2 <= WS_LACT && WS_LACT + (size_t)M * LA * 2 <= WS_MASK && WS_MASK + (size_t)NB * 64 * 4096 * 8 <= WS_VF &&
              WS_VF + (size_t)M * 512 * 2 <= WS_H && WS_H + (size_t)M * D * 2 <= WS_MIX && WS_MIX + (size_t)M * D * 2 <= WS_PROJ && WS_PROJ + (size_t)M * NP * 2 <= WS_END, "d_ws map");
constexpr int CW_BAR = 4096;
constexpr int RING_BYTES = 131072, HIST_OFF = 131072, LDSCTL_OFF = 131072 + 8192, MISC_OFF = LDSCTL_OFF + 320, LDS_BYTES = 147456;
static_assert(att::L_END <= RING_BYTES && MISC_OFF + 128 <= LDS_BYTES, "LDS map");
constexpr int NWAVES = 8;

__device__ __forceinline__ void ph_mod(const float* c, const float* w_ada, const float* b_ada, float* MOD, LAS unsigned char* lds, int vcu, int G, int tid) {
    LAS float* ca = (LAS float*)lds; LAS float* part = (LAS float*)(lds + 32768);
    for (int i = tid; i < NB * D; i += 512) { const float v = c[i]; ca[i] = v / (1.f + __expf(-v)); }
    __syncthreads();
    const int wave = tid >> 6, lane = tid & 63;
    for (int task = vcu; task < 192; task += G) {
        const int l = task / 96, j0 = (task % 96) * 64;
        float acc[8];
#pragma unroll
        for (int b = 0; b < 8; ++b) acc[b] = 0.f;
        const float* wp = w_ada + ((size_t)l * D + wave * 128) * 6144 + j0 + lane;
#pragma unroll 8
        for (int k = 0; k < 128; ++k) { const float w = wp[(size_t)k * 6144];
#pragma unroll
            for (int b = 0; b < 8; ++b) acc[b] += ca[b * D + wave * 128 + k] * w; }
#pragma unroll
        for (int b = 0; b < 8; ++b) part[(wave * 8 + b) * 64 + lane] = acc[b];
        __syncthreads();
        { float s = 0.f;
#pragma unroll
          for (int w = 0; w < 8; ++w) s += part[(w * 8 + wave) * 64 + lane];
          MOD[((size_t)l * 8 + wave) * 6144 + j0 + lane] = s + b_ada[l * 6144 + j0 + lane]; }
        __syncthreads();
    }
}

__device__ __forceinline__ void tr_item(const float* W, int ldw, int nvalid, int K, bf16_t* WT, int row_off, LAS float* scr, int kb, int nb, int lane, const float* mu, int mode) {
    const int k0 = 64 * kb, n0 = 32 * nb; const int n = n0 + (lane & 31);
#pragma unroll 8
    for (int i = 0; i < 32; ++i) { const int kk = 2 * i + (lane >> 5); float v = (n < nvalid) ? W[(size_t)(k0 + kk) * ldw + n] : 0.f;
        if (mode) { const float m = mu[k0 + kk]; v *= (mode == 1) ? (1.f - m) : m; }
        scr[kk * 33 + (lane & 31)] = v; }
    LDS_WAIT(); asm volatile("" ::: "memory");
    const int c = lane & 7;
#pragma unroll
    for (int j = 0; j < 4; ++j) { const int nn = (lane >> 3) + 8 * j; const LAS float* s = scr + (8 * c) * 33 + nn;
        u32x4 o; o.x = pkbf(s[0 * 33], s[1 * 33]); o.y = pkbf(s[2 * 33], s[3 * 33]); o.z = pkbf(s[4 * 33], s[5 * 33]); o.w = pkbf(s[6 * 33], s[7 * 33]);
        if (n0 + nn < nvalid) *(u32x4*)(WT + (size_t)(row_off + n0 + nn) * K + k0 + 8 * c) = o; }
    LDS_WAIT(); asm volatile("" ::: "memory");
}
struct WPtrs { const float *w_in, *decay_a, *iclr_a, *gate_a, *vres_a, *mu_lora, *vres_mu, *w_out, *w1, *w2, *decay_b, *iclr_b, *gate_b, *vres_b; };
__device__ __forceinline__ void ph_weights(const WPtrs& P, int l, unsigned char* ws, LAS unsigned char* lds, int vcu, int G, int tid) {
    const int wave = tid >> 6, lane = tid & 63; const int gw = vcu * NWAVES + wave, NGW = G * NWAVES;
    LAS float* scr = (LAS float*)(lds + wave * 16384);
    bf16_t* WIN = (bf16_t*)(ws + WS_WIN); bf16_t* WOUT = (bf16_t*)(ws + WS_WOUT); bf16_t* W1 = (bf16_t*)(ws + WS_W1); bf16_t* W2 = (bf16_t*)(ws + WS_W2);
    constexpr int I_IN = 16 * 115, I_D = 16 * 2, I_G = 16 * 4, I_V = 16 * 1, I_O = 16 * 32, I_1 = 16 * 128, I_2 = 64 * 32;
    constexpr int I_LO = 2 * I_D + I_G + I_V; constexpr int NITEMS = I_IN + 2 * I_LO + I_O + I_1 + I_2;
    for (int it = gw; it < NITEMS; it += NGW) {
        int r = it;
        if (r < I_IN) { tr_item(P.w_in + (size_t)l * D * 3656, 3656, 3656, D, WIN, 0, scr, r / 115, r % 115, lane, nullptr, 0); continue; } r -= I_IN;
        if (r < 2 * I_LO) { const int md = (r < I_LO) ? 1 : 2; int q = (r < I_LO) ? r : r - I_LO; const int rbase = (md == 1) ? C_P1 : C_P2;
            if (q < I_D) { tr_item(P.decay_a + (size_t)l * D * 64, 64, 64, D, WIN, rbase + 0, scr, q / 2, q % 2, lane, P.mu_lora + (size_t)(l * 3 + 0) * D, md); continue; } q -= I_D;
            if (q < I_D) { tr_item(P.iclr_a + (size_t)l * D * 64, 64, 64, D, WIN, rbase + 64, scr, q / 2, q % 2, lane, P.mu_lora + (size_t)(l * 3 + 1) * D, md); continue; } q -= I_D;
            if (q < I_G) { tr_item(P.gate_a + (size_t)l * D * 128, 128, 128, D, WIN, rbase + 128, scr, q / 4, q % 4, lane, P.mu_lora + (size_t)(l * 3 + 2) * D, md); continue; } q -= I_G;
            if (l >= 1) tr_item(P.vres_a + (size_t)(l - 1) * D * 32, 32, 32, D, WIN, rbase + 256, scr, q, 0, lane, P.vres_mu + (size_t)(l - 1) * D, md);
            continue; }
        r -= 2 * I_LO;
        if (r < I_O) { tr_item(P.w_out + (size_t)l * D * D, D, D, D, WOUT, 0, scr, r / 32, r % 32, lane, nullptr, 0); continue; } r -= I_O;
        if (r < I_1) { tr_item(P.w1 + (size_t)l * D * FF, FF, FF, D, W1, 0, scr, r / 128, r % 128, lane, nullptr, 0); continue; } r -= I_1;
        tr_item(P.w2 + (size_t)l * FF * D, D, D, FF, W2, 0, scr, r / 32, r % 32, lane, nullptr, 0);
    }
    const int gt = vcu * 512 + tid, NGT = G * 512;
    { const int nzr = (NP - C_END) + (l == 0 ? 64 : 0);
      for (int i = gt; i < nzr * 128; i += NGT) { const int zr = i >> 7, ch = i & 127; int row;
          if (zr < NP - C_END) row = C_END + zr; else { const int z2 = zr - (NP - C_END); row = (z2 < 32) ? (C_P1 + 256 + z2) : (C_P2 + 256 + z2 - 32); }
          *(u32x4*)(WIN + (size_t)row * D + ch * 8) = (u32x4){0u, 0u, 0u, 0u}; } }
    { bf16_t* LW = (bf16_t*)(ws + WS_LW);
      for (int i = gt; i < 2048 * 128; i += NGT) { const int n = i >> 7, k = i & 127; float v = 0.f;
          if (n < 512) { if (k < 64) v = P.decay_b[((size_t)l * 64 + k) * 512 + n]; }
          else if (n < 1024) { if (k >= 64) v = P.iclr_b[((size_t)l * 64 + (k - 64)) * 512 + (n - 512)]; }
          else if (n < 1536) { v = P.gate_b[((size_t)l * 128 + k) * 512 + (n - 1024)]; }
          else { if (l >= 1 && k < 32) v = P.vres_b[((size_t)(l - 1) * 32 + k) * 512 + (n - 1536)]; }
          LW[i] = (bf16_t)(pkbf(v, 0.f) & 0xffffu); } }
}

__device__ __forceinline__ void ph_norm(const float* X, const float* g, const float* sh, const float* sc, bf16_t* Hout, int gw, int NGW, int lane) {
    for (int m0 = gw; m0 < M; m0 += 2 * NGW) {
        f32x4 v[2][4]; float s[2] = {0.f, 0.f};
#pragma unroll
        for (int q = 0; q < 2; ++q) { const f32x4* xr = (const f32x4*)(X + (size_t)(m0 + q * NGW) * D) + lane;
#pragma unroll
            for (int j = 0; j < 4; ++j) v[q][j] = xr[64 * j]; }
#pragma unroll
        for (int q = 0; q < 2; ++q)
#pragma unroll
            for (int j = 0; j < 4; ++j) s[q] += (v[q][j][0] * v[q][j][0] + v[q][j][1] * v[q][j][1]) + (v[q][j][2] * v[q][j][2] + v[q][j][3] * v[q][j][3]);
#pragma unroll
        for (int q = 0; q < 2; ++q) { const int m = m0 + q * NGW; const int b = m >> 12;
            const float rstd = rsqrtf(wave_sum(s[q]) * (1.f / D) + 1e-6f);
            u32x2* o8 = (u32x2*)(Hout + (size_t)m * D) + lane;
#pragma unroll
            for (int j = 0; j < 4; ++j) { const int c = 256 * j + 4 * lane;
                const f32x4 gv = *(const f32x4*)(g + c), sv = *(const f32x4*)(sc + (size_t)b * 6144 + c), hv = *(const f32x4*)(sh + (size_t)b * 6144 + c);
                const f32x4 y = v[q][j] * rstd * gv * (sv + 1.f) + hv;
                u32x2 w; w.x = pkbf(y[0], y[1]); w.y = pkbf(y[2], y[3]); o8[64 * j] = w; } } }
}
__device__ __forceinline__ void ph_final_norm(float* X, const float* g, int gw, int NGW, int lane) {
    for (int m = gw; m < M; m += NGW) {
        f32x4* xr = (f32x4*)(X + (size_t)m * D) + lane; f32x4 v[4]; float s = 0.f;
#pragma unroll
        for (int j = 0; j < 4; ++j) { v[j] = xr[64 * j]; s += (v[j][0] * v[j][0] + v[j][1] * v[j][1]) + (v[j][2] * v[j][2] + v[j][3] * v[j][3]); }
        const float rstd = rsqrtf(wave_sum(s) * (1.f / D) + 1e-6f);
#pragma unroll
        for (int j = 0; j < 4; ++j) { const f32x4 gv = *(const f32x4*)(g + 256 * j + 4 * lane); xr[64 * j] = v[j] * rstd * gv; } }
}

__device__ __forceinline__ void ph_lora_act(const bf16_t* PROJ, bf16_t* LACT, bf16_t* VF, const float* mu_v  , bool write_v, int gw, int NGW, int lane) {
    float muv[8];
#pragma unroll
    for (int i = 0; i < 8; ++i) muv[i] = mu_v[lane * 8 + i];
    for (int m = gw; m < M; m += NGW) { const int t = m & (T - 1);
        if (lane < 36) {
            const u32x4 p1 = *(const u32x4*)(PROJ + (size_t)m * NP + C_P1 + lane * 8);
            u32x4 p2 = (u32x4){0u, 0u, 0u, 0u}; if (t > 0) p2 = *(const u32x4*)(PROJ + (size_t)(m - 1) * NP + C_P2 + lane * 8);
            float x[8];
#pragma unroll
            for (int i = 0; i < 4; ++i) { x[2 * i] = bfl(p1[i]) + bfl(p2[i]); x[2 * i + 1] = bfh(p1[i]) + bfh(p2[i]); }
            if (lane < 8) {
#pragma unroll
                for (int i = 0; i < 8; ++i) x[i] = 1.f - 2.f / (__expf(2.f * x[i]) + 1.f);
            } else if (lane >= 16 && lane < 32) {
#pragma unroll
                for (int i = 0; i < 8; ++i) x[i] = 1.f / (1.f + __expf(-x[i]));
            }
            u32x4 w; w.x = pkbf(x[0], x[1]); w.y = pkbf(x[2], x[3]); w.z = pkbf(x[4], x[5]); w.w = pkbf(x[6], x[7]);
            *(u32x4*)(LACT + (size_t)m * LA + lane * 8) = w;
        } else if (lane < 48) { *(u32x4*)(LACT + (size_t)m * LA + lane * 8) = (u32x4){0u, 0u, 0u, 0u}; }
        if (write_v) {
            const u32x4 vc = *(const u32x4*)(PROJ + (size_t)m * NP + C_V + lane * 8);
            u32x4 vp = (u32x4){0u, 0u, 0u, 0u}; if (t > 0) vp = *(const u32x4*)(PROJ + (size_t)(m - 1) * NP + C_V + lane * 8);
            float y[8];
#pragma unroll
            for (int i = 0; i < 4; ++i) { const float c0 = bfl(vc[i]), c1 = bfh(vc[i]); y[2 * i] = c0 + (bfl(vp[i]) - c0) * muv[2 * i]; y[2 * i + 1] = c1 + (bfh(vp[i]) - c1) * muv[2 * i + 1]; }
            u32x4 w; w.x = pkbf(y[0], y[1]); w.y = pkbf(y[2], y[3]); w.z = pkbf(y[4], y[5]); w.w = pkbf(y[6], y[7]);
            *(u32x4*)(VF + (size_t)m * 512 + lane * 8) = w;
        }
    }
}

#ifndef DUP_MASK
#define DUP_MASK 0
#endif
__device__ __forceinline__ unsigned sortable(float s) { const unsigned u = __float_as_uint(s + 0.f); return u ^ ((u >> 31) ? 0xFFFFFFFFu : 0x80000000u); }
__device__ __forceinline__ void ph_select(const bf16_t* PROJ, unsigned long long* MASK, LAS unsigned char* lds, int vcu, int G, int tid) {
    const int lane = tid & 63, wid = __builtin_amdgcn_readfirstlane(tid >> 6), r32 = lane & 31, hi = lane >> 5;
    LAS unsigned* SC = (LAS unsigned*)lds;
    LAS unsigned* HI = (LAS unsigned*)(lds + HIST_OFF) + wid * 256;
    const float WSC = 0.35355339059f * 0.125f;
    bf16x8 AfN[2][4]; u32x4 wN[2][2]; bf16x8 BfN[4];
    const int ql_ = (r32 >> 4) * 2 + ((r32 >> 2) & 1), hd_ = (r32 & 3) + 4 * ((r32 >> 3) & 1);
#define SEL_LOAD(q0_, nblk_, rb_) do { \
        _Pragma("unroll") for (int tq = 0; tq < 2; ++tq) _Pragma("unroll") for (int ks = 0; ks < 4; ++ks) AfN[tq][ks] = *(const bf16x8*)(PROJ + (rb_ + q0_ + tq * 4 + ql_) * NP + C_QI + hd_ * 64 + ks * 16 + hi * 8); \
        _Pragma("unroll") for (int tq = 0; tq < 2; ++tq) _Pragma("unroll") for (int g = 0; g < 2; ++g) wN[tq][g] = *(const u32x4*)(PROJ + (rb_ + q0_ + tq * 4 + 2 * g + hi) * NP + C_WI); \
        if (wid < nblk_) { _Pragma("unroll") for (int ks = 0; ks < 4; ++ks) BfN[ks] = *(const bf16x8*)(PROJ + (rb_ + wid * 32 + r32) * NP + C_KI + ks * 16 + hi * 8); } } while (0)
    if (vcu < NB * 512) { const int bn = vcu & 7, jn = vcu >> 3, basen = jn & 31, rndn = jn >> 5;
        const int q8n = (rndn & 1) ? (32 * rndn + 31 - basen) : (32 * rndn + basen); const int q0n = q8n * 8, nblkn = (q0n >> 5) + 1; const size_t rbn = (size_t)bn * T;
        SEL_LOAD(q0n, nblkn, rbn); }
    for (int it = 0;; ++it) {
        const int tsk = vcu + it * G; if (tsk >= NB * 512) break;
        const int b = tsk & 7, j = tsk >> 3, base = j & 31, rnd = j >> 5;
        const int q8 = (rnd & 1) ? (32 * rnd + 31 - base) : (32 * rnd + base);
        const int q0 = q8 * 8, nblk = (q0 >> 5) + 1; const size_t rb = (size_t)b * T;
        bf16x8 Af[2][4]; float wv[2][16]; bf16x8 Bf[4], Bn[4];
#pragma unroll
        for (int tq = 0; tq < 2; ++tq) {
#pragma unroll
            for (int ks = 0; ks < 4; ++ks) Af[tq][ks] = AfN[tq][ks];
#pragma unroll
            for (int g = 0; g < 2; ++g) { const u32x4 w8 = wN[tq][g];
#pragma unroll
                for (int x = 0; x < 4; ++x) { wv[tq][8 * g + 2 * x] = bfl(w8[x]) * WSC; wv[tq][8 * g + 2 * x + 1] = bfh(w8[x]) * WSC; } } }
#pragma unroll
        for (int ks = 0; ks < 4; ++ks) Bf[ks] = BfN[ks];
        for (int blk = wid; blk < nblk; blk += 8) {
            const int key = blk * 32 + r32;
            if (blk + 8 < nblk) {
#pragma unroll
                for (int ks = 0; ks < 4; ++ks) Bn[ks] = *(const bf16x8*)(PROJ + (rb + key + 256) * NP + C_KI + ks * 16 + hi * 8);
            }
#pragma unroll
            for (int tq = 0; tq < 2; ++tq) { f32x16 acc = {};
#pragma unroll
                for (int ks = 0; ks < 4; ++ks) acc = __builtin_amdgcn_mfma_f32_32x32x16_f16(__builtin_bit_cast(pg8::half8, Af[tq][ks]), __builtin_bit_cast(pg8::half8, Bf[ks]), acc, 0, 0, 0);
#pragma unroll
                for (int g = 0; g < 2; ++g) { float s = 0.f;
#pragma unroll
                    for (int x = 0; x < 8; ++x) s += wv[tq][8 * g + x] * fmaxf(acc[8 * g + x], 0.f);
                    const int ql = tq * 4 + 2 * g + hi; const int qp = q0 + ql;
                    SC[ql * 4096 + key] = (key > qp) ? 0u : sortable(s); } }
#pragma unroll
            for (int ks = 0; ks < 4; ++ks) Bf[ks] = Bn[ks];
        }
        if (tsk + G < NB * 512) { const int tn = tsk + G; const int bn = tn & 7, jn = tn >> 3, basen = jn & 31, rndn = jn >> 5;
            const int q8n = (rndn & 1) ? (32 * rndn + 31 - basen) : (32 * rndn + basen); const int q0n = q8n * 8, nblkn = (q0n >> 5) + 1; const size_t rbn = (size_t)bn * T;
            SEL_LOAD(q0n, nblkn, rbn); }
        __syncthreads();
        for (int rep_r = 0; rep_r < (int)((DUP_MASK >> 14) & 1) + 1; ++rep_r)
        {
            const int qp = q0 + wid; unsigned long long myword = 0ull;
            if (qp < 256) { const int lo = lane * 64; myword = (qp >= lo + 63) ? ~0ull : (qp < lo ? 0ull : ((2ull << (qp - lo)) - 1ull)); }
            else {
                int lane_t = lane; asm volatile("" : "+v"(lane_t));
                const LAS unsigned* scl = SC + wid * 4096 + lane_t; const int nscan = nblk * 32;
                unsigned u[64]; const int nreg = (nscan + 63) >> 6;
#pragma unroll
                for (int j4 = 0; j4 < 64; ++j4) { if ((j4 & ~15) < nreg) { const unsigned v_ = scl[64 * j4]; u[j4] = (lane_t < nscan - 64 * j4) ? v_ : 0u; } else u[j4] = 0u; }
                unsigned umax = 0u, umin = 0xFFFFFFFFu;
#pragma unroll
                for (int j4 = 0; j4 < 64; ++j4) { if ((j4 & ~15) < nreg) { umax = max(umax, u[j4]); umin = min(umin, u[j4] ? u[j4] : 0xFFFFFFFFu); } }
                umax = wave_max_u(umax); umin = wave_min_u(umin);
                unsigned lo = umin, hi = umax + 1u; int c_lo = qp + 1, c_hi = 0;
                while (c_lo - c_hi > 64 && hi - lo > 1u) {
                    const unsigned hm = hi - 1u;
                    const float lf = __uint_as_float((lo & 0x80000000u) ? (lo ^ 0x80000000u) : ~lo), hf = __uint_as_float((hm & 0x80000000u) ? (hm ^ 0x80000000u) : ~hm);
                    unsigned mid = sortable(0.5f * lf + 0.5f * hf);
                    mid = (mid <= lo) ? lo + 1u : ((mid >= hi) ? hi - 1u : mid);
                    int cl = 0;
#pragma unroll
                    for (int j4 = 0; j4 < 64; ++j4) { if ((j4 & ~15) < nreg) cl += (u[j4] >= mid) ? 1 : 0; }
                    const int c = wave_sum_i(cl);
                    if (c >= 256) { lo = mid; c_lo = c; } else { hi = mid; c_hi = c; }
                }
                unsigned Tk; int kth, neq;
                if (hi - lo == 1u) { Tk = lo; kth = 256 - c_hi; neq = c_lo - c_hi; }
                else {
                    LAS unsigned* CAND = HI; int pos = 0;
#pragma unroll
                    for (int j4 = 0; j4 < 64; ++j4) { if ((j4 & ~15) < nreg) { const bool in_ = (u[j4] >= lo) && (u[j4] < hi); const unsigned long long bm = __ballot(in_);
                        if (bm) { if (in_) CAND[pos + __builtin_popcountll(bm & ((1ull << lane_t) - 1ull))] = u[j4]; pos += __builtin_popcountll(bm); } } }
                    LDS_WAIT();
                    const int m_ = pos; const unsigned mine = (lane_t < m_) ? CAND[lane_t] : 0u;
                    int rg = 0, re = 0;
                    for (int x = 0; x < m_; ++x) { const unsigned v_ = __builtin_amdgcn_readlane(mine, x); rg += (v_ > mine) ? 1 : 0; re += (v_ == mine) ? 1 : 0; }
                    const int need = 256 - c_hi;
                    const bool is_t = (lane_t < m_) && (rg < need) && (need <= rg + re);
                    const unsigned long long bt = __ballot(is_t); const int Lt = (int)__builtin_ctzll(bt | (1ull << 63));
                    Tk = __builtin_amdgcn_readlane(mine, Lt); kth = need - __builtin_amdgcn_readlane(rg, Lt); neq = __builtin_amdgcn_readlane(re, Lt);
                }
                int eqtaken = 0; unsigned mw_lo = 0u, mw_hi = 0u;
                if (kth == neq) {
#pragma unroll
                    for (int jt = 0; jt < 64; ++jt) { if ((jt & ~15) < nreg) { const unsigned long long w = __ballot(u[jt] >= Tk); if (lane_t == jt) { mw_lo = (unsigned)w; mw_hi = (unsigned)(w >> 32); } } }
                } else
#pragma unroll
                for (int jt = 0; jt < 64; ++jt) { if ((jt & ~15) < nreg) { const bool gt = u[jt] > Tk, eq = (u[jt] == Tk); const unsigned long long beq = __ballot(eq);
                    const int rank = eqtaken + __builtin_popcountll(beq & ((1ull << lane_t) - 1ull));
                    const unsigned long long w = __ballot(gt || (eq && rank < kth)); eqtaken += __builtin_popcountll(beq);
                    if (lane_t == jt) { mw_lo = (unsigned)w; mw_hi = (unsigned)(w >> 32); } asm volatile("" : "+s"(eqtaken)); } }
                myword = ((unsigned long long)mw_hi << 32) | mw_lo;
            }
            MASK[((size_t)b * 4096 + qp) * 64 + lane] = myword;
        }
        __syncthreads();
    }
#undef SEL_LOAD
}

constexpr int SC_BUF = 43008, SC_YB = 2 * SC_BUF, SC_END = SC_YB + 2 * 2048;
static_assert(SC_END <= RING_BYTES, "scan LDS");
struct ScanP { const bf16_t* PROJ; bf16_t* PROJw; const _Float16* E; const _Float16* A; const bf16_t* VF; const float *mu_r, *mu_k, *k_k, *k_a, *r_k; };
__device__ __forceinline__ void scan_unit(const ScanP& P, int b, int h, int q4, LAS unsigned char* lds, int tid) {
    const int wave = __builtin_amdgcn_readfirstlane(tid >> 6), lane = tid & 63;
    const size_t rb = (size_t)b * T;
    if (wave >= 4) {
        const int pt = tid - 256, tl = pt >> 3, cg = pt & 7; const int ch0 = h * 64 + cg * 8;
        float mur[8], muk[8], kkp[8], kap[8], rkp[8];
#pragma unroll
        for (int i = 0; i < 8; ++i) { mur[i] = P.mu_r[ch0 + i]; muk[i] = P.mu_k[ch0 + i]; kkp[i] = P.k_k[ch0 + i]; kap[i] = P.k_a[ch0 + i]; rkp[i] = P.r_k[ch0 + i]; }
        u32x4 rc, kc, rp, kp, e8, a8; unsigned v2;
#define P_LOAD(cn) do { const int t_ = (cn) * 32 + tl; const size_t m_ = rb + t_; \
            rc = *(const u32x4*)(P.PROJ + m_ * NP + C_R + ch0); kc = *(const u32x4*)(P.PROJ + m_ * NP + C_K + ch0); rp = (u32x4){0u, 0u, 0u, 0u}; kp = (u32x4){0u, 0u, 0u, 0u}; \
            if (t_ > 0) { rp = *(const u32x4*)(P.PROJ + (m_ - 1) * NP + C_R + ch0); kp = *(const u32x4*)(P.PROJ + (m_ - 1) * NP + C_K + ch0); } \
            e8 = *(const u32x4*)(P.E + m_ * 512 + ch0); a8 = *(const u32x4*)(P.A + m_ * 512 + ch0); v2 = *(const unsigned*)(P.VF + m_ * 512 + h * 64 + q4 * 16 + 2 * cg); } while (0)
#define P_COMPUTE(cn) do { LAS unsigned char* buf = lds + ((cn) & 1) * SC_BUF; const size_t m = rb + (cn) * 32 + tl; \
            float r_[8], kl[8], kkv[8], a_[8], e_[8]; float ss = 0.f; \
            _Pragma("unroll") for (int i = 0; i < 8; ++i) { const unsigned wr_ = rc[i >> 1], wrp = rp[i >> 1], wk_ = kc[i >> 1], wkp = kp[i >> 1]; \
                const float xr = (i & 1) ? bfh(wr_) : bfl(wr_), xrp = (i & 1) ? bfh(wrp) : bfl(wrp), xk = (i & 1) ? bfh(wk_) : bfl(wk_), xkp = (i & 1) ? bfh(wkp) : bfl(wkp); \
                r_[i] = xr + (xrp - xr) * mur[i]; kl[i] = xk + (xkp - xk) * muk[i]; kkv[i] = kl[i] * kkp[i]; ss += kkv[i] * kkv[i]; \
                const unsigned we_ = e8[i >> 1], wa_ = a8[i >> 1]; const float el = (i & 1) ? bfh(we_) : bfl(we_), al = (i & 1) ? bfh(wa_) : bfl(wa_); \
                e_[i] = -0.60653065971f * pg8::sigmoidf_(el); a_[i] = pg8::sigmoidf_(al); } \
            ss = allsum8(ss); const float inv = 1.0f / fmaxf(sqrtf(ss), 1e-12f); \
            float kp_[8], kk_[8], nb_[8], dc_[8]; float rk = 0.f; \
            _Pragma("unroll") for (int i = 0; i < 8; ++i) { kk_[i] = kkv[i] * inv; kp_[i] = kl[i] * (1.f + (a_[i] - 1.f) * kap[i]); nb_[i] = -kk_[i] * a_[i]; dc_[i] = __expf(e_[i]); rk += r_[i] * kp_[i] * rkp[i]; } \
            rk = allsum8(rk); \
              \
            const bool wh = (tl & 1) != 0; const int pr = tl >> 1; \
            float rA[8], rB[8]; \
            _Pragma("unroll") for (int i = 0; i < 8; ++i) { rA[i] = dpp_f<0x128>(wh ? dc_[i] : nb_[i]); rB[i] = dpp_f<0x128>(wh ? kk_[i] : kp_[i]); }     \
            float o0[8], o1[8], o2[8], o3[8]; float sa = 0.f, sb = 0.f; \
            _Pragma("unroll") for (int i = 0; i < 8; ++i) { const float dA = dc_[i] * rA[i], dB = dc_[i] * rB[i]; \
                o0[i] = wh ? dA : kk_[i];            \
                o1[i] = dB;                          \
                o2[i] = wh ? nb_[i] : dc_[i] * r_[i];     \
                o3[i] = wh ? kp_[i] : dA;            \
                sa += wh ? rA[i] * kk_[i] : nb_[i] * r_[i];      \
                sb += wh ? rB[i] * kk_[i] : kp_[i] * r_[i]; }    \
            sa = allsum8(sa); sb = allsum8(sb); \
            LAS float* Ob = (LAS float*)buf + (wh ? 4096 : 0) + pr * 64 + cg * 8;            \
            *(LAS f32x4*)(Ob) = (f32x4){o0[0], o0[1], o0[2], o0[3]}; *(LAS f32x4*)(Ob + 4) = (f32x4){o0[4], o0[5], o0[6], o0[7]}; \
            *(LAS f32x4*)(Ob + 1024) = (f32x4){o1[0], o1[1], o1[2], o1[3]}; *(LAS f32x4*)(Ob + 1024 + 4) = (f32x4){o1[4], o1[5], o1[6], o1[7]}; \
            *(LAS f32x4*)(Ob + 2048) = (f32x4){o2[0], o2[1], o2[2], o2[3]}; *(LAS f32x4*)(Ob + 2048 + 4) = (f32x4){o2[4], o2[5], o2[6], o2[7]}; \
            *(LAS f32x4*)(Ob + 3072) = (f32x4){o3[0], o3[1], o3[2], o3[3]}; *(LAS f32x4*)(Ob + 3072 + 4) = (f32x4){o3[4], o3[5], o3[6], o3[7]}; \
            if (wh) { *(LAS f32x4*)(Ob + 4096) = (f32x4){r_[0], r_[1], r_[2], r_[3]}; *(LAS f32x4*)(Ob + 4096 + 4) = (f32x4){r_[4], r_[5], r_[6], r_[7]}; } \
            if (cg == 0) { LAS float* SCL = (LAS float*)buf + 9216 + pr * 4 + (wh ? 0 : 2); SCL[0] = sa; SCL[1] = sb; }       \
            LAS float* VV = (LAS float*)buf + 9280; VV[tl * 16 + 2 * cg] = bfl(v2); VV[tl * 16 + 2 * cg + 1] = bfh(v2); \
            if (q4 == 0 && cg == 0) P.PROJw[m * NP + C_RK + h] = (bf16_t)(pkbf(rk, 0.f) & 0xffffu); } while (0)
        P_LOAD(0); P_COMPUTE(0); P_LOAD(1);
        __syncthreads();
        for (int c = 0; c < T / 32; ++c) {
            if (c >= 1) { const LAS float* YB = (const LAS float*)(lds + SC_YB + ((c - 1) & 1) * 2048); const int t = (c - 1) * 32 + tl;
                const float y0 = YB[tl * 16 + 2 * cg], y1 = YB[tl * 16 + 2 * cg + 1];
                *(unsigned*)(P.PROJw + (rb + t) * NP + C_Y + h * 64 + q4 * 16 + 2 * cg) = pkbf(y0, y1); }
            if (c + 1 < T / 32) { P_COMPUTE(c + 1); if (c + 2 < T / 32) P_LOAD(c + 2); }
            __syncthreads();
        }
#undef P_LOAD
#undef P_COMPUTE
        {
            const int c = T / 32; const LAS float* YB = (const LAS float*)(lds + SC_YB + ((c - 1) & 1) * 2048); const int t = (c - 1) * 32 + tl;
            const float y0 = YB[tl * 16 + 2 * cg], y1 = YB[tl * 16 + 2 * cg + 1];
            *(unsigned*)(P.PROJw + (rb + t) * NP + C_Y + h * 64 + q4 * 16 + 2 * cg) = pkbf(y0, y1);
        }
    } else {
        __builtin_amdgcn_s_setprio(3);
        const int rl = lane >> 4, kg = lane & 15, row = wave * 4 + rl;
        f32x4 S = {0.f, 0.f, 0.f, 0.f};
#ifdef SCAN_DUP_CONS
        f32x4 S2 = {0.f, 0.f, 0.f, 0.f}; float ydump = 0.f;
#endif
        __syncthreads();
        for (int c = 0; c < T / 32; ++c) {
            const LAS float* buf = (const LAS float*)(lds + (c & 1) * SC_BUF); LAS float* YB = (LAS float*)(lds + SC_YB + (c & 1) * 2048);
            struct PairOps { f32x4 kk1, wkk2, wr1, w12, n1, k1, nb2, k2, r2, sc; float v1, v2; };
#define SC_LOADP(O, pp) do { const LAS float* b_ = buf + (pp) * 64 + kg * 4; O.kk1 = *(const LAS f32x4*)(b_); O.wkk2 = *(const LAS f32x4*)(b_ + 1024); O.wr1 = *(const LAS f32x4*)(b_ + 2048); O.w12 = *(const LAS f32x4*)(b_ + 3072); \
                O.n1 = *(const LAS f32x4*)(b_ + 4096); O.k1 = *(const LAS f32x4*)(b_ + 5120); O.nb2 = *(const LAS f32x4*)(b_ + 6144); O.k2 = *(const LAS f32x4*)(b_ + 7168); O.r2 = *(const LAS f32x4*)(b_ + 8192); \
                O.sc = *(const LAS f32x4*)(buf + 9216 + (pp) * 4); O.v1 = buf[9280 + (2 * (pp)) * 16 + row]; O.v2 = buf[9280 + (2 * (pp) + 1) * 16 + row]; } while (0)
#define SC_DOT(A, B) ((A[0] * B[0] + A[1] * B[1]) + (A[2] * B[2] + A[3] * B[3]))
#define SC_STEPP(O, pp) do { float d1 = SC_DOT(S, O.kk1), d2 = SC_DOT(S, O.wkk2), d3 = SC_DOT(S, O.wr1); d1 = allsum16(d1); d2 = allsum16(d2); d3 = allsum16(d3); \
                const float s1 = d1, s2 = d2 + s1 * O.sc[0] + O.v1 * O.sc[1], y1 = d3 + s1 * O.sc[2] + O.v1 * O.sc[3]; \
                S = (S * O.w12 + (O.n1 * s1 + O.k1 * O.v1)) + (O.nb2 * s2 + O.k2 * O.v2); \
                float y2 = SC_DOT(S, O.r2); y2 = allsum16(y2); if (kg == 0) { YB[(2 * (pp)) * 16 + row] = y1; YB[(2 * (pp) + 1) * 16 + row] = y2; } } while (0)
            PairOps oA, oB;
            SC_LOADP(oA, 0);
#pragma unroll 2
            for (int pp = 0; pp < 16; pp += 2) {
                SC_LOADP(oB, pp + 1);
                SC_STEPP(oA, pp);
                if (pp + 2 < 16) SC_LOADP(oA, pp + 2);
                SC_STEPP(oB, pp + 1);
            }
#undef SC_LOADP
#undef SC_DOT
#undef SC_STEPP
            __syncthreads();
        }
        __builtin_amdgcn_s_setprio(0);
    }
    __syncthreads();
}

namespace sck {
typedef float f32x2v __attribute__((ext_vector_type(2)));
constexpr int SLOT = 10496, GBUF = 4 * SLOT;
constexpr int PS_OFF = 2 * GBUF, PS_SZ = 4608;
constexpr int CS_OFF = PS_OFF + 4 * PS_SZ;
constexpr int YB_OFF = CS_OFF + 3072, CST_OFF = YB_OFF + 2 * 4096, END = CST_OFF + 5 * 256;
static_assert(END <= 131072, "chunked scan LDS");
__device__ __forceinline__ f32x4 mf(u32x4 a, u32x4 b, f32x4 c) { return __builtin_amdgcn_mfma_f32_16x16x32_f16(__builtin_bit_cast(pg8::half8, a), __builtin_bit_cast(pg8::half8, b), c, 0, 0, 0); }
__device__ __forceinline__ u32x4 pack8(const float* x) { u32x4 w; w.x = pkbf(x[0], x[1]); w.y = pkbf(x[2], x[3]); w.z = pkbf(x[4], x[5]); w.w = pkbf(x[6], x[7]); return w; }
__device__ __forceinline__ u32x2 pack4(f32x4 v) { u32x2 w; w.x = pkbf(v[0], v[1]); w.y = pkbf(v[2], v[3]); return w; }
__device__ __forceinline__ f32x4 unpack4(u32x2 w) { return (f32x4){bfl(w.x), bfh(w.x), bfl(w.y), bfh(w.y)}; }
__device__ __forceinline__ void sth(LAS bf16_t* p, float v) { *p = (bf16_t)(pkbf(v, 0.f) & 0xffffu); }
}

__device__ __forceinline__ void scan_unit_chunk(const ScanP& P, int b, int h, int q4, LAS unsigned char* lds, int tid) {
    using namespace sck;
    const int wave = __builtin_amdgcn_readfirstlane(tid >> 6), lane = tid & 63;
    const int n16 = lane & 15, g = lane >> 4;
    const size_t rb = (size_t)b * T;
    constexpr int NG = T / 64;
    if (tid < 64) { LAS float* cst = (LAS float*)(lds + CST_OFF); const int ch = h * 64 + tid; cst[tid] = P.mu_r[ch]; cst[64 + tid] = P.mu_k[ch]; cst[128 + tid] = P.k_k[ch]; cst[192 + tid] = P.k_a[ch]; cst[256 + tid] = P.r_k[ch]; }
    __syncthreads();
    if (wave >= 4) {
        const int p = wave - 4;
        LAS unsigned char* ps = lds + PS_OFF + p * PS_SZ;
        LAS float* LAB = (LAS float*)ps; LAS bf16_t* LAK = (LAS bf16_t*)(ps + 1024); LAS bf16_t* MRK = (LAS bf16_t*)(ps + 1536); LAS bf16_t* VT = (LAS bf16_t*)(ps + 2048); LAS bf16_t* K2T = (LAS bf16_t*)(ps + 2560);
        const LAS float* CST = (const LAS float*)(lds + CST_OFF);
        u32x4 rc[2], kc[2], rp[2], kp[2], e8[2], a8[2]; u32x2 v4;
#define CK_LOAD(gi) do { const int t_ = (gi) * 64 + p * 16 + n16; const size_t m_ = rb + t_; \
            _Pragma("unroll") for (int s = 0; s < 2; ++s) { const int co = h * 64 + 32 * s + 8 * g; \
                rc[s] = *(const u32x4*)(P.PROJ + m_ * NP + C_R + co); kc[s] = *(const u32x4*)(P.PROJ + m_ * NP + C_K + co); rp[s] = (u32x4){0u, 0u, 0u, 0u}; kp[s] = (u32x4){0u, 0u, 0u, 0u}; \
                if (t_ > 0) { rp[s] = *(const u32x4*)(P.PROJ + (m_ - 1) * NP + C_R + co); kp[s] = *(const u32x4*)(P.PROJ + (m_ - 1) * NP + C_K + co); } \
                e8[s] = *(const u32x4*)(P.E + m_ * 512 + co); a8[s] = *(const u32x4*)(P.A + m_ * 512 + co); } \
            v4 = *(const u32x2*)(P.VF + m_ * 512 + h * 64 + q4 * 16 + 4 * g); } while (0)
        CK_LOAD(0);
        for (int gi = 0; gi <= NG; ++gi) {
            if (gi < NG) {
                int n16q_ = n16, gq_ = g; asm volatile("" : "+v"(n16q_), "+v"(gq_));
                { const int n16 = n16q_, g = gq_, lane = gq_ * 16 + n16q_; (void)lane;
                LAS unsigned char* sl = lds + (gi & 1) * GBUF + p * SLOT;
                const size_t m = rb + gi * 64 + p * 16 + n16;
                const LAS float* CSTg = CST + 8 * g; LAS bf16_t* B2Tg = (LAS bf16_t*)(sl + 4096) + (8 * g) * 16 + n16; LAS bf16_t* K2Tg = K2T + (8 * g) * 16 + n16; LAS float* G15g = (LAS float*)(sl + 10240) + 8 * g;
                asm volatile("" : "+v"(CSTg), "+v"(B2Tg), "+v"(K2Tg), "+v"(G15g));
                float ss = 0.f;
#pragma unroll
                for (int s = 0; s < 2; ++s)
#pragma unroll
                    for (int e = 0; e < 8; ++e) { const unsigned wk_ = kc[s][e >> 1], wkp = kp[s][e >> 1]; const float xk = (e & 1) ? bfh(wk_) : bfl(wk_), xkp = (e & 1) ? bfh(wkp) : bfl(wkp);
                        const float kkv = (xk + (xkp - xk) * CSTg[64 + 32 * s + e]) * CSTg[128 + 32 * s + e]; ss += kkv * kkv; }
                ss += __shfl_xor(ss, 16); ss += __shfl_xor(ss, 32);
                const float inv = 1.0f / fmaxf(sqrtf(ss), 1e-12f);
                u32x4 AFf[2], PFf[2], A1f[2], B1f[2], K1f[2], P1f[2]; float rk = 0.f;
#pragma unroll
                for (int s = 0; s < 2; ++s) { float al[8], al1[8], be1[8], ka1[8], rh[8], rh1[8];
#pragma unroll
                    for (int e = 0; e < 8; ++e) { const unsigned wr_ = rc[s][e >> 1], wrp = rp[s][e >> 1], wk_ = kc[s][e >> 1], wkp = kp[s][e >> 1], we_ = e8[s][e >> 1], wa_ = a8[s][e >> 1];
                        const float xr = (e & 1) ? bfh(wr_) : bfl(wr_), xrp = (e & 1) ? bfh(wrp) : bfl(wrp), xk = (e & 1) ? bfh(wk_) : bfl(wk_), xkp = (e & 1) ? bfh(wkp) : bfl(wkp);
                        const float el = (e & 1) ? bfh(we_) : bfl(we_), alg = (e & 1) ? bfh(wa_) : bfl(wa_);
                        constexpr int dummy_ = 0; (void)dummy_; const float rq = xr + (xrp - xr) * CSTg[32 * s + e], kl = xk + (xkp - xk) * CSTg[64 + 32 * s + e]; const float kk = kl * CSTg[128 + 32 * s + e] * inv;
                        const float a_ = alg, ev = el;
                        const float kpv = kl * (1.f + (a_ - 1.f) * CSTg[192 + 32 * s + e]), bb = kk * a_; rk += rq * kpv * CSTg[256 + 32 * s + e];
                        float cum = ev;
                        cum += dpp_f<0x111>(cum); cum += dpp_f<0x112>(cum); cum += dpp_f<0x114>(cum); cum += dpp_f<0x118>(cum);
                        const float cumx = cum - ev; const float c7 = dpp_f<0x157>(cum), c15 = dpp_f<0x15F>(cum);
                        const float GGm = __builtin_amdgcn_exp2f(cum - c7), iGm = __builtin_amdgcn_rcpf(GGm), iW = __builtin_amdgcn_exp2f(-ev), Gm = __builtin_amdgcn_exp2f(c7), Dm = __builtin_amdgcn_exp2f(c15 - c7);
                        const float G = GGm * Gm, GpGm = GGm * iW, Gp = GpGm * Gm, iG15 = Dm * iGm; (void)cumx;
                        al[e] = Gp * kk; al1[e] = GpGm * kk; be1[e] = bb * iGm; ka1[e] = kpv * iGm; rh[e] = G * rq; rh1[e] = GGm * rq;
                        sth(B2Tg + (32 * s + e) * 16, bb * iG15); sth(K2Tg + (32 * s + e) * 16, kpv * iG15);
                        if (n16 == 0) G15g[32 * s + e] = Gm * Dm;
                        asm volatile("" ::: "memory"); }
                    AFf[s] = pack8(al); PFf[s] = pack8(rh); A1f[s] = pack8(al1); B1f[s] = pack8(be1); K1f[s] = pack8(ka1); P1f[s] = pack8(rh1);
                    *(LAS u32x4*)(sl + 0 + n16 * 128 + (32 * s + 8 * g) * 2) = AFf[s]; *(LAS u32x4*)(sl + 2048 + n16 * 128 + (32 * s + 8 * g) * 2) = PFf[s]; }
                rk += __shfl_xor(rk, 16); rk += __shfl_xor(rk, 32);
                if (q4 == 0 && g == 0) P.PROJw[m * NP + C_RK + h] = (bf16_t)(pkbf(rk, 0.f) & 0xffffu);
                const f32x4 z4 = {0.f, 0.f, 0.f, 0.f};
                f32x4 Lab = mf(A1f[1], B1f[1], mf(A1f[0], B1f[0], z4)), Lak = mf(A1f[1], K1f[1], mf(A1f[0], K1f[0], z4)), Mrb = mf(P1f[1], B1f[1], mf(P1f[0], B1f[0], z4)), Mrk = mf(P1f[1], K1f[1], mf(P1f[0], K1f[0], z4));
                { int nm = n16, gm = g; asm volatile("" : "+v"(nm), "+v"(gm));
#pragma unroll
                  for (int x = 0; x < 4; ++x) { const int j = 4 * gm + x; if (!(j > nm)) { Lab[x] = 0.f; Lak[x] = 0.f; } if (!(j >= nm)) { Mrb[x] = 0.f; Mrk[x] = 0.f; } } }
#pragma unroll
                for (int x = 0; x < 4; ++x) { const int j = 4 * g + x; LAB[j * 16 + n16] = Lab[x]; sth(LAK + j * 16 + n16, Lak[x]); sth(MRK + j * 16 + n16, Mrk[x]); sth((LAS bf16_t*)(sl + 6656) + j * 16 + n16, Mrb[x]); }
                { VT[(4 * g + 0) * 16 + n16] = (bf16_t)(v4.x & 0xffffu); VT[(4 * g + 1) * 16 + n16] = (bf16_t)(v4.x >> 16); VT[(4 * g + 2) * 16 + n16] = (bf16_t)(v4.y & 0xffffu); VT[(4 * g + 3) * 16 + n16] = (bf16_t)(v4.y >> 16); }
                LDS_WAIT();
                { float t[16]; int nl = n16; asm volatile("" : "+v"(nl));
#pragma unroll
                  for (int j = 0; j < 16; ++j) { const f32x4 r0 = *(const LAS f32x4*)(LAB + j * 16), r1 = *(const LAS f32x4*)(LAB + j * 16 + 4), r2 = *(const LAS f32x4*)(LAB + j * 16 + 8), r3 = *(const LAS f32x4*)(LAB + j * 16 + 12);
                      const float row[16] = {r0[0], r0[1], r0[2], r0[3], r1[0], r1[1], r1[2], r1[3], r2[0], r2[1], r2[2], r2[3], r3[0], r3[1], r3[2], r3[3]};
                      float acc = (j == nl) ? 1.f : 0.f;
#pragma unroll
                      for (int i = 0; i < 16; ++i) if (i < j) acc -= row[i] * t[i];
                      t[j] = acc; asm volatile("" ::: "memory"); }
                  if (g == 0) {
#pragma unroll
                      for (int j = 0; j < 16; ++j) sth((LAS bf16_t*)(sl + 6144) + j * 16 + n16, t[j]); } }
                { const u32x4 z = {0u, 0u, 0u, 0u};
                  const u32x4 LakF = (g < 2) ? *(const LAS u32x4*)(LAK + n16 * 16 + 8 * g) : z, MrkF = (g < 2) ? *(const LAS u32x4*)(MRK + n16 * 16 + 8 * g) : z, VFr = (g < 2) ? *(const LAS u32x4*)(VT + n16 * 16 + 8 * g) : z;
                  const f32x4 LV = mf(LakF, VFr, z4), YV = mf(MrkF, VFr, z4);
                  *(LAS u32x2*)(sl + 7168 + lane * 8) = pack4(LV); *(LAS u32x2*)(sl + 7680 + lane * 8) = pack4(YV);
#pragma unroll
                  for (int rt = 0; rt < 4; ++rt) { const u32x4 K2F = (g < 2) ? *(const LAS u32x4*)(K2T + (16 * rt + n16) * 16 + 8 * g) : z; const f32x4 KV = mf(K2F, VFr, z4);
                      *(LAS u32x2*)(sl + 8192 + rt * 512 + lane * 8) = pack4(KV); } }
                if (gi + 1 < NG) CK_LOAD(gi + 1);
                }
            }
            __syncthreads();
        }
#undef CK_LOAD
    } else {
        f32x4 S32[4]; S32[0] = S32[1] = S32[2] = S32[3] = (f32x4){0.f, 0.f, 0.f, 0.f};
        LAS unsigned char* cs = lds + CS_OFF;
        if (wave == 0) {
#pragma unroll
            for (int rt = 0; rt < 4; ++rt) *(LAS u32x2*)(cs + 1024 + n16 * 128 + (16 * rt + 4 * g) * 2) = (u32x2){0u, 0u};
        }
        __syncthreads();
        for (int gi = 0; gi < NG; ++gi) {
            if (wave == 0) {
                const u32x4 z = {0u, 0u, 0u, 0u}; const f32x4 z4 = {0.f, 0.f, 0.f, 0.f};
                LAS float* YB = (LAS float*)(lds + YB_OFF + (gi & 1) * 4096);
                for (int pc = 0; pc < 4; ++pc) {
                    int n16q_ = n16, gq_ = g; asm volatile("" : "+v"(n16q_), "+v"(gq_));
                    const int n16 = n16q_, g = gq_, lane = gq_ * 16 + n16q_;
                    const LAS unsigned char* sl = lds + (gi & 1) * GBUF + pc * SLOT;
                    LDS_WAIT();
                    const u32x4 S0 = *(const LAS u32x4*)(cs + 1024 + n16 * 128 + (8 * g) * 2), S1 = *(const LAS u32x4*)(cs + 1024 + n16 * 128 + (32 + 8 * g) * 2);
                    const u32x4 A0 = *(const LAS u32x4*)(sl + n16 * 128 + (8 * g) * 2), A1 = *(const LAS u32x4*)(sl + n16 * 128 + (32 + 8 * g) * 2);
                    const u32x4 P0 = *(const LAS u32x4*)(sl + 2048 + n16 * 128 + (8 * g) * 2), P1 = *(const LAS u32x4*)(sl + 2048 + n16 * 128 + (32 + 8 * g) * 2);
                    const f32x4 LV = unpack4(*(const LAS u32x2*)(sl + 7168 + lane * 8)), YV = unpack4(*(const LAS u32x2*)(sl + 7680 + lane * 8));
                    const f32x4 Ub = mf(A1, S1, mf(A0, S0, LV));
                    *(LAS u32x2*)(cs + 0 + n16 * 32 + (4 * g) * 2) = pack4(Ub);
                    LDS_WAIT();
                    const u32x4 UbF = (g < 2) ? *(const LAS u32x4*)(cs + 0 + n16 * 32 + (8 * g) * 2) : z;
                    const u32x4 TF = (g < 2) ? *(const LAS u32x4*)(sl + 6144 + n16 * 32 + (8 * g) * 2) : z;
                    f32x4 U = mf(TF, UbF, z4); U = -U;
                    *(LAS u32x2*)(cs + 512 + n16 * 32 + (4 * g) * 2) = pack4(U);
                    LDS_WAIT();
                    const u32x4 UF = (g < 2) ? *(const LAS u32x4*)(cs + 512 + n16 * 32 + (8 * g) * 2) : z;
                    const u32x4 MF = (g < 2) ? *(const LAS u32x4*)(sl + 6656 + n16 * 32 + (8 * g) * 2) : z;
                    const f32x4 Y = mf(MF, UF, mf(P1, S1, mf(P0, S0, YV)));
#pragma unroll
                    for (int x = 0; x < 4; ++x) YB[(pc * 16 + 4 * g + x) * 16 + n16] = Y[x];
#pragma unroll
                    for (int rt = 0; rt < 4; ++rt) { const u32x4 BF = (g < 2) ? *(const LAS u32x4*)(sl + 4096 + (16 * rt + n16) * 32 + (8 * g) * 2) : z;
                        const f32x4 KV = unpack4(*(const LAS u32x2*)(sl + 8192 + rt * 512 + lane * 8)); const f32x4 G15 = *(const LAS f32x4*)(sl + 10240 + (16 * rt + 4 * g) * 4);
                        S32[rt] = mf(BF, UF, S32[rt] * G15 + KV);
                        *(LAS u32x2*)(cs + 1024 + n16 * 128 + (16 * rt + 4 * g) * 2) = pack4(S32[rt]); }
                }
            } else if (wave == 1 && gi >= 1) {
                const LAS float* YB = (const LAS float*)(lds + YB_OFF + ((gi - 1) & 1) * 4096) + lane * 16;
                const f32x4 y0 = *(const LAS f32x4*)(YB), y1 = *(const LAS f32x4*)(YB + 4), y2 = *(const LAS f32x4*)(YB + 8), y3 = *(const LAS f32x4*)(YB + 12);
                bf16_t* dst = P.PROJw + (rb + (gi - 1) * 64 + lane) * NP + C_Y + h * 64 + q4 * 16;
                u32x4 w0, w1; w0.x = pkbf(y0[0], y0[1]); w0.y = pkbf(y0[2], y0[3]); w0.z = pkbf(y1[0], y1[1]); w0.w = pkbf(y1[2], y1[3]); w1.x = pkbf(y2[0], y2[1]); w1.y = pkbf(y2[2], y2[3]); w1.z = pkbf(y3[0], y3[1]); w1.w = pkbf(y3[2], y3[3]);
                *(u32x4*)dst = w0; *(u32x4*)(dst + 8) = w1;
            }
            __syncthreads();
        }
        if (wave == 1) {
            const LAS float* YB = (const LAS float*)(lds + YB_OFF + ((NG - 1) & 1) * 4096) + lane * 16;
            const f32x4 y0 = *(const LAS f32x4*)(YB), y1 = *(const LAS f32x4*)(YB + 4), y2 = *(const LAS f32x4*)(YB + 8), y3 = *(const LAS f32x4*)(YB + 12);
            bf16_t* dst = P.PROJw + (rb + (NG - 1) * 64 + lane) * NP + C_Y + h * 64 + q4 * 16;
            u32x4 w0, w1; w0.x = pkbf(y0[0], y0[1]); w0.y = pkbf(y0[2], y0[3]); w0.z = pkbf(y1[0], y1[1]); w0.w = pkbf(y1[2], y1[3]); w1.x = pkbf(y2[0], y2[1]); w1.y = pkbf(y2[2], y2[3]); w1.z = pkbf(y3[0], y3[1]); w1.w = pkbf(y3[2], y3[3]);
            *(u32x4*)dst = w0; *(u32x4*)(dst + 8) = w1;
        }
    }
    __syncthreads();
}

namespace sck2 {
using namespace sck;
constexpr int RG = 8;
constexpr int O_AF = 0, O_PF = 2048, O_B2T = 4096, O_K2T = 6656, O_TT = 9216, O_MRB = 9856, O_LAK = 10496, O_MRK = 11136, O_G15 = 11776, RSLOT = 12288, SA = 128, SB = 40;
constexpr size_t RING_HEAD = (size_t)RG * 4 * RSLOT;
constexpr int PW_SZ = RSLOT + 1024;
constexpr int PCST_OFF = 8 * PW_SZ;
constexpr int GB_SZ = 4 * RSLOT, VT_OFF = 2 * GB_SZ, VT_SZ = 64 * SB, END2 = VT_OFF + 2 * 4 * VT_SZ;
static_assert(PCST_OFF + 1280 <= 131072 && END2 <= 131072 && (size_t)64 * RING_HEAD <= 24 * MiB, "role-split scan: LDS / ring");
constexpr int CW_SCAN = 131072, CW_SCAN_LAYER = 16384;
constexpr unsigned SPIN_CAP = 1u << 21;
__device__ __forceinline__ void spin_ge(unsigned* w, unsigned want, int lane, unsigned* tmo) {
    unsigned sp = 0;
    for (;;) { unsigned v = 0; if (lane == 0) v = __hip_atomic_load(w, __ATOMIC_RELAXED, __HIP_MEMORY_SCOPE_AGENT);
        if ((unsigned)__builtin_amdgcn_readfirstlane(v) >= want) break; __builtin_amdgcn_s_sleep(1);
        if ((++sp & 255u) == 0u) { unsigned t = 0; if (lane == 0) t = __hip_atomic_load(tmo, __ATOMIC_RELAXED, __HIP_MEMORY_SCOPE_AGENT); if (__builtin_amdgcn_readfirstlane(t)) break;
            if (sp > SPIN_CAP) { if (lane == 0) __hip_atomic_store(tmo, 1u, __ATOMIC_RELAXED, __HIP_MEMORY_SCOPE_AGENT); break; } } }
}
__device__ __forceinline__ void spin_min4_ge(unsigned* w, unsigned want, int lane, unsigned* tmo) {
    unsigned sp = 0;
    for (;;) { unsigned v = 0xffffffffu; if (lane < 4) v = __hip_atomic_load(w + lane, __ATOMIC_RELAXED, __HIP_MEMORY_SCOPE_AGENT);
        const unsigned m = min(min((unsigned)__builtin_amdgcn_readlane(v, 0), (unsigned)__builtin_amdgcn_readlane(v, 1)), min((unsigned)__builtin_amdgcn_readlane(v, 2), (unsigned)__builtin_amdgcn_readlane(v, 3)));
        if (m >= want) break; __builtin_amdgcn_s_sleep(1);
        if ((++sp & 255u) == 0u) { unsigned t = 0; if (lane == 0) t = __hip_atomic_load(tmo, __ATOMIC_RELAXED, __HIP_MEMORY_SCOPE_AGENT); if (__builtin_amdgcn_readfirstlane(t)) break;
            if (sp > SPIN_CAP) { if (lane == 0) __hip_atomic_store(tmo, 1u, __ATOMIC_RELAXED, __HIP_MEMORY_SCOPE_AGENT); break; } } }
}
typedef _Float16 half4 __attribute__((ext_vector_type(4)));
__device__ __forceinline__ f32x4 mf16(u32x2 a, u32x2 b, f32x4 c) { return __builtin_amdgcn_mfma_f32_16x16x16f16(__builtin_bit_cast(half4, a), __builtin_bit_cast(half4, b), c, 0, 0, 0); }
__device__ __forceinline__ void store_wt(unsigned char* p, u32x4 v) { asm volatile("global_store_dwordx4 %0, %1, off sc1" :: "v"((GAS unsigned char*)p), "v"(v) : "memory"); }
}

__device__ __forceinline__ void scan_unit_share(const ScanP& P, int b, int h, int role, LAS unsigned char* lds, int tid, unsigned char* ring_all, unsigned* flags, unsigned xcc) {
    using namespace sck2;
    const int wave = __builtin_amdgcn_readfirstlane(tid >> 6), lane = tid & 63;
    const int n16 = lane & 15, g = lane >> 4;
    const size_t rb = (size_t)b * T;
    constexpr int NG = T / 64, NC = T / 16;
    const int head = b * 8 + h;
    unsigned char* ring = ring_all + (size_t)head * RING_HEAD;
    unsigned* ready = flags + head * 64; unsigned* done = flags + 8192 + head * 64; unsigned* tmo = flags + 16320; unsigned* xw = flags + 12288 + head * 4;
    if (tid == 0) __hip_atomic_store(xw + role, xcc + 1u, __ATOMIC_RELAXED, __HIP_MEMORY_SCOPE_AGENT);
#define COXCD(res_) do { unsigned v_[4]; _Pragma("unroll") for (int q_ = 0; q_ < 4; ++q_) { spin_ge(xw + q_, 1u, lane, tmo); unsigned t_ = 0; if (lane == 0) t_ = __hip_atomic_load(xw + q_, __ATOMIC_RELAXED, __HIP_MEMORY_SCOPE_AGENT); v_[q_] = (unsigned)__builtin_amdgcn_readfirstlane(t_); } \
        res_ = (v_[0] == v_[1]) && (v_[1] == v_[2]) && (v_[2] == v_[3]) && (v_[0] != 0u); } while (0)
    if (role != 0) {
        if (tid < 64) { LAS float* cst = (LAS float*)(lds + PCST_OFF); const int ch = h * 64 + tid; cst[tid] = P.mu_r[ch]; cst[64 + tid] = P.mu_k[ch]; cst[128 + tid] = P.k_k[ch]; cst[192 + tid] = P.k_a[ch]; cst[256 + tid] = P.r_k[ch]; }
        __syncthreads();
        const int pw = (role - 1) * 8 + wave;
        LAS unsigned char* sl = lds + wave * PW_SZ; LAS float* LAB = (LAS float*)(sl + RSLOT);
        const LAS float* CST = (const LAS float*)(lds + PCST_OFF);
        u32x4 rc[2], kc[2], rp[2], kp[2], e8[2], a8[2];
#define CK_LOAD(cx) do { const int t_ = (cx) * 16 + n16; const size_t m_ = rb + t_; \
            _Pragma("unroll") for (int s = 0; s < 2; ++s) { const int co = h * 64 + 32 * s + 8 * g; \
                rc[s] = *(const u32x4*)(P.PROJ + m_ * NP + C_R + co); kc[s] = *(const u32x4*)(P.PROJ + m_ * NP + C_K + co); rp[s] = (u32x4){0u, 0u, 0u, 0u}; kp[s] = (u32x4){0u, 0u, 0u, 0u}; \
                if (t_ > 0) { rp[s] = *(const u32x4*)(P.PROJ + (m_ - 1) * NP + C_R + co); kp[s] = *(const u32x4*)(P.PROJ + (m_ - 1) * NP + C_K + co); } \
                e8[s] = *(const u32x4*)(P.E + m_ * 512 + co); a8[s] = *(const u32x4*)(P.A + m_ * 512 + co); } } while (0)
        CK_LOAD(pw);
        bool cox; COXCD(cox);
        for (int c = pw; c < NC; c += 24) {
            int n16q_ = n16, gq_ = g; asm volatile("" : "+v"(n16q_), "+v"(gq_));
            { const int n16 = n16q_, g = gq_, lane = gq_ * 16 + n16q_;
            const size_t m = rb + c * 16 + n16;
            const LAS float* CSTg = CST + 8 * g; LAS bf16_t* B2Tg = (LAS bf16_t*)(sl + O_B2T) + (8 * g) * (SB / 2) + n16; LAS bf16_t* K2Tg = (LAS bf16_t*)(sl + O_K2T) + (8 * g) * (SB / 2) + n16; LAS float* G15g = (LAS float*)(sl + O_G15) + 8 * g;
            asm volatile("" : "+v"(CSTg), "+v"(B2Tg), "+v"(K2Tg), "+v"(G15g));
            float ss = 0.f;
#pragma unroll
            for (int s = 0; s < 2; ++s)
#pragma unroll
                for (int e = 0; e < 8; ++e) { const unsigned wk_ = kc[s][e >> 1], wkp = kp[s][e >> 1]; const float xk = (e & 1) ? bfh(wk_) : bfl(wk_), xkp = (e & 1) ? bfh(wkp) : bfl(wkp);
                    const float kkv = (xk + (xkp - xk) * CSTg[64 + 32 * s + e]) * CSTg[128 + 32 * s + e]; ss += kkv * kkv; }
            ss += __shfl_xor(ss, 16); ss += __shfl_xor(ss, 32);
            const float inv = 1.0f / fmaxf(sqrtf(ss), 1e-12f);
            u32x4 A1f[2], B1f[2], K1f[2], P1f[2]; float rk = 0.f;
#pragma unroll
            for (int s = 0; s < 2; ++s) { float al[8], al1[8], be1[8], ka1[8], rh[8], rh1[8];
#pragma unroll
                for (int e = 0; e < 8; ++e) { const unsigned wr_ = rc[s][e >> 1], wrp = rp[s][e >> 1], wk_ = kc[s][e >> 1], wkp = kp[s][e >> 1], we_ = e8[s][e >> 1], wa_ = a8[s][e >> 1];
                    const float xr = (e & 1) ? bfh(wr_) : bfl(wr_), xrp = (e & 1) ? bfh(wrp) : bfl(wrp), xk = (e & 1) ? bfh(wk_) : bfl(wk_), xkp = (e & 1) ? bfh(wkp) : bfl(wkp);
                    const float ev = (e & 1) ? bfh(we_) : bfl(we_), a_ = (e & 1) ? bfh(wa_) : bfl(wa_);
                    const float rq = xr + (xrp - xr) * CSTg[32 * s + e], kl = xk + (xkp - xk) * CSTg[64 + 32 * s + e]; const float kk = kl * CSTg[128 + 32 * s + e] * inv;
                    const float kpv = kl * (1.f + (a_ - 1.f) * CSTg[192 + 32 * s + e]), bb = kk * a_; rk += rq * kpv * CSTg[256 + 32 * s + e];
                    float cum = ev;
                    cum += dpp_f<0x111>(cum); cum += dpp_f<0x112>(cum); cum += dpp_f<0x114>(cum); cum += dpp_f<0x118>(cum);
                    const float c7 = dpp_f<0x157>(cum), c15 = dpp_f<0x15F>(cum);
                    const float GGm = __builtin_amdgcn_exp2f(cum - c7), iGm = __builtin_amdgcn_rcpf(GGm), iW = __builtin_amdgcn_exp2f(-ev), Gm = __builtin_amdgcn_exp2f(c7), Dm = __builtin_amdgcn_exp2f(c15 - c7);
                    const float G = GGm * Gm, GpGm = GGm * iW, Gp = GpGm * Gm, iG15 = Dm * iGm;
                    al[e] = Gp * kk; al1[e] = GpGm * kk; be1[e] = bb * iGm; ka1[e] = kpv * iGm; rh[e] = G * rq; rh1[e] = GGm * rq;
                    sth(B2Tg + (32 * s + e) * (SB / 2), bb * iG15); sth(K2Tg + (32 * s + e) * (SB / 2), kpv * iG15);
                    if (n16 == 0) G15g[32 * s + e] = Gm * Dm;
                    asm volatile("" ::: "memory"); }
                A1f[s] = pack8(al1); B1f[s] = pack8(be1); K1f[s] = pack8(ka1); P1f[s] = pack8(rh1);
                { const u32x4 wa = pack8(al), wp = pack8(rh); LAS unsigned char* ra = sl + n16 * SA; const int u0 = ((8 * s + 2 * g) ^ n16) * 8, u1 = ((8 * s + 2 * g + 1) ^ n16) * 8;
                  *(LAS u32x2*)(ra + O_AF + u0) = (u32x2){wa.x, wa.y}; *(LAS u32x2*)(ra + O_AF + u1) = (u32x2){wa.z, wa.w}; *(LAS u32x2*)(ra + O_PF + u0) = (u32x2){wp.x, wp.y}; *(LAS u32x2*)(ra + O_PF + u1) = (u32x2){wp.z, wp.w}; } }
            rk += __shfl_xor(rk, 16); rk += __shfl_xor(rk, 32);
            if (g == 0) P.PROJw[m * NP + C_RK + h] = (bf16_t)(pkbf(rk, 0.f) & 0xffffu);
            const f32x4 z4 = {0.f, 0.f, 0.f, 0.f};
            f32x4 Lab = mf(A1f[1], B1f[1], mf(A1f[0], B1f[0], z4)), Lak = mf(A1f[1], K1f[1], mf(A1f[0], K1f[0], z4)), Mrb = mf(P1f[1], B1f[1], mf(P1f[0], B1f[0], z4)), Mrk = mf(P1f[1], K1f[1], mf(P1f[0], K1f[0], z4));
            { int nm = n16, gm = g; asm volatile("" : "+v"(nm), "+v"(gm));
#pragma unroll
              for (int x = 0; x < 4; ++x) { const int j = 4 * gm + x; if (!(j > nm)) { Lab[x] = 0.f; Lak[x] = 0.f; } if (!(j >= nm)) { Mrb[x] = 0.f; Mrk[x] = 0.f; } } }
#pragma unroll
            for (int x = 0; x < 4; ++x) { const int j = 4 * g + x; LAB[j * 16 + n16] = Lab[x]; sth((LAS bf16_t*)(sl + O_LAK) + j * (SB / 2) + n16, Lak[x]); sth((LAS bf16_t*)(sl + O_MRK) + j * (SB / 2) + n16, Mrk[x]); sth((LAS bf16_t*)(sl + O_MRB) + j * (SB / 2) + n16, Mrb[x]); }
            LDS_WAIT();
            { float t[16]; int nl = n16; asm volatile("" : "+v"(nl));
#pragma unroll
              for (int j = 0; j < 16; ++j) { const f32x4 r0 = *(const LAS f32x4*)(LAB + j * 16), r1 = *(const LAS f32x4*)(LAB + j * 16 + 4), r2 = *(const LAS f32x4*)(LAB + j * 16 + 8), r3 = *(const LAS f32x4*)(LAB + j * 16 + 12);
                  const float row[16] = {r0[0], r0[1], r0[2], r0[3], r1[0], r1[1], r1[2], r1[3], r2[0], r2[1], r2[2], r2[3], r3[0], r3[1], r3[2], r3[3]};
                  float acc = (j == nl) ? 1.f : 0.f;
#pragma unroll
                  for (int i = 0; i < 16; ++i) if (i < j) acc -= row[i] * t[i];
                  t[j] = acc; asm volatile("" ::: "memory"); }
              if (g == 0) {
#pragma unroll
                  for (int j = 0; j < 16; ++j) sth((LAS bf16_t*)(sl + O_TT) + j * (SB / 2) + n16, t[j]); } }
            if (c + 24 < NC) CK_LOAD(c + 24);
            const int gi = c >> 2;
            if (gi >= RG) spin_ge(done, (unsigned)(gi - RG + 1), lane, tmo);
            LDS_WAIT();
            unsigned char* dst = ring + (size_t)((gi % RG) * 4 + (c & 3)) * RSLOT;
            if (cox) {
#pragma unroll
                for (int i = 0; i < RSLOT / 1024; ++i) *(u32x4*)(dst + (i * 64 + lane) * 16) = *(const LAS u32x4*)(sl + (i * 64 + lane) * 16);
            } else {
#pragma unroll
                for (int i = 0; i < RSLOT / 1024; ++i) store_wt(dst + (i * 64 + lane) * 16, *(const LAS u32x4*)(sl + (i * 64 + lane) * 16));
            }
            VM_WAIT();
            if (lane == 0) (void)__hip_atomic_fetch_add(ready + gi, 1u, __ATOMIC_RELAXED, __HIP_MEMORY_SCOPE_AGENT);
            }
        }
#undef CK_LOAD
    } else {
        if (wave < 4) {
            const int c = wave;
            const f32x4 z4 = {0.f, 0.f, 0.f, 0.f};
            f32x4 S32[4]; S32[0] = S32[1] = S32[2] = S32[3] = z4;
            __syncthreads(); __syncthreads();
            for (int gi = 0; gi < NG; ++gi) {
                int n16q_ = n16, gq_ = g; asm volatile("" : "+v"(n16q_), "+v"(gq_));
                { const int n16 = n16q_, g = gq_;
                const LAS unsigned char* fa0 = lds + (gi & 1) * GB_SZ + n16 * SA;
                const LAS unsigned char* far[4] = {fa0 + ((0 + g) ^ n16) * 8, fa0 + ((4 + g) ^ n16) * 8, fa0 + ((8 + g) ^ n16) * 8, fa0 + ((12 + g) ^ n16) * 8};
                const LAS unsigned char* fb = lds + (gi & 1) * GB_SZ + n16 * SB + 8 * g;
                const LAS unsigned char* fg = lds + (gi & 1) * GB_SZ + O_G15 + 16 * g;
                const LAS unsigned char* fv = lds + VT_OFF + (gi & 1) * 4 * VT_SZ + (16 * c + n16) * SB + 8 * g;
                bf16_t* yp = P.PROJw + (rb + gi * 64 + 4 * g) * NP + C_Y + h * 64 + c * 16 + n16;
#pragma unroll
                for (int pc = 0; pc < 4; ++pc) {
                    const LAS unsigned char* b_ = fb + pc * RSLOT; const LAS unsigned char* g_ = fg + pc * RSLOT;
                    const u32x2 Vh = *(const LAS u32x2*)(fv + pc * VT_SZ);
                    u32x2 sB[4];
#pragma unroll
                    for (int rt = 0; rt < 4; ++rt) sB[rt] = pack4(S32[rt]);
                    f32x4 Ub = mf16(*(const LAS u32x2*)(b_ + O_LAK), Vh, z4);
#pragma unroll
                    for (int rt = 0; rt < 4; ++rt) Ub = mf16(*(const LAS u32x2*)(far[rt] + pc * RSLOT + O_AF), sB[rt], Ub);
                    f32x4 U = mf16(*(const LAS u32x2*)(b_ + O_TT), pack4(Ub), z4); U = -U;
                    const u32x2 Uh = pack4(U);
                    f32x4 Y = mf16(*(const LAS u32x2*)(b_ + O_MRK), Vh, z4);
#pragma unroll
                    for (int rt = 0; rt < 4; ++rt) Y = mf16(*(const LAS u32x2*)(far[rt] + pc * RSLOT + O_PF), sB[rt], Y);
                    Y = mf16(*(const LAS u32x2*)(b_ + O_MRB), Uh, Y);
#pragma unroll
                    for (int x = 0; x < 4; ++x) yp[(size_t)(pc * 16 + x) * NP] = (bf16_t)(pkbf(Y[x], 0.f) & 0xffffu);
#pragma unroll
                    for (int rt = 0; rt < 4; ++rt)
                        S32[rt] = mf16(*(const LAS u32x2*)(b_ + O_B2T + 16 * rt * SB), Uh, mf16(*(const LAS u32x2*)(b_ + O_K2T + 16 * rt * SB), Vh, S32[rt] * *(const LAS f32x4*)(g_ + 64 * rt)));
                }
                }
                __syncthreads();
            }
        } else {
            if (wave < 7) {
                const int lt = tid - 256;
                unsigned long long LR[2][32];
                u32x4 LV2[2][4]; const int vtok = (lt >> 1) & 63, vhalf = lt & 1;
#define LD_GROUP(st_, gj) do { unsigned char* sg = ring + (size_t)(((gj) % RG) * 4) * RSLOT + lt * 16; \
                _Pragma("unroll") for (int i = 0; i < 16; ++i) { LR[st_][2 * i] = __hip_atomic_load((unsigned long long*)(sg + i * 3072), __ATOMIC_RELAXED, __HIP_MEMORY_SCOPE_AGENT);       \
                    LR[st_][2 * i + 1] = __hip_atomic_load((unsigned long long*)(sg + i * 3072 + 8), __ATOMIC_RELAXED, __HIP_MEMORY_SCOPE_AGENT); } \
                if (lt < 128) { const bf16_t* vp = P.VF + (rb + (gj) * 64 + vtok) * 512 + h * 64 + vhalf * 32; _Pragma("unroll") for (int i = 0; i < 4; ++i) LV2[st_][i] = *(const u32x4*)(vp + 8 * i); } } while (0)
#define ST_GROUP(st_, gj) do { LAS unsigned char* db = lds + ((gj) & 1) * GB_SZ + lt * 16; \
                _Pragma("unroll") for (int i = 0; i < 16; ++i) { const unsigned long long a_ = LR[st_][2 * i], b_ = LR[st_][2 * i + 1]; \
                    *(LAS u32x4*)(db + i * 3072) = (u32x4){(unsigned)a_, (unsigned)(a_ >> 32), (unsigned)b_, (unsigned)(b_ >> 32)}; } \
                if (lt < 128) { LAS bf16_t* vt = (LAS bf16_t*)(lds + VT_OFF + (((gj) & 1) * 4 + (vtok >> 4)) * VT_SZ) + (vhalf * 32) * (SB / 2) + (vtok & 15); \
                    _Pragma("unroll") for (int i = 0; i < 4; ++i) { _Pragma("unroll") for (int e = 0; e < 8; ++e) { const unsigned w_ = LV2[st_][i][e >> 1]; \
                        vt[(8 * i + e) * (SB / 2)] = (bf16_t)((e & 1) ? (w_ >> 16) : (w_ & 0xffffu)); } } } } while (0)
                __syncthreads();
                LD_GROUP(0, 0); ST_GROUP(0, 0); LD_GROUP(1, 1); LD_GROUP(0, 2);
                __syncthreads();
                for (int gi = 0; gi < NG; gi += 2) {
                    ST_GROUP(1, gi + 1); if (gi + 3 < NG) LD_GROUP(1, gi + 3);
                    __syncthreads();
                    if (gi + 2 < NG) ST_GROUP(0, gi + 2); if (gi + 4 < NG) LD_GROUP(0, gi + 4);
                    __syncthreads();
                }
#undef LD_GROUP
#undef ST_GROUP
            } else {
                bool cox; COXCD(cox);
                spin_ge(ready + 0, 4u, lane, tmo); spin_ge(ready + 1, 4u, lane, tmo); spin_ge(ready + 2, 4u, lane, tmo); spin_ge(ready + 3, 4u, lane, tmo);
                if (!cox) { __builtin_amdgcn_fence(__ATOMIC_ACQUIRE, "agent"); VM_WAIT(); }
                unsigned pv = __hip_atomic_load(ready + 4, __ATOMIC_RELAXED, __HIP_MEMORY_SCOPE_AGENT);
                __syncthreads();
                __syncthreads();
                for (int gi = 0; gi < NG; ++gi) {
                    if (gi + 4 < NG) { if ((unsigned)__builtin_amdgcn_readfirstlane(pv) < 4u) spin_ge(ready + gi + 4, 4u, lane, tmo);
                        if (!cox) { __builtin_amdgcn_fence(__ATOMIC_ACQUIRE, "agent"); VM_WAIT(); } }
                    if (gi + 5 < NG) pv = __hip_atomic_load(ready + gi + 5, __ATOMIC_RELAXED, __HIP_MEMORY_SCOPE_AGENT);
                    __syncthreads();
                    if (lane == 0) __hip_atomic_store(done, (unsigned)min(gi + 2, NG), __ATOMIC_RELAXED, __HIP_MEMORY_SCOPE_AGENT);
                }
            }
        }
    }
#undef COXCD
    __syncthreads();
}

__device__ __forceinline__ void ph_scan_naive(const ScanP& P, int gw, int NGW, int lane) {
    for (int task = gw; task < 4096; task += NGW) { const int b = task >> 9, h = (task >> 6) & 7, row = task & 63; const int ch = h * 64 + lane;
        const float mur = P.mu_r[ch], muk = P.mu_k[ch], kkp = P.k_k[ch], kap = P.k_a[ch], rkp = P.r_k[ch];
        float S = 0.f, rprev = 0.f, kprev = 0.f;
        for (int t = 0; t < T; ++t) { const size_t m = (size_t)b * 4096 + t;
            const float rc = bf1(P.PROJ[m * NP + C_R + ch]), kc = bf1(P.PROJ[m * NP + C_K + ch]);
            const float r = rc + (rprev - rc) * mur, kl = kc + (kprev - kc) * muk; rprev = rc; kprev = kc;
            const float a = pg8::sigmoidf_((float)P.A[m * 512 + ch]); const float dec = __expf(-0.60653065971f * pg8::sigmoidf_((float)P.E[m * 512 + ch]));
            const float kkv = kl * kkp; const float ss = wave_sum(kkv * kkv); const float kk = kkv / fmaxf(sqrtf(ss), 1e-12f);
            const float kp = kl * (1.f + (a - 1.f) * kap); const float v = bf1(P.VF[m * 512 + h * 64 + row]);
            const float sk = wave_sum(S * kk); S = S * dec - sk * kk * a + v * kp; const float y = wave_sum(S * r);
            if (lane == 0) P.PROJw[m * NP + C_Y + h * 64 + row] = (bf16_t)(pkbf(y, 0.f) & 0xffffu);
            if (row == 0) { const float rk = wave_sum(r * kp * rkp); if (lane == 0) P.PROJw[m * NP + C_RK + h] = (bf16_t)(pkbf(rk, 0.f) & 0xffffu); } } }
}

__device__ __forceinline__ void ph_rwkv_post(const bf16_t* PROJ, const bf16_t* VF, bf16_t* MIX, const float* lnx_g, const float* lnx_b, int gw, int NGW, int lane) {
    float lg[8], lb[8];
#pragma unroll
    for (int i = 0; i < 8; ++i) { lg[i] = lnx_g[lane * 8 + i]; lb[i] = lnx_b[lane * 8 + i]; }
    for (int m = gw; m < M; m += NGW) {
        const u32x4 y8 = *(const u32x4*)(PROJ + (size_t)m * NP + C_Y + lane * 8), v8 = *(const u32x4*)(VF + (size_t)m * 512 + lane * 8), g8 = *(const u32x4*)(MIX + (size_t)m * D + lane * 8);
        const float rk = bf1(PROJ[(size_t)m * NP + C_RK + (lane >> 3)]);
        float y[8]; float s = 0.f;
#pragma unroll
        for (int i = 0; i < 4; ++i) { y[2 * i] = bfl(y8[i]); y[2 * i + 1] = bfh(y8[i]); s += y[2 * i] + y[2 * i + 1]; }
        const float mean = allsum8(s) * (1.f / 64.f); float q = 0.f;
#pragma unroll
        for (int i = 0; i < 8; ++i) { y[i] -= mean; q += y[i] * y[i]; }
        const float rstd = rsqrtf(allsum8(q) * (1.f / 64.f) + 64e-5f);
        float o[8];
#pragma unroll
        for (int i = 0; i < 8; ++i) { const float vv = (i & 1) ? bfh(v8[i >> 1]) : bfl(v8[i >> 1]), gg = (i & 1) ? bfh(g8[i >> 1]) : bfl(g8[i >> 1]);
            o[i] = (y[i] * rstd * lg[i] + lb[i] + rk * vv) * gg; }
        u32x4 w; w.x = pkbf(o[0], o[1]); w.y = pkbf(o[2], o[3]); w.z = pkbf(o[4], o[5]); w.w = pkbf(o[6], o[7]);
        *(u32x4*)(MIX + (size_t)m * D + lane * 8) = w;
    }
}

#ifndef MK_PER_PHASE
#define MK_PER_PHASE 0
#endif
constexpr int N_PHASES = 22;
struct Args { const float* in[32]; float* out; unsigned char* ws; int ph_lo, ph_hi, li, pad; };
__device__ __forceinline__ int opq(int k) { asm volatile("" : "+s"(k)); return k; }
#define INP(k) ((const float*)(const GAS float*)args.in[opq(k)])
#define WSP(T_, off) ((T_*)(wsl + (off)))
#define LAUNDER_WS() GAS unsigned char* wsl = (GAS unsigned char*)args.ws; asm volatile("" : "+s"(wsl)); GAS float* Xg = (GAS float*)Xp_; asm volatile("" : "+s"(Xg)); float* X = (float*)Xg; (void)X; int wave = wave_s; asm volatile("" : "+s"(wave)); \
    unsigned ones_ = ~0u; asm volatile("" : "+s"(ones_)); int tid = wave * 64 + (int)__builtin_amdgcn_mbcnt_hi(ones_, __builtin_amdgcn_mbcnt_lo(ones_, 0u)); asm volatile("" : "+v"(tid)); int G = gridDim.x, bx = blockIdx.x; asm volatile("" : "+s"(G), "+s"(bx)); \
    const int lane = tid & 63; const int vcu = (G % 8 == 0) ? (bx % 8) * (G / 8) + bx / 8 : bx; const int gw = vcu * NWAVES + wave, NGW = G * NWAVES; (void)lane; (void)gw; (void)NGW; (void)vcu
#ifndef PH_MASK
#define PH_MASK 0xFFFFu
#endif
#define PHBIT(k) ((k) == 0 ? 0 : ((k) == 21 ? 11 : (((k) - 1) % 10) + 1))
#define IN(k) (((PH_MASK >> PHBIT(k)) & 1u) && lo <= (k) && (k) < hi)
#ifndef DUP_MASK
#define DUP_MASK 0
#endif
#define DUPN(j) for (int rep_ = 0; rep_ < (int)((DUP_MASK >> (j)) & 1) + 1; ++rep_)
#define SEAM(k) do { if (IN(k) && IN((k) + 1)) { XcdBarrier b2_ = bar; asm volatile("" : "+s"(b2_.bar), "+s"(b2_.x)); xcd_barrier(b2_); } } while (0)
template <int l> __device__ __forceinline__ void layer_body(const Args& args, LAS unsigned char* lds, const XcdBarrier& bar, float* Xp_, const int lo, const int hi, const int wave_s) {
        const int pb = 1 + 10 * l;
        if (IN(pb + 0)) DUPN(0) { LAUNDER_WS();
            WPtrs P; P.w_in = INP(6); P.decay_a = INP(10); P.iclr_a = INP(13); P.gate_a = INP(15); P.vres_a = INP(24); P.mu_lora = INP(8); P.vres_mu = INP(22);
            P.w_out = INP(28); P.w1 = INP(29); P.w2 = INP(30); P.decay_b = INP(11); P.iclr_b = INP(14); P.gate_b = INP(16); P.vres_b = INP(25);
            if (l != 0) ph_weights(P, l, (unsigned char*)wsl, lds, vcu, G, tid);
            const float* MODl = WSP(float, WS_MOD) + (size_t)l * 8 * 6144;
            ph_norm((l == 0) ? INP(0) : (const float*)X, INP(4) + (size_t)l * D, MODl + 0 * D, MODl + 1 * D, WSP(bf16_t, WS_H), gw, NGW, lane);
        }
        SEAM(pb + 0);
        if (IN(pb + 1)) DUPN(1) { LAUNDER_WS();
            pg8::Gemm g{WSP(bf16_t, WS_H), WSP(bf16_t, WS_WIN), M, NP, D, D, D}; pg8::StaticOrder S; S.init(M, NP, G, bx);
            pg8::EpiBf<0> E{WSP(bf16_t, WS_PROJ), NP, C_QA / 256, C_KA / 256, att::C2};
            pg8::gemm_phase<pg8::EpiBf<0>, pg8::StaticOrder, true, true>(lds, g, S, E, tid);
        }
        SEAM(pb + 1);
        if (IN(pb + 2)) DUPN(2) { LAUNDER_WS();
            for (int rep_l = 0; rep_l < (int)((DUP_MASK >> 12) & 1) + 1; ++rep_l)
            ph_lora_act(WSP(bf16_t, WS_PROJ), WSP(bf16_t, WS_LACT), WSP(bf16_t, WS_VF), INP(7) + (size_t)(l * 3 + 2) * 512, l == 0, gw, NGW, lane);
            ph_select(WSP(bf16_t, WS_PROJ), WSP(unsigned long long, WS_MASK), lds, vcu, G, tid);
        }
        SEAM(pb + 2);
        if (IN(pb + 3)) {
            DUPN(3) { LAUNDER_WS(); pg8::Gemm g{WSP(bf16_t, WS_LACT), WSP(bf16_t, WS_LW), M, 1024, 128, LA, 128}; pg8::StaticOrder S; S.init(M, 1024, G, bx);
              pg8::EpiDecIclr E{WSP(_Float16, WS_H), WSP(_Float16, WS_H + 32 * MiB), INP(9) + (size_t)l * 512, INP(12) + (size_t)l * 512};
              pg8::gemm_phase<pg8::EpiDecIclr, pg8::StaticOrder, true, true>(lds, g, S, E, tid); }
            __syncthreads();
            DUPN(3) { LAUNDER_WS(); pg8::Gemm g{WSP(bf16_t, WS_LACT) + 128, WSP(bf16_t, WS_LW) + 1024 * 128, M, 512, 128, LA, 128}; pg8::StaticOrder S; S.init(M, 512, G, bx);
              pg8::EpiBf<0> E{WSP(bf16_t, WS_MIX), D, 0, 0, 1.f};
              pg8::gemm_phase<pg8::EpiBf<0>, pg8::StaticOrder, true, true>(lds, g, S, E, tid); }
            __syncthreads();
            if (l >= 1) { LAUNDER_WS(); pg8::Gemm g{WSP(bf16_t, WS_LACT) + 256, WSP(bf16_t, WS_LW) + 1536 * 128, M, 512, 128, LA, 128}; pg8::StaticOrder S; S.init(M, 512, G, bx);
              pg8::EpiVres E{WSP(bf16_t, WS_PROJ) + C_V, NP, WSP(bf16_t, WS_VF), INP(23) + (size_t)(l - 1) * 512, INP(7) + (size_t)(l * 3 + 2) * 512};
              pg8::gemm_phase<pg8::EpiVres, pg8::StaticOrder, true, true>(lds, g, S, E, tid); }
        }
        SEAM(pb + 3);
        if (IN(pb + 4)) {
            DUPN(4) { LAUNDER_WS();
              ScanP P; P.PROJ = WSP(bf16_t, WS_PROJ); P.PROJw = WSP(bf16_t, WS_PROJ); P.E = WSP(_Float16, WS_H); P.A = WSP(_Float16, WS_H + 32 * MiB); P.VF = WSP(bf16_t, WS_VF);
              P.mu_r = INP(7) + (size_t)(l * 3 + 0) * 512; P.mu_k = INP(7) + (size_t)(l * 3 + 1) * 512;
              P.k_k = INP(17) + (size_t)l * 512; P.k_a = INP(18) + (size_t)l * 512; P.r_k = INP(19) + (size_t)l * 512;
#if defined(SCAN_SHARE)
              if (G == 256) scan_unit_share(P, vcu >> 5, (vcu >> 2) & 7, vcu & 3, lds, tid, WSP(unsigned char, WS_LACT), WSP(unsigned, WS_CTL) + sck2::CW_SCAN + l * sck2::CW_SCAN_LAYER, bar.x);
              else for (int u = vcu; u < 256; u += G) scan_unit_chunk(P, u >> 5, (u >> 2) & 7, u & 3, lds, tid); }
#elif defined(SCAN_CHUNK)
              for (int u = vcu; u < 256; u += G) scan_unit_chunk(P, u >> 5, (u >> 2) & 7, u & 3, lds, tid); }
#elif defined(SCAN_FAST)
              for (int u = vcu; u < 256; u += G) scan_unit(P, u >> 5, (u >> 2) & 7, u & 3, lds, tid); }
#else
              ph_scan_naive(P, gw, NGW, lane); }
#endif
            __syncthreads();
            DUPN(11) { LAUNDER_WS();
              att::build_bias_table(INP(27), (LAS char*)lds, tid);
              __syncthreads();
              const float* gain = INP(26) + (size_t)l * 512;
              for (int v = vcu; v < 256; v += G) { const int bh = v >> 2, s = v & 3;
                  for (int i = 0; i < 4; ++i) { const int qb = (i == 0) ? s : (i == 1) ? 7 - s : (i == 2) ? 8 + s : 15 - s;
                      att::attn_unit(bh >> 3, bh & 7, qb, WSP(bf16_t, WS_PROJ), WSP(unsigned long long, WS_MASK), WSP(bf16_t, WS_MIX), gain, (LAS char*)lds, tid); } } }
        }
        SEAM(pb + 4);
        if (IN(pb + 5)) { LAUNDER_WS(); ph_rwkv_post(WSP(bf16_t, WS_PROJ), WSP(bf16_t, WS_VF), WSP(bf16_t, WS_MIX), INP(20) + (size_t)l * 512, INP(21) + (size_t)l * 512, gw, NGW, lane); }
        SEAM(pb + 5);
        if (IN(pb + 6)) { LAUNDER_WS();
            pg8::Gemm g{WSP(bf16_t, WS_MIX), WSP(bf16_t, WS_WOUT), M, D, D, D, D}; pg8::StaticOrder S; S.init(M, D, G, bx);
            pg8::EpiResid E{(l == 0) ? INP(0) : (const float*)X, X, WSP(float, WS_MOD) + (size_t)l * 8 * 6144 + 2 * D, D};
            pg8::gemm_phase<pg8::EpiResid, pg8::StaticOrder, true, true>(lds, g, S, E, tid);
        }
        SEAM(pb + 6);
        if (IN(pb + 7)) DUPN(7) { LAUNDER_WS(); const float* MODl = WSP(float, WS_MOD) + (size_t)l * 8 * 6144;
            ph_norm(X, INP(5) + (size_t)l * D, MODl + 3 * D, MODl + 4 * D, WSP(bf16_t, WS_H), gw, NGW, lane); }
        SEAM(pb + 7);
        if (IN(pb + 8)) DUPN(8) { LAUNDER_WS();
            pg8::Gemm g{WSP(bf16_t, WS_H), WSP(bf16_t, WS_W1), M, FF, D, D, D}; pg8::StaticOrder S; S.init(M, FF, G, bx);
            pg8::EpiBf<1> E{WSP(bf16_t, WS_PROJ), FF, 0, 0, 1.f};
            pg8::gemm_phase<pg8::EpiBf<1>, pg8::StaticOrder, true, true>(lds, g, S, E, tid);
        }
        SEAM(pb + 8);
        if (IN(pb + 9)) { LAUNDER_WS();
            pg8::Gemm g{WSP(bf16_t, WS_PROJ), WSP(bf16_t, WS_W2), M, D, FF, FF, FF}; pg8::StaticOrder S; S.init(M, D, G, bx);
            pg8::EpiResid E{X, X, WSP(float, WS_MOD) + (size_t)l * 8 * 6144 + 5 * D, D};
            pg8::gemm_phase<pg8::EpiResid, pg8::StaticOrder, true, true>(lds, g, S, E, tid);
        }
        SEAM(pb + 9);
}
__global__ void __launch_bounds__(NWAVES * 64, 2) trunk_fwd(Args args) {
    extern __shared__ __attribute__((aligned(16))) unsigned char lds_raw[];
    LAS unsigned char* lds = (LAS unsigned char*)lds_raw;
    volatile LAS unsigned* MISC = (volatile LAS unsigned*)(lds + MISC_OFF);
    unsigned* ctl = (unsigned*)(args.ws + WS_CTL);
    for (int u = threadIdx.x; u < (LDS_BYTES - LDSCTL_OFF) / 4; u += NWAVES * 64) ((LAS unsigned*)(lds + LDSCTL_OFF))[u] = 0u;
    __syncthreads();
    XcdBarrier bar = xcd_barrier_post(ctl + CW_BAR + args.li * XCD_BAR_WORDS, MISC + 8);
    const int lo = args.ph_lo, hi = args.ph_hi; const int wave_s = __builtin_amdgcn_readfirstlane((int)threadIdx.x >> 6);
    float* Xp_ = args.out;

    if (IN(0)) { LAUNDER_WS(); ph_mod(INP(1), INP(2), INP(3), WSP(float, WS_MOD), lds, vcu, G, tid);
        WPtrs P; P.w_in = INP(6); P.decay_a = INP(10); P.iclr_a = INP(13); P.gate_a = INP(15); P.vres_a = INP(24); P.mu_lora = INP(8); P.vres_mu = INP(22);
        P.w_out = INP(28); P.w1 = INP(29); P.w2 = INP(30); P.decay_b = INP(11); P.iclr_b = INP(14); P.gate_b = INP(16); P.vres_b = INP(25);
        __syncthreads();
        ph_weights(P, 0, (unsigned char*)wsl, lds, vcu, G, tid); }
    SEAM(0);

    layer_body<0>(args, lds, bar, Xp_, lo, hi, wave_s);
    layer_body<1>(args, lds, bar, Xp_, lo, hi, wave_s);
    if (IN(21)) { LAUNDER_WS(); (void)wsl; ph_final_norm(X, INP(31), gw, NGW, lane); }
#undef IN
#undef SEAM
}

extern "C" void kernel_launch(void* const* d_in, const int* in_sizes, int n_in, void* d_out, int out_size, void* d_ws, size_t ws_size, hipStream_t stream) {
    static int grid = 0;
    if (grid == 0) {
        if (n_in != 32 || in_sizes[0] != M * D || out_size != M * D || ws_size < WS_END) { fprintf(stderr, "kernel_launch: unexpected problem: n_in %d in0 %d out %d ws %zu (need %zu)\n", n_in, n_in > 0 ? in_sizes[0] : -1, out_size, ws_size, (size_t)WS_END); grid = -1; return; }
        int dev = 0, cus = 0, per_cu = 0;
        if (hipGetDevice(&dev) != hipSuccess || hipDeviceGetAttribute(&cus, hipDeviceAttributeMultiprocessorCount, dev) != hipSuccess) { grid = -1; return; }
        if (hipFuncSetAttribute((const void*)trunk_fwd, hipFuncAttributeMaxDynamicSharedMemorySize, LDS_BYTES) != hipSuccess) { fprintf(stderr, "kernel_launch: hipFuncSetAttribute failed\n"); grid = -1; return; }
        if (hipOccupancyMaxActiveBlocksPerMultiprocessor(&per_cu, (const void*)trunk_fwd, NWAVES * 64, LDS_BYTES) != hipSuccess || per_cu < 1) { fprintf(stderr, "kernel_launch: occupancy query reports %d workgroups per CU\n", per_cu); }
        (void)hipGetLastError();
        grid = cus;
        if (grid > 256) grid = 256;
    }
    if (grid < 0) return;
    if (hipMemsetAsync((char*)d_ws + WS_CTL, 0, CTL_ZERO_BYTES, stream) != hipSuccess) return;
    Args a{};
    for (int i = 0; i < 32; ++i) a.in[i] = (const float*)d_in[i];
    a.out = (float*)d_out; a.ws = (unsigned char*)d_ws; a.pad = 0;
#if MK_PER_PHASE
    for (int p = 0; p < N_PHASES; ++p) { a.ph_lo = p; a.ph_hi = p + 1; a.li = 0;
        hipLaunchKernelGGL(trunk_fwd, dim3(grid), dim3(NWAVES * 64), LDS_BYTES, stream, a); }
#else
    a.ph_lo = 0; a.ph_hi = N_PHASES; a.li = 0;
    hipLaunchKernelGGL(trunk_fwd, dim3(grid), dim3(NWAVES * 64), LDS_BYTES, stream, a);
#endif
}
```

```cpp
#define SCAN_FAST 1
#define SCAN_CHUNK 1
#define SCAN_SHARE 1
#include <hip/hip_runtime.h>
#include <hip/hip_bf16.h>
#include <cstdio>
#include <cstdint>
#include <cmath>
namespace pg8 {
#define PG8_LAS __attribute__((address_space(3)))
typedef unsigned short bf16_t;
typedef short bf16x8 __attribute__((ext_vector_type(8)));
typedef float f32x4 __attribute__((ext_vector_type(4)));
typedef unsigned u32x4 __attribute__((ext_vector_type(4)));
constexpr int BM = 256, BK = 64, HALF = 128, HTB = HALF * BK * 2  , STAGE_BYTES = 8 * HTB, NXCD = 8, WGM = 8;

__host__ __device__ __forceinline__ int lds_byte(int r, int c) { const int st = (r >> 4) * 2 + (c >> 5), rr = r & 15, cc = c & 31, ob = rr * 64 + cc * 2; return st * 1024 + (ob ^ (((ob >> 9) & 1) << 5)); }
__host__ __device__ __forceinline__ void stage_rc(int b, int& R, int& C) { const int st = b / 1024, sb = b % 1024, swz = sb ^ (((sb >> 9) & 1) << 5); R = (st >> 1) * 16 + swz / 64; C = (st & 1) * 32 + (swz % 64) / 2; }
__host__ __device__ __forceinline__ int perm32(int rho) { const int n = rho >> 4, i = rho & 15; return 8 * (i >> 2) + 4 * n + (i & 3); }

struct Unit { int pm, pn; };
struct Gemm { const bf16_t* A; const bf16_t* Bt; int M, N, K, lda, ldb; };

struct StaticOrder {
    int nM, nN, nwg, G, c;
    __host__ __device__ void init(int M, int N, int G_, int c_) { nM = M / BM; nN = N / BM; nwg = nM * nN; G = G_; c = c_; }
    __host__ __device__ bool next(int i, Unit& u) const {
        const long L = (long)i * G + c; if (L >= nwg) return false;
        int wgid = (int)L; { const int q = nwg / NXCD, r = nwg % NXCD, xcd = wgid % NXCD, off = wgid / NXCD; wgid = (xcd < r ? xcd * (q + 1) : r * (q + 1) + (xcd - r) * q) + off; }
        const int nig = WGM * nN, gid = wgid / nig, fm = gid * WGM, gsz = (nM - fm) < WGM ? (nM - fm) : WGM;
        u.pm = fm + ((wgid % nig) % gsz); u.pn = (wgid % nig) / gsz; return true;
    }
    __device__ __forceinline__ void a_ready(const Unit&) const {}
    __device__ __forceinline__ void done(const Unit&) const {}
};

typedef _Float16 f16x2_t __attribute__((ext_vector_type(2)));
typedef _Float16 half8 __attribute__((ext_vector_type(8)));
__device__ __forceinline__ unsigned cvt_pk_bf16(float lo, float hi) { f16x2_t h = {(_Float16)lo, (_Float16)hi}; return __builtin_bit_cast(unsigned, h); }
__device__ __forceinline__ unsigned cvt_pk_f16(float lo, float hi) { f16x2_t h = {(_Float16)lo, (_Float16)hi}; return __builtin_bit_cast(unsigned, h); }
__device__ __forceinline__ float bf_lo(unsigned w) { return (float)__builtin_bit_cast(_Float16, (unsigned short)(w & 0xffffu)); }
__device__ __forceinline__ float bf_hi(unsigned w) { return (float)__builtin_bit_cast(_Float16, (unsigned short)(w >> 16)); }
__device__ __forceinline__ float sigmoidf_(float x) { return __builtin_amdgcn_rcpf(1.0f + __expf(-x)); }

template <int MODE> struct EpiBf {
    static constexpr bool PERM = true, AFTER_DRAIN = false;
    bf16_t* O; int ldc; int qlo, qhi; float qscale;
    __device__ __forceinline__ void operator()(const f32x4 (&acc)[2][2][4][2], const Unit& u, int wr, int wc, int fr, int fq) const {
        const int row0 = u.pm * BM + wr * 64 + fr, col0 = u.pn * BM + wc * 32 + 8 * fq;
        const float sc = (MODE == 0 && u.pn >= qlo && u.pn < qhi) ? qscale : 1.f;
#pragma unroll
        for (int ai = 0; ai < 2; ++ai)
#pragma unroll
            for (int m = 0; m < 4; ++m) { bf16_t* rowp = O + (size_t)(row0 + ai * HALF + m * 16) * ldc + col0;
#pragma unroll
                for (int bj = 0; bj < 2; ++bj) { f32x4 v0 = acc[ai][bj][m][0], v1 = acc[ai][bj][m][1];
                    if (MODE == 1) { v0 = __builtin_elementwise_max(v0, (f32x4){0.f, 0.f, 0.f, 0.f}); v1 = __builtin_elementwise_max(v1, (f32x4){0.f, 0.f, 0.f, 0.f}); v0 = v0 * v0; v1 = v1 * v1; }
                    else { v0 = v0 * sc; v1 = v1 * sc; }
                    u32x4 w; w.x = cvt_pk_bf16(v0[0], v0[1]); w.y = cvt_pk_bf16(v0[2], v0[3]); w.z = cvt_pk_bf16(v1[0], v1[1]); w.w = cvt_pk_bf16(v1[2], v1[3]);
                    *(u32x4*)(rowp + bj * HALF) = w; } }
    }
};
struct EpiResid {
    static constexpr bool PERM = false, AFTER_DRAIN = false;
    const float* base; float* out; const float* gate; int ldc;
    __device__ __forceinline__ void operator()(const f32x4 (&acc)[2][2][4][2], const Unit& u, int wr, int wc, int fr, int fq) const {
        const int row0 = u.pm * BM + wr * 64 + fr, col0 = u.pn * BM + wc * 32 + 4 * fq;
        const float* gp = gate + (size_t)((u.pm * BM) >> 12) * 6144 + col0;
#pragma unroll
        for (int bj = 0; bj < 2; ++bj)
#pragma unroll
            for (int n = 0; n < 2; ++n) { const f32x4 gv = *(const f32x4*)(gp + bj * HALF + n * 16);
#pragma unroll
                for (int ai = 0; ai < 2; ++ai)
#pragma unroll
                    for (int m = 0; m < 4; ++m) { const size_t off = (size_t)(row0 + ai * HALF + m * 16) * ldc + col0 + bj * HALF + n * 16;
                        const f32x4 bs = *(const f32x4*)(base + off); *(f32x4*)(out + off) = bs + gv * acc[ai][bj][m][n]; } }
    }
};
struct EpiDecIclr {
    static constexpr bool PERM = true, AFTER_DRAIN = false;
    _Float16* E; _Float16* A; const float* w0; const float* a0;
    __device__ __forceinline__ void operator()(const f32x4 (&acc)[2][2][4][2], const Unit& u, int wr, int wc, int fr, int fq) const {
        asm volatile("" : "+v"(fr), "+v"(fq));
        const int row0 = u.pm * BM + wr * 64 + fr; const int kind = u.pn >> 1; const int c0 = (u.pn & 1) * BM + wc * 32 + 8 * fq;
        _Float16* O = kind ? A : E; const float* bp = kind ? a0 : w0;
#pragma unroll
        for (int bj = 0; bj < 2; ++bj) { const f32x4 bv0 = *(const f32x4*)(bp + c0 + bj * HALF), bv1 = *(const f32x4*)(bp + c0 + bj * HALF + 4);
#pragma unroll
            for (int ai = 0; ai < 2; ++ai)
#pragma unroll
                for (int m = 0; m < 4; ++m) { _Float16* rowp = O + (size_t)(row0 + ai * HALF + m * 16) * 512 + c0 + bj * HALF;
                    f32x4 v0 = acc[ai][bj][m][0] + bv0, v1 = acc[ai][bj][m][1] + bv1;
#ifdef SCAN_CHUNK
                    const float mul_ = kind ? 1.0f : (-0.60653065971f * 1.4426950408889634f);
                    unsigned wx, wy, wz, ww;
                    asm volatile("" : "+v"(v0));
                    wx = cvt_pk_f16(mul_ * sigmoidf_(v0[0]), mul_ * sigmoidf_(v0[1])); wy = cvt_pk_f16(mul_ * sigmoidf_(v0[2]), mul_ * sigmoidf_(v0[3]));
                    asm volatile("" : "+v"(wx), "+v"(wy), "+v"(v1));
                    wz = cvt_pk_f16(mul_ * sigmoidf_(v1[0]), mul_ * sigmoidf_(v1[1])); ww = cvt_pk_f16(mul_ * sigmoidf_(v1[2]), mul_ * sigmoidf_(v1[3]));
                    asm volatile("" : "+v"(wz), "+v"(ww));
                    u32x4 w; w.x = wx; w.y = wy; w.z = wz; w.w = ww;
#else
                    u32x4 w; w.x = cvt_pk_f16(v0[0], v0[1]); w.y = cvt_pk_f16(v0[2], v0[3]); w.z = cvt_pk_f16(v1[0], v1[1]); w.w = cvt_pk_f16(v1[2], v1[3]);
#endif
                    *(u32x4*)rowp = w; asm volatile("" ::: "memory"); } }
    }
};
struct EpiVres {
    static constexpr bool PERM = true, AFTER_DRAIN = false;
    const bf16_t* PV; int ldp; bf16_t* VF; const float* v0; const float* muv;
    __device__ __forceinline__ void operator()(const f32x4 (&acc)[2][2][4][2], const Unit& u, int wr, int wc, int fr, int fq) const {
        const int row0 = u.pm * BM + wr * 64 + fr; const int c0 = u.pn * BM + wc * 32 + 8 * fq;
#pragma unroll
        for (int bj = 0; bj < 2; ++bj) { const int c = c0 + bj * HALF;
            float b8[8], m8[8];
#pragma unroll
            for (int i = 0; i < 8; ++i) { b8[i] = v0[c + i]; m8[i] = muv[c + i]; }
#pragma unroll
            for (int ai = 0; ai < 2; ++ai)
#pragma unroll
                for (int m = 0; m < 4; ++m) { const int row = row0 + ai * HALF + m * 16;
                    const u32x4 vc = *(const u32x4*)(PV + (size_t)row * ldp + c);
                    u32x4 vp = (u32x4){0u, 0u, 0u, 0u}; if ((row & 4095) != 0) vp = *(const u32x4*)(PV + (size_t)(row - 1) * ldp + c);
                    const u32x4 vf = *(const u32x4*)(VF + (size_t)row * 512 + c);
                    float o[8];
#pragma unroll
                    for (int i = 0; i < 8; ++i) { const unsigned wc_ = vc[i >> 1], wp_ = vp[i >> 1], wf_ = vf[i >> 1];
                        const float xc = (i & 1) ? bf_hi(wc_) : bf_lo(wc_), xp = (i & 1) ? bf_hi(wp_) : bf_lo(wp_), xf = (i & 1) ? bf_hi(wf_) : bf_lo(wf_);
                        const float a = (i < 4) ? acc[ai][bj][m][0][i & 3] : acc[ai][bj][m][1][i & 3];
                        const float vl = xc + (xp - xc) * m8[i]; const float g = sigmoidf_(b8[i] + a); o[i] = vl + (xf - vl) * g; }
                    u32x4 w; w.x = cvt_pk_bf16(o[0], o[1]); w.y = cvt_pk_bf16(o[2], o[3]); w.z = cvt_pk_bf16(o[4], o[5]); w.w = cvt_pk_bf16(o[6], o[7]);
                    *(u32x4*)(VF + (size_t)row * 512 + c) = w; asm volatile("" ::: "memory"); } }
    }
};

template <class Epi, class Sched, bool ALIGN_EPI = false, bool SP2 = false>
__device__ __forceinline__ void gemm_phase(PG8_LAS unsigned char* lds, const Gemm g, const Sched& S, const Epi& E, const int tid) {
    const int wid = __builtin_amdgcn_readfirstlane(tid >> 6), lane = tid & 63, wr = wid >> 2, wc = wid & 3, fr = lane & 15, fq = lane >> 4;
    const int K = g.K, nt = K / BK;
    unsigned voffA[2], voffB[2];
#pragma unroll
    for (int i = 0; i < 2; ++i) { int R, C; stage_rc(tid * 16 + i * 8192, R, C); const int Rb = Epi::PERM ? ((R & ~31) + perm32(R & 31)) : R;
        voffA[i] = (unsigned)(R * g.lda + C) * 2u; voffB[i] = (unsigned)(Rb * g.ldb + C) * 2u; }
    const size_t kstep = (size_t)(BK * 2);
    const size_t hstepA = (size_t)HALF * g.lda * 2, hstepB = (size_t)HALF * g.ldb * 2;
    const size_t tstepA = 2 * hstepA, tstepB = 2 * hstepB;
    const unsigned ldsw = (unsigned)wid * 1024u;
    const int aoff = lds_byte(wr * 64 + fr, fq * 8), boff = lds_byte(wc * 32 + fr, fq * 8);
#define PG8_SA(b, h) (((b) * 2 + (h)) * HTB)
#define PG8_SB(b, h) ((4 + (b) * 2 + (h)) * HTB)
#define PG8_STAGE(bufoff, gbase, voff) do { _Pragma("unroll") for (int _i = 0; _i < 2; ++_i) \
        __builtin_amdgcn_global_load_lds((const unsigned*)((const char*)(gbase) + (voff)[_i]), (PG8_LAS unsigned*)(lds + (bufoff) + ldsw + _i * 8192), 16, 0, 0); } while (0)
#define PG8_LDA(dst, b, h) do { _Pragma("unroll") for (int m = 0; m < 4; ++m) _Pragma("unroll") for (int k = 0; k < 2; ++k) dst[m][k] = *(const PG8_LAS bf16x8*)(lds + PG8_SA(b, h) + aoff + m * 2048 + k * 1024); } while (0)
#define PG8_LDB(dst, b, h) do { _Pragma("unroll") for (int n = 0; n < 2; ++n) _Pragma("unroll") for (int k = 0; k < 2; ++k) dst[n][k] = *(const PG8_LAS bf16x8*)(lds + PG8_SB(b, h) + boff + n * 2048 + k * 1024); } while (0)
#define PG8_MMA(ai, bj, At, Bt) do { __builtin_amdgcn_s_setprio(1); _Pragma("unroll") for (int m = 0; m < 4; ++m) _Pragma("unroll") for (int n = 0; n < 2; ++n) _Pragma("unroll") for (int k = 0; k < 2; ++k) \
        acc[ai][bj][m][n] = __builtin_amdgcn_mfma_f32_16x16x32_f16(__builtin_bit_cast(half8, Bt[n][k]), __builtin_bit_cast(half8, At[m][k]), acc[ai][bj][m][n], 0, 0, 0); __builtin_amdgcn_s_setprio(0); } while (0)
#define PG8_WAIT_V(n) asm volatile("s_waitcnt vmcnt(" #n ")" ::: "memory")
#define PG8_WAIT_L(n) asm volatile("s_waitcnt lgkmcnt(" #n ")" ::: "memory")
#define PG8_BAR __builtin_amdgcn_s_barrier()
#define PG8_SCHED __builtin_amdgcn_sched_barrier(0)
    Unit cur, nxt; int ui = 0;
    if (!S.next(0, cur)) return;
    f32x4 acc[2][2][4][2];
#pragma unroll
    for (int a = 0; a < 2; ++a)
#pragma unroll
        for (int b = 0; b < 2; ++b)
#pragma unroll
            for (int m = 0; m < 4; ++m)
#pragma unroll
                for (int n = 0; n < 2; ++n) acc[a][b][m][n] = (f32x4){0.f, 0.f, 0.f, 0.f};
    bf16x8 At[4][2], B0[2][2], B1[2][2];
    const char* cA = (const char*)g.A + (size_t)cur.pm * tstepA; const char* cB = (const char*)g.Bt + (size_t)cur.pn * tstepB;
    S.a_ready(cur);
    if constexpr (SP2) {
        PG8_STAGE(PG8_SB(0, 0), cB, voffB); PG8_STAGE(PG8_SB(0, 1), cB + hstepB, voffB); PG8_STAGE(PG8_SA(0, 0), cA, voffA); PG8_STAGE(PG8_SA(0, 1), cA + hstepA, voffA);
        if (wr == 1) PG8_BAR;
        PG8_WAIT_V(2); PG8_BAR;
        PG8_STAGE(PG8_SB(1, 0), cB + kstep, voffB); PG8_STAGE(PG8_SA(1, 0), cA + kstep, voffA); PG8_STAGE(PG8_SB(1, 1), cB + hstepB + kstep, voffB);
        PG8_WAIT_V(6); PG8_BAR;
    } else {
        PG8_STAGE(PG8_SB(0, 0), cB, voffB); PG8_STAGE(PG8_SA(0, 0), cA, voffA); PG8_STAGE(PG8_SB(0, 1), cB + hstepB, voffB); PG8_STAGE(PG8_SA(0, 1), cA + hstepA, voffA);
        if (wr == 1) PG8_BAR;
        PG8_WAIT_V(4); PG8_BAR;
        PG8_STAGE(PG8_SB(1, 0), cB + kstep, voffB); PG8_STAGE(PG8_SA(1, 0), cA + kstep, voffA); PG8_STAGE(PG8_SB(1, 1), cB + hstepB + kstep, voffB);
        PG8_WAIT_V(6); PG8_BAR;
    }
    for (;;) {
        const bool has_next = S.next(ui + 1, nxt);
        const char* nA = has_next ? (const char*)g.A + (size_t)nxt.pm * tstepA : cA; const char* nB = has_next ? (const char*)g.Bt + (size_t)nxt.pn * tstepB : cB;
        for (int t = 0; t < nt; t += 2) {
            const bool last = (t == nt - 2);
            const char* a1 = cA + (size_t)(t + 1) * kstep;
            const char* a2 = last ? nA : cA + (size_t)(t + 2) * kstep; const char* b2 = last ? nB : cB + (size_t)(t + 2) * kstep;
            const char* a3 = a2 + kstep; const char* b3 = b2 + kstep;
            if (last && has_next) S.a_ready(nxt);
            if constexpr (SP2) {
            PG8_LDB(B0, 0, 0); PG8_LDB(B1, 0, 1); PG8_SCHED; PG8_LDA(At, 0, 0); PG8_STAGE(PG8_SA(1, 1), a1 + hstepA, voffA);
            PG8_WAIT_V(8); PG8_WAIT_L(0); PG8_BAR; PG8_MMA(0, 0, At, B0); PG8_MMA(0, 1, At, B1); PG8_BAR; PG8_SCHED;
            PG8_LDA(At, 0, 1); PG8_STAGE(PG8_SB(0, 0), b2, voffB); PG8_STAGE(PG8_SB(0, 1), b2 + hstepB, voffB); PG8_STAGE(PG8_SA(0, 0), a2, voffA);
            PG8_WAIT_V(8); PG8_WAIT_L(0); PG8_BAR; PG8_MMA(1, 0, At, B0); PG8_MMA(1, 1, At, B1); PG8_BAR; PG8_SCHED;
            PG8_LDB(B0, 1, 0); PG8_LDB(B1, 1, 1); PG8_SCHED; PG8_LDA(At, 1, 0); PG8_STAGE(PG8_SA(0, 1), a2 + hstepA, voffA);
            PG8_WAIT_V(8); PG8_WAIT_L(0); PG8_BAR; PG8_MMA(0, 0, At, B0); PG8_MMA(0, 1, At, B1); PG8_BAR; PG8_SCHED;
            PG8_LDA(At, 1, 1); PG8_STAGE(PG8_SB(1, 0), b3, voffB); PG8_STAGE(PG8_SB(1, 1), b3 + hstepB, voffB); PG8_STAGE(PG8_SA(1, 0), a3, voffA);
            PG8_WAIT_V(8); PG8_WAIT_L(0); PG8_BAR; PG8_MMA(1, 0, At, B0); PG8_MMA(1, 1, At, B1); PG8_BAR; PG8_SCHED;
            } else {
            PG8_LDB(B0, 0, 0); PG8_SCHED; PG8_LDA(At, 0, 0); PG8_STAGE(PG8_SA(1, 1), a1 + hstepA, voffA);
            PG8_WAIT_L(8); PG8_BAR; PG8_WAIT_L(0); PG8_MMA(0, 0, At, B0); PG8_BAR; PG8_SCHED;
            PG8_LDB(B1, 0, 1); PG8_STAGE(PG8_SB(0, 0), b2, voffB);
            PG8_BAR; PG8_WAIT_L(0); PG8_MMA(0, 1, At, B1); PG8_BAR;
            PG8_LDA(At, 0, 1); PG8_STAGE(PG8_SA(0, 0), a2, voffA);
            PG8_BAR; PG8_WAIT_L(0); PG8_MMA(1, 0, At, B0); PG8_BAR; PG8_SCHED;
            PG8_STAGE(PG8_SB(0, 1), b2 + hstepB, voffB);
            PG8_WAIT_V(6); PG8_BAR; PG8_MMA(1, 1, At, B1); PG8_BAR;
            PG8_LDB(B0, 1, 0); PG8_SCHED; PG8_LDA(At, 1, 0); PG8_STAGE(PG8_SA(0, 1), a2 + hstepA, voffA);
            PG8_WAIT_L(8); PG8_BAR; PG8_WAIT_L(0); PG8_MMA(0, 0, At, B0); PG8_BAR; PG8_SCHED;
            PG8_LDB(B1, 1, 1); PG8_STAGE(PG8_SB(1, 0), b3, voffB);
            PG8_BAR; PG8_WAIT_L(0); PG8_MMA(0, 1, At, B1); PG8_BAR;
            PG8_LDA(At, 1, 1); PG8_STAGE(PG8_SA(1, 0), a3, voffA);
            PG8_BAR; PG8_WAIT_L(0); PG8_MMA(1, 0, At, B0); PG8_BAR; PG8_SCHED;
            PG8_STAGE(PG8_SB(1, 1), b3 + hstepB, voffB);
            PG8_WAIT_V(6); PG8_BAR; PG8_MMA(1, 1, At, B1); PG8_BAR;
            }
        }
        if constexpr (ALIGN_EPI) { if (wr == 0) PG8_BAR; }
        if constexpr (!Epi::AFTER_DRAIN) { E(acc, cur, wr, wc, fr, fq); S.done(cur); }
        if (!has_next) break;
#pragma unroll
        for (int a = 0; a < 2; ++a)
#pragma unroll
            for (int b = 0; b < 2; ++b)
#pragma unroll
                for (int m = 0; m < 4; ++m)
#pragma unroll
                    for (int n = 0; n < 2; ++n) acc[a][b][m][n] = (f32x4){0.f, 0.f, 0.f, 0.f};
        cur = nxt; cA = nA; cB = nB; ++ui;
        if constexpr (ALIGN_EPI) { if (wr == 1) PG8_BAR; }
    }
    PG8_WAIT_V(0);
    if constexpr (!ALIGN_EPI) { if (wr == 0) PG8_BAR; }
    PG8_BAR;
    if constexpr (Epi::AFTER_DRAIN) { E.fused(acc, cur, wr, wc, fr, fq, lds, wid, lane); S.done(cur); }
#undef PG8_SA
#undef PG8_SB
#undef PG8_STAGE
#undef PG8_LDA
#undef PG8_LDB
#undef PG8_MMA
#undef PG8_WAIT_V
#undef PG8_WAIT_L
#undef PG8_BAR
#undef PG8_SCHED
}
}
constexpr int NB = 8, T = 4096, D = 1024, M = NB * T, NP = 4352, FF = 4096, LA = 384;
constexpr int C_R = 0, C_K = 512, C_V = 1024, C_QA = 1536, C_KA = 2048, C_VA = 2560, C_QI = 3072, C_KI = 3584, C_WI = 3648, C_P1 = 3656, C_P2 = 3944, C_END = 4232, C_Y = 3656, C_RK = 4168;
#define GAS __attribute__((address_space(1)))
#define LAS __attribute__((address_space(3)))
typedef unsigned short bf16_t;
typedef short bf16x8 __attribute__((ext_vector_type(8)));
typedef float f32x4 __attribute__((ext_vector_type(4)));
typedef float f32x16 __attribute__((ext_vector_type(16)));
typedef unsigned u32x4 __attribute__((ext_vector_type(4)));
typedef unsigned u32x2 __attribute__((ext_vector_type(2)));
typedef short s16x4 __attribute__((ext_vector_type(4)));
#define LDS_WAIT() asm volatile("s_waitcnt lgkmcnt(0)" ::: "memory")
#define VM_WAIT() asm volatile("s_waitcnt vmcnt(0)" ::: "memory")
__device__ __forceinline__ float bfl(unsigned w) { return (float)__builtin_bit_cast(_Float16, (unsigned short)(w & 0xffffu)); }
__device__ __forceinline__ float bfh(unsigned w) { return (float)__builtin_bit_cast(_Float16, (unsigned short)(w >> 16)); }
__device__ __forceinline__ float bf1(bf16_t v) { return (float)__builtin_bit_cast(_Float16, v); }
__device__ __forceinline__ unsigned pkbf(float lo, float hi) { return pg8::cvt_pk_bf16(lo, hi); }
template <int CTRL> __device__ __forceinline__ float dpp_f(float x) { return __builtin_bit_cast(float, __builtin_amdgcn_update_dpp(0, __builtin_bit_cast(int, x), CTRL, 0xf, 0xf, true)); }
__device__ __forceinline__ float allsum8(float x) { x += dpp_f<0xB1>(x); x += dpp_f<0x4E>(x); x += dpp_f<0x141>(x); return x; }
__device__ __forceinline__ float allsum16(float x) { x = allsum8(x); x += dpp_f<0x140>(x); return x; }
template <int CTRL> __device__ __forceinline__ int dpp_i(int x) { return __builtin_amdgcn_update_dpp(0, x, CTRL, 0xf, 0xf, true); }
__device__ __forceinline__ int wave_sum_i(int x) {
    x += dpp_i<0xB1>(x); x += dpp_i<0x4E>(x); x += dpp_i<0x141>(x); x += dpp_i<0x140>(x);
    return __builtin_amdgcn_readlane(x, 0) + __builtin_amdgcn_readlane(x, 16) + __builtin_amdgcn_readlane(x, 32) + __builtin_amdgcn_readlane(x, 48); }
__device__ __forceinline__ unsigned wave_max_u(unsigned x) {
    x = max(x, (unsigned)dpp_i<0xB1>((int)x)); x = max(x, (unsigned)dpp_i<0x4E>((int)x)); x = max(x, (unsigned)dpp_i<0x141>((int)x)); x = max(x, (unsigned)dpp_i<0x140>((int)x));
    return max(max((unsigned)__builtin_amdgcn_readlane((int)x, 0), (unsigned)__builtin_amdgcn_readlane((int)x, 16)), max((unsigned)__builtin_amdgcn_readlane((int)x, 32), (unsigned)__builtin_amdgcn_readlane((int)x, 48))); }
__device__ __forceinline__ unsigned wave_min_u(unsigned x) { return ~wave_max_u(~x); }
__device__ __forceinline__ float wave_sum(float v) {
    v += dpp_f<0xB1>(v); v += dpp_f<0x4E>(v); v += dpp_f<0x141>(v); v += dpp_f<0x140>(v);
    const float r0 = __builtin_bit_cast(float, __builtin_amdgcn_readlane(__builtin_bit_cast(int, v), 0)), r1 = __builtin_bit_cast(float, __builtin_amdgcn_readlane(__builtin_bit_cast(int, v), 16)),
                r2 = __builtin_bit_cast(float, __builtin_amdgcn_readlane(__builtin_bit_cast(int, v), 32)), r3 = __builtin_bit_cast(float, __builtin_amdgcn_readlane(__builtin_bit_cast(int, v), 48));
    return (r0 + r1) + (r2 + r3);
}

namespace att {
__device__ __forceinline__ int crow(int r, int hi) { return (r & 3) + 8 * (r >> 2) + 4 * hi; }
#define SBAR() __builtin_amdgcn_sched_barrier(0)
__device__ __forceinline__ void glds16(const void* gsrc, unsigned lds_dst) { unsigned keep;
    asm volatile("s_mov_b32 %0, m0\n\ts_mov_b32 m0, %2\n\ts_nop 0\n\tglobal_load_lds_dwordx4 %1, off\n\ts_mov_b32 m0, %0" : "=&s"(keep) : "v"(gsrc), "s"(lds_dst) : "memory"); }
typedef LAS const char* lds_cptr;
__device__ __forceinline__ void qkt(f32x16& p0, f32x16& p1, lds_cptr kb, const bf16x8* qr, const f32x16& z) {
#pragma unroll
    for (int d0 = 0; d0 < 4; ++d0) {
        const bf16x8 b0 = *(const LAS bf16x8*)(kb + d0 * 2048);
        const bf16x8 b1 = *(const LAS bf16x8*)(kb + d0 * 2048 + 512);
        if (d0 == 0) { p0 = __builtin_amdgcn_mfma_f32_32x32x16_f16(__builtin_bit_cast(pg8::half8, b0), __builtin_bit_cast(pg8::half8, qr[0]), z, 0, 0, 0); p1 = __builtin_amdgcn_mfma_f32_32x32x16_f16(__builtin_bit_cast(pg8::half8, b1), __builtin_bit_cast(pg8::half8, qr[0]), z, 0, 0, 0); }
        else { p0 = __builtin_amdgcn_mfma_f32_32x32x16_f16(__builtin_bit_cast(pg8::half8, b0), __builtin_bit_cast(pg8::half8, qr[d0]), p0, 0, 0, 0); p1 = __builtin_amdgcn_mfma_f32_32x32x16_f16(__builtin_bit_cast(pg8::half8, b1), __builtin_bit_cast(pg8::half8, qr[d0]), p1, 0, 0, 0); } }
}
__device__ __forceinline__ void pv(f32x16* o, int vb, bf16x8 pa0, bf16x8 pa1, bf16x8 pa2, bf16x8 pa3) {
#pragma unroll
    for (int d0 = 0; d0 < 2; ++d0) { s16x4 lo[4], hi[4];
#pragma unroll
        for (int ks = 0; ks < 4; ++ks) {
            asm volatile("ds_read_b64_tr_b16 %0,%1 offset:%c2" : "=&v"(lo[ks]) : "v"(vb), "i"(d0 * 4096 + ks * 1024) : "memory");
            asm volatile("ds_read_b64_tr_b16 %0,%1 offset:%c2" : "=&v"(hi[ks]) : "v"(vb), "i"(d0 * 4096 + ks * 1024 + 512) : "memory"); }
        asm volatile("s_waitcnt lgkmcnt(0)" ::: "memory"); SBAR();
#define PK(k) (bf16x8){lo[k][0], lo[k][1], lo[k][2], lo[k][3], hi[k][0], hi[k][1], hi[k][2], hi[k][3]}
        o[d0] = __builtin_amdgcn_mfma_f32_32x32x16_f16(__builtin_bit_cast(pg8::half8, pa0), __builtin_bit_cast(pg8::half8, PK(0)), o[d0], 0, 0, 0);
        o[d0] = __builtin_amdgcn_mfma_f32_32x32x16_f16(__builtin_bit_cast(pg8::half8, pa1), __builtin_bit_cast(pg8::half8, PK(1)), o[d0], 0, 0, 0);
        o[d0] = __builtin_amdgcn_mfma_f32_32x32x16_f16(__builtin_bit_cast(pg8::half8, pa2), __builtin_bit_cast(pg8::half8, PK(2)), o[d0], 0, 0, 0);
        o[d0] = __builtin_amdgcn_mfma_f32_32x32x16_f16(__builtin_bit_cast(pg8::half8, pa3), __builtin_bit_cast(pg8::half8, PK(3)), o[d0], 0, 0, 0);
#undef PK
    }
}
constexpr int SLOTB = 8192;
constexpr int L_K = 0, L_V = 3 * SLOTB, L_WS = 7 * SLOTB, L_OST = L_WS + 8 * 64 * 4, L_BT = L_OST + 8 * 8192, L_END = L_BT + 8 * 129 * 4;
constexpr float C2 = 0.125f * 1.4426950408889634f;

__device__ __forceinline__ int t5_bucket(int n) {
    if (n < 16) return n;
    const int thr[15] = {19, 21, 24, 27, 31, 35, 40, 46, 52, 59, 67, 77, 87, 99, 113};
    int b = 16;
#pragma unroll
    for (int i = 0; i < 15; ++i) b += (n >= thr[i]) ? 1 : 0;
    return b;
}
__device__ __forceinline__ void build_bias_table(const float* rel_bias, LAS char* shm, int tid) {
    LAS float* BT = (LAS float*)(shm + L_BT);
    for (int i = tid; i < 8 * 129; i += 512) { const int h = i / 129, d = i % 129;
        BT[i] = (d >= 128) ? 0.f : (rel_bias[t5_bucket(d) * 8 + h] - rel_bias[31 * 8 + h]) * 1.4426950408889634f; }
}

__device__ __forceinline__ void attn_unit(int b, int h, int qb, const bf16_t* PROJ, const unsigned long long* MASK, bf16_t* MIX, const float* gain, LAS char* shm, const int tid) {
    const int lane = tid & 63, r32 = lane & 31, hi = lane >> 5; const int wid = __builtin_amdgcn_readfirstlane(tid >> 6);
    const long rowbase = (long)b * T; const int q0 = qb * 256;
    const bf16_t* Qw = PROJ + (rowbase + q0 + wid * 32) * NP + C_QA + h * 64;
    const bf16_t* Kh = PROJ + rowbase * NP + C_KA + h * 64; const bf16_t* Vh = PROJ + rowbase * NP + C_VA + h * 64;
    const unsigned lds0 = (unsigned)(uintptr_t)shm;
    LAS float* wsf = (LAS float*)(shm + L_WS) + wid * 64;
    const LAS float* BT = (const LAS float*)(shm + L_BT) + h * 129;
    const bf16_t* ksrc = Kh + (long)lane * NP + wid * 8;
    const bf16_t* vsrc = Vh + (long)(16 * (wid & 3) + (lane >> 2)) * NP + (wid >> 2) * 32 + (lane & 3) * 8;
    const unsigned kdst = lds0 + L_K + wid * 1024, vdst = lds0 + L_V + wid * 1024;
#define DMA_K(t, slot) glds16(ksrc + (long)(t) * 64 * NP, (unsigned)__builtin_amdgcn_readfirstlane(kdst + (slot)))
#define DMA_V(t, slot) glds16(vsrc + (long)(t) * 64 * NP, (unsigned)__builtin_amdgcn_readfirstlane(vdst + (slot)))
    const int vb0 = (int)(lds0 + L_V) + ((lane >> 4) & 1) * 32 + (lane & 3) * 8 + (4 * hi + ((lane & 15) >> 2)) * 64;
    const lds_cptr kp0 = (lds_cptr)shm + L_K + hi * 1024 + r32 * 16;
    const int NT = (q0 + 256) / 64;
    const int qabs = q0 + wid * 32 + r32;
    const unsigned long long* mp = MASK + ((size_t)b * 4096 + qabs) * 64;
    unsigned long long mw_next = 0ull;
#define MASK_LD(t) asm volatile("global_load_dwordx2 %0, %1, off" : "+v"(mw_next) : "v"(mp + (t)) : "memory")
    MASK_LD(0); DMA_K(0, 0); DMA_V(0, 0); DMA_K(1, SLOTB); DMA_V(1, SLOTB);
    bf16x8 qr[4];
#pragma unroll
    for (int d0 = 0; d0 < 4; ++d0) qr[d0] = *(const bf16x8*)(Qw + (long)r32 * NP + d0 * 16 + hi * 8);
    float m_run = 0.f, l_run = 0.f; f32x16 o[2]; o[0] = f32x16{}; o[1] = f32x16{}; f32x16 negm = f32x16{}; asm volatile("" : "+v"(negm));
    int slot = 0, slot2 = 2 * SLOTB;
    int vs = 0, vsp = 3 * SLOTB, vs2 = 2 * SLOTB;
    u32x4 pw0 = {0u, 0u, 0u, 0u}, pw1 = pw0, pw2 = pw0, pw3 = pw0;
    for (int t = 0; t < NT; ++t) {
        if (t + 1 < NT) asm volatile("s_waitcnt vmcnt(2) lgkmcnt(0)\n\ts_barrier" : "+v"(mw_next) :: "memory");
        else asm volatile("s_waitcnt vmcnt(0) lgkmcnt(0)\n\ts_barrier" : "+v"(mw_next) :: "memory");
        const unsigned long long mw = mw_next;
        asm volatile("" : "+v"(mw_next));
        if (t + 1 < NT) MASK_LD(t + 1);
        if (t + 2 < NT) { DMA_K(t + 2, slot2); DMA_V(t + 2, vs2); }
        f32x16 p0, p1; qkt(p0, p1, kp0 + slot, qr, negm);
        if (t > 0) pv(o, vb0 + vsp, __builtin_bit_cast(bf16x8, pw0), __builtin_bit_cast(bf16x8, pw1), __builtin_bit_cast(bf16x8, pw2), __builtin_bit_cast(bf16x8, pw3));
        if (64 * t + 191 > q0 + 32 * wid) {
#pragma unroll
            for (int r = 0; r < 16; ++r) { const int d0_ = qabs - (64 * t + crow(r, hi));
                const int i0 = d0_ < 0 ? 0 : (d0_ > 128 ? 128 : d0_); const int d1_ = d0_ - 32; const int i1 = d1_ < 0 ? 0 : (d1_ > 128 ? 128 : d1_);
                p0[r] += BT[i0]; p1[r] += BT[i1]; }
        }
        { const int mlo = (int)((unsigned)mw >> (4 * hi)), mhi = (int)((unsigned)(mw >> 32) >> (4 * hi)); const int NEGB = (int)0xff800000u;
#pragma unroll
          for (int r = 0; r < 16; ++r) { const int bit = (r & 3) + 8 * (r >> 2);
              const int t0 = __builtin_amdgcn_sbfe(mlo, bit, 1), t1 = __builtin_amdgcn_sbfe(mhi, bit, 1);
              { const float x0 = p0[r]; p0[r] = __int_as_float((__float_as_int(x0) & t0) | (NEGB & ~t0)); }
              { const float x1 = p1[r]; p1[r] = __int_as_float((__float_as_int(x1) & t1) | (NEGB & ~t1)); } } }
        float rm;
        { float a = __builtin_fmaxf(__builtin_fmaxf(p0[0], p0[1]), p1[0]), b2 = __builtin_fmaxf(__builtin_fmaxf(p0[2], p0[3]), p1[1]); a = __builtin_fmaxf(__builtin_fmaxf(a, p1[2]), p1[3]);
#pragma unroll
          for (int r = 4; r < 16; r += 4) { a = __builtin_fmaxf(__builtin_fmaxf(a, p0[r]), p0[r + 1]); b2 = __builtin_fmaxf(__builtin_fmaxf(b2, p0[r + 2]), p0[r + 3]); a = __builtin_fmaxf(__builtin_fmaxf(a, p1[r]), p1[r + 1]); b2 = __builtin_fmaxf(__builtin_fmaxf(b2, p1[r + 2]), p1[r + 3]); }
          rm = __builtin_fmaxf(a, b2); }
        { auto rr = __builtin_amdgcn_permlane32_swap(__float_as_uint(rm), __float_as_uint(rm), false, false); rm = fmaxf(__uint_as_float(rr[0]), __uint_as_float(rr[1])); }
        const float dl = (t == 0) ? ((rm == -INFINITY) ? 0.f : rm) : fmaxf(rm, 0.f);
        if (__ballot(dl != 0.f)) {
            m_run += dl;
#pragma unroll
            for (int r = 0; r < 16; ++r) { p0[r] -= dl; p1[r] -= dl; }
            const float f = __builtin_amdgcn_exp2f(-dl); l_run *= f;
#pragma unroll
            for (int r = 0; r < 16; ++r) negm[r] = -m_run;
            asm volatile("" : "+v"(negm));
            if (hi == 0) wsf[r32] = f;
            LDS_WAIT();
#pragma unroll
            for (int r = 0; r < 16; ++r) { const float fr_ = wsf[crow(r, hi)]; o[0][r] *= fr_; o[1][r] *= fr_; }
        }
        float sacc = 0.f;
#pragma unroll
        for (int r = 0; r < 16; ++r) { p0[r] = __builtin_amdgcn_exp2f(p0[r]); p1[r] = __builtin_amdgcn_exp2f(p1[r]); sacc += p0[r] + p1[r]; }
        l_run += sacc;
#define PKW(P, B) __builtin_bit_cast(unsigned, __builtin_amdgcn_cvt_pkrtz(P[B], P[B + 1]))
        pw0 = (u32x4){PKW(p0, 0), PKW(p0, 2), PKW(p0, 4), PKW(p0, 6)}; pw1 = (u32x4){PKW(p0, 8), PKW(p0, 10), PKW(p0, 12), PKW(p0, 14)};
        pw2 = (u32x4){PKW(p1, 0), PKW(p1, 2), PKW(p1, 4), PKW(p1, 6)}; pw3 = (u32x4){PKW(p1, 8), PKW(p1, 10), PKW(p1, 12), PKW(p1, 14)};
#undef PKW
        { const int old_ = slot; slot = (slot == 2 * SLOTB) ? 0 : slot + SLOTB; slot2 = old_; }
        { vsp = vs; vs = (vs == 3 * SLOTB) ? 0 : vs + SLOTB; vs2 = (vs2 == 3 * SLOTB) ? 0 : vs2 + SLOTB; }
    }
    LDS_WAIT(); SBAR();
    pv(o, vb0 + vsp, __builtin_bit_cast(bf16x8, pw0), __builtin_bit_cast(bf16x8, pw1), __builtin_bit_cast(bf16x8, pw2), __builtin_bit_cast(bf16x8, pw3));
    { auto rr = __builtin_amdgcn_permlane32_swap(__float_as_uint(l_run), __float_as_uint(l_run), false, false); l_run = __uint_as_float(rr[0]) + __uint_as_float(rr[1]); }
    LDS_WAIT();
    if (hi == 0) wsf[32 + r32] = l_run;
    LDS_WAIT();
    LAS float* stg = (LAS float*)(shm + L_OST) + wid * 2048;
#pragma unroll
    for (int r = 0; r < 16; ++r) { const int orow = crow(r, hi); const float rl = 1.0f / wsf[32 + orow];
#pragma unroll
        for (int d0 = 0; d0 < 2; ++d0) stg[orow * 64 + d0 * 32 + r32] = o[d0][r] * rl; }
    LDS_WAIT();
    bf16_t* Ow = MIX + (rowbase + q0 + wid * 32) * 1024 + 512 + h * 64;
#pragma unroll
    for (int i = 0; i < 4; ++i) { const int row = i * 8 + (lane >> 3), ch = lane & 7;
        const f32x4 a = *(const LAS f32x4*)(stg + row * 64 + ch * 8), c = *(const LAS f32x4*)(stg + row * 64 + ch * 8 + 4);
        float ss = (a[0] * a[0] + a[1] * a[1]) + (a[2] * a[2] + a[3] * a[3]) + (c[0] * c[0] + c[1] * c[1]) + (c[2] * c[2] + c[3] * c[3]);
        ss = allsum8(ss);
        const float rs = rsqrtf(ss * (1.0f / 64.0f) + 1e-6f);
        const f32x4 g0 = *(const f32x4*)(gain + h * 64 + ch * 8), g1 = *(const f32x4*)(gain + h * 64 + ch * 8 + 4);
        u32x4 w; w.x = pkbf(a[0] * rs * g0[0], a[1] * rs * g0[1]); w.y = pkbf(a[2] * rs * g0[2], a[3] * rs * g0[3]); w.z = pkbf(c[0] * rs * g1[0], c[1] * rs * g1[1]); w.w = pkbf(c[2] * rs * g1[2], c[3] * rs * g1[3]);
        *(u32x4*)(Ow + (long)row * 1024 + ch * 8) = w; }
    asm volatile("s_waitcnt lgkmcnt(0)\n\ts_barrier" ::: "memory");
#undef DMA_K
#undef DMA_V
#undef MASK_LD
}
#undef SBAR
}

#define GAS __attribute__((address_space(1)))
#define LAS __attribute__((address_space(3)))
typedef unsigned short bf16;
typedef unsigned v4u __attribute__((ext_vector_type(4)));
typedef float f32x4 __attribute__((ext_vector_type(4)));
typedef short bf16x8 __attribute__((ext_vector_type(8)));
typedef GAS unsigned gu32;
typedef GAS unsigned long long gu64;
#define RLX_AGENT __ATOMIC_RELAXED, __HIP_MEMORY_SCOPE_AGENT
#define LDS_WAIT() asm volatile("s_waitcnt lgkmcnt(0)" ::: "memory")
#define VM_WAIT() asm volatile("s_waitcnt vmcnt(0)" ::: "memory")
__device__ __forceinline__ unsigned long long rt() { return __builtin_amdgcn_s_memrealtime(); }
__device__ __forceinline__ unsigned f2bf(float f) { unsigned u = __builtin_bit_cast(unsigned, f); return (u + 0x7fffu + ((u >> 16) & 1u)) >> 16; }
__device__ __forceinline__ unsigned pk2(float lo, float hi) { return f2bf(lo) | (f2bf(hi) << 16); }

#define XB_TMO      128
#define XB_XCNT(j)  (256  + 64 * (j))
#define XB_XSUB(j)  (1280 + 64 * (j))
#define XB_XGEN(j)  (2304 + 64 * (j))
#define XB_TOP      3328
#define XB_TOPGEN   3392
#define XCD_BAR_WORDS 3456
#define XB_SPIN_CAP (1u << 22)

__device__ __forceinline__ unsigned xb_ld(unsigned* p)              { return __hip_atomic_load(p, __ATOMIC_RELAXED, __HIP_MEMORY_SCOPE_AGENT); }
__device__ __forceinline__ unsigned xb_add(unsigned* p, unsigned v) { return __hip_atomic_fetch_add(p, v, __ATOMIC_RELAXED, __HIP_MEMORY_SCOPE_AGENT); }
__device__ __forceinline__ unsigned xb_xcc_id() { return (unsigned)__builtin_amdgcn_s_getreg((3 << 11) | 20) & 0xFu; }
#define XB_SPIN(cond, bar) do { unsigned _sp = 0; while (cond) { __builtin_amdgcn_s_sleep(1); \
    if ((++_sp & 255u) == 0u) { if (xb_ld(&(bar)[XB_TMO])) break; if (_sp > XB_SPIN_CAP) { atomicAdd(&(bar)[XB_TMO], 1u); break; } } } } while (0)

struct XcdBarrier {
    unsigned* bar; unsigned x;
    volatile LAS unsigned* st;
};

__device__ __forceinline__ XcdBarrier xcd_barrier_post(unsigned* bar, volatile LAS unsigned* st) {
    XcdBarrier b; b.bar = bar; b.x = xb_xcc_id(); b.st = st;
    if (threadIdx.x == 0) (void)xb_add(&bar[XB_XCNT(b.x)], 1u);
    return b;
}
__device__ __forceinline__ void xcd_barrier_complete(unsigned* bar, unsigned x, unsigned& nloc, unsigned& nx) {
    const unsigned G = gridDim.x * gridDim.y * gridDim.z;
    unsigned sum, cnt, mine, sp = 0u;
    for (;;) {
        sum = 0u; cnt = 0u; mine = 0u;
#pragma unroll
        for (unsigned j = 0; j < 16; ++j) { const unsigned c = xb_ld(&bar[XB_XCNT(j)]); sum += c; cnt += (c > 0u) ? 1u : 0u; mine = (j == x) ? c : mine; }
        if (sum == G) break;
        __builtin_amdgcn_s_sleep(1);
        if ((++sp & 255u) == 0u) { if (xb_ld(&bar[XB_TMO])) break; if (sp > XB_SPIN_CAP) { atomicAdd(&bar[XB_TMO], 1u); break; } }
    }
    nloc = mine > 0u ? mine : 1u; nx = cnt > 0u ? cnt : 1u;
}

__device__ __forceinline__ void xcd_barrier(const XcdBarrier& b) {
    asm volatile("s_waitcnt vmcnt(0)" ::: "memory");
    __syncthreads();
    if (threadIdx.x == 0) {
        unsigned* bar = b.bar;
        __builtin_amdgcn_s_waitcnt(0);
        unsigned nloc = b.st[0], nx = b.st[1];
        if (nloc == 0u) { xcd_barrier_complete(bar, b.x, nloc, nx); b.st[0] = nloc; b.st[1] = nx; }
        const unsigned old = xb_add(&bar[XB_XSUB(b.x)], 1u);
        const unsigned gen = old / nloc;
        if (old + 1u == (gen + 1u) * nloc) {
            __builtin_amdgcn_fence(__ATOMIC_RELEASE, "agent");
            asm volatile("s_waitcnt vmcnt(0)" ::: "memory");
            const unsigned og = xb_add(&bar[XB_TOP], 1u);
            const unsigned tg = og / nx;
            if (og + 1u == (tg + 1u) * nx) xb_add(&bar[XB_TOPGEN], 1u);
            else XB_SPIN(xb_ld(&bar[XB_TOPGEN]) == tg, bar);
            __builtin_amdgcn_fence(__ATOMIC_ACQUIRE, "agent");
            xb_add(&bar[XB_XGEN(b.x)], 1u);
            asm volatile("s_waitcnt vmcnt(0)" ::: "memory");
        } else {
            XB_SPIN(xb_ld(&bar[XB_XGEN(b.x)]) == gen, bar);
            __builtin_amdgcn_fence(__ATOMIC_ACQUIRE, "agent");
            asm volatile("s_waitcnt vmcnt(0)" ::: "memory");
        }
    }
    __syncthreads();
}
constexpr size_t MiB = 1u << 20;
constexpr size_t WS_CTL = 0, CTL_ZERO_BYTES = 1 * MiB;
constexpr size_t WS_MOD = 1 * MiB;
constexpr size_t WS_LW = 2 * MiB;
constexpr size_t WS_WIN = 3 * MiB, WS_WOUT = 12 * MiB, WS_W1 = 14 * MiB, WS_W2 = 22 * MiB;
constexpr size_t WS_LACT = 30 * MiB;
constexpr size_t WS_MASK = 54 * MiB;
constexpr size_t WS_VF = 70 * MiB;
constexpr size_t WS_H = 102 * MiB;
constexpr size_t WS_MIX = 166 * MiB;
constexpr size_t WS_PROJ = 230 * MiB;
constexpr size_t WS_END = 502 * MiB;
static_assert(WS_WIN + (size_t)NP * D * 2 <= WS_WOUT && WS_W2 + (size_t)D * FF * 2 <= WS_LACT && WS_LACT + (size_t)M * LA * 2 <= WS_MASK && WS_MASK + (size_t)NB * 64 * 4096 * 8 <= WS_VF &&
              WS_VF + (size_t)M * 512 * 2 <= WS_H && WS_H + (size_t)M * D * 2 <= WS_MIX && WS_MIX + (size_t)M * D * 2 <= WS_PROJ && WS_PROJ + (size_t)M * NP * 2 <= WS_END, "d_ws map");
constexpr int CW_BAR = 4096;
constexpr int RING_BYTES = 131072, HIST_OFF = 131072, LDSCTL_OFF = 131072 + 8192, MISC_OFF = LDSCTL_OFF + 320, LDS_BYTES = 147456;
static_assert(att::L_END <= RING_BYTES && MISC_OFF + 128 <= LDS_BYTES, "LDS map");
constexpr int NWAVES = 8;

__device__ __forceinline__ void ph_mod(const float* c, const float* w_ada, const float* b_ada, float* MOD, LAS unsigned char* lds, int vcu, int G, int tid) {
    LAS float* ca = (LAS float*)lds; LAS float* part = (LAS float*)(lds + 32768);
    for (int i = tid; i < NB * D; i += 512) { const float v = c[i]; ca[i] = v / (1.f + __expf(-v)); }
    __syncthreads();
    const int wave = tid >> 6, lane = tid & 63;
    for (int task = vcu; task < 192; task += G) {
        const int l = task / 96, j0 = (task % 96) * 64;
        float acc[8];
#pragma unroll
        for (int b = 0; b < 8; ++b) acc[b] = 0.f;
        const float* wp = w_ada + ((size_t)l * D + wave * 128) * 6144 + j0 + lane;
#pragma unroll 8
        for (int k = 0; k < 128; ++k) { const float w = wp[(size_t)k * 6144];
#pragma unroll
            for (int b = 0; b < 8; ++b) acc[b] += ca[b * D + wave * 128 + k] * w; }
#pragma unroll
        for (int b = 0; b < 8; ++b) part[(wave * 8 + b) * 64 + lane] = acc[b];
        __syncthreads();
        { float s = 0.f;
#pragma unroll
          for (int w = 0; w < 8; ++w) s += part[(w * 8 + wave) * 64 + lane];
          MOD[((size_t)l * 8 + wave) * 6144 + j0 + lane] = s + b_ada[l * 6144 + j0 + lane]; }
        __syncthreads();
    }
}

__device__ __forceinline__ void tr_item(const float* W, int ldw, int nvalid, int K, bf16_t* WT, int row_off, LAS float* scr, int kb, int nb, int lane, const float* mu, int mode) {
    const int k0 = 64 * kb, n0 = 32 * nb; const int n = n0 + (lane & 31);
#pragma unroll 8
    for (int i = 0; i < 32; ++i) { const int kk = 2 * i + (lane >> 5); float v = (n < nvalid) ? W[(size_t)(k0 + kk) * ldw + n] : 0.f;
        if (mode) { const float m = mu[k0 + kk]; v *= (mode == 1) ? (1.f - m) : m; }
        scr[kk * 33 + (lane & 31)] = v; }
    LDS_WAIT(); asm volatile("" ::: "memory");
    const int c = lane & 7;
#pragma unroll
    for (int j = 0; j < 4; ++j) { const int nn = (lane >> 3) + 8 * j; const LAS float* s = scr + (8 * c) * 33 + nn;
        u32x4 o; o.x = pkbf(s[0 * 33], s[1 * 33]); o.y = pkbf(s[2 * 33], s[3 * 33]); o.z = pkbf(s[4 * 33], s[5 * 33]); o.w = pkbf(s[6 * 33], s[7 * 33]);
        if (n0 + nn < nvalid) *(u32x4*)(WT + (size_t)(row_off + n0 + nn) * K + k0 + 8 * c) = o; }
    LDS_WAIT(); asm volatile("" ::: "memory");
}
struct WPtrs { const float *w_in, *decay_a, *iclr_a, *gate_a, *vres_a, *mu_lora, *vres_mu, *w_out, *w1, *w2, *decay_b, *iclr_b, *gate_b, *vres_b; };
__device__ __forceinline__ void ph_weights(const WPtrs& P, int l, unsigned char* ws, LAS unsigned char* lds, int vcu, int G, int tid) {
    const int wave = tid >> 6, lane = tid & 63; const int gw = vcu * NWAVES + wave, NGW = G * NWAVES;
    LAS float* scr = (LAS float*)(lds + wave * 16384);
    bf16_t* WIN = (bf16_t*)(ws + WS_WIN); bf16_t* WOUT = (bf16_t*)(ws + WS_WOUT); bf16_t* W1 = (bf16_t*)(ws + WS_W1); bf16_t* W2 = (bf16_t*)(ws + WS_W2);
    constexpr int I_IN = 16 * 115, I_D = 16 * 2, I_G = 16 * 4, I_V = 16 * 1, I_O = 16 * 32, I_1 = 16 * 128, I_2 = 64 * 32;
    constexpr int I_LO = 2 * I_D + I_G + I_V; constexpr int NITEMS = I_IN + 2 * I_LO + I_O + I_1 + I_2;
    for (int it = gw; it < NITEMS; it += NGW) {
        int r = it;
        if (r < I_IN) { tr_item(P.w_in + (size_t)l * D * 3656, 3656, 3656, D, WIN, 0, scr, r / 115, r % 115, lane, nullptr, 0); continue; } r -= I_IN;
        if (r < 2 * I_LO) { const int md = (r < I_LO) ? 1 : 2; int q = (r < I_LO) ? r : r - I_LO; const int rbase = (md == 1) ? C_P1 : C_P2;
            if (q < I_D) { tr_item(P.decay_a + (size_t)l * D * 64, 64, 64, D, WIN, rbase + 0, scr, q / 2, q % 2, lane, P.mu_lora + (size_t)(l * 3 + 0) * D, md); continue; } q -= I_D;
            if (q < I_D) { tr_item(P.iclr_a + (size_t)l * D * 64, 64, 64, D, WIN, rbase + 64, scr, q / 2, q % 2, lane, P.mu_lora + (size_t)(l * 3 + 1) * D, md); continue; } q -= I_D;
            if (q < I_G) { tr_item(P.gate_a + (size_t)l * D * 128, 128, 128, D, WIN, rbase + 128, scr, q / 4, q % 4, lane, P.mu_lora + (size_t)(l * 3 + 2) * D, md); continue; } q -= I_G;
            if (l >= 1) tr_item(P.vres_a + (size_t)(l - 1) * D * 32, 32, 32, D, WIN, rbase + 256, scr, q, 0, lane, P.vres_mu + (size_t)(l - 1) * D, md);
            continue; }
        r -= 2 * I_LO;
        if (r < I_O) { tr_item(P.w_out + (size_t)l * D * D, D, D, D, WOUT, 0, scr, r / 32, r % 32, lane, nullptr, 0); continue; } r -= I_O;
        if (r < I_1) { tr_item(P.w1 + (size_t)l * D * FF, FF, FF, D, W1, 0, scr, r / 128, r % 128, lane, nullptr, 0); continue; } r -= I_1;
        tr_item(P.w2 + (size_t)l * FF * D, D, D, FF, W2, 0, scr, r / 32, r % 32, lane, nullptr, 0);
    }
    const int gt = vcu * 512 + tid, NGT = G * 512;
    { const int nzr = (NP - C_END) + (l == 0 ? 64 : 0);
      for (int i = gt; i < nzr * 128; i += NGT) { const int zr = i >> 7, ch = i & 127; int row;
          if (zr < NP - C_END) row = C_END + zr; else { const int z2 = zr - (NP - C_END); row = (z2 < 32) ? (C_P1 + 256 + z2) : (C_P2 + 256 + z2 - 32); }
          *(u32x4*)(WIN + (size_t)row * D + ch * 8) = (u32x4){0u, 0u, 0u, 0u}; } }
    { bf16_t* LW = (bf16_t*)(ws + WS_LW);
      for (int i = gt; i < 2048 * 128; i += NGT) { const int n = i >> 7, k = i & 127; float v = 0.f;
          if (n < 512) { if (k < 64) v = P.decay_b[((size_t)l * 64 + k) * 512 + n]; }
          else if (n < 1024) { if (k >= 64) v = P.iclr_b[((size_t)l * 64 + (k - 64)) * 512 + (n - 512)]; }
          else if (n < 1536) { v = P.gate_b[((size_t)l * 128 + k) * 512 + (n - 1024)]; }
          else { if (l >= 1 && k < 32) v = P.vres_b[((size_t)(l - 1) * 32 + k) * 512 + (n - 1536)]; }
          LW[i] = (bf16_t)(pkbf(v, 0.f) & 0xffffu); } }
}

__device__ __forceinline__ void ph_norm(const float* X, const float* g, const float* sh, const float* sc, bf16_t* Hout, int gw, int NGW, int lane) {
    for (int m0 = gw; m0 < M; m0 += 2 * NGW) {
        f32x4 v[2][4]; float s[2] = {0.f, 0.f};
#pragma unroll
        for (int q = 0; q < 2; ++q) { const f32x4* xr = (const f32x4*)(X + (size_t)(m0 + q * NGW) * D) + lane;
#pragma unroll
            for (int j = 0; j < 4; ++j) v[q][j] = xr[64 * j]; }
#pragma unroll
        for (int q = 0; q < 2; ++q)
#pragma unroll
            for (int j = 0; j < 4; ++j) s[q] += (v[q][j][0] * v[q][j][0] + v[q][j][1] * v[q][j][1]) + (v[q][j][2] * v[q][j][2] + v[q][j][3] * v[q][j][3]);
#pragma unroll
        for (int q = 0; q < 2; ++q) { const int m = m0 + q * NGW; const int b = m >> 12;
            const float rstd = rsqrtf(wave_sum(s[q]) * (1.f / D) + 1e-6f);
            u32x2* o8 = (u32x2*)(Hout + (size_t)m * D) + lane;
#pragma unroll
            for (int j = 0; j < 4; ++j) { const int c = 256 * j + 4 * lane;
                const f32x4 gv = *(const f32x4*)(g + c), sv = *(const f32x4*)(sc + (size_t)b * 6144 + c), hv = *(const f32x4*)(sh + (size_t)b * 6144 + c);
                const f32x4 y = v[q][j] * rstd * gv * (sv + 1.f) + hv;
                u32x2 w; w.x = pkbf(y[0], y[1]); w.y = pkbf(y[2], y[3]); o8[64 * j] = w; } } }
}
__device__ __forceinline__ void ph_final_norm(float* X, const float* g, int gw, int NGW, int lane) {
    for (int m = gw; m < M; m += NGW) {
        f32x4* xr = (f32x4*)(X + (size_t)m * D) + lane; f32x4 v[4]; float s = 0.f;
#pragma unroll
        for (int j = 0; j < 4; ++j) { v[j] = xr[64 * j]; s += (v[j][0] * v[j][0] + v[j][1] * v[j][1]) + (v[j][2] * v[j][2] + v[j][3] * v[j][3]); }
        const float rstd = rsqrtf(wave_sum(s) * (1.f / D) + 1e-6f);
#pragma unroll
        for (int j = 0; j < 4; ++j) { const f32x4 gv = *(const f32x4*)(g + 256 * j + 4 * lane); xr[64 * j] = v[j] * rstd * gv; } }
}

__device__ __forceinline__ void ph_lora_act(const bf16_t* PROJ, bf16_t* LACT, bf16_t* VF, const float* mu_v  , bool write_v, int gw, int NGW, int lane) {
    float muv[8];
#pragma unroll
    for (int i = 0; i < 8; ++i) muv[i] = mu_v[lane * 8 + i];
    for (int m = gw; m < M; m += NGW) { const int t = m & (T - 1);
        if (lane < 36) {
            const u32x4 p1 = *(const u32x4*)(PROJ + (size_t)m * NP + C_P1 + lane * 8);
            u32x4 p2 = (u32x4){0u, 0u, 0u, 0u}; if (t > 0) p2 = *(const u32x4*)(PROJ + (size_t)(m - 1) * NP + C_P2 + lane * 8);
            float x[8];
#pragma unroll
            for (int i = 0; i < 4; ++i) { x[2 * i] = bfl(p1[i]) + bfl(p2[i]); x[2 * i + 1] = bfh(p1[i]) + bfh(p2[i]); }
            if (lane < 8) {
#pragma unroll
                for (int i = 0; i < 8; ++i) x[i] = 1.f - 2.f / (__expf(2.f * x[i]) + 1.f);
            } else if (lane >= 16 && lane < 32) {
#pragma unroll
                for (int i = 0; i < 8; ++i) x[i] = 1.f / (1.f + __expf(-x[i]));
            }
            u32x4 w; w.x = pkbf(x[0], x[1]); w.y = pkbf(x[2], x[3]); w.z = pkbf(x[4], x[5]); w.w = pkbf(x[6], x[7]);
            *(u32x4*)(LACT + (size_t)m * LA + lane * 8) = w;
        } else if (lane < 48) { *(u32x4*)(LACT + (size_t)m * LA + lane * 8) = (u32x4){0u, 0u, 0u, 0u}; }
        if (write_v) {
            const u32x4 vc = *(const u32x4*)(PROJ + (size_t)m * NP + C_V + lane * 8);
            u32x4 vp = (u32x4){0u, 0u, 0u, 0u}; if (t > 0) vp = *(const u32x4*)(PROJ + (size_t)(m - 1) * NP + C_V + lane * 8);
            float y[8];
#pragma unroll
            for (int i = 0; i < 4; ++i) { const float c0 = bfl(vc[i]), c1 = bfh(vc[i]); y[2 * i] = c0 + (bfl(vp[i]) - c0) * muv[2 * i]; y[2 * i + 1] = c1 + (bfh(vp[i]) - c1) * muv[2 * i + 1]; }
            u32x4 w; w.x = pkbf(y[0], y[1]); w.y = pkbf(y[2], y[3]); w.z = pkbf(y[4], y[5]); w.w = pkbf(y[6], y[7]);
            *(u32x4*)(VF + (size_t)m * 512 + lane * 8) = w;
        }
    }
}

#ifndef DUP_MASK
#define DUP_MASK 0
#endif
__device__ __forceinline__ unsigned sortable(float s) { const unsigned u = __float_as_uint(s + 0.f); return u ^ ((u >> 31) ? 0xFFFFFFFFu : 0x80000000u); }
__device__ __forceinline__ void ph_select(const bf16_t* PROJ, unsigned long long* MASK, LAS unsigned char* lds, int vcu, int G, int tid) {
    const int lane = tid & 63, wid = __builtin_amdgcn_readfirstlane(tid >> 6), r32 = lane & 31, hi = lane >> 5;
    LAS unsigned* SC = (LAS unsigned*)lds;
    LAS unsigned* HI = (LAS unsigned*)(lds + HIST_OFF) + wid * 256;
    const float WSC = 0.35355339059f * 0.125f;
    bf16x8 AfN[2][4]; u32x4 wN[2][2]; bf16x8 BfN[4];
    const int ql_ = (r32 >> 4) * 2 + ((r32 >> 2) & 1), hd_ = (r32 & 3) + 4 * ((r32 >> 3) & 1);
#define SEL_LOAD(q0_, nblk_, rb_) do { \
        _Pragma("unroll") for (int tq = 0; tq < 2; ++tq) _Pragma("unroll") for (int ks = 0; ks < 4; ++ks) AfN[tq][ks] = *(const bf16x8*)(PROJ + (rb_ + q0_ + tq * 4 + ql_) * NP + C_QI + hd_ * 64 + ks * 16 + hi * 8); \
        _Pragma("unroll") for (int tq = 0; tq < 2; ++tq) _Pragma("unroll") for (int g = 0; g < 2; ++g) wN[tq][g] = *(const u32x4*)(PROJ + (rb_ + q0_ + tq * 4 + 2 * g + hi) * NP + C_WI); \
        if (wid < nblk_) { _Pragma("unroll") for (int ks = 0; ks < 4; ++ks) BfN[ks] = *(const bf16x8*)(PROJ + (rb_ + wid * 32 + r32) * NP + C_KI + ks * 16 + hi * 8); } } while (0)
    if (vcu < NB * 512) { const int bn = vcu & 7, jn = vcu >> 3, basen = jn & 31, rndn = jn >> 5;
        const int q8n = (rndn & 1) ? (32 * rndn + 31 - basen) : (32 * rndn + basen); const int q0n = q8n * 8, nblkn = (q0n >> 5) + 1; const size_t rbn = (size_t)bn * T;
        SEL_LOAD(q0n, nblkn, rbn); }
    for (int it = 0;; ++it) {
        const int tsk = vcu + it * G; if (tsk >= NB * 512) break;
        const int b = tsk & 7, j = tsk >> 3, base = j & 31, rnd = j >> 5;
        const int q8 = (rnd & 1) ? (32 * rnd + 31 - base) : (32 * rnd + base);
        const int q0 = q8 * 8, nblk = (q0 >> 5) + 1; const size_t rb = (size_t)b * T;
        bf16x8 Af[2][4]; float wv[2][16]; bf16x8 Bf[4], Bn[4];
#pragma unroll
        for (int tq = 0; tq < 2; ++tq) {
#pragma unroll
            for (int ks = 0; ks < 4; ++ks) Af[tq][ks] = AfN[tq][ks];
#pragma unroll
            for (int g = 0; g < 2; ++g) { const u32x4 w8 = wN[tq][g];
#pragma unroll
                for (int x = 0; x < 4; ++x) { wv[tq][8 * g + 2 * x] = bfl(w8[x]) * WSC; wv[tq][8 * g + 2 * x + 1] = bfh(w8[x]) * WSC; } } }
#pragma unroll
        for (int ks = 0; ks < 4; ++ks) Bf[ks] = BfN[ks];
        for (int blk = wid; blk < nblk; blk += 8) {
            const int key = blk * 32 + r32;
            if (blk + 8 < nblk) {
#pragma unroll
                for (int ks = 0; ks < 4; ++ks) Bn[ks] = *(const bf16x8*)(PROJ + (rb + key + 256) * NP + C_KI + ks * 16 + hi * 8);
            }
#pragma unroll
            for (int tq = 0; tq < 2; ++tq) { f32x16 acc = {};
#pragma unroll
                for (int ks = 0; ks < 4; ++ks) acc = __builtin_amdgcn_mfma_f32_32x32x16_f16(__builtin_bit_cast(pg8::half8, Af[tq][ks]), __builtin_bit_cast(pg8::half8, Bf[ks]), acc, 0, 0, 0);
#pragma unroll
                for (int g = 0; g < 2; ++g) { float s = 0.f;
#pragma unroll
                    for (int x = 0; x < 8; ++x) s += wv[tq][8 * g + x] * fmaxf(acc[8 * g + x], 0.f);
                    const int ql = tq * 4 + 2 * g + hi; const int qp = q0 + ql;
                    SC[ql * 4096 + key] = (key > qp) ? 0u : sortable(s); } }
#pragma unroll
            for (int ks = 0; ks < 4; ++ks) Bf[ks] = Bn[ks];
        }
        if (tsk + G < NB * 512) { const int tn = tsk + G; const int bn = tn & 7, jn = tn >> 3, basen = jn & 31, rndn = jn >> 5;
            const int q8n = (rndn & 1) ? (32 * rndn + 31 - basen) : (32 * rndn + basen); const int q0n = q8n * 8, nblkn = (q0n >> 5) + 1; const size_t rbn = (size_t)bn * T;
            SEL_LOAD(q0n, nblkn, rbn); }
        __syncthreads();
        for (int rep_r = 0; rep_r < (int)((DUP_MASK >> 14) & 1) + 1; ++rep_r)
        {
            const int qp = q0 + wid; unsigned long long myword = 0ull;
            if (qp < 256) { const int lo = lane * 64; myword = (qp >= lo + 63) ? ~0ull : (qp < lo ? 0ull : ((2ull << (qp - lo)) - 1ull)); }
            else {
                int lane_t = lane; asm volatile("" : "+v"(lane_t));
                const LAS unsigned* scl = SC + wid * 4096 + lane_t; const int nscan = nblk * 32;
                unsigned u[64]; const int nreg = (nscan + 63) >> 6;
#pragma unroll
                for (int j4 = 0; j4 < 64; ++j4) { if ((j4 & ~15) < nreg) { const unsigned v_ = scl[64 * j4]; u[j4] = (lane_t < nscan - 64 * j4) ? v_ : 0u; } else u[j4] = 0u; }
                unsigned umax = 0u, umin = 0xFFFFFFFFu;
#pragma unroll
                for (int j4 = 0; j4 < 64; ++j4) { if ((j4 & ~15) < nreg) { umax = max(umax, u[j4]); umin = min(umin, u[j4] ? u[j4] : 0xFFFFFFFFu); } }
                umax = wave_max_u(umax); umin = wave_min_u(umin);
                unsigned lo = umin, hi = umax + 1u; int c_lo = qp + 1, c_hi = 0;
                while (c_lo - c_hi > 64 && hi - lo > 1u) {
                    const unsigned hm = hi - 1u;
                    const float lf = __uint_as_float((lo & 0x80000000u) ? (lo ^ 0x80000000u) : ~lo), hf = __uint_as_float((hm & 0x80000000u) ? (hm ^ 0x80000000u) : ~hm);
                    unsigned mid = sortable(0.5f * lf + 0.5f * hf);
                    mid = (mid <= lo) ? lo + 1u : ((mid >= hi) ? hi - 1u : mid);
                    int cl = 0;
#pragma unroll
                    for (int j4 = 0; j4 < 64; ++j4) { if ((j4 & ~15) < nreg) cl += (u[j4] >= mid) ? 1 : 0; }
                    const int c = wave_sum_i(cl);
                    if (c >= 256) { lo = mid; c_lo = c; } else { hi = mid; c_hi = c; }
                }
                unsigned Tk; int kth, neq;
                if (hi - lo == 1u) { Tk = lo; kth = 256 - c_hi; neq = c_lo - c_hi; }
                else {
                    LAS unsigned* CAND = HI; int pos = 0;
#pragma unroll
                    for (int j4 = 0; j4 < 64; ++j4) { if ((j4 & ~15) < nreg) { const bool in_ = (u[j4] >= lo) && (u[j4] < hi); const unsigned long long bm = __ballot(in_);
                        if (bm) { if (in_) CAND[pos + __builtin_popcountll(bm & ((1ull << lane_t) - 1ull))] = u[j4]; pos += __builtin_popcountll(bm); } } }
                    LDS_WAIT();
                    const int m_ = pos; const unsigned mine = (lane_t < m_) ? CAND[lane_t] : 0u;
                    int rg = 0, re = 0;
                    for (int x = 0; x < m_; ++x) { const unsigned v_ = __builtin_amdgcn_readlane(mine, x); rg += (v_ > mine) ? 1 : 0; re += (v_ == mine) ? 1 : 0; }
                    const int need = 256 - c_hi;
                    const bool is_t = (lane_t < m_) && (rg < need) && (need <= rg + re);
                    const unsigned long long bt = __ballot(is_t); const int Lt = (int)__builtin_ctzll(bt | (1ull << 63));
                    Tk = __builtin_amdgcn_readlane(mine, Lt); kth = need - __builtin_amdgcn_readlane(rg, Lt); neq = __builtin_amdgcn_readlane(re, Lt);
                }
                int eqtaken = 0; unsigned mw_lo = 0u, mw_hi = 0u;
                if (kth == neq) {
#pragma unroll
                    for (int jt = 0; jt < 64; ++jt) { if ((jt & ~15) < nreg) { const unsigned long long w = __ballot(u[jt] >= Tk); if (lane_t == jt) { mw_lo = (unsigned)w; mw_hi = (unsigned)(w >> 32); } } }
                } else
#pragma unroll
                for (int jt = 0; jt < 64; ++jt) { if ((jt & ~15) < nreg) { const bool gt = u[jt] > Tk, eq = (u[jt] == Tk); const unsigned long long beq = __ballot(eq);
                    const int rank = eqtaken + __builtin_popcountll(beq & ((1ull << lane_t) - 1ull));
                    const unsigned long long w = __ballot(gt || (eq && rank < kth)); eqtaken += __builtin_popcountll(beq);
                    if (lane_t == jt) { mw_lo = (unsigned)w; mw_hi = (unsigned)(w >> 32); } asm volatile("" : "+s"(eqtaken)); } }
                myword = ((unsigned long long)mw_hi << 32) | mw_lo;
            }
            MASK[((size_t)b * 4096 + qp) * 64 + lane] = myword;
        }
        __syncthreads();
    }
#undef SEL_LOAD
}

constexpr int SC_BUF = 43008, SC_YB = 2 * SC_BUF, SC_END = SC_YB + 2 * 2048;
static_assert(SC_END <= RING_BYTES, "scan LDS");
struct ScanP { const bf16_t* PROJ; bf16_t* PROJw; const _Float16* E; const _Float16* A; const bf16_t* VF; const float *mu_r, *mu_k, *k_k, *k_a, *r_k; };
__device__ __forceinline__ void scan_unit(const ScanP& P, int b, int h, int q4, LAS unsigned char* lds, int tid) {
    const int wave = __builtin_amdgcn_readfirstlane(tid >> 6), lane = tid & 63;
    const size_t rb = (size_t)b * T;
    if (wave >= 4) {
        const int pt = tid - 256, tl = pt >> 3, cg = pt & 7; const int ch0 = h * 64 + cg * 8;
        float mur[8], muk[8], kkp[8], kap[8], rkp[8];
#pragma unroll
        for (int i = 0; i < 8; ++i) { mur[i] = P.mu_r[ch0 + i]; muk[i] = P.mu_k[ch0 + i]; kkp[i] = P.k_k[ch0 + i]; kap[i] = P.k_a[ch0 + i]; rkp[i] = P.r_k[ch0 + i]; }
        u32x4 rc, kc, rp, kp, e8, a8; unsigned v2;
#define P_LOAD(cn) do { const int t_ = (cn) * 32 + tl; const size_t m_ = rb + t_; \
            rc = *(const u32x4*)(P.PROJ + m_ * NP + C_R + ch0); kc = *(const u32x4*)(P.PROJ + m_ * NP + C_K + ch0); rp = (u32x4){0u, 0u, 0u, 0u}; kp = (u32x4){0u, 0u, 0u, 0u}; \
            if (t_ > 0) { rp = *(const u32x4*)(P.PROJ + (m_ - 1) * NP + C_R + ch0); kp = *(const u32x4*)(P.PROJ + (m_ - 1) * NP + C_K + ch0); } \
            e8 = *(const u32x4*)(P.E + m_ * 512 + ch0); a8 = *(const u32x4*)(P.A + m_ * 512 + ch0); v2 = *(const unsigned*)(P.VF + m_ * 512 + h * 64 + q4 * 16 + 2 * cg); } while (0)
#define P_COMPUTE(cn) do { LAS unsigned char* buf = lds + ((cn) & 1) * SC_BUF; const size_t m = rb + (cn) * 32 + tl; \
            float r_[8], kl[8], kkv[8], a_[8], e_[8]; float ss = 0.f; \
            _Pragma("unroll") for (int i = 0; i < 8; ++i) { const unsigned wr_ = rc[i >> 1], wrp = rp[i >> 1], wk_ = kc[i >> 1], wkp = kp[i >> 1]; \
                const float xr = (i & 1) ? bfh(wr_) : bfl(wr_), xrp = (i & 1) ? bfh(wrp) : bfl(wrp), xk = (i & 1) ? bfh(wk_) : bfl(wk_), xkp = (i & 1) ? bfh(wkp) : bfl(wkp); \
                r_[i] = xr + (xrp - xr) * mur[i]; kl[i] = xk + (xkp - xk) * muk[i]; kkv[i] = kl[i] * kkp[i]; ss += kkv[i] * kkv[i]; \
                const unsigned we_ = e8[i >> 1], wa_ = a8[i >> 1]; const float el = (i & 1) ? bfh(we_) : bfl(we_), al = (i & 1) ? bfh(wa_) : bfl(wa_); \
                e_[i] = -0.60653065971f * pg8::sigmoidf_(el); a_[i] = pg8::sigmoidf_(al); } \
            ss = allsum8(ss); const float inv = 1.0f / fmaxf(sqrtf(ss), 1e-12f); \
            float kp_[8], kk_[8], nb_[8], dc_[8]; float rk = 0.f; \
            _Pragma("unroll") for (int i = 0; i < 8; ++i) { kk_[i] = kkv[i] * inv; kp_[i] = kl[i] * (1.f + (a_[i] - 1.f) * kap[i]); nb_[i] = -kk_[i] * a_[i]; dc_[i] = __expf(e_[i]); rk += r_[i] * kp_[i] * rkp[i]; } \
            rk = allsum8(rk); \
              \
            const bool wh = (tl & 1) != 0; const int pr = tl >> 1; \
            float rA[8], rB[8]; \
            _Pragma("unroll") for (int i = 0; i < 8; ++i) { rA[i] = dpp_f<0x128>(wh ? dc_[i] : nb_[i]); rB[i] = dpp_f<0x128>(wh ? kk_[i] : kp_[i]); }     \
            float o0[8], o1[8], o2[8], o3[8]; float sa = 0.f, sb = 0.f; \
            _Pragma("unroll") for (int i = 0; i < 8; ++i) { const float dA = dc_[i] * rA[i], dB = dc_[i] * rB[i]; \
                o0[i] = wh ? dA : kk_[i];            \
                o1[i] = dB;                          \
                o2[i] = wh ? nb_[i] : dc_[i] * r_[i];     \
                o3[i] = wh ? kp_[i] : dA;            \
                sa += wh ? rA[i] * kk_[i] : nb_[i] * r_[i];      \
                sb += wh ? rB[i] * kk_[i] : kp_[i] * r_[i]; }    \
            sa = allsum8(sa); sb = allsum8(sb); \
            LAS float* Ob = (LAS float*)buf + (wh ? 4096 : 0) + pr * 64 + cg * 8;            \
            *(LAS f32x4*)(Ob) = (f32x4){o0[0], o0[1], o0[2], o0[3]}; *(LAS f32x4*)(Ob + 4) = (f32x4){o0[4], o0[5], o0[6], o0[7]}; \
            *(LAS f32x4*)(Ob + 1024) = (f32x4){o1[0], o1[1], o1[2], o1[3]}; *(LAS f32x4*)(Ob + 1024 + 4) = (f32x4){o1[4], o1[5], o1[6], o1[7]}; \
            *(LAS f32x4*)(Ob + 2048) = (f32x4){o2[0], o2[1], o2[2], o2[3]}; *(LAS f32x4*)(Ob + 2048 + 4) = (f32x4){o2[4], o2[5], o2[6], o2[7]}; \
            *(LAS f32x4*)(Ob + 3072) = (f32x4){o3[0], o3[1], o3[2], o3[3]}; *(LAS f32x4*)(Ob + 3072 + 4) = (f32x4){o3[4], o3[5], o3[6], o3[7]}; \
            if (wh) { *(LAS f32x4*)(Ob + 4096) = (f32x4){r_[0], r_[1], r_[2], r_[3]}; *(LAS f32x4*)(Ob + 4096 + 4) = (f32x4){r_[4], r_[5], r_[6], r_[7]}; } \
            if (cg == 0) { LAS float* SCL = (LAS float*)buf + 9216 + pr * 4 + (wh ? 0 : 2); SCL[0] = sa; SCL[1] = sb; }       \
            LAS float* VV = (LAS float*)buf + 9280; VV[tl * 16 + 2 * cg] = bfl(v2); VV[tl * 16 + 2 * cg + 1] = bfh(v2); \
            if (q4 == 0 && cg == 0) P.PROJw[m * NP + C_RK + h] = (bf16_t)(pkbf(rk, 0.f) & 0xffffu); } while (0)
        P_LOAD(0); P_COMPUTE(0); P_LOAD(1);
        __syncthreads();
        for (int c = 0; c < T / 32; ++c) {
            if (c >= 1) { const LAS float* YB = (const LAS float*)(lds + SC_YB + ((c - 1) & 1) * 2048); const int t = (c - 1) * 32 + tl;
                const float y0 = YB[tl * 16 + 2 * cg], y1 = YB[tl * 16 + 2 * cg + 1];
                *(unsigned*)(P.PROJw + (rb + t) * NP + C_Y + h * 64 + q4 * 16 + 2 * cg) = pkbf(y0, y1); }
            if (c + 1 < T / 32) { P_COMPUTE(c + 1); if (c + 2 < T / 32) P_LOAD(c + 2); }
            __syncthreads();
        }
#undef P_LOAD
#undef P_COMPUTE
        {
            const int c = T / 32; const LAS float* YB = (const LAS float*)(lds + SC_YB + ((c - 1) & 1) * 2048); const int t = (c - 1) * 32 + tl;
            const float y0 = YB[tl * 16 + 2 * cg], y1 = YB[tl * 16 + 2 * cg + 1];
            *(unsigned*)(P.PROJw + (rb + t) * NP + C_Y + h * 64 + q4 * 16 + 2 * cg) = pkbf(y0, y1);
        }
    } else {
        __builtin_amdgcn_s_setprio(3);
        const int rl = lane >> 4, kg = lane & 15, row = wave * 4 + rl;
        f32x4 S = {0.f, 0.f, 0.f, 0.f};
#ifdef SCAN_DUP_CONS
        f32x4 S2 = {0.f, 0.f, 0.f, 0.f}; float ydump = 0.f;
#endif
        __syncthreads();
        for (int c = 0; c < T / 32; ++c) {
            const LAS float* buf = (const LAS float*)(lds + (c & 1) * SC_BUF); LAS float* YB = (LAS float*)(lds + SC_YB + (c & 1) * 2048);
            struct PairOps { f32x4 kk1, wkk2, wr1, w12, n1, k1, nb2, k2, r2, sc; float v1, v2; };
#define SC_LOADP(O, pp) do { const LAS float* b_ = buf + (pp) * 64 + kg * 4; O.kk1 = *(const LAS f32x4*)(b_); O.wkk2 = *(const LAS f32x4*)(b_ + 1024); O.wr1 = *(const LAS f32x4*)(b_ + 2048); O.w12 = *(const LAS f32x4*)(b_ + 3072); \
                O.n1 = *(const LAS f32x4*)(b_ + 4096); O.k1 = *(const LAS f32x4*)(b_ + 5120); O.nb2 = *(const LAS f32x4*)(b_ + 6144); O.k2 = *(const LAS f32x4*)(b_ + 7168); O.r2 = *(const LAS f32x4*)(b_ + 8192); \
                O.sc = *(const LAS f32x4*)(buf + 9216 + (pp) * 4); O.v1 = buf[9280 + (2 * (pp)) * 16 + row]; O.v2 = buf[9280 + (2 * (pp) + 1) * 16 + row]; } while (0)
#define SC_DOT(A, B) ((A[0] * B[0] + A[1] * B[1]) + (A[2] * B[2] + A[3] * B[3]))
#define SC_STEPP(O, pp) do { float d1 = SC_DOT(S, O.kk1), d2 = SC_DOT(S, O.wkk2), d3 = SC_DOT(S, O.wr1); d1 = allsum16(d1); d2 = allsum16(d2); d3 = allsum16(d3); \
                const float s1 = d1, s2 = d2 + s1 * O.sc[0] + O.v1 * O.sc[1], y1 = d3 + s1 * O.sc[2] + O.v1 * O.sc[3]; \
                S = (S * O.w12 + (O.n1 * s1 + O.k1 * O.v1)) + (O.nb2 * s2 + O.k2 * O.v2); \
                float y2 = SC_DOT(S, O.r2); y2 = allsum16(y2); if (kg == 0) { YB[(2 * (pp)) * 16 + row] = y1; YB[(2 * (pp) + 1) * 16 + row] = y2; } } while (0)
            PairOps oA, oB;
            SC_LOADP(oA, 0);
#pragma unroll 2
            for (int pp = 0; pp < 16; pp += 2) {
                SC_LOADP(oB, pp + 1);
                SC_STEPP(oA, pp);
                if (pp + 2 < 16) SC_LOADP(oA, pp + 2);
                SC_STEPP(oB, pp + 1);
            }
#undef SC_LOADP
#undef SC_DOT
#undef SC_STEPP
            __syncthreads();
        }
        __builtin_amdgcn_s_setprio(0);
    }
    __syncthreads();
}

namespace sck {
typedef float f32x2v __attribute__((ext_vector_type(2)));
constexpr int SLOT = 10496, GBUF = 4 * SLOT;
constexpr int PS_OFF = 2 * GBUF, PS_SZ = 4608;
constexpr int CS_OFF = PS_OFF + 4 * PS_SZ;
constexpr int YB_OFF = CS_OFF + 3072, CST_OFF = YB_OFF + 2 * 4096, END = CST_OFF + 5 * 256;
static_assert(END <= 131072, "chunked scan LDS");
__device__ __forceinline__ f32x4 mf(u32x4 a, u32x4 b, f32x4 c) { return __builtin_amdgcn_mfma_f32_16x16x32_f16(__builtin_bit_cast(pg8::half8, a), __builtin_bit_cast(pg8::half8, b), c, 0, 0, 0); }
__device__ __forceinline__ u32x4 pack8(const float* x) { u32x4 w; w.x = pkbf(x[0], x[1]); w.y = pkbf(x[2], x[3]); w.z = pkbf(x[4], x[5]); w.w = pkbf(x[6], x[7]); return w; }
__device__ __forceinline__ u32x2 pack4(f32x4 v) { u32x2 w; w.x = pkbf(v[0], v[1]); w.y = pkbf(v[2], v[3]); return w; }
__device__ __forceinline__ f32x4 unpack4(u32x2 w) { return (f32x4){bfl(w.x), bfh(w.x), bfl(w.y), bfh(w.y)}; }
__device__ __forceinline__ void sth(LAS bf16_t* p, float v) { *p = (bf16_t)(pkbf(v, 0.f) & 0xffffu); }
}

__device__ __forceinline__ void scan_unit_chunk(const ScanP& P, int b, int h, int q4, LAS unsigned char* lds, int tid) {
    using namespace sck;
    const int wave = __builtin_amdgcn_readfirstlane(tid >> 6), lane = tid & 63;
    const int n16 = lane & 15, g = lane >> 4;
    const size_t rb = (size_t)b * T;
    constexpr int NG = T / 64;
    if (tid < 64) { LAS float* cst = (LAS float*)(lds + CST_OFF); const int ch = h * 64 + tid; cst[tid] = P.mu_r[ch]; cst[64 + tid] = P.mu_k[ch]; cst[128 + tid] = P.k_k[ch]; cst[192 + tid] = P.k_a[ch]; cst[256 + tid] = P.r_k[ch]; }
    __syncthreads();
    if (wave >= 4) {
        const int p = wave - 4;
        LAS unsigned char* ps = lds + PS_OFF + p * PS_SZ;
        LAS float* LAB = (LAS float*)ps; LAS bf16_t* LAK = (LAS bf16_t*)(ps + 1024); LAS bf16_t* MRK = (LAS bf16_t*)(ps + 1536); LAS bf16_t* VT = (LAS bf16_t*)(ps + 2048); LAS bf16_t* K2T = (LAS bf16_t*)(ps + 2560);
        const LAS float* CST = (const LAS float*)(lds + CST_OFF);
        u32x4 rc[2], kc[2], rp[2], kp[2], e8[2], a8[2]; u32x2 v4;
#define CK_LOAD(gi) do { const int t_ = (gi) * 64 + p * 16 + n16; const size_t m_ = rb + t_; \
            _Pragma("unroll") for (int s = 0; s < 2; ++s) { const int co = h * 64 + 32 * s + 8 * g; \
                rc[s] = *(const u32x4*)(P.PROJ + m_ * NP + C_R + co); kc[s] = *(const u32x4*)(P.PROJ + m_ * NP + C_K + co); rp[s] = (u32x4){0u, 0u, 0u, 0u}; kp[s] = (u32x4){0u, 0u, 0u, 0u}; \
                if (t_ > 0) { rp[s] = *(const u32x4*)(P.PROJ + (m_ - 1) * NP + C_R + co); kp[s] = *(const u32x4*)(P.PROJ + (m_ - 1) * NP + C_K + co); } \
                e8[s] = *(const u32x4*)(P.E + m_ * 512 + co); a8[s] = *(const u32x4*)(P.A + m_ * 512 + co); } \
            v4 = *(const u32x2*)(P.VF + m_ * 512 + h * 64 + q4 * 16 + 4 * g); } while (0)
        CK_LOAD(0);
        for (int gi = 0; gi <= NG; ++gi) {
            if (gi < NG) {
                int n16q_ = n16, gq_ = g; asm volatile("" : "+v"(n16q_), "+v"(gq_));
                { const int n16 = n16q_, g = gq_, lane = gq_ * 16 + n16q_; (void)lane;
                LAS unsigned char* sl = lds + (gi & 1) * GBUF + p * SLOT;
                const size_t m = rb + gi * 64 + p * 16 + n16;
                const LAS float* CSTg = CST + 8 * g; LAS bf16_t* B2Tg = (LAS bf16_t*)(sl + 4096) + (8 * g) * 16 + n16; LAS bf16_t* K2Tg = K2T + (8 * g) * 16 + n16; LAS float* G15g = (LAS float*)(sl + 10240) + 8 * g;
                asm volatile("" : "+v"(CSTg), "+v"(B2Tg), "+v"(K2Tg), "+v"(G15g));
                float ss = 0.f;
#pragma unroll
                for (int s = 0; s < 2; ++s)
#pragma unroll
                    for (int e = 0; e < 8; ++e) { const unsigned wk_ = kc[s][e >> 1], wkp = kp[s][e >> 1]; const float xk = (e & 1) ? bfh(wk_) : bfl(wk_), xkp = (e & 1) ? bfh(wkp) : bfl(wkp);
                        const float kkv = (xk + (xkp - xk) * CSTg[64 + 32 * s + e]) * CSTg[128 + 32 * s + e]; ss += kkv * kkv; }
                ss += __shfl_xor(ss, 16); ss += __shfl_xor(ss, 32);
                const float inv = 1.0f / fmaxf(sqrtf(ss), 1e-12f);
                u32x4 AFf[2], PFf[2], A1f[2], B1f[2], K1f[2], P1f[2]; float rk = 0.f;
#pragma unroll
                for (int s = 0; s < 2; ++s) { float al[8], al1[8], be1[8], ka1[8], rh[8], rh1[8];
#pragma unroll
                    for (int e = 0; e < 8; ++e) { const unsigned wr_ = rc[s][e >> 1], wrp = rp[s][e >> 1], wk_ = kc[s][e >> 1], wkp = kp[s][e >> 1], we_ = e8[s][e >> 1], wa_ = a8[s][e >> 1];
                        const float xr = (e & 1) ? bfh(wr_) : bfl(wr_), xrp = (e & 1) ? bfh(wrp) : bfl(wrp), xk = (e & 1) ? bfh(wk_) : bfl(wk_), xkp = (e & 1) ? bfh(wkp) : bfl(wkp);
                        const float el = (e & 1) ? bfh(we_) : bfl(we_), alg = (e & 1) ? bfh(wa_) : bfl(wa_);
                        constexpr int dummy_ = 0; (void)dummy_; const float rq = xr + (xrp - xr) * CSTg[32 * s + e], kl = xk + (xkp - xk) * CSTg[64 + 32 * s + e]; const float kk = kl * CSTg[128 + 32 * s + e] * inv;
                        const float a_ = alg, ev = el;
                        const float kpv = kl * (1.f + (a_ - 1.f) * CSTg[192 + 32 * s + e]), bb = kk * a_; rk += rq * kpv * CSTg[256 + 32 * s + e];
                        float cum = ev;
                        cum += dpp_f<0x111>(cum); cum += dpp_f<0x112>(cum); cum += dpp_f<0x114>(cum); cum += dpp_f<0x118>(cum);
                        const float cumx = cum - ev; const float c7 = dpp_f<0x157>(cum), c15 = dpp_f<0x15F>(cum);
                        const float GGm = __builtin_amdgcn_exp2f(cum - c7), iGm = __builtin_amdgcn_rcpf(GGm), iW = __builtin_amdgcn_exp2f(-ev), Gm = __builtin_amdgcn_exp2f(c7), Dm = __builtin_amdgcn_exp2f(c15 - c7);
                        const float G = GGm * Gm, GpGm = GGm * iW, Gp = GpGm * Gm, iG15 = Dm * iGm; (void)cumx;
                        al[e] = Gp * kk; al1[e] = GpGm * kk; be1[e] = bb * iGm; ka1[e] = kpv * iGm; rh[e] = G * rq; rh1[e] = GGm * rq;
                        sth(B2Tg + (32 * s + e) * 16, bb * iG15); sth(K2Tg + (32 * s + e) * 16, kpv * iG15);
                        if (n16 == 0) G15g[32 * s + e] = Gm * Dm;
                        asm volatile("" ::: "memory"); }
                    AFf[s] = pack8(al); PFf[s] = pack8(rh); A1f[s] = pack8(al1); B1f[s] = pack8(be1); K1f[s] = pack8(ka1); P1f[s] = pack8(rh1);
                    *(LAS u32x4*)(sl + 0 + n16 * 128 + (32 * s + 8 * g) * 2) = AFf[s]; *(LAS u32x4*)(sl + 2048 + n16 * 128 + (32 * s + 8 * g) * 2) = PFf[s]; }
                rk += __shfl_xor(rk, 16); rk += __shfl_xor(rk, 32);
                if (q4 == 0 && g == 0) P.PROJw[m * NP + C_RK + h] = (bf16_t)(pkbf(rk, 0.f) & 0xffffu);
                const f32x4 z4 = {0.f, 0.f, 0.f, 0.f};
                f32x4 Lab = mf(A1f[1], B1f[1], mf(A1f[0], B1f[0], z4)), Lak = mf(A1f[1], K1f[1], mf(A1f[0], K1f[0], z4)), Mrb = mf(P1f[1], B1f[1], mf(P1f[0], B1f[0], z4)), Mrk = mf(P1f[1], K1f[1], mf(P1f[0], K1f[0], z4));
                { int nm = n16, gm = g; asm volatile("" : "+v"(nm), "+v"(gm));
#pragma unroll
                  for (int x = 0; x < 4; ++x) { const int j = 4 * gm + x; if (!(j > nm)) { Lab[x] = 0.f; Lak[x] = 0.f; } if (!(j >= nm)) { Mrb[x] = 0.f; Mrk[x] = 0.f; } } }
#pragma unroll
                for (int x = 0; x < 4; ++x) { const int j = 4 * g + x; LAB[j * 16 + n16] = Lab[x]; sth(LAK + j * 16 + n16, Lak[x]); sth(MRK + j * 16 + n16, Mrk[x]); sth((LAS bf16_t*)(sl + 6656) + j * 16 + n16, Mrb[x]); }
                { VT[(4 * g + 0) * 16 + n16] = (bf16_t)(v4.x & 0xffffu); VT[(4 * g + 1) * 16 + n16] = (bf16_t)(v4.x >> 16); VT[(4 * g + 2) * 16 + n16] = (bf16_t)(v4.y & 0xffffu); VT[(4 * g + 3) * 16 + n16] = (bf16_t)(v4.y >> 16); }
                LDS_WAIT();
                { float t[16]; int nl = n16; asm volatile("" : "+v"(nl));
#pragma unroll
                  for (int j = 0; j < 16; ++j) { const f32x4 r0 = *(const LAS f32x4*)(LAB + j * 16), r1 = *(const LAS f32x4*)(LAB + j * 16 + 4), r2 = *(const LAS f32x4*)(LAB + j * 16 + 8), r3 = *(const LAS f32x4*)(LAB + j * 16 + 12);
                      const float row[16] = {r0[0], r0[1], r0[2], r0[3], r1[0], r1[1], r1[2], r1[3], r2[0], r2[1], r2[2], r2[3], r3[0], r3[1], r3[2], r3[3]};
                      float acc = (j == nl) ? 1.f : 0.f;
#pragma unroll
                      for (int i = 0; i < 16; ++i) if (i < j) acc -= row[i] * t[i];
                      t[j] = acc; asm volatile("" ::: "memory"); }
                  if (g == 0) {
#pragma unroll
                      for (int j = 0; j < 16; ++j) sth((LAS bf16_t*)(sl + 6144) + j * 16 + n16, t[j]); } }
                { const u32x4 z = {0u, 0u, 0u, 0u};
                  const u32x4 LakF = (g < 2) ? *(const LAS u32x4*)(LAK + n16 * 16 + 8 * g) : z, MrkF = (g < 2) ? *(const LAS u32x4*)(MRK + n16 * 16 + 8 * g) : z, VFr = (g < 2) ? *(const LAS u32x4*)(VT + n16 * 16 + 8 * g) : z;
                  const f32x4 LV = mf(LakF, VFr, z4), YV = mf(MrkF, VFr, z4);
                  *(LAS u32x2*)(sl + 7168 + lane * 8) = pack4(LV); *(LAS u32x2*)(sl + 7680 + lane * 8) = pack4(YV);
#pragma unroll
                  for (int rt = 0; rt < 4; ++rt) { const u32x4 K2F = (g < 2) ? *(const LAS u32x4*)(K2T + (16 * rt + n16) * 16 + 8 * g) : z; const f32x4 KV = mf(K2F, VFr, z4);
                      *(LAS u32x2*)(sl + 8192 + rt * 512 + lane * 8) = pack4(KV); } }
                if (gi + 1 < NG) CK_LOAD(gi + 1);
                }
            }
            __syncthreads();
        }
#undef CK_LOAD
    } else {
        f32x4 S32[4]; S32[0] = S32[1] = S32[2] = S32[3] = (f32x4){0.f, 0.f, 0.f, 0.f};
        LAS unsigned char* cs = lds + CS_OFF;
        if (wave == 0) {
#pragma unroll
            for (int rt = 0; rt < 4; ++rt) *(LAS u32x2*)(cs + 1024 + n16 * 128 + (16 * rt + 4 * g) * 2) = (u32x2){0u, 0u};
        }
        __syncthreads();
        for (int gi = 0; gi < NG; ++gi) {
            if (wave == 0) {
                const u32x4 z = {0u, 0u, 0u, 0u}; const f32x4 z4 = {0.f, 0.f, 0.f, 0.f};
                LAS float* YB = (LAS float*)(lds + YB_OFF + (gi & 1) * 4096);
                for (int pc = 0; pc < 4; ++pc) {
                    int n16q_ = n16, gq_ = g; asm volatile("" : "+v"(n16q_), "+v"(gq_));
                    const int n16 = n16q_, g = gq_, lane = gq_ * 16 + n16q_;
                    const LAS unsigned char* sl = lds + (gi & 1) * GBUF + pc * SLOT;
                    LDS_WAIT();
                    const u32x4 S0 = *(const LAS u32x4*)(cs + 1024 + n16 * 128 + (8 * g) * 2), S1 = *(const LAS u32x4*)(cs + 1024 + n16 * 128 + (32 + 8 * g) * 2);
                    const u32x4 A0 = *(const LAS u32x4*)(sl + n16 * 128 + (8 * g) * 2), A1 = *(const LAS u32x4*)(sl + n16 * 128 + (32 + 8 * g) * 2);
                    const u32x4 P0 = *(const LAS u32x4*)(sl + 2048 + n16 * 128 + (8 * g) * 2), P1 = *(const LAS u32x4*)(sl + 2048 + n16 * 128 + (32 + 8 * g) * 2);
                    const f32x4 LV = unpack4(*(const LAS u32x2*)(sl + 7168 + lane * 8)), YV = unpack4(*(const LAS u32x2*)(sl + 7680 + lane * 8));
                    const f32x4 Ub = mf(A1, S1, mf(A0, S0, LV));
                    *(LAS u32x2*)(cs + 0 + n16 * 32 + (4 * g) * 2) = pack4(Ub);
                    LDS_WAIT();
                    const u32x4 UbF = (g < 2) ? *(const LAS u32x4*)(cs + 0 + n16 * 32 + (8 * g) * 2) : z;
                    const u32x4 TF = (g < 2) ? *(const LAS u32x4*)(sl + 6144 + n16 * 32 + (8 * g) * 2) : z;
                    f32x4 U = mf(TF, UbF, z4); U = -U;
                    *(LAS u32x2*)(cs + 512 + n16 * 32 + (4 * g) * 2) = pack4(U);
                    LDS_WAIT();
                    const u32x4 UF = (g < 2) ? *(const LAS u32x4*)(cs + 512 + n16 * 32 + (8 * g) * 2) : z;
                    const u32x4 MF = (g < 2) ? *(const LAS u32x4*)(sl + 6656 + n16 * 32 + (8 * g) * 2) : z;
                    const f32x4 Y = mf(MF, UF, mf(P1, S1, mf(P0, S0, YV)));
#pragma unroll
                    for (int x = 0; x < 4; ++x) YB[(pc * 16 + 4 * g + x) * 16 + n16] = Y[x];
#pragma unroll
                    for (int rt = 0; rt < 4; ++rt) { const u32x4 BF = (g < 2) ? *(const LAS u32x4*)(sl + 4096 + (16 * rt + n16) * 32 + (8 * g) * 2) : z;
                        const f32x4 KV = unpack4(*(const LAS u32x2*)(sl + 8192 + rt * 512 + lane * 8)); const f32x4 G15 = *(const LAS f32x4*)(sl + 10240 + (16 * rt + 4 * g) * 4);
                        S32[rt] = mf(BF, UF, S32[rt] * G15 + KV);
                        *(LAS u32x2*)(cs + 1024 + n16 * 128 + (16 * rt + 4 * g) * 2) = pack4(S32[rt]); }
                }
            } else if (wave == 1 && gi >= 1) {
                const LAS float* YB = (const LAS float*)(lds + YB_OFF + ((gi - 1) & 1) * 4096) + lane * 16;
                const f32x4 y0 = *(const LAS f32x4*)(YB), y1 = *(const LAS f32x4*)(YB + 4), y2 = *(const LAS f32x4*)(YB + 8), y3 = *(const LAS f32x4*)(YB + 12);
                bf16_t* dst = P.PROJw + (rb + (gi - 1) * 64 + lane) * NP + C_Y + h * 64 + q4 * 16;
                u32x4 w0, w1; w0.x = pkbf(y0[0], y0[1]); w0.y = pkbf(y0[2], y0[3]); w0.z = pkbf(y1[0], y1[1]); w0.w = pkbf(y1[2], y1[3]); w1.x = pkbf(y2[0], y2[1]); w1.y = pkbf(y2[2], y2[3]); w1.z = pkbf(y3[0], y3[1]); w1.w = pkbf(y3[2], y3[3]);
                *(u32x4*)dst = w0; *(u32x4*)(dst + 8) = w1;
            }
            __syncthreads();
        }
        if (wave == 1) {
            const LAS float* YB = (const LAS float*)(lds + YB_OFF + ((NG - 1) & 1) * 4096) + lane * 16;
            const f32x4 y0 = *(const LAS f32x4*)(YB), y1 = *(const LAS f32x4*)(YB + 4), y2 = *(const LAS f32x4*)(YB + 8), y3 = *(const LAS f32x4*)(YB + 12);
            bf16_t* dst = P.PROJw + (rb + (NG - 1) * 64 + lane) * NP + C_Y + h * 64 + q4 * 16;
            u32x4 w0, w1; w0.x = pkbf(y0[0], y0[1]); w0.y = pkbf(y0[2], y0[3]); w0.z = pkbf(y1[0], y1[1]); w0.w = pkbf(y1[2], y1[3]); w1.x = pkbf(y2[0], y2[1]); w1.y = pkbf(y2[2], y2[3]); w1.z = pkbf(y3[0], y3[1]); w1.w = pkbf(y3[2], y3[3]);
            *(u32x4*)dst = w0; *(u32x4*)(dst + 8) = w1;
        }
    }
    __syncthreads();
}

namespace sck2 {
using namespace sck;
constexpr int RG = 8;
constexpr int O_AF = 0, O_PF = 2048, O_B2T = 4096, O_K2T = 6656, O_TT = 9216, O_MRB = 9856, O_LAK = 10496, O_MRK = 11136, O_G15 = 11776, RSLOT = 12288, SA = 128, SB = 40;
constexpr size_t RING_HEAD = (size_t)RG * 4 * RSLOT;
constexpr int PW_SZ = RSLOT + 1024;
constexpr int PCST_OFF = 8 * PW_SZ;
constexpr int GB_SZ = 4 * RSLOT, VT_OFF = 2 * GB_SZ, VT_SZ = 64 * SB, END2 = VT_OFF + 2 * 4 * VT_SZ;
static_assert(PCST_OFF + 1280 <= 131072 && END2 <= 131072 && (size_t)64 * RING_HEAD <= 24 * MiB, "role-split scan: LDS / ring");
constexpr int CW_SCAN = 131072, CW_SCAN_LAYER = 16384;
constexpr unsigned SPIN_CAP = 1u << 21;
__device__ __forceinline__ void spin_ge(unsigned* w, unsigned want, int lane, unsigned* tmo) {
    unsigned sp = 0;
    for (;;) { unsigned v = 0; if (lane == 0) v = __hip_atomic_load(w, __ATOMIC_RELAXED, __HIP_MEMORY_SCOPE_AGENT);
        if ((unsigned)__builtin_amdgcn_readfirstlane(v) >= want) break; __builtin_amdgcn_s_sleep(1);
        if ((++sp & 255u) == 0u) { unsigned t = 0; if (lane == 0) t = __hip_atomic_load(tmo, __ATOMIC_RELAXED, __HIP_MEMORY_SCOPE_AGENT); if (__builtin_amdgcn_readfirstlane(t)) break;
            if (sp > SPIN_CAP) { if (lane == 0) __hip_atomic_store(tmo, 1u, __ATOMIC_RELAXED, __HIP_MEMORY_SCOPE_AGENT); break; } } }
}
__device__ __forceinline__ void spin_min4_ge(unsigned* w, unsigned want, int lane, unsigned* tmo) {
    unsigned sp = 0;
    for (;;) { unsigned v = 0xffffffffu; if (lane < 4) v = __hip_atomic_load(w + lane, __ATOMIC_RELAXED, __HIP_MEMORY_SCOPE_AGENT);
        const unsigned m = min(min((unsigned)__builtin_amdgcn_readlane(v, 0), (unsigned)__builtin_amdgcn_readlane(v, 1)), min((unsigned)__builtin_amdgcn_readlane(v, 2), (unsigned)__builtin_amdgcn_readlane(v, 3)));
        if (m >= want) break; __builtin_amdgcn_s_sleep(1);
        if ((++sp & 255u) == 0u) { unsigned t = 0; if (lane == 0) t = __hip_atomic_load(tmo, __ATOMIC_RELAXED, __HIP_MEMORY_SCOPE_AGENT); if (__builtin_amdgcn_readfirstlane(t)) break;
            if (sp > SPIN_CAP) { if (lane == 0) __hip_atomic_store(tmo, 1u, __ATOMIC_RELAXED, __HIP_MEMORY_SCOPE_AGENT); break; } } }
}
typedef _Float16 half4 __attribute__((ext_vector_type(4)));
__device__ __forceinline__ f32x4 mf16(u32x2 a, u32x2 b, f32x4 c) { return __builtin_amdgcn_mfma_f32_16x16x16f16(__builtin_bit_cast(half4, a), __builtin_bit_cast(half4, b), c, 0, 0, 0); }
__device__ __forceinline__ void store_wt(unsigned char* p, u32x4 v) { asm volatile("global_store_dwordx4 %0, %1, off sc1" :: "v"((GAS unsigned char*)p), "v"(v) : "memory"); }
}

__device__ __forceinline__ void scan_unit_share(const ScanP& P, int b, int h, int role, LAS unsigned char* lds, int tid, unsigned char* ring_all, unsigned* flags, unsigned xcc) {
    using namespace sck2;
    const int wave = __builtin_amdgcn_readfirstlane(tid >> 6), lane = tid & 63;
    const int n16 = lane & 15, g = lane >> 4;
    const size_t rb = (size_t)b * T;
    constexpr int NG = T / 64, NC = T / 16;
    const int head = b * 8 + h;
    unsigned char* ring = ring_all + (size_t)head * RING_HEAD;
    unsigned* ready = flags + head * 64; unsigned* done = flags + 8192 + head * 64; unsigned* tmo = flags + 16320; unsigned* xw = flags + 12288 + head * 4;
    if (tid == 0) __hip_atomic_store(xw + role, xcc + 1u, __ATOMIC_RELAXED, __HIP_MEMORY_SCOPE_AGENT);
#define COXCD(res_) do { unsigned v_[4]; _Pragma("unroll") for (int q_ = 0; q_ < 4; ++q_) { spin_ge(xw + q_, 1u, lane, tmo); unsigned t_ = 0; if (lane == 0) t_ = __hip_atomic_load(xw + q_, __ATOMIC_RELAXED, __HIP_MEMORY_SCOPE_AGENT); v_[q_] = (unsigned)__builtin_amdgcn_readfirstlane(t_); } \
        res_ = (v_[0] == v_[1]) && (v_[1] == v_[2]) && (v_[2] == v_[3]) && (v_[0] != 0u); } while (0)
    if (role == 3) {
    } else if (role != 0) {
        if (tid < 64) { LAS float* cst = (LAS float*)(lds + PCST_OFF); const int ch = h * 64 + tid; cst[tid] = P.mu_r[ch]; cst[64 + tid] = P.mu_k[ch]; cst[128 + tid] = P.k_k[ch]; cst[192 + tid] = P.k_a[ch]; cst[256 + tid] = P.r_k[ch]; }
        __syncthreads();
        const int pw = (role - 1) * 8 + wave;
        LAS unsigned char* sl = lds + wave * PW_SZ; LAS float* LAB = (LAS float*)(sl + RSLOT);
        const LAS float* CST = (const LAS float*)(lds + PCST_OFF);
        u32x4 rc[2], kc[2], rp[2], kp[2], e8[2], a8[2];
#define CK_LOAD(cx) do { const int t_ = (cx) * 16 + n16; const size_t m_ = rb + t_; \
            _Pragma("unroll") for (int s = 0; s < 2; ++s) { const int co = h * 64 + 32 * s + 8 * g; \
                rc[s] = *(const u32x4*)(P.PROJ + m_ * NP + C_R + co); kc[s] = *(const u32x4*)(P.PROJ + m_ * NP + C_K + co); rp[s] = (u32x4){0u, 0u, 0u, 0u}; kp[s] = (u32x4){0u, 0u, 0u, 0u}; \
                if (t_ > 0) { rp[s] = *(const u32x4*)(P.PROJ + (m_ - 1) * NP + C_R + co); kp[s] = *(const u32x4*)(P.PROJ + (m_ - 1) * NP + C_K + co); } \
                e8[s] = *(const u32x4*)(P.E + m_ * 512 + co); a8[s] = *(const u32x4*)(P.A + m_ * 512 + co); } } while (0)
        CK_LOAD(pw);
        bool cox; COXCD(cox);
        for (int c = pw; c < NC; c += 16) {
            int n16q_ = n16, gq_ = g; asm volatile("" : "+v"(n16q_), "+v"(gq_));
            { const int n16 = n16q_, g = gq_, lane = gq_ * 16 + n16q_;
            const size_t m = rb + c * 16 + n16;
            const LAS float* CSTg = CST + 8 * g; LAS bf16_t* B2Tg = (LAS bf16_t*)(sl + O_B2T) + (8 * g) * (SB / 2) + n16; LAS bf16_t* K2Tg = (LAS bf16_t*)(sl + O_K2T) + (8 * g) * (SB / 2) + n16; LAS float* G15g = (LAS float*)(sl + O_G15) + 8 * g;
            asm volatile("" : "+v"(CSTg), "+v"(B2Tg), "+v"(K2Tg), "+v"(G15g));
            float ss = 0.f;
#pragma unroll
            for (int s = 0; s < 2; ++s)
#pragma unroll
                for (int e = 0; e < 8; ++e) { const unsigned wk_ = kc[s][e >> 1], wkp = kp[s][e >> 1]; const float xk = (e & 1) ? bfh(wk_) : bfl(wk_), xkp = (e & 1) ? bfh(wkp) : bfl(wkp);
                    const float kkv = (xk + (xkp - xk) * CSTg[64 + 32 * s + e]) * CSTg[128 + 32 * s + e]; ss += kkv * kkv; }
            ss += __shfl_xor(ss, 16); ss += __shfl_xor(ss, 32);
            const float inv = 1.0f / fmaxf(sqrtf(ss), 1e-12f);
            u32x4 A1f[2], B1f[2], K1f[2], P1f[2]; float rk = 0.f;
#pragma unroll
            for (int s = 0; s < 2; ++s) { float al[8], al1[8], be1[8], ka1[8], rh[8], rh1[8];
#pragma unroll
                for (int e = 0; e < 8; ++e) { const unsigned wr_ = rc[s][e >> 1], wrp = rp[s][e >> 1], wk_ = kc[s][e >> 1], wkp = kp[s][e >> 1], we_ = e8[s][e >> 1], wa_ = a8[s][e >> 1];
                    const float xr = (e & 1) ? bfh(wr_) : bfl(wr_), xrp = (e & 1) ? bfh(wrp) : bfl(wrp), xk = (e & 1) ? bfh(wk_) : bfl(wk_), xkp = (e & 1) ? bfh(wkp) : bfl(wkp);
                    const float ev = (e & 1) ? bfh(we_) : bfl(we_), a_ = (e & 1) ? bfh(wa_) : bfl(wa_);
                    const float rq = xr + (xrp - xr) * CSTg[32 * s + e], kl = xk + (xkp - xk) * CSTg[64 + 32 * s + e]; const float kk = kl * CSTg[128 + 32 * s + e] * inv;
                    const float kpv = kl * (1.f + (a_ - 1.f) * CSTg[192 + 32 * s + e]), bb = kk * a_; rk += rq * kpv * CSTg[256 + 32 * s + e];
                    float cum = ev;
                    cum += dpp_f<0x111>(cum); cum += dpp_f<0x112>(cum); cum += dpp_f<0x114>(cum); cum += dpp_f<0x118>(cum);
                    const float c7 = dpp_f<0x157>(cum), c15 = dpp_f<0x15F>(cum);
                    const float GGm = __builtin_amdgcn_exp2f(cum - c7), iGm = __builtin_amdgcn_rcpf(GGm), iW = __builtin_amdgcn_exp2f(-ev), Gm = __builtin_amdgcn_exp2f(c7), Dm = __builtin_amdgcn_exp2f(c15 - c7);
                    const float G = GGm * Gm, GpGm = GGm * iW, Gp = GpGm * Gm, iG15 = Dm * iGm;
                    al[e] = Gp * kk; al1[e] = GpGm * kk; be1[e] = bb * iGm; ka1[e] = kpv * iGm; rh[e] = G * rq; rh1[e] = GGm * rq;
                    sth(B2Tg + (32 * s + e) * (SB / 2), bb * iG15); sth(K2Tg + (32 * s + e) * (SB / 2), kpv * iG15);
                    if (n16 == 0) G15g[32 * s + e] = Gm * Dm;
                    asm volatile("" ::: "memory"); }
                A1f[s] = pack8(al1); B1f[s] = pack8(be1); K1f[s] = pack8(ka1); P1f[s] = pack8(rh1);
                { const u32x4 wa = pack8(al), wp = pack8(rh); LAS unsigned char* ra = sl + n16 * SA; const int u0 = ((8 * s + 2 * g) ^ n16) * 8, u1 = ((8 * s + 2 * g + 1) ^ n16) * 8;
                  *(LAS u32x2*)(ra + O_AF + u0) = (u32x2){wa.x, wa.y}; *(LAS u32x2*)(ra + O_AF + u1) = (u32x2){wa.z, wa.w}; *(LAS u32x2*)(ra + O_PF + u0) = (u32x2){wp.x, wp.y}; *(LAS u32x2*)(ra + O_PF + u1) = (u32x2){wp.z, wp.w}; } }
            rk += __shfl_xor(rk, 16); rk += __shfl_xor(rk, 32);
            if (g == 0) P.PROJw[m * NP + C_RK + h] = (bf16_t)(pkbf(rk, 0.f) & 0xffffu);
            const f32x4 z4 = {0.f, 0.f, 0.f, 0.f};
            f32x4 Lab = mf(A1f[1], B1f[1], mf(A1f[0], B1f[0], z4)), Lak = mf(A1f[1], K1f[1], mf(A1f[0], K1f[0], z4)), Mrb = mf(P1f[1], B1f[1], mf(P1f[0], B1f[0], z4)), Mrk = mf(P1f[1], K1f[1], mf(P1f[0], K1f[0], z4));
            { int nm = n16, gm = g; asm volatile("" : "+v"(nm), "+v"(gm));
#pragma unroll
              for (int x = 0; x < 4; ++x) { const int j = 4 * gm + x; if (!(j > nm)) { Lab[x] = 0.f; Lak[x] = 0.f; } if (!(j >= nm)) { Mrb[x] = 0.f; Mrk[x] = 0.f; } } }
#pragma unroll
            for (int x = 0; x < 4; ++x) { const int j = 4 * g + x; LAB[j * 16 + n16] = Lab[x]; sth((LAS bf16_t*)(sl + O_LAK) + j * (SB / 2) + n16, Lak[x]); sth((LAS bf16_t*)(sl + O_MRK) + j * (SB / 2) + n16, Mrk[x]); sth((LAS bf16_t*)(sl + O_MRB) + j * (SB / 2) + n16, Mrb[x]); }
            LDS_WAIT();
            { float t[16]; int nl = n16; asm volatile("" : "+v"(nl));
#pragma unroll
              for (int j = 0; j < 16; ++j) { const f32x4 r0 = *(const LAS f32x4*)(LAB + j * 16), r1 = *(const LAS f32x4*)(LAB + j * 16 + 4), r2 = *(const LAS f32x4*)(LAB + j * 16 + 8), r3 = *(const LAS f32x4*)(LAB + j * 16 + 12);
                  const float row[16] = {r0[0], r0[1], r0[2], r0[3], r1[0], r1[1], r1[2], r1[3], r2[0], r2[1], r2[2], r2[3], r3[0], r3[1], r3[2], r3[3]};
                  float acc = (j == nl) ? 1.f : 0.f;
#pragma unroll
                  for (int i = 0; i < 16; ++i) if (i < j) acc -= row[i] * t[i];
                  t[j] = acc; asm volatile("" ::: "memory"); }
              if (g == 0) {
#pragma unroll
                  for (int j = 0; j < 16; ++j) sth((LAS bf16_t*)(sl + O_TT) + j * (SB / 2) + n16, t[j]); } }
            if (c + 16 < NC) CK_LOAD(c + 16);
            const int gi = c >> 2;
            if (gi >= RG) spin_ge(done, (unsigned)(gi - RG + 1), lane, tmo);
            LDS_WAIT();
            unsigned char* dst = ring + (size_t)((gi % RG) * 4 + (c & 3)) * RSLOT;
            if (cox) {
#pragma unroll
                for (int i = 0; i < RSLOT / 1024; ++i) *(u32x4*)(dst + (i * 64 + lane) * 16) = *(const LAS u32x4*)(sl + (i * 64 + lane) * 16);
            } else {
#pragma unroll
                for (int i = 0; i < RSLOT / 1024; ++i) store_wt(dst + (i * 64 + lane) * 16, *(const LAS u32x4*)(sl + (i * 64 + lane) * 16));
            }
            VM_WAIT();
            if (lane == 0) (void)__hip_atomic_fetch_add(ready + gi, 1u, __ATOMIC_RELAXED, __HIP_MEMORY_SCOPE_AGENT);
            }
        }
#undef CK_LOAD
    } else {
        if (wave < 4) {
            const int c = wave;
            const f32x4 z4 = {0.f, 0.f, 0.f, 0.f};
            f32x4 S32[4]; S32[0] = S32[1] = S32[2] = S32[3] = z4;
            __syncthreads(); __syncthreads();
            for (int gi = 0; gi < NG; ++gi) {
                int n16q_ = n16, gq_ = g; asm volatile("" : "+v"(n16q_), "+v"(gq_));
                { const int n16 = n16q_, g = gq_;
                const LAS unsigned char* fa0 = lds + (gi & 1) * GB_SZ + n16 * SA;
                const LAS unsigned char* far[4] = {fa0 + ((0 + g) ^ n16) * 8, fa0 + ((4 + g) ^ n16) * 8, fa0 + ((8 + g) ^ n16) * 8, fa0 + ((12 + g) ^ n16) * 8};
                const LAS unsigned char* fb = lds + (gi & 1) * GB_SZ + n16 * SB + 8 * g;
                const LAS unsigned char* fg = lds + (gi & 1) * GB_SZ + O_G15 + 16 * g;
                const LAS unsigned char* fv = lds + VT_OFF + (gi & 1) * 4 * VT_SZ + (16 * c + n16) * SB + 8 * g;
                bf16_t* yp = P.PROJw + (rb + gi * 64 + 4 * g) * NP + C_Y + h * 64 + c * 16 + n16;
#pragma unroll
                for (int pc = 0; pc < 4; ++pc) {
                    const LAS unsigned char* b_ = fb + pc * RSLOT; const LAS unsigned char* g_ = fg + pc * RSLOT;
                    const u32x2 Vh = *(const LAS u32x2*)(fv + pc * VT_SZ);
                    u32x2 sB[4];
#pragma unroll
                    for (int rt = 0; rt < 4; ++rt) sB[rt] = pack4(S32[rt]);
                    f32x4 Ub = mf16(*(const LAS u32x2*)(b_ + O_LAK), Vh, z4);
#pragma unroll
                    for (int rt = 0; rt < 4; ++rt) Ub = mf16(*(const LAS u32x2*)(far[rt] + pc * RSLOT + O_AF), sB[rt], Ub);
                    f32x4 U = mf16(*(const LAS u32x2*)(b_ + O_TT), pack4(Ub), z4); U = -U;
                    const u32x2 Uh = pack4(U);
                    f32x4 Y = mf16(*(const LAS u32x2*)(b_ + O_MRK), Vh, z4);
#pragma unroll
                    for (int rt = 0; rt < 4; ++rt) Y = mf16(*(const LAS u32x2*)(far[rt] + pc * RSLOT + O_PF), sB[rt], Y);
                    Y = mf16(*(const LAS u32x2*)(b_ + O_MRB), Uh, Y);
#pragma unroll
                    for (int x = 0; x < 4; ++x) yp[(size_t)(pc * 16 + x) * NP] = (bf16_t)(pkbf(Y[x], 0.f) & 0xffffu);
#pragma unroll
                    for (int rt = 0; rt < 4; ++rt)
                        S32[rt] = mf16(*(const LAS u32x2*)(b_ + O_B2T + 16 * rt * SB), Uh, mf16(*(const LAS u32x2*)(b_ + O_K2T + 16 * rt * SB), Vh, S32[rt] * *(const LAS f32x4*)(g_ + 64 * rt)));
                }
                }
                __syncthreads();
            }
        } else {
            if (wave < 7) {
                const int lt = tid - 256;
                unsigned long long LR[2][32];
                u32x4 LV2[2][4]; const int vtok = (lt >> 1) & 63, vhalf = lt & 1;
#define LD_GROUP(st_, gj) do { unsigned char* sg = ring + (size_t)(((gj) % RG) * 4) * RSLOT + lt * 16; \
                _Pragma("unroll") for (int i = 0; i < 16; ++i) { LR[st_][2 * i] = __hip_atomic_load((unsigned long long*)(sg + i * 3072), __ATOMIC_RELAXED, __HIP_MEMORY_SCOPE_AGENT);       \
                    LR[st_][2 * i + 1] = __hip_atomic_load((unsigned long long*)(sg + i * 3072 + 8), __ATOMIC_RELAXED, __HIP_MEMORY_SCOPE_AGENT); } \
                if (lt < 128) { const bf16_t* vp = P.VF + (rb + (gj) * 64 + vtok) * 512 + h * 64 + vhalf * 32; _Pragma("unroll") for (int i = 0; i < 4; ++i) LV2[st_][i] = *(const u32x4*)(vp + 8 * i); } } while (0)
#define ST_GROUP(st_, gj) do { LAS unsigned char* db = lds + ((gj) & 1) * GB_SZ + lt * 16; \
                _Pragma("unroll") for (int i = 0; i < 16; ++i) { const unsigned long long a_ = LR[st_][2 * i], b_ = LR[st_][2 * i + 1]; \
                    *(LAS u32x4*)(db + i * 3072) = (u32x4){(unsigned)a_, (unsigned)(a_ >> 32), (unsigned)b_, (unsigned)(b_ >> 32)}; } \
                if (lt < 128) { LAS bf16_t* vt = (LAS bf16_t*)(lds + VT_OFF + (((gj) & 1) * 4 + (vtok >> 4)) * VT_SZ) + (vhalf * 32) * (SB / 2) + (vtok & 15); \
                    _Pragma("unroll") for (int i = 0; i < 4; ++i) { _Pragma("unroll") for (int e = 0; e < 8; ++e) { const unsigned w_ = LV2[st_][i][e >> 1]; \
                        vt[(8 * i + e) * (SB / 2)] = (bf16_t)((e & 1) ? (w_ >> 16) : (w_ & 0xffffu)); } } } } while (0)
                __syncthreads();
                LD_GROUP(0, 0); ST_GROUP(0, 0); LD_GROUP(1, 1); LD_GROUP(0, 2);
                __syncthreads();
                for (int gi = 0; gi < NG; gi += 2) {
                    ST_GROUP(1, gi + 1); if (gi + 3 < NG) LD_GROUP(1, gi + 3);
                    __syncthreads();
                    if (gi + 2 < NG) ST_GROUP(0, gi + 2); if (gi + 4 < NG) LD_GROUP(0, gi + 4);
                    __syncthreads();
                }
#undef LD_GROUP
#undef ST_GROUP
            } else {
                bool cox; COXCD(cox);
                spin_ge(ready + 0, 4u, lane, tmo); spin_ge(ready + 1, 4u, lane, tmo); spin_ge(ready + 2, 4u, lane, tmo); spin_ge(ready + 3, 4u, lane, tmo);
                if (!cox) { __builtin_amdgcn_fence(__ATOMIC_ACQUIRE, "agent"); VM_WAIT(); }
                unsigned pv = __hip_atomic_load(ready + 4, __ATOMIC_RELAXED, __HIP_MEMORY_SCOPE_AGENT);
                __syncthreads();
                __syncthreads();
                for (int gi = 0; gi < NG; ++gi) {
                    if (gi + 4 < NG) { if ((unsigned)__builtin_amdgcn_readfirstlane(pv) < 4u) spin_ge(ready + gi + 4, 4u, lane, tmo);
                        if (!cox) { __builtin_amdgcn_fence(__ATOMIC_ACQUIRE, "agent"); VM_WAIT(); } }
                    if (gi + 5 < NG) pv = __hip_atomic_load(ready + gi + 5, __ATOMIC_RELAXED, __HIP_MEMORY_SCOPE_AGENT);
                    __syncthreads();
                    if (lane == 0) __hip_atomic_store(done, (unsigned)min(gi + 2, NG), __ATOMIC_RELAXED, __HIP_MEMORY_SCOPE_AGENT);
                }
            }
        }
    }
#undef COXCD
    __syncthreads();
}

__device__ __forceinline__ void ph_scan_naive(const ScanP& P, int gw, int NGW, int lane) {
    for (int task = gw; task < 4096; task += NGW) { const int b = task >> 9, h = (task >> 6) & 7, row = task & 63; const int ch = h * 64 + lane;
        const float mur = P.mu_r[ch], muk = P.mu_k[ch], kkp = P.k_k[ch], kap = P.k_a[ch], rkp = P.r_k[ch];
        float S = 0.f, rprev = 0.f, kprev = 0.f;
        for (int t = 0; t < T; ++t) { const size_t m = (size_t)b * 4096 + t;
            const float rc = bf1(P.PROJ[m * NP + C_R + ch]), kc = bf1(P.PROJ[m * NP + C_K + ch]);
            const float r = rc + (rprev - rc) * mur, kl = kc + (kprev - kc) * muk; rprev = rc; kprev = kc;
            const float a = pg8::sigmoidf_((float)P.A[m * 512 + ch]); const float dec = __expf(-0.60653065971f * pg8::sigmoidf_((float)P.E[m * 512 + ch]));
            const float kkv = kl * kkp; const float ss = wave_sum(kkv * kkv); const float kk = kkv / fmaxf(sqrtf(ss), 1e-12f);
            const float kp = kl * (1.f + (a - 1.f) * kap); const float v = bf1(P.VF[m * 512 + h * 64 + row]);
            const float sk = wave_sum(S * kk); S = S * dec - sk * kk * a + v * kp; const float y = wave_sum(S * r);
            if (lane == 0) P.PROJw[m * NP + C_Y + h * 64 + row] = (bf16_t)(pkbf(y, 0.f) & 0xffffu);
            if (row == 0) { const float rk = wave_sum(r * kp * rkp); if (lane == 0) P.PROJw[m * NP + C_RK + h] = (bf16_t)(pkbf(rk, 0.f) & 0xffffu); } } }
}

__device__ __forceinline__ void ph_rwkv_post(const bf16_t* PROJ, const bf16_t* VF, bf16_t* MIX, const float* lnx_g, const float* lnx_b, int gw, int NGW, int lane) {
    float lg[8], lb[8];
#pragma unroll
    for (int i = 0; i < 8; ++i) { lg[i] = lnx_g[lane * 8 + i]; lb[i] = lnx_b[lane * 8 + i]; }
    for (int m = gw; m < M; m += NGW) {
        const u32x4 y8 = *(const u32x4*)(PROJ + (size_t)m * NP + C_Y + lane * 8), v8 = *(const u32x4*)(VF + (size_t)m * 512 + lane * 8), g8 = *(const u32x4*)(MIX + (size_t)m * D + lane * 8);
        const float rk = bf1(PROJ[(size_t)m * NP + C_RK + (lane >> 3)]);
        float y[8]; float s = 0.f;
#pragma unroll
        for (int i = 0; i < 4; ++i) { y[2 * i] = bfl(y8[i]); y[2 * i + 1] = bfh(y8[i]); s += y[2 * i] + y[2 * i + 1]; }
        const float mean = allsum8(s) * (1.f / 64.f); float q = 0.f;
#pragma unroll
        for (int i = 0; i < 8; ++i) { y[i] -= mean; q += y[i] * y[i]; }
        const float rstd = rsqrtf(allsum8(q) * (1.f / 64.f) + 64e-5f);
        float o[8];
#pragma unroll
        for (int i = 0; i < 8; ++i) { const float vv = (i & 1) ? bfh(v8[i >> 1]) : bfl(v8[i >> 1]), gg = (i & 1) ? bfh(g8[i >> 1]) : bfl(g8[i >> 1]);
            o[i] = (y[i] * rstd * lg[i] + lb[i] + rk * vv) * gg; }
        u32x4 w; w.x = pkbf(o[0], o[1]); w.y = pkbf(o[2], o[3]); w.z = pkbf(o[4], o[5]); w.w = pkbf(o[6], o[7]);
        *(u32x4*)(MIX + (size_t)m * D + lane * 8) = w;
    }
}

#ifndef MK_PER_PHASE
#define MK_PER_PHASE 0
#endif
constexpr int N_PHASES = 22;
struct Args { const float* in[32]; float* out; unsigned char* ws; int ph_lo, ph_hi, li, pad; };
__device__ __forceinline__ int opq(int k) { asm volatile("" : "+s"(k)); return k; }
#define INP(k) ((const float*)(const GAS float*)args.in[opq(k)])
#define WSP(T_, off) ((T_*)(wsl + (off)))
#define LAUNDER_WS() GAS unsigned char* wsl = (GAS unsigned char*)args.ws; asm volatile("" : "+s"(wsl)); GAS float* Xg = (GAS float*)Xp_; asm volatile("" : "+s"(Xg)); float* X = (float*)Xg; (void)X; int wave = wave_s; asm volatile("" : "+s"(wave)); \
    unsigned ones_ = ~0u; asm volatile("" : "+s"(ones_)); int tid = wave * 64 + (int)__builtin_amdgcn_mbcnt_hi(ones_, __builtin_amdgcn_mbcnt_lo(ones_, 0u)); asm volatile("" : "+v"(tid)); int G = gridDim.x, bx = blockIdx.x; asm volatile("" : "+s"(G), "+s"(bx)); \
    const int lane = tid & 63; const int vcu = (G % 8 == 0) ? (bx % 8) * (G / 8) + bx / 8 : bx; const int gw = vcu * NWAVES + wave, NGW = G * NWAVES; (void)lane; (void)gw; (void)NGW; (void)vcu
#ifndef PH_MASK
#define PH_MASK 0xFFFFu
#endif
#define PHBIT(k) ((k) == 0 ? 0 : ((k) == 21 ? 11 : (((k) - 1) % 10) + 1))
#define IN(k) (((PH_MASK >> PHBIT(k)) & 1u) && lo <= (k) && (k) < hi)
#ifndef DUP_MASK
#define DUP_MASK 0
#endif
#define DUPN(j) for (int rep_ = 0; rep_ < (int)((DUP_MASK >> (j)) & 1) + 1; ++rep_)
#define SEAM(k) do { if (IN(k) && IN((k) + 1)) { XcdBarrier b2_ = bar; asm volatile("" : "+s"(b2_.bar), "+s"(b2_.x)); xcd_barrier(b2_); } } while (0)
template <int l> __device__ __forceinline__ void layer_body(const Args& args, LAS unsigned char* lds, const XcdBarrier& bar, float* Xp_, const int lo, const int hi, const int wave_s) {
        const int pb = 1 + 10 * l;
        if (IN(pb + 0)) DUPN(0) { LAUNDER_WS();
            WPtrs P; P.w_in = INP(6); P.decay_a = INP(10); P.iclr_a = INP(13); P.gate_a = INP(15); P.vres_a = INP(24); P.mu_lora = INP(8); P.vres_mu = INP(22);
            P.w_out = INP(28); P.w1 = INP(29); P.w2 = INP(30); P.decay_b = INP(11); P.iclr_b = INP(14); P.gate_b = INP(16); P.vres_b = INP(25);
            if (l != 0) ph_weights(P, l, (unsigned char*)wsl, lds, vcu, G, tid);
            const float* MODl = WSP(float, WS_MOD) + (size_t)l * 8 * 6144;
            ph_norm((l == 0) ? INP(0) : (const float*)X, INP(4) + (size_t)l * D, MODl + 0 * D, MODl + 1 * D, WSP(bf16_t, WS_H), gw, NGW, lane);
        }
        SEAM(pb + 0);
        if (IN(pb + 1)) DUPN(1) { LAUNDER_WS();
            pg8::Gemm g{WSP(bf16_t, WS_H), WSP(bf16_t, WS_WIN), M, NP, D, D, D}; pg8::StaticOrder S; S.init(M, NP, G, bx);
            pg8::EpiBf<0> E{WSP(bf16_t, WS_PROJ), NP, C_QA / 256, C_KA / 256, att::C2};
            pg8::gemm_phase<pg8::EpiBf<0>, pg8::StaticOrder, true, true>(lds, g, S, E, tid);
        }
        SEAM(pb + 1);
        if (IN(pb + 2)) DUPN(2) { LAUNDER_WS();
            for (int rep_l = 0; rep_l < (int)((DUP_MASK >> 12) & 1) + 1; ++rep_l)
            ph_lora_act(WSP(bf16_t, WS_PROJ), WSP(bf16_t, WS_LACT), WSP(bf16_t, WS_VF), INP(7) + (size_t)(l * 3 + 2) * 512, l == 0, gw, NGW, lane);
            ph_select(WSP(bf16_t, WS_PROJ), WSP(unsigned long long, WS_MASK), lds, vcu, G, tid);
        }
        SEAM(pb + 2);
        if (IN(pb + 3)) {
            DUPN(3) { LAUNDER_WS(); pg8::Gemm g{WSP(bf16_t, WS_LACT), WSP(bf16_t, WS_LW), M, 1024, 128, LA, 128}; pg8::StaticOrder S; S.init(M, 1024, G, bx);
              pg8::EpiDecIclr E{WSP(_Float16, WS_H), WSP(_Float16, WS_H + 32 * MiB), INP(9) + (size_t)l * 512, INP(12) + (size_t)l * 512};
              pg8::gemm_phase<pg8::EpiDecIclr, pg8::StaticOrder, true, true>(lds, g, S, E, tid); }
            __syncthreads();
            DUPN(3) { LAUNDER_WS(); pg8::Gemm g{WSP(bf16_t, WS_LACT) + 128, WSP(bf16_t, WS_LW) + 1024 * 128, M, 512, 128, LA, 128}; pg8::StaticOrder S; S.init(M, 512, G, bx);
              pg8::EpiBf<0> E{WSP(bf16_t, WS_MIX), D, 0, 0, 1.f};
              pg8::gemm_phase<pg8::EpiBf<0>, pg8::StaticOrder, true, true>(lds, g, S, E, tid); }
            __syncthreads();
            if (l >= 1) { LAUNDER_WS(); pg8::Gemm g{WSP(bf16_t, WS_LACT) + 256, WSP(bf16_t, WS_LW) + 1536 * 128, M, 512, 128, LA, 128}; pg8::StaticOrder S; S.init(M, 512, G, bx);
              pg8::EpiVres E{WSP(bf16_t, WS_PROJ) + C_V, NP, WSP(bf16_t, WS_VF), INP(23) + (size_t)(l - 1) * 512, INP(7) + (size_t)(l * 3 + 2) * 512};
              pg8::gemm_phase<pg8::EpiVres, pg8::StaticOrder, true, true>(lds, g, S, E, tid); }
        }
        SEAM(pb + 3);
        if (IN(pb + 4)) {
            DUPN(4) { LAUNDER_WS();
              ScanP P; P.PROJ = WSP(bf16_t, WS_PROJ); P.PROJw = WSP(bf16_t, WS_PROJ); P.E = WSP(_Float16, WS_H); P.A = WSP(_Float16, WS_H + 32 * MiB); P.VF = WSP(bf16_t, WS_VF);
              P.mu_r = INP(7) + (size_t)(l * 3 + 0) * 512; P.mu_k = INP(7) + (size_t)(l * 3 + 1) * 512;
              P.k_k = INP(17) + (size_t)l * 512; P.k_a = INP(18) + (size_t)l * 512; P.r_k = INP(19) + (size_t)l * 512;
#if defined(SCAN_SHARE)
              if (G == 256) scan_unit_share(P, vcu >> 5, (vcu >> 2) & 7, vcu & 3, lds, tid, WSP(unsigned char, WS_LACT), WSP(unsigned, WS_CTL) + sck2::CW_SCAN + l * sck2::CW_SCAN_LAYER, bar.x);
              else for (int u = vcu; u < 256; u += G) scan_unit_chunk(P, u >> 5, (u >> 2) & 7, u & 3, lds, tid); }
#elif defined(SCAN_CHUNK)
              for (int u = vcu; u < 256; u += G) scan_unit_chunk(P, u >> 5, (u >> 2) & 7, u & 3, lds, tid); }
#elif defined(SCAN_FAST)
              for (int u = vcu; u < 256; u += G) scan_unit(P, u >> 5, (u >> 2) & 7, u & 3, lds, tid); }
#else
              ph_scan_naive(P, gw, NGW, lane); }
#endif
            __syncthreads();
            DUPN(11) { LAUNDER_WS();
              att::build_bias_table(INP(27), (LAS char*)lds, tid);
              __syncthreads();
              const float* gain = INP(26) + (size_t)l * 512;
#if defined(SCAN_SHARE)
              if (G == 256) {
                  const int bh = vcu >> 2, role = vcu & 3;
                  const unsigned long long lst = (role == 3) ? 0x1DEFull : (role == 0) ? 0x4BCull : (role == 1) ? 0x89Aull : 0x023567ull;
                  const int cnt = (role == 3) ? 4 : (role == 2) ? 6 : 3;
                  for (int i = cnt - 1; i >= 0; --i) { const int qb = (int)((lst >> (4 * i)) & 15ull);
                      att::attn_unit(bh >> 3, bh & 7, qb, WSP(bf16_t, WS_PROJ), WSP(unsigned long long, WS_MASK), WSP(bf16_t, WS_MIX), gain, (LAS char*)lds, tid); }
              } else
#endif
              for (int v = vcu; v < 256; v += G) { const int bh = v >> 2, s = v & 3;
                  for (int i = 0; i < 4; ++i) { const int qb = (i == 0) ? s : (i == 1) ? 7 - s : (i == 2) ? 8 + s : 15 - s;
                      att::attn_unit(bh >> 3, bh & 7, qb, WSP(bf16_t, WS_PROJ), WSP(unsigned long long, WS_MASK), WSP(bf16_t, WS_MIX), gain, (LAS char*)lds, tid); } } }
        }
        SEAM(pb + 4);
        if (IN(pb + 5)) { LAUNDER_WS(); ph_rwkv_post(WSP(bf16_t, WS_PROJ), WSP(bf16_t, WS_VF), WSP(bf16_t, WS_MIX), INP(20) + (size_t)l * 512, INP(21) + (size_t)l * 512, gw, NGW, lane); }
        SEAM(pb + 5);
        if (IN(pb + 6)) { LAUNDER_WS();
            pg8::Gemm g{WSP(bf16_t, WS_MIX), WSP(bf16_t, WS_WOUT), M, D, D, D, D}; pg8::StaticOrder S; S.init(M, D, G, bx);
            pg8::EpiResid E{(l == 0) ? INP(0) : (const float*)X, X, WSP(float, WS_MOD) + (size_t)l * 8 * 6144 + 2 * D, D};
            pg8::gemm_phase<pg8::EpiResid, pg8::StaticOrder, true, true>(lds, g, S, E, tid);
        }
        SEAM(pb + 6);
        if (IN(pb + 7)) DUPN(7) { LAUNDER_WS(); const float* MODl = WSP(float, WS_MOD) + (size_t)l * 8 * 6144;
            ph_norm(X, INP(5) + (size_t)l * D, MODl + 3 * D, MODl + 4 * D, WSP(bf16_t, WS_H), gw, NGW, lane); }
        SEAM(pb + 7);
        if (IN(pb + 8)) DUPN(8) { LAUNDER_WS();
            pg8::Gemm g{WSP(bf16_t, WS_H), WSP(bf16_t, WS_W1), M, FF, D, D, D}; pg8::StaticOrder S; S.init(M, FF, G, bx);
            pg8::EpiBf<1> E{WSP(bf16_t, WS_PROJ), FF, 0, 0, 1.f};
            pg8::gemm_phase<pg8::EpiBf<1>, pg8::StaticOrder, true, true>(lds, g, S, E, tid);
        }
        SEAM(pb + 8);
        if (IN(pb + 9)) { LAUNDER_WS();
            pg8::Gemm g{WSP(bf16_t, WS_PROJ), WSP(bf16_t, WS_W2), M, D, FF, FF, FF}; pg8::StaticOrder S; S.init(M, D, G, bx);
            pg8::EpiResid E{X, X, WSP(float, WS_MOD) + (size_t)l * 8 * 6144 + 5 * D, D};
            pg8::gemm_phase<pg8::EpiResid, pg8::StaticOrder, true, true>(lds, g, S, E, tid);
        }
        SEAM(pb + 9);
}
__global__ void __launch_bounds__(NWAVES * 64, 2) trunk_fwd(Args args) {
    extern __shared__ __attribute__((aligned(16))) unsigned char lds_raw[];
    LAS unsigned char* lds = (LAS unsigned char*)lds_raw;
    volatile LAS unsigned* MISC = (volatile LAS unsigned*)(lds + MISC_OFF);
    unsigned* ctl = (unsigned*)(args.ws + WS_CTL);
    for (int u = threadIdx.x; u < (LDS_BYTES - LDSCTL_OFF) / 4; u += NWAVES * 64) ((LAS unsigned*)(lds + LDSCTL_OFF))[u] = 0u;
    __syncthreads();
    XcdBarrier bar = xcd_barrier_post(ctl + CW_BAR + args.li * XCD_BAR_WORDS, MISC + 8);
    const int lo = args.ph_lo, hi = args.ph_hi; const int wave_s = __builtin_amdgcn_readfirstlane((int)threadIdx.x >> 6);
    float* Xp_ = args.out;

    if (IN(0)) { LAUNDER_WS(); ph_mod(INP(1), INP(2), INP(3), WSP(float, WS_MOD), lds, vcu, G, tid);
        WPtrs P; P.w_in = INP(6); P.decay_a = INP(10); P.iclr_a = INP(13); P.gate_a = INP(15); P.vres_a = INP(24); P.mu_lora = INP(8); P.vres_mu = INP(22);
        P.w_out = INP(28); P.w1 = INP(29); P.w2 = INP(30); P.decay_b = INP(11); P.iclr_b = INP(14); P.gate_b = INP(16); P.vres_b = INP(25);
        __syncthreads();
        ph_weights(P, 0, (unsigned char*)wsl, lds, vcu, G, tid); }
    SEAM(0);

    layer_body<0>(args, lds, bar, Xp_, lo, hi, wave_s);
    layer_body<1>(args, lds, bar, Xp_, lo, hi, wave_s);
    if (IN(21)) { LAUNDER_WS(); (void)wsl; ph_final_norm(X, INP(31), gw, NGW, lane); }
#undef IN
#undef SEAM
}

extern "C" void kernel_launch(void* const* d_in, const int* in_sizes, int n_in, void* d_out, int out_size, void* d_ws, size_t ws_size, hipStream_t stream) {
    static int grid = 0;
    if (grid == 0) {
        if (n_in != 32 || in_sizes[0] != M * D || out_size != M * D || ws_size < WS_END) { fprintf(stderr, "kernel_launch: unexpected problem: n_in %d in0 %d out %d ws %zu (need %zu)\n", n_in, n_in > 0 ? in_sizes[0] : -1, out_size, ws_size, (size_t)WS_END); grid = -1; return; }
        int dev = 0, cus = 0, per_cu = 0;
        if (hipGetDevice(&dev) != hipSuccess || hipDeviceGetAttribute(&cus, hipDeviceAttributeMultiprocessorCount, dev) != hipSuccess) { grid = -1; return; }
        if (hipFuncSetAttribute((const void*)trunk_fwd, hipFuncAttributeMaxDynamicSharedMemorySize, LDS_BYTES) != hipSuccess) { fprintf(stderr, "kernel_launch: hipFuncSetAttribute failed\n"); grid = -1; return; }
        if (hipOccupancyMaxActiveBlocksPerMultiprocessor(&per_cu, (const void*)trunk_fwd, NWAVES * 64, LDS_BYTES) != hipSuccess || per_cu < 1) { fprintf(stderr, "kernel_launch: occupancy query reports %d workgroups per CU\n", per_cu); }
        (void)hipGetLastError();
        grid = cus;
        if (grid > 256) grid = 256;
    }
    if (grid < 0) return;
    if (hipMemsetAsync((char*)d_ws + WS_CTL, 0, CTL_ZERO_BYTES, stream) != hipSuccess) return;
    Args a{};
    for (int i = 0; i < 32; ++i) a.in[i] = (const float*)d_in[i];
    a.out = (float*)d_out; a.ws = (unsigned char*)d_ws; a.pad = 0;
#if MK_PER_PHASE
    for (int p = 0; p < N_PHASES; ++p) { a.ph_lo = p; a.ph_hi = p + 1; a.li = 0;
        hipLaunchKernelGGL(trunk_fwd, dim3(grid), dim3(NWAVES * 64), LDS_BYTES, stream, a); }
#else
    a.ph_lo = 0; a.ph_hi = N_PHASES; a.li = 0;
    hipLaunchKernelGGL(trunk_fwd, dim3(grid), dim3(NWAVES * 64), LDS_BYTES, stream, a);
#endif
}
```
